# Optimizing an MI355X kernel written in HIP

```python
import math
import jax, jax.numpy as jnp
from jax import lax
import numpy as np

D_MODEL = 2048
BATCH = 1
SEQ = 8192
DEPTH = 1
DEC_BATCH = 32
DEC_SEQ = 16
PAST_LEN = 1024

CHUNK = 64
MIX_HALF = D_MODEL // 2
DIFF_QK_DIM = 64
DIFF_V_DIM = 2 * DIFF_QK_DIM
DIFF_HEADS = MIX_HALF // DIFF_V_DIM
ROT_DIM = DIFF_QK_DIM // 4
ROPE_THETA = 500000.0
MLSTM_HEADS = 4
MLSTM_HEAD_DIM = MIX_HALF // MLSTM_HEADS
M_WIDTH = MLSTM_HEADS * MLSTM_HEAD_DIM
A_QK = DIFF_HEADS * 2 * DIFF_QK_DIM
A_V = DIFF_HEADS * DIFF_V_DIM
MIX_WIDTH = A_V + M_WIDTH
IN_WIDTH = 2 * A_QK + A_V + 2 * M_WIDTH + 2 * M_WIDTH + 2 * MLSTM_HEADS
CONV_W = 4
D_FF = 4 * D_MODEL
Q_BLOCK = 128
EPS = 1e-6

kernel_name = 'hybrid_diffattn_mlstm_stream_step'


def _rmsnorm(x, g):
    xf = x.astype(jnp.float32)
    y = xf * lax.rsqrt(jnp.mean(xf * xf, axis=-1, keepdims=True) + EPS)
    return (y * g.astype(jnp.float32)).astype(x.dtype)


def _rope(x, pos):
    half = ROT_DIM // 2
    inv_freq = ROPE_THETA ** (-jnp.arange(half, dtype=jnp.float32) * 2.0 / ROT_DIM)
    ang = pos.astype(jnp.float32)[:, None] * inv_freq[None, :]
    cos = jnp.cos(ang)[None, :, None, None, :]
    sin = jnp.sin(ang)[None, :, None, None, :]
    xf = x.astype(jnp.float32)
    x1 = xf[..., :half]
    x2 = xf[..., half:ROT_DIM]
    out = jnp.concatenate([x1 * cos - x2 * sin, x2 * cos + x1 * sin, xf[..., ROT_DIM:]], axis=-1)
    return out.astype(x.dtype)


def _diff_attn_core(q, q_pos, k, v, k_pos, lam):
    s = jnp.einsum('bqhmd,bkhmd->bhmqk', q.astype(jnp.float32), k.astype(jnp.float32)) * (DIFF_QK_DIM ** -0.5)
    mask = (k_pos[None, :] // CHUNK) <= (q_pos[:, None] // CHUNK)
    s = jnp.where(mask[None, None, None], s, -jnp.inf)
    p = jax.nn.softmax(s, axis=-1)
    a = p[:, :, 0] - lam * p[:, :, 1]
    return jnp.einsum('bhqk,bkhe->bqhe', a, v.astype(jnp.float32)).astype(v.dtype)


def _diff_attn(q, k, v, q_pos, k_pos, lam):
    B, S = q.shape[0], q.shape[1]
    if S > Q_BLOCK and S % Q_BLOCK == 0:
        nb = S // Q_BLOCK
        qb = jnp.moveaxis(q.reshape((B, nb, Q_BLOCK) + q.shape[2:]), 1, 0)
        pb = q_pos.reshape(nb, Q_BLOCK)
        out = lax.map(lambda a: _diff_attn_core(a[0], a[1], k, v, k_pos, lam), (qb, pb))
        return jnp.moveaxis(out, 0, 1).reshape(B, S, DIFF_HEADS, DIFF_V_DIM)
    return _diff_attn_core(q, q_pos, k, v, k_pos, lam)


def _mlstm_chunk(carry, xs):
    C, n, m = carry
    q, k, v, ig, lf = xs
    L = q.shape[1]
    b = jnp.cumsum(lf, axis=1)
    a = b + m[:, None, :]
    causal = jnp.tril(jnp.ones((L, L), dtype=bool))[None, :, :, None]
    dlog = jnp.where(causal, b[:, :, None, :] - b[:, None, :, :] + ig[:, None, :, :], -jnp.inf)
    m_t = jnp.maximum(a, jnp.max(dlog, axis=2))
    w_inter = jnp.exp(a - m_t)
    w_intra = jnp.exp(dlog - m_t[:, :, None, :])
    s = w_intra * jnp.einsum('bthd,bshd->btsh', q, k)
    num = w_inter[..., None] * jnp.einsum('bhed,bthd->bthe', C, q) + jnp.einsum('btsh,bshe->bthe', s, v)
    den = w_inter * jnp.einsum('bhd,bthd->bth', n, q) + jnp.sum(s, axis=2)
    h = num / jnp.maximum(jnp.abs(den), jnp.exp(-m_t))[..., None]
    m_new = m_t[:, -1]
    w_end = jnp.exp(b[:, -1:, :] - b + ig - m_new[:, None, :])
    decay = jnp.exp(a[:, -1] - m_new)
    C_new = decay[..., None, None] * C + jnp.einsum('bsh,bshe,bshd->bhed', w_end, v, k)
    n_new = decay[..., None] * n + jnp.einsum('bsh,bshd->bhd', w_end, k)
    return (C_new, n_new, m_new), h


def _mlstm(q, k, v, ig, lf, C0, n0, m0):
    B, S, H, Dh = q.shape
    f32 = jnp.float32
    carry = (C0.astype(f32), n0.astype(f32), m0.astype(f32))
    xs = (q.astype(f32), k.astype(f32), v.astype(f32), ig.astype(f32), lf.astype(f32))
    if S <= CHUNK:
        (C1, n1, m1), h = _mlstm_chunk(carry, xs)
        return h, C1, n1, m1
    nc = S // CHUNK
    xs_c = tuple(jnp.moveaxis(t.reshape((B, nc, CHUNK) + t.shape[2:]), 1, 0) for t in xs)
    (C1, n1, m1), h = lax.scan(_mlstm_chunk, carry, xs_c)
    h = jnp.moveaxis(h, 0, 1).reshape(B, S, H, Dh)
    return h, C1, n1, m1


def _layer(x, c, k_past, v_past, conv_st, C0, n0, m0, lam_init,
           w_ada, b_ada, g_attn, w_in, lam_q1, lam_k1, lam_q2, lam_k2, g_sub,
           w_conv, b_conv, b_i, b_f, g_m, w_out, g_ffn, w_up, w_down):
    B, S, _ = x.shape
    past = k_past.shape[1]
    dt = x.dtype
    f32 = jnp.float32
    mod = (jax.nn.silu(c.astype(f32)) @ w_ada.astype(f32) + b_ada.astype(f32)).astype(dt)
    sh_a, sc_a, g_a, sh_f, sc_f, g_f = jnp.split(mod, 6, axis=-1)
    h = _rmsnorm(x, g_attn) * (1 + sc_a[:, None]) + sh_a[:, None]
    proj = h @ w_in
    cuts = [int(i) for i in np.cumsum([A_QK, A_QK, A_V, 2 * M_WIDTH, M_WIDTH, M_WIDTH, MLSTM_HEADS])]
    qa, ka, va, qk_m, v_m, o_m, i_m, f_m = jnp.split(proj, cuts, axis=-1)

    q_pos = past + jnp.arange(S, dtype=jnp.int32)
    k_pos = jnp.arange(past + S, dtype=jnp.int32)
    qa = _rope(qa.reshape(B, S, DIFF_HEADS, 2, DIFF_QK_DIM), q_pos)
    ka = _rope(ka.reshape(B, S, DIFF_HEADS, 2, DIFF_QK_DIM), q_pos)
    va = va.reshape(B, S, DIFF_HEADS, DIFF_V_DIM)
    k_new = ka.reshape(B, S, DIFF_HEADS, 2 * DIFF_QK_DIM)
    k_all = jnp.concatenate([k_past.astype(dt), k_new], axis=1).reshape(B, past + S, DIFF_HEADS, 2, DIFF_QK_DIM)
    v_all = jnp.concatenate([v_past.astype(dt), va], axis=1)
    lam = (jnp.exp(jnp.sum(lam_q1.astype(f32) * lam_k1.astype(f32)))
           - jnp.exp(jnp.sum(lam_q2.astype(f32) * lam_k2.astype(f32))) + lam_init)
    att = _diff_attn(qa, k_all, v_all, q_pos, k_pos, lam)
    att = (_rmsnorm(att, g_sub) * (1.0 - lam_init)).reshape(B, S, A_V)

    conv_in = jnp.concatenate([conv_st.astype(dt), qk_m], axis=1)
    conv = sum(conv_in[:, j:j + S] * w_conv[j] for j in range(CONV_W)) + b_conv
    conv = jax.nn.silu(conv)
    conv_new = conv_in[:, S:]
    q_m = conv[..., :M_WIDTH].reshape(B, S, MLSTM_HEADS, MLSTM_HEAD_DIM)
    k_m = conv[..., M_WIDTH:].reshape(B, S, MLSTM_HEADS, MLSTM_HEAD_DIM) * (MLSTM_HEAD_DIM ** -0.5)
    v_m = v_m.reshape(B, S, MLSTM_HEADS, MLSTM_HEAD_DIM)
    ig = i_m.astype(f32) + b_i.astype(f32)
    lf = jax.nn.log_sigmoid(f_m.astype(f32) + b_f.astype(f32))
    hm, C1, n1, m1 = _mlstm(q_m, k_m, v_m, ig, lf, C0, n0, m0)
    hm = _rmsnorm(hm.astype(dt), g_m).reshape(B, S, M_WIDTH) * jax.nn.sigmoid(o_m)

    mix = jnp.concatenate([att, hm], axis=-1) @ w_out
    x = x + g_a[:, None] * mix
    h2 = _rmsnorm(x, g_ffn) * (1 + sc_f[:, None]) + sh_f[:, None]
    ff = jnp.square(jax.nn.relu(h2 @ w_up)) @ w_down
    x = x + g_f[:, None] * ff
    return x, k_new, va, conv_new, C1, n1, m1


def setup_inputs(seed: int = 0) -> dict:
    key = jax.random.key(seed)
    ks = jax.random.split(key, 32)
    f32 = jnp.float32

    def nrm(k, shape, s):
        return s * jax.random.normal(k, shape, f32)

    return {
        'x_prompt': nrm(ks[0], (BATCH, SEQ, D_MODEL), 1.0),
        'x_sample': nrm(ks[1], (DEC_BATCH, DEC_SEQ, D_MODEL), 1.0),
        'cache_k': nrm(ks[2], (DEPTH, DEC_BATCH, PAST_LEN, DIFF_HEADS, 2 * DIFF_QK_DIM), 1.0),
        'cache_v': nrm(ks[3], (DEPTH, DEC_BATCH, PAST_LEN, DIFF_HEADS, DIFF_V_DIM), 1.0),
        'state_conv': nrm(ks[4], (DEPTH, DEC_BATCH, CONV_W - 1, 2 * M_WIDTH), 1.0),
        'state_C': nrm(ks[5], (DEPTH, DEC_BATCH, MLSTM_HEADS, MLSTM_HEAD_DIM, MLSTM_HEAD_DIM), 0.1),
        'state_n': nrm(ks[6], (DEPTH, DEC_BATCH, MLSTM_HEADS, MLSTM_HEAD_DIM), 0.1),
        'state_m': nrm(ks[7], (DEPTH, DEC_BATCH, MLSTM_HEADS), 1.0),
        'c_prompt': nrm(ks[8], (BATCH, D_MODEL), 1.0),
        'c_sample': nrm(ks[9], (DEC_BATCH, D_MODEL), 1.0),
        'w_ada': nrm(ks[10], (DEPTH, D_MODEL, 6 * D_MODEL), 0.5 * D_MODEL ** -0.5),
        'b_ada': nrm(ks[11], (DEPTH, 6 * D_MODEL), 0.02),
        'g_attn': 1.0 + nrm(ks[12], (DEPTH, D_MODEL), 0.02),
        'w_in': nrm(ks[13], (DEPTH, D_MODEL, IN_WIDTH), D_MODEL ** -0.5),
        'lam_q1': nrm(ks[14], (DEPTH, DIFF_QK_DIM), 0.1),
        'lam_k1': nrm(ks[15], (DEPTH, DIFF_QK_DIM), 0.1),
        'lam_q2': nrm(ks[16], (DEPTH, DIFF_QK_DIM), 0.1),
        'lam_k2': nrm(ks[17], (DEPTH, DIFF_QK_DIM), 0.1),
        'g_sub': 1.0 + nrm(ks[18], (DEPTH, DIFF_HEADS, DIFF_V_DIM), 0.02),
        'w_conv': nrm(ks[19], (DEPTH, CONV_W, 2 * M_WIDTH), CONV_W ** -0.5),
        'b_conv': nrm(ks[20], (DEPTH, 2 * M_WIDTH), 0.02),
        'b_i': nrm(ks[21], (DEPTH, MLSTM_HEADS), 0.1),
        'b_f': 3.0 + 3.0 * jax.random.uniform(ks[22], (DEPTH, MLSTM_HEADS), f32),
        'g_m': 1.0 + nrm(ks[23], (DEPTH, MLSTM_HEADS, MLSTM_HEAD_DIM), 0.02),
        'w_out': nrm(ks[24], (DEPTH, MIX_WIDTH, D_MODEL), MIX_WIDTH ** -0.5),
        'g_ffn': 1.0 + nrm(ks[25], (DEPTH, D_MODEL), 0.02),
        'w_up': nrm(ks[26], (DEPTH, D_MODEL, D_FF), D_MODEL ** -0.5),
        'w_down': nrm(ks[27], (DEPTH, D_FF, D_MODEL), D_FF ** -0.5),
        'g_final': 1.0 + nrm(ks[28], (D_MODEL,), 0.02),
    }


def reference(x_prompt, x_sample, cache_k, cache_v, state_conv, state_C, state_n, state_m,
              c_prompt, c_sample, w_ada, b_ada, g_attn, w_in, lam_q1, lam_k1, lam_q2, lam_k2,
              g_sub, w_conv, b_conv, b_i, b_f, g_m, w_out, g_ffn, w_up, w_down, g_final):
    B = x_prompt.shape[0]
    dt = x_prompt.dtype
    f32 = jnp.float32
    xp, xs = x_prompt, x_sample
    kp_l, vp_l, cvp_l, Cp_l, np_l, mp_l = [], [], [], [], [], []
    ks_l, vs_l, cvs_l, Cs_l, ns_l, ms_l = [], [], [], [], [], []
    for l in range(DEPTH):
        lam_init = 0.8 - 0.6 * math.exp(-0.3 * l)
        lw = (w_ada[l], b_ada[l], g_attn[l], w_in[l], lam_q1[l], lam_k1[l], lam_q2[l], lam_k2[l],
              g_sub[l], w_conv[l], b_conv[l], b_i[l], b_f[l], g_m[l], w_out[l], g_ffn[l], w_up[l], w_down[l])
        zk = jnp.zeros((B, 0, DIFF_HEADS, 2 * DIFF_QK_DIM), dt)
        zv = jnp.zeros((B, 0, DIFF_HEADS, DIFF_V_DIM), dt)
        zconv = jnp.zeros((B, CONV_W - 1, 2 * M_WIDTH), dt)
        zC = jnp.zeros((B, MLSTM_HEADS, MLSTM_HEAD_DIM, MLSTM_HEAD_DIM), f32)
        zn = jnp.zeros((B, MLSTM_HEADS, MLSTM_HEAD_DIM), f32)
        zm = jnp.zeros((B, MLSTM_HEADS), f32)
        xp, k_p, v_p, cv_p, C_p, n_p, m_p = _layer(xp, c_prompt, zk, zv, zconv, zC, zn, zm, lam_init, *lw)
        xs, k_s, v_s, cv_s, C_s, n_s, m_s = _layer(xs, c_sample, cache_k[l], cache_v[l], state_conv[l],
                                                   state_C[l], state_n[l], state_m[l], lam_init, *lw)
        kp_l.append(k_p); vp_l.append(v_p); cvp_l.append(cv_p); Cp_l.append(C_p); np_l.append(n_p); mp_l.append(m_p)
        ks_l.append(k_s); vs_l.append(v_s); cvs_l.append(cv_s); Cs_l.append(C_s); ns_l.append(n_s); ms_l.append(m_s)
    y_prompt = _rmsnorm(xp, g_final)
    y_sample = _rmsnorm(xs, g_final)
    return (y_prompt, y_sample,
            jnp.stack(kp_l), jnp.stack(vp_l), jnp.stack(cvp_l), jnp.stack(Cp_l), jnp.stack(np_l), jnp.stack(mp_l),
            jnp.stack(ks_l), jnp.stack(vs_l), jnp.stack(cvs_l), jnp.stack(Cs_l), jnp.stack(ns_l), jnp.stack(ms_l))
```

```cpp
#include <hip/hip_runtime.h>
#include <hip/hip_cooperative_groups.h>
#include <cstdio>
#include <cstdint>
namespace cg = cooperative_groups;
namespace pg8 {
#define PG8_LAS __attribute__((address_space(3)))
typedef unsigned short bf16_t;
typedef short bf16x8 __attribute__((ext_vector_type(8)));
typedef float f32x4 __attribute__((ext_vector_type(4)));
typedef unsigned u32x4 __attribute__((ext_vector_type(4)));
constexpr int BM = 256, BK = 64, HALF = 128, HTB = HALF * BK * 2  , STAGE_BYTES = 8 * HTB, NXCD = 8, WGM = 8;

__host__ __device__ __forceinline__ int lds_byte(int r, int c) { const int st = (r >> 4) * 2 + (c >> 5), rr = r & 15, cc = c & 31, ob = rr * 64 + cc * 2; return st * 1024 + (ob ^ (((ob >> 9) & 1) << 5)); }
__host__ __device__ __forceinline__ void stage_rc(int b, int& R, int& C) { const int st = b / 1024, sb = b % 1024, swz = sb ^ (((sb >> 9) & 1) << 5); R = (st >> 1) * 16 + swz / 64; C = (st & 1) * 32 + (swz % 64) / 2; }
__host__ __device__ __forceinline__ int perm32(int rho) { const int n = rho >> 4, i = rho & 15; return 8 * (i >> 2) + 4 * n + (i & 3); }

struct Unit { int pm, pn; };
struct Gemm { const bf16_t* A; const bf16_t* Bt; int M, N, K, ld; };

struct StaticOrder {
    int nM, nN, nwg, G, c;
    __host__ __device__ void init(int M, int N, int G_, int c_) { nM = M / BM; nN = N / BM; nwg = nM * nN; G = G_; c = c_; }
    __host__ __device__ bool next(int i, Unit& u) const {
        const long L = (long)i * G + c; if (L >= nwg) return false;
        int wgid = (int)L; { const int q = nwg / NXCD, r = nwg % NXCD, xcd = wgid % NXCD, off = wgid / NXCD; wgid = (xcd < r ? xcd * (q + 1) : r * (q + 1) + (xcd - r) * q) + off; }
        const int nig = WGM * nN, gid = wgid / nig, fm = gid * WGM, gsz = (nM - fm) < WGM ? (nM - fm) : WGM;
        u.pm = fm + ((wgid % nig) % gsz); u.pn = (wgid % nig) / gsz; return true;
    }
    __device__ __forceinline__ void a_ready(const Unit&) const {}
    __device__ __forceinline__ void done(const Unit&) const {}
};

typedef float f32x2_t __attribute__((ext_vector_type(2)));
typedef __bf16 bf16x2_t __attribute__((ext_vector_type(2)));
__device__ __forceinline__ unsigned cvt_pk_bf16(float lo, float hi) { f32x2_t v = {lo, hi}; bf16x2_t b = __builtin_convertvector(v, bf16x2_t); return __builtin_bit_cast(unsigned, b); }
template <int ACT  > struct EpiStore {
    static constexpr bool PERM = true, AFTER_DRAIN = false;
    bf16_t* O; int ldc;
    __device__ __forceinline__ void operator()(const f32x4 (&acc)[2][2][4][2], const Unit& u, int wr, int wc, int fr, int fq) const {
        const int row0 = u.pm * BM + wr * 64 + fr; const int col0 = u.pn * BM + wc * 32 + 8 * fq;
#pragma unroll
        for (int ai = 0; ai < 2; ++ai)
#pragma unroll
            for (int m = 0; m < 4; ++m) { bf16_t* rowp = O + (size_t)(row0 + ai * HALF + m * 16) * ldc + col0;
#pragma unroll
                for (int bj = 0; bj < 2; ++bj) { f32x4 v0 = acc[ai][bj][m][0], v1 = acc[ai][bj][m][1];
                    if (ACT == 2) {
#pragma unroll
                        for (int j = 0; j < 4; ++j) { float a = fmaxf(v0[j], 0.f), b = fmaxf(v1[j], 0.f); v0[j] = a * a; v1[j] = b * b; } }
                    u32x4 w; w.x = cvt_pk_bf16(v0[0], v0[1]); w.y = cvt_pk_bf16(v0[2], v0[3]); w.z = cvt_pk_bf16(v1[0], v1[1]); w.w = cvt_pk_bf16(v1[2], v1[3]);
                    *(u32x4*)(rowp + bj * HALF) = w; } }
    }
};
struct EpiResid {
    static constexpr bool PERM = true, AFTER_DRAIN = false;
    const float* baseP; const float* baseS; const float* gate; float* out;
    __device__ __forceinline__ void operator()(const f32x4 (&acc)[2][2][4][2], const Unit& u, int wr, int wc, int fr, int fq) const {
        const int row0 = u.pm * BM + wr * 64 + fr; const int col0 = u.pn * BM + wc * 32 + 8 * fq;
#pragma unroll
        for (int ai = 0; ai < 2; ++ai)
#pragma unroll
            for (int m = 0; m < 4; ++m) { const int r = row0 + ai * HALF + m * 16;
                const float* bp = (r < 8192) ? baseP + (size_t)r * 2048 : baseS + (size_t)(r - 8192) * 2048;
                const float* gp = gate + (size_t)((r < 8192) ? 0 : 1 + ((r - 8192) >> 4)) * 12288;
                float* op = out + (size_t)r * 2048;
#pragma unroll
                for (int bj = 0; bj < 2; ++bj) { const int c = col0 + bj * HALF;
#pragma unroll
                    for (int n = 0; n < 2; ++n) { const f32x4 b = *(const f32x4*)(bp + c + 4 * n), g = *(const f32x4*)(gp + c + 4 * n);
                        *(f32x4*)(op + c + 4 * n) = b + g * acc[ai][bj][m][n]; } }
                asm volatile("" ::: "memory"); }
    }
};

struct EpiPart {
    static constexpr bool PERM = true, AFTER_DRAIN = false;
    bf16_t* out; int ldc;
    __device__ __forceinline__ void operator()(const f32x4 (&acc)[2][2][4][2], const Unit& u, int wr, int wc, int fr, int fq) const {
        const int row0 = u.pm * BM + wr * 64 + fr - 8192; const int col0 = u.pn * BM + wc * 32 + 8 * fq;
#pragma unroll
        for (int ai = 0; ai < 2; ++ai)
#pragma unroll
            for (int m = 0; m < 4; ++m) { bf16_t* op = out + (size_t)(row0 + ai * HALF + m * 16) * ldc + col0;
#pragma unroll
                for (int bj = 0; bj < 2; ++bj) { const f32x4 v0 = acc[ai][bj][m][0], v1 = acc[ai][bj][m][1];
                    u32x4 w; w.x = cvt_pk_bf16(v0[0], v0[1]); w.y = cvt_pk_bf16(v0[2], v0[3]); w.z = cvt_pk_bf16(v1[0], v1[1]); w.w = cvt_pk_bf16(v1[2], v1[3]);
                    *(u32x4*)(op + bj * HALF) = w; } }
    }
};
struct OneUnit { Unit u;
    __device__ __forceinline__ bool next(int i, Unit& o) const { if (i != 0) return false; o = u; return true; }
    __device__ __forceinline__ void a_ready(const Unit&) const {}
    __device__ __forceinline__ void done(const Unit&) const {}
};
template <class Epi, class Sched, bool ALIGN_EPI = false, bool SP2 = false>
__device__ __forceinline__ void gemm_phase(PG8_LAS unsigned char* lds, const Gemm g, const Sched& S, const Epi& E) {
    int tid_ = threadIdx.x; asm volatile("" : "+v"(tid_));
    const int tid = tid_, wid = __builtin_amdgcn_readfirstlane(tid >> 6), lane = tid & 63, wr = wid >> 2, wc = wid & 3, fr = lane & 15, fq = lane >> 4;
    const int K = g.ld, nt = g.K / BK;
    unsigned voffA[2], voffB[2];
#pragma unroll
    for (int i = 0; i < 2; ++i) { int R, C; stage_rc(tid * 16 + i * 8192, R, C); const int Rb = Epi::PERM ? ((R & ~31) + perm32(R & 31)) : R;
        voffA[i] = (unsigned)(R * K + C) * 2u; voffB[i] = (unsigned)(Rb * K + C) * 2u; }
    const size_t kstep = (size_t)(BK * 2);
    const size_t hstep = (size_t)HALF * K * 2;
    const size_t tstep = 2 * hstep;
    const unsigned ldsw = (unsigned)wid * 1024u;
    const int aoff = lds_byte(wr * 64 + fr, fq * 8), boff = lds_byte(wc * 32 + fr, fq * 8);
#define PG8_SA(b, h) (((b) * 2 + (h)) * HTB)
#define PG8_SB(b, h) ((4 + (b) * 2 + (h)) * HTB)
#define PG8_STAGE(bufoff, gbase, voff) do { _Pragma("unroll") for (int _i = 0; _i < 2; ++_i) \
        __builtin_amdgcn_global_load_lds((const unsigned*)((const char*)(gbase) + (voff)[_i]), (PG8_LAS unsigned*)(lds + (bufoff) + ldsw + _i * 8192), 16, 0, 0); } while (0)
#define PG8_LDA(dst, b, h) do { _Pragma("unroll") for (int m = 0; m < 4; ++m) _Pragma("unroll") for (int k = 0; k < 2; ++k) dst[m][k] = *(const PG8_LAS bf16x8*)(lds + PG8_SA(b, h) + aoff + m * 2048 + k * 1024); } while (0)
#define PG8_LDB(dst, b, h) do { _Pragma("unroll") for (int n = 0; n < 2; ++n) _Pragma("unroll") for (int k = 0; k < 2; ++k) dst[n][k] = *(const PG8_LAS bf16x8*)(lds + PG8_SB(b, h) + boff + n * 2048 + k * 1024); } while (0)
#define PG8_MMA(ai, bj, At, Bt) do { __builtin_amdgcn_s_setprio(1); _Pragma("unroll") for (int m = 0; m < 4; ++m) _Pragma("unroll") for (int n = 0; n < 2; ++n) _Pragma("unroll") for (int k = 0; k < 2; ++k) \
        acc[ai][bj][m][n] = __builtin_amdgcn_mfma_f32_16x16x32_bf16(Bt[n][k], At[m][k], acc[ai][bj][m][n], 0, 0, 0); __builtin_amdgcn_s_setprio(0); } while (0)
#define PG8_WAIT_V(n) asm volatile("s_waitcnt vmcnt(" #n ")" ::: "memory")
#define PG8_WAIT_L(n) asm volatile("s_waitcnt lgkmcnt(" #n ")" ::: "memory")
#define PG8_BAR __builtin_amdgcn_s_barrier()
#define PG8_SCHED __builtin_amdgcn_sched_barrier(0)
    Unit cur, nxt; int ui = 0;
    if (!S.next(0, cur)) return;
    f32x4 acc[2][2][4][2];
#pragma unroll
    for (int a = 0; a < 2; ++a)
#pragma unroll
        for (int b = 0; b < 2; ++b)
#pragma unroll
            for (int m = 0; m < 4; ++m)
#pragma unroll
                for (int n = 0; n < 2; ++n) acc[a][b][m][n] = (f32x4){0.f, 0.f, 0.f, 0.f};
    bf16x8 At[4][2], B0[2][2], B1[2][2];
    const char* cA = (const char*)g.A + (size_t)cur.pm * tstep; const char* cB = (const char*)g.Bt + (size_t)cur.pn * tstep;
    S.a_ready(cur);
    if constexpr (SP2) {
        PG8_STAGE(PG8_SB(0, 0), cB, voffB); PG8_STAGE(PG8_SB(0, 1), cB + hstep, voffB); PG8_STAGE(PG8_SA(0, 0), cA, voffA); PG8_STAGE(PG8_SA(0, 1), cA + hstep, voffA);
        if (wr == 1) PG8_BAR;
        PG8_WAIT_V(2); PG8_BAR;
        PG8_STAGE(PG8_SB(1, 0), cB + kstep, voffB); PG8_STAGE(PG8_SA(1, 0), cA + kstep, voffA); PG8_STAGE(PG8_SB(1, 1), cB + hstep + kstep, voffB);
        PG8_WAIT_V(6); PG8_BAR;
    } else {
        PG8_STAGE(PG8_SB(0, 0), cB, voffB); PG8_STAGE(PG8_SA(0, 0), cA, voffA); PG8_STAGE(PG8_SB(0, 1), cB + hstep, voffB); PG8_STAGE(PG8_SA(0, 1), cA + hstep, voffA);
        if (wr == 1) PG8_BAR;
        PG8_WAIT_V(4); PG8_BAR;
        PG8_STAGE(PG8_SB(1, 0), cB + kstep, voffB); PG8_STAGE(PG8_SA(1, 0), cA + kstep, voffA); PG8_STAGE(PG8_SB(1, 1), cB + hstep + kstep, voffB);
        PG8_WAIT_V(6); PG8_BAR;
    }
    for (;;) {
        const bool has_next = S.next(ui + 1, nxt);
        const char* nA = has_next ? (const char*)g.A + (size_t)nxt.pm * tstep : cA; const char* nB = has_next ? (const char*)g.Bt + (size_t)nxt.pn * tstep : cB;
        for (int t = 0; t < nt; t += 2) {
            const bool last = (t == nt - 2);
            const char* a1 = cA + (size_t)(t + 1) * kstep;
            const char* a2 = last ? nA : cA + (size_t)(t + 2) * kstep; const char* b2 = last ? nB : cB + (size_t)(t + 2) * kstep;
            const char* a3 = a2 + kstep; const char* b3 = b2 + kstep;
            if (last && has_next) S.a_ready(nxt);
            if constexpr (SP2) {
            PG8_LDB(B0, 0, 0); PG8_LDB(B1, 0, 1); PG8_SCHED; PG8_LDA(At, 0, 0); PG8_STAGE(PG8_SA(1, 1), a1 + hstep, voffA);
            PG8_WAIT_V(8); PG8_WAIT_L(0); PG8_BAR; PG8_MMA(0, 0, At, B0); PG8_MMA(0, 1, At, B1); PG8_BAR; PG8_SCHED;
            PG8_LDA(At, 0, 1); PG8_STAGE(PG8_SB(0, 0), b2, voffB); PG8_STAGE(PG8_SB(0, 1), b2 + hstep, voffB); PG8_STAGE(PG8_SA(0, 0), a2, voffA);
            PG8_WAIT_V(8); PG8_WAIT_L(0); PG8_BAR; PG8_MMA(1, 0, At, B0); PG8_MMA(1, 1, At, B1); PG8_BAR; PG8_SCHED;
            PG8_LDB(B0, 1, 0); PG8_LDB(B1, 1, 1); PG8_SCHED; PG8_LDA(At, 1, 0); PG8_STAGE(PG8_SA(0, 1), a2 + hstep, voffA);
            PG8_WAIT_V(8); PG8_WAIT_L(0); PG8_BAR; PG8_MMA(0, 0, At, B0); PG8_MMA(0, 1, At, B1); PG8_BAR; PG8_SCHED;
            PG8_LDA(At, 1, 1); PG8_STAGE(PG8_SB(1, 0), b3, voffB); PG8_STAGE(PG8_SB(1, 1), b3 + hstep, voffB); PG8_STAGE(PG8_SA(1, 0), a3, voffA);
            PG8_WAIT_V(8); PG8_WAIT_L(0); PG8_BAR; PG8_MMA(1, 0, At, B0); PG8_MMA(1, 1, At, B1); PG8_BAR; PG8_SCHED;
            } else {
            PG8_LDB(B0, 0, 0); PG8_SCHED; PG8_LDA(At, 0, 0); PG8_STAGE(PG8_SA(1, 1), a1 + hstep, voffA);
            PG8_WAIT_L(8); PG8_BAR; PG8_WAIT_L(0); PG8_MMA(0, 0, At, B0); PG8_BAR; PG8_SCHED;
            PG8_LDB(B1, 0, 1); PG8_STAGE(PG8_SB(0, 0), b2, voffB);
            PG8_BAR; PG8_WAIT_L(0); PG8_MMA(0, 1, At, B1); PG8_BAR;
            PG8_LDA(At, 0, 1); PG8_STAGE(PG8_SA(0, 0), a2, voffA);
            PG8_BAR; PG8_WAIT_L(0); PG8_MMA(1, 0, At, B0); PG8_BAR; PG8_SCHED;
            PG8_STAGE(PG8_SB(0, 1), b2 + hstep, voffB);
            PG8_WAIT_V(6); PG8_BAR; PG8_MMA(1, 1, At, B1); PG8_BAR;
            PG8_LDB(B0, 1, 0); PG8_SCHED; PG8_LDA(At, 1, 0); PG8_STAGE(PG8_SA(0, 1), a2 + hstep, voffA);
            PG8_WAIT_L(8); PG8_BAR; PG8_WAIT_L(0); PG8_MMA(0, 0, At, B0); PG8_BAR; PG8_SCHED;
            PG8_LDB(B1, 1, 1); PG8_STAGE(PG8_SB(1, 0), b3, voffB);
            PG8_BAR; PG8_WAIT_L(0); PG8_MMA(0, 1, At, B1); PG8_BAR;
            PG8_LDA(At, 1, 1); PG8_STAGE(PG8_SA(1, 0), a3, voffA);
            PG8_BAR; PG8_WAIT_L(0); PG8_MMA(1, 0, At, B0); PG8_BAR; PG8_SCHED;
            PG8_STAGE(PG8_SB(1, 1), b3 + hstep, voffB);
            PG8_WAIT_V(6); PG8_BAR; PG8_MMA(1, 1, At, B1); PG8_BAR;
            }
        }
        if constexpr (ALIGN_EPI) { if (wr == 0) PG8_BAR; }
        if constexpr (!Epi::AFTER_DRAIN) { E(acc, cur, wr, wc, fr, fq); S.done(cur); }
        if (!has_next) break;
#pragma unroll
        for (int a = 0; a < 2; ++a)
#pragma unroll
            for (int b = 0; b < 2; ++b)
#pragma unroll
                for (int m = 0; m < 4; ++m)
#pragma unroll
                    for (int n = 0; n < 2; ++n) acc[a][b][m][n] = (f32x4){0.f, 0.f, 0.f, 0.f};
        cur = nxt; cA = nA; cB = nB; ++ui;
        if constexpr (ALIGN_EPI) { if (wr == 1) PG8_BAR; }
    }
    PG8_WAIT_V(0);
    if constexpr (!ALIGN_EPI) { if (wr == 0) PG8_BAR; }
    PG8_BAR;
    if constexpr (Epi::AFTER_DRAIN) { E.fused(acc, cur, wr, wc, fr, fq, lds, wid, lane); S.done(cur); }
#undef PG8_SA
#undef PG8_SB
#undef PG8_STAGE
#undef PG8_LDA
#undef PG8_LDB
#undef PG8_MMA
#undef PG8_WAIT_V
#undef PG8_WAIT_L
#undef PG8_BAR
#undef PG8_SCHED
}
}
#define GAS __attribute__((address_space(1)))
#define LAS __attribute__((address_space(3)))
typedef unsigned short bf16;
typedef unsigned u32x4 __attribute__((ext_vector_type(4)));
typedef unsigned u32x2 __attribute__((ext_vector_type(2)));
typedef float f32x4 __attribute__((ext_vector_type(4)));
typedef float f32x16 __attribute__((ext_vector_type(16)));
typedef short bf16x8 __attribute__((ext_vector_type(8)));
typedef short s16x4 __attribute__((ext_vector_type(4)));
typedef float f32x2_t __attribute__((ext_vector_type(2)));
constexpr int NW = 8, NT = 512;
constexpr int MTOK = 8704, MP = 8192, MS = 512, DM = 2048, NIN = 7176, NINP = 7424, DFF = 8192;
constexpr int NSEQ = 33;
constexpr int PAST = 1024;
constexpr int C_QA = 0, C_KA = 1024, C_VA = 2048, C_QM = 3072, C_KM = 4096, C_VM = 5120, C_OM = 6144, C_IG = 7168, C_FG = 7172;
constexpr int NCH = 160;
constexpr float EPS = 1e-6f;
constexpr float LAM_INIT = 0.2f;
constexpr float QSCALE = 0.125f * 1.4426950408889634f;
constexpr size_t O_YP = 0, O_YS = 16777216, O_KP = 17825792, O_VP = 26214400, O_CVP = 34603008, O_CP = 34609152, O_NP = 34871296, O_MPO = 34872320,
                 O_KS = 34872324, O_VS = 35396612, O_CVS = 35920900, O_CS = 36117508, O_NS = 44506116, O_MSO = 44538884;
constexpr size_t MiB = 1u << 20;
constexpr size_t WS_MOD = 1 * MiB;
constexpr size_t WS_ROPE = 3 * MiB;
constexpr size_t WS_SCAL = 4 * MiB;
constexpr size_t WS_DN = 5 * MiB;
constexpr size_t WS_NPREV = 6 * MiB;
constexpr size_t WS_WIN = 8 * MiB;
constexpr size_t WS_WOUT = 40 * MiB;
constexpr size_t WS_WUP = 48 * MiB;
constexpr size_t WS_WDN = 80 * MiB;
constexpr size_t WS_XN = 112 * MiB;
constexpr size_t WS_PROJ = 148 * MiB;
constexpr size_t WS_QA = 272 * MiB;
constexpr size_t WS_KA = 289 * MiB;
constexpr size_t WS_VT = 306 * MiB;
constexpr size_t WS_DC = 322 * MiB;
constexpr size_t WS_CPREV = 482 * MiB;
constexpr size_t WS_MIX = 562 * MiB;
constexpr size_t WS_END = 596 * MiB;
constexpr size_t WS_H = WS_PROJ;
constexpr size_t WS_X1 = WS_DC;
constexpr size_t WS_PART6 = 390 * MiB;
constexpr size_t WS_PART8 = 422 * MiB;
constexpr size_t WS_PART9 = 486 * MiB;
constexpr size_t WS_FLAG = 0;
static_assert(WS_H + (size_t)MTOK * DFF * 2 <= WS_VT + 16 * MiB && WS_X1 + (size_t)MTOK * DM * 4 <= WS_CPREV, "overlays");

constexpr int LDS_BYTES = 147456;

__device__ __forceinline__ f32x4 ld_bf4(const bf16* p) { const u32x2 w = *(const u32x2*)p; return (f32x4){__uint_as_float(w.x << 16), __uint_as_float(w.x & 0xffff0000u), __uint_as_float(w.y << 16), __uint_as_float(w.y & 0xffff0000u)}; }
__device__ __forceinline__ float bf2f(unsigned short u) { return __uint_as_float((unsigned)u << 16); }
__device__ __forceinline__ unsigned pk2(float lo, float hi) { return pg8::cvt_pk_bf16(lo, hi); }
__device__ __forceinline__ float lane_get(float v, int src_lane) { return __int_as_float(__builtin_amdgcn_ds_bpermute(src_lane << 2, __float_as_int(v))); }
__device__ __forceinline__ float xhalf_other(float v) { auto rr = __builtin_amdgcn_permlane32_swap(__float_as_uint(v), __float_as_uint(v), false, false); return __uint_as_float(rr[0]) + __uint_as_float(rr[1]) - v; }
__device__ __forceinline__ float xhalf_sum(float v) { auto rr = __builtin_amdgcn_permlane32_swap(__float_as_uint(v), __float_as_uint(v), false, false); return __uint_as_float(rr[0]) + __uint_as_float(rr[1]); }
__device__ __forceinline__ float wave_sum(float v, int lane) {
#pragma unroll
    for (int o = 1; o < 32; o <<= 1) v += lane_get(v, lane ^ o);
    return xhalf_sum(v);
}
__device__ __forceinline__ float wave_max(float v, int lane) {
#pragma unroll
    for (int o = 1; o < 64; o <<= 1) v = fmaxf(v, lane_get(v, lane ^ o));
    return v;
}
__device__ __forceinline__ float silu_f(float x) { return x / (1.f + __expf(-x)); }
__device__ __forceinline__ float sigmoid_f(float x) { return 1.f / (1.f + __expf(-x)); }
__device__ __forceinline__ int crow(int r, int hi) { return (r & 3) + 8 * (r >> 2) + 4 * hi; }
#define LDS_WAIT() asm volatile("s_waitcnt lgkmcnt(0)" ::: "memory")

struct Args {
    const float* in[29]; float* out; unsigned char* ws;
};
typedef const __attribute__((address_space(4))) Args* ArgsP;
#define FRESH_ARGS() ({ ArgsP p_ = (ArgsP)__builtin_amdgcn_kernarg_segment_ptr(); asm volatile("" : "+s"(p_)); p_; })

__device__ __forceinline__ void p0_transpose_item(const float* __restrict__ W, int K, int N, int Npad, bf16* WT, LAS float* T, int item, int tid, int wave, int lane) {
    const int nblk = Npad / 256, kb = item / nblk, nb = item % nblk, k0 = 64 * kb, n0 = 256 * nb;
    const int n = n0 + 4 * lane;
    f32x4 v[8];
#pragma unroll
    for (int i = 0; i < 8; ++i) v[i] = (n < N) ? *(const f32x4*)(W + (size_t)(k0 + 8 * wave + i) * N + n) : (f32x4){0.f, 0.f, 0.f, 0.f};
#pragma unroll
    for (int i = 0; i < 8; ++i) *(LAS f32x4*)(T + (8 * wave + i) * 260 + 4 * lane) = v[i];
    __syncthreads();
#pragma unroll
    for (int j = 0; j < 4; ++j) { const int q = tid + NT * j, nn = q >> 3, c = q & 7; const LAS float* s = T + (8 * c) * 260 + nn;
        u32x4 o; o.x = pk2(s[0], s[260]); o.y = pk2(s[2 * 260], s[3 * 260]); o.z = pk2(s[4 * 260], s[5 * 260]); o.w = pk2(s[6 * 260], s[7 * 260]);
        *(u32x4*)(WT + (size_t)(n0 + nn) * K + k0 + 8 * c) = o; }
    __syncthreads();
}

__device__ __forceinline__ void p0_ada_item(const float* __restrict__ cP, const float* __restrict__ cS, const float* __restrict__ Wada, const float* __restrict__ bada,
                                            float* mod, LAS float* red, int jb, int wave, int lane, int tid) {
    const int i32 = lane & 31, hi = lane >> 5;
    f32x16 acc[4]; f32x4 accp = {0.f, 0.f, 0.f, 0.f};
#pragma unroll
    for (int c = 0; c < 4; ++c) acc[c] = (f32x16){};
    const float* wp = Wada + (size_t)128 * jb + 4 * i32;
    for (int st = 0; st < 16; ++st) {
        const int k0 = 256 * wave + 16 * st + 8 * hi;
        f32x4 w[8];
#pragma unroll
        for (int i = 0; i < 8; ++i) w[i] = *(const f32x4*)(wp + (size_t)(k0 + i) * 12288);
        const f32x4 c0 = *(const f32x4*)(cS + (size_t)i32 * DM + k0), c1 = *(const f32x4*)(cS + (size_t)i32 * DM + k0 + 4);
        const f32x4 p0 = *(const f32x4*)(cP + k0), p1 = *(const f32x4*)(cP + k0 + 4);
        u32x4 a;
        a.x = pk2(silu_f(c0[0]), silu_f(c0[1])); a.y = pk2(silu_f(c0[2]), silu_f(c0[3])); a.z = pk2(silu_f(c1[0]), silu_f(c1[1])); a.w = pk2(silu_f(c1[2]), silu_f(c1[3]));
#pragma unroll
        for (int i = 0; i < 4; ++i) { accp += w[i] * silu_f(p0[i]); accp += w[4 + i] * silu_f(p1[i]); }
#pragma unroll
        for (int c = 0; c < 4; ++c) { u32x4 b; b.x = pk2(w[0][c], w[1][c]); b.y = pk2(w[2][c], w[3][c]); b.z = pk2(w[4][c], w[5][c]); b.w = pk2(w[6][c], w[7][c]);
            acc[c] = __builtin_amdgcn_mfma_f32_32x32x16_bf16(__builtin_bit_cast(bf16x8, a), __builtin_bit_cast(bf16x8, b), acc[c], 0, 0, 0); }
    }
    accp = (f32x4){xhalf_sum(accp[0]), xhalf_sum(accp[1]), xhalf_sum(accp[2]), xhalf_sum(accp[3])};
    LAS float* rp = red + 16384;
    if (hi == 0) *(LAS f32x4*)(rp + wave * 128 + 4 * i32) = accp;
#pragma unroll
    for (int half = 4; half >= 1; half >>= 1) {
        if (wave >= half && wave < 2 * half) { LAS float* dst = red + (wave - half) * 4096;
#pragma unroll
            for (int r = 0; r < 16; ++r) *(LAS f32x4*)(dst + crow(r, hi) * 128 + 4 * i32) = (f32x4){acc[0][r], acc[1][r], acc[2][r], acc[3][r]}; }
        __syncthreads();
        if (wave < half) { const LAS float* src = red + wave * 4096;
#pragma unroll
            for (int r = 0; r < 16; ++r) { const f32x4 t = *(const LAS f32x4*)(src + crow(r, hi) * 128 + 4 * i32); acc[0][r] += t[0]; acc[1][r] += t[1]; acc[2][r] += t[2]; acc[3][r] += t[3]; } }
        __syncthreads();
    }
    if (wave == 0) { const f32x4 bv = *(const f32x4*)(bada + 128 * jb + 4 * i32);
#pragma unroll
        for (int r = 0; r < 16; ++r) *(f32x4*)(mod + (size_t)(1 + crow(r, hi)) * 12288 + 128 * jb + 4 * i32) = (f32x4){acc[0][r], acc[1][r], acc[2][r], acc[3][r]} + bv; }
    if (wave == 1 && hi == 0) { f32x4 t = *(const f32x4*)(bada + 128 * jb + 4 * i32);
#pragma unroll
        for (int w = 0; w < 8; ++w) t += *(const LAS f32x4*)(rp + w * 128 + 4 * i32);
        *(f32x4*)(mod + 128 * jb + 4 * i32) = t; }
    __syncthreads();
}

__constant__ double INV_FREQ_TURNS[8] = {
    1.0 / 6.283185307179586, 0.19392274474868576 / 6.283185307179586, 0.03760603093086393 / 6.283185307179586, 0.007292664737217109 / 6.283185307179586,
    0.001414213562373095 / 6.283185307179586, 0.0002742481756762073 / 6.283185307179586, 5.318295896944988e-05 / 6.283185307179586, 1.031338537721246e-05 / 6.283185307179586 };

__device__ __forceinline__ void p0_prologue(ArgsP A, LAS unsigned char* lds, int tid, int wave, int lane) {
    unsigned char* ws = A->ws;
    const int G = gridDim.x, bid = blockIdx.x;
    for (int jb = bid; jb < 96; jb += G)
        p0_ada_item(A->in[8], A->in[9], A->in[10], A->in[11], (float*)(ws + WS_MOD), (LAS float*)lds, jb, wave, lane, tid);
    constexpr int I_IN = 32 * (NINP / 256), I_OUT = 32 * 8, I_UP = 32 * 32, I_DN = 128 * 8, I_ALL = I_IN + I_OUT + I_UP + I_DN;
    const bool split = (G > 128);
    const int nfree = split ? G - 96 : G, first = split ? 14 * nfree : 0;
    for (int pass = 0; pass < 2; ++pass) {
        int it, step, end;
        if (pass == 0) { if (!split || bid < 96) continue; it = bid - 96; step = nfree; end = (first < I_ALL) ? first : I_ALL; }
        else { it = first + bid; step = G; end = I_ALL; }
        for (; it < end; it += step) { int r = it;
            if (r < I_IN) { p0_transpose_item(A->in[13], DM, NIN, NINP, (bf16*)(ws + WS_WIN), (LAS float*)lds, r, tid, wave, lane); continue; } r -= I_IN;
            if (r < I_OUT) { p0_transpose_item(A->in[24], DM, DM, DM, (bf16*)(ws + WS_WOUT), (LAS float*)lds, r, tid, wave, lane); continue; } r -= I_OUT;
            if (r < I_UP) { p0_transpose_item(A->in[26], DM, DFF, DFF, (bf16*)(ws + WS_WUP), (LAS float*)lds, r, tid, wave, lane); continue; } r -= I_UP;
            p0_transpose_item(A->in[27], DFF, DM, DM, (bf16*)(ws + WS_WDN), (LAS float*)lds, r, tid, wave, lane); }
    }
    for (int idx = blockIdx.x * NT + tid; idx < 8192 * 8; idx += gridDim.x * NT) {
        const int pos = idx >> 3, i = idx & 7;
        const double t = (double)pos * INV_FREQ_TURNS[i]; const float fr = (float)(t - __builtin_rint(t));
        float* tab = (float*)(ws + WS_ROPE) + (size_t)pos * 16;
        tab[i] = __builtin_amdgcn_cosf(fr); tab[8 + i] = __builtin_amdgcn_sinf(fr);
    }
}

template <int NPART> __device__ __forceinline__ void norm_mod_rows(const float* xP, const float* xS, const float* __restrict__ g, const float* __restrict__ mod, int sh_off, int sc_off, bf16* out, int wave, int lane,
                                              const bf16* part = nullptr, int gate_off = 0, float* x1S = nullptr) {
    const int gw = blockIdx.x * NW + wave, NGW = gridDim.x * NW;
    for (int r = gw; r < MTOK; r += NGW) {
        const float* xr = (r < MP) ? xP + (size_t)r * DM : xS + (size_t)(r - MP) * DM;
        const float* mr = mod + (size_t)((r < MP) ? 0 : 1 + ((r - MP) >> 4)) * 12288;
        f32x4 v[8]; float s = 0.f;
#pragma unroll
        for (int j = 0; j < 8; ++j) v[j] = *(const f32x4*)(xr + 256 * j + 4 * lane);
        if (NPART > 0 && r >= MP) {
#pragma unroll
            for (int j = 0; j < 8; ++j) { const int c = 256 * j + 4 * lane; f32x4 a = {0.f, 0.f, 0.f, 0.f};
                f32x4 t[NPART > 0 ? NPART : 1];
#pragma unroll
                for (int p = 0; p < NPART; ++p) t[p] = ld_bf4(part + ((size_t)p * MS + (r - MP)) * DM + c);
#pragma unroll
                for (int p = 0; p < NPART; ++p) a += t[p];
                v[j] += *(const f32x4*)(mr + gate_off + c) * a; *(f32x4*)(x1S + (size_t)(r - MP) * DM + c) = v[j]; } }
#pragma unroll
        for (int j = 0; j < 8; ++j) s += (v[j].x * v[j].x + v[j].y * v[j].y) + (v[j].z * v[j].z + v[j].w * v[j].w);
        const float rstd = 1.f / sqrtf(wave_sum(s, lane) * (1.f / DM) + EPS);
#pragma unroll
        for (int j = 0; j < 8; ++j) { const int c = 256 * j + 4 * lane;
            const f32x4 gg = *(const f32x4*)(g + c), sc = *(const f32x4*)(mr + sc_off + c), sh = *(const f32x4*)(mr + sh_off + c);
            const f32x4 y = v[j] * rstd * gg * (sc + 1.f) + sh;
            u32x2 o; o.x = pk2(y.x, y.y); o.y = pk2(y.z, y.w);
            *(u32x2*)(out + (size_t)r * DM + c) = o; }
    }
}
#define XB_TMO      128
#define XB_XCNT(j)  (256  + 64 * (j))
#define XB_XSUB(j)  (1280 + 64 * (j))
#define XB_XGEN(j)  (2304 + 64 * (j))
#define XB_TOP      3328
#define XB_TOPGEN   3392
#define XCD_BAR_WORDS 3456
#define XB_SPIN_CAP (1u << 18)

__device__ __forceinline__ unsigned xb_ld(unsigned* p)              { return __hip_atomic_load(p, __ATOMIC_RELAXED, __HIP_MEMORY_SCOPE_AGENT); }
__device__ __forceinline__ unsigned xb_add(unsigned* p, unsigned v) { return __hip_atomic_fetch_add(p, v, __ATOMIC_RELAXED, __HIP_MEMORY_SCOPE_AGENT); }
__device__ __forceinline__ unsigned xb_xcc_id() { return (unsigned)__builtin_amdgcn_s_getreg((3 << 11) | 20) & 0xFu; }
#define XB_SPIN(cond, bar) do { unsigned _sp = 0; while (cond) { __builtin_amdgcn_s_sleep(1); \
    if ((++_sp & 255u) == 0u) { if (xb_ld(&(bar)[XB_TMO])) break; if (_sp > XB_SPIN_CAP) { atomicAdd(&(bar)[XB_TMO], 1u); break; } } } } while (0)

struct XcdBarrier {
    unsigned* bar; unsigned x;
    volatile LAS unsigned* st;
};

__device__ __forceinline__ XcdBarrier xcd_barrier_post(unsigned* bar, volatile LAS unsigned* st) {
    XcdBarrier b; b.bar = bar; b.x = xb_xcc_id(); b.st = st;
    if (threadIdx.x == 0) (void)xb_add(&bar[XB_XCNT(b.x)], 1u);
    return b;
}
__device__ __forceinline__ void xcd_barrier_complete(unsigned* bar, unsigned x, unsigned& nloc, unsigned& nx) {
    const unsigned G = gridDim.x * gridDim.y * gridDim.z;
    unsigned sum, cnt, mine, sp = 0u;
    for (;;) {
        sum = 0u; cnt = 0u; mine = 0u;
#pragma unroll
        for (unsigned j = 0; j < 16; ++j) { const unsigned c = xb_ld(&bar[XB_XCNT(j)]); sum += c; cnt += (c > 0u) ? 1u : 0u; mine = (j == x) ? c : mine; }
        if (sum == G) break;
        __builtin_amdgcn_s_sleep(1);
        if ((++sp & 255u) == 0u) { if (xb_ld(&bar[XB_TMO])) break; if (sp > XB_SPIN_CAP) { atomicAdd(&bar[XB_TMO], 1u); break; } }
    }
    nloc = mine > 0u ? mine : 1u; nx = cnt > 0u ? cnt : 1u;
}

__device__ __forceinline__ void xcd_barrier(const XcdBarrier& b) {
    asm volatile("s_waitcnt vmcnt(0)" ::: "memory");
    __syncthreads();
    if (threadIdx.x == 0) {
        unsigned* bar = b.bar;
        __builtin_amdgcn_s_waitcnt(0);
        unsigned nloc = b.st[0], nx = b.st[1];
        if (nloc == 0u) { xcd_barrier_complete(bar, b.x, nloc, nx); b.st[0] = nloc; b.st[1] = nx; }
        const unsigned old = xb_add(&bar[XB_XSUB(b.x)], 1u);
        const unsigned gen = old / nloc;
        if (old + 1u == (gen + 1u) * nloc) {
            __builtin_amdgcn_fence(__ATOMIC_RELEASE, "agent");
            asm volatile("s_waitcnt vmcnt(0)" ::: "memory");
            const unsigned og = xb_add(&bar[XB_TOP], 1u);
            const unsigned tg = og / nx;
            if (og + 1u == (tg + 1u) * nx) xb_add(&bar[XB_TOPGEN], 1u);
            else XB_SPIN(xb_ld(&bar[XB_TOPGEN]) == tg, bar);
            __builtin_amdgcn_fence(__ATOMIC_ACQUIRE, "agent");
            xb_add(&bar[XB_XGEN(b.x)], 1u);
            asm volatile("s_waitcnt vmcnt(0)" ::: "memory");
        } else {
            XB_SPIN(xb_ld(&bar[XB_XGEN(b.x)]) == gen, bar);
            __builtin_amdgcn_fence(__ATOMIC_ACQUIRE, "agent");
            asm volatile("s_waitcnt vmcnt(0)" ::: "memory");
        }
    }
    __syncthreads();
}
__device__ __forceinline__ void unpack16(const u32x4 a, const u32x4 b, float* v) {
#pragma unroll
    for (int i = 0; i < 4; ++i) { v[2 * i] = __uint_as_float(a[i] << 16); v[2 * i + 1] = __uint_as_float(a[i] & 0xffff0000u); v[8 + 2 * i] = __uint_as_float(b[i] << 16); v[8 + 2 * i + 1] = __uint_as_float(b[i] & 0xffff0000u); }
}
__device__ __forceinline__ void p3_post(ArgsP A, int tid) {
    unsigned char* ws = A->ws;
    const bf16* PROJ = (const bf16*)(ws + WS_PROJ); bf16* QA = (bf16*)(ws + WS_QA); bf16* KA = (bf16*)(ws + WS_KA);
    const float* rope = (const float*)(ws + WS_ROPE);
    for (int it = blockIdx.x * NT + tid; it < MTOK * 64; it += gridDim.x * NT) {
        const int r = it >> 6, cg16 = it & 63;
        const int pos = (r < MP) ? r : PAST + ((r - MP) & 15);
        const bf16* pr = PROJ + (size_t)r * NINP + 16 * cg16;
        float q[16], k[16], v[16];
        unpack16(*(const u32x4*)(pr + C_QA), *(const u32x4*)(pr + C_QA + 8), q);
        unpack16(*(const u32x4*)(pr + C_KA), *(const u32x4*)(pr + C_KA + 8), k);
        unpack16(*(const u32x4*)(pr + C_VA), *(const u32x4*)(pr + C_VA + 8), v);
        if ((cg16 & 3) == 0) {
            const float* tb = rope + (size_t)pos * 16;
#pragma unroll
            for (int i = 0; i < 8; ++i) { const float c = tb[i], s = tb[8 + i];
                const float q1 = q[i], q2 = q[8 + i]; q[i] = q1 * c - q2 * s; q[8 + i] = q2 * c + q1 * s;
                const float k1 = k[i], k2 = k[8 + i]; k[i] = k1 * c - k2 * s; k[8 + i] = k2 * c + k1 * s; }
        }
        u32x4 o0, o1;
#pragma unroll
        for (int i = 0; i < 4; ++i) { o0[i] = pk2(q[2 * i] * QSCALE, q[2 * i + 1] * QSCALE); o1[i] = pk2(q[8 + 2 * i] * QSCALE, q[8 + 2 * i + 1] * QSCALE); }
        *(u32x4*)(QA + (size_t)r * 1024 + 16 * cg16) = o0; *(u32x4*)(QA + (size_t)r * 1024 + 16 * cg16 + 8) = o1;
#pragma unroll
        for (int i = 0; i < 4; ++i) { o0[i] = pk2(k[2 * i], k[2 * i + 1]); o1[i] = pk2(k[8 + 2 * i], k[8 + 2 * i + 1]); }
        *(u32x4*)(KA + (size_t)r * 1024 + 16 * cg16) = o0; *(u32x4*)(KA + (size_t)r * 1024 + 16 * cg16 + 8) = o1;
        float* ko = A->out + ((r < MP) ? O_KP + (size_t)r * 1024 : O_KS + (size_t)(r - MP) * 1024) + 16 * cg16;
        float* vo = A->out + ((r < MP) ? O_VP + (size_t)r * 1024 : O_VS + (size_t)(r - MP) * 1024) + 16 * cg16;
#pragma unroll
        for (int i = 0; i < 4; ++i) { *(f32x4*)(ko + 4 * i) = (f32x4){k[4 * i], k[4 * i + 1], k[4 * i + 2], k[4 * i + 3]}; *(f32x4*)(vo + 4 * i) = (f32x4){v[4 * i], v[4 * i + 1], v[4 * i + 2], v[4 * i + 3]}; }
    }
    for (int it = blockIdx.x * NT + tid; it < 33 * 3 * 2048; it += gridDim.x * NT) {
        const int ch = it & 2047, j = (it >> 11) % 3, sq = it / (3 * 2048);
        const int r = (sq == 0) ? (MP - 3 + j) : (MP + 16 * (sq - 1) + 13 + j);
        const float val = bf2f(PROJ[(size_t)r * NINP + C_QM + ch]);
        if (sq == 0) A->out[O_CVP + (size_t)j * 2048 + ch] = val; else A->out[O_CVS + ((size_t)(sq - 1) * 3 + j) * 2048 + ch] = val;
    }
}
typedef short v4i16_t __attribute__((ext_vector_type(4)));
__device__ __forceinline__ s16x4 tr_rd(LAS const unsigned char* p) { return __builtin_bit_cast(s16x4, __builtin_amdgcn_ds_read_tr16_b64_v4i16((LAS v4i16_t*)p)); }
__device__ __forceinline__ bf16x8 mk8(s16x4 a, s16x4 b) { return (bf16x8){a[0], a[1], a[2], a[3], b[0], b[1], b[2], b[3]}; }
__device__ __forceinline__ int tr_off(int pitch, int krow, int colbase, int lane) { return (krow + ((lane & 15) >> 2)) * pitch + (colbase + 16 * ((lane >> 4) & 1) + 4 * (lane & 3)) * 2; }
__device__ __forceinline__ void unpack8(const u32x4 a, float* v) {
#pragma unroll
    for (int i = 0; i < 4; ++i) { v[2 * i] = __uint_as_float(a[i] << 16); v[2 * i + 1] = __uint_as_float(a[i] & 0xffff0000u); }
}
__device__ __forceinline__ int unit_row0(int u) { return (u < 128) ? 64 * u : MP + 16 * (u - 128); }
__device__ __forceinline__ void conv8(const bf16* PROJ, const float* __restrict__ stconv, const float* __restrict__ wconv, const float* __restrict__ bconv, int u, int s, int ch0, float* o) {
    const int r0 = unit_row0(u);
    f32x4 a0 = *(const f32x4*)(bconv + ch0), a1 = *(const f32x4*)(bconv + ch0 + 4);
#pragma unroll
    for (int j = 0; j < 4; ++j) { const int tau = s - 3 + j; float x[8];
        if (tau >= 0 || (u > 0 && u < 128)) unpack8(*(const u32x4*)(PROJ + (size_t)(r0 + tau) * NINP + C_QM + ch0), x);
        else if (u >= 128) { const float* p = stconv + ((size_t)(u - 128) * 3 + (3 + tau)) * 2048 + ch0; const f32x4 y0 = *(const f32x4*)p, y1 = *(const f32x4*)(p + 4);
            x[0] = y0[0]; x[1] = y0[1]; x[2] = y0[2]; x[3] = y0[3]; x[4] = y1[0]; x[5] = y1[1]; x[6] = y1[2]; x[7] = y1[3]; }
        else {
#pragma unroll
            for (int i = 0; i < 8; ++i) x[i] = 0.f; }
        const f32x4 w0 = *(const f32x4*)(wconv + j * 2048 + ch0), w1 = *(const f32x4*)(wconv + j * 2048 + ch0 + 4);
        a0 += (f32x4){x[0], x[1], x[2], x[3]} * w0; a1 += (f32x4){x[4], x[5], x[6], x[7]} * w1; }
#pragma unroll
    for (int i = 0; i < 4; ++i) { o[i] = silu_f(a0[i]); o[4 + i] = silu_f(a1[i]); }
}
__device__ __forceinline__ u32x4 pack8(const float* v, float sc) { u32x4 o; o.x = pk2(v[0] * sc, v[1] * sc); o.y = pk2(v[2] * sc, v[3] * sc); o.z = pk2(v[4] * sc, v[5] * sc); o.w = pk2(v[6] * sc, v[7] * sc); return o; }
__device__ __forceinline__ float logsigmoid_f(float f) { return fminf(f, 0.f) - log1pf(__expf(-fabsf(f))); }
__device__ __forceinline__ void load_gates(const bf16* PROJ, const float* bi, const float* bfg, int u, int h, int t, float& ig, float& lf) {
    const int L = (u < 128) ? 64 : 16; const int r = unit_row0(u) + t;
    ig = -INFINITY; lf = 0.f;
    if (t < L) { ig = bf2f(PROJ[(size_t)r * NINP + C_IG + h]) + bi[h]; lf = logsigmoid_f(bf2f(PROJ[(size_t)r * NINP + C_FG + h]) + bfg[h]); }
}
__device__ __forceinline__ float scan_add(float v, int lane) {
#pragma unroll
    for (int o = 1; o < 64; o <<= 1) { const float x = lane_get(v, lane - o); if (lane >= o) v += x; }
    return v;
}
__device__ __forceinline__ float scan_max(float v, int lane) {
#pragma unroll
    for (int o = 1; o < 64; o <<= 1) { const float x = lane_get(v, lane - o); if (lane >= o) v = fmaxf(v, x); }
    return v;
}
constexpr int MA_K = 0, MA_V = 36864, MA_W = 73728;
constexpr int PK = 576;
__device__ __forceinline__ void mlstm_phaseA(ArgsP A, LAS unsigned char* lds, int u, int h, int tid, int wave, int lane) {
    unsigned char* ws = A->ws; const bf16* PROJ = (const bf16*)(ws + WS_PROJ);
    float* SC = (float*)(ws + WS_SCAL);
    LAS float* wl = (LAS float*)(lds + MA_W);
    const int L = (u < 128) ? 64 : 16, r0 = unit_row0(u);
    if (wave == 0) {
        float ig, lf; load_gates(PROJ, A->in[21], A->in[22], u, h, lane, ig, lf);
        const float b = scan_add(lf, lane); const float G = lane_get(b, 63);
        const float uu = (lane < L) ? G - b + ig : -INFINITY; const float mloc = wave_max(uu, lane);
        wl[lane] = (lane < L) ? __expf(uu - mloc) : 0.f;
        if (lane == 0) { SC[u * 4 + h] = G; SC[640 + u * 4 + h] = mloc; }
    }
    { const int s = tid >> 3, dg = tid & 7;
#pragma unroll
      for (int i = 0; i < 4; ++i) { const int c8 = 32 * dg + 8 * i; u32x4 ko = {0u, 0u, 0u, 0u};
          if (s < L) { float k[8]; conv8(PROJ, A->in[4], A->in[19], A->in[20], u, s, 1024 + h * 256 + c8, k); ko = pack8(k, 0.0625f); }
          *(LAS u32x4*)(lds + MA_K + s * PK + c8 * 2) = ko; }
      __syncthreads();
      const float wsv = wl[s];
#pragma unroll
      for (int i = 0; i < 4; ++i) { const int c8 = 32 * dg + 8 * i; u32x4 vo = {0u, 0u, 0u, 0u};
          if (s < L) { float v[8]; unpack8(*(const u32x4*)(PROJ + (size_t)(r0 + s) * NINP + C_VM + h * 256 + c8), v); vo = pack8(v, wsv); }
          *(LAS u32x4*)(lds + MA_V + s * PK + c8 * 2) = vo; } }
    __syncthreads();
    { const int i32 = lane & 31, hi = lane >> 5, eb = wave;
      bf16x8 af[4];
#pragma unroll
      for (int ks = 0; ks < 4; ++ks) { const int o = tr_off(PK, 16 * ks + 8 * hi, 32 * eb, lane); af[ks] = mk8(tr_rd(lds + MA_V + o), tr_rd(lds + MA_V + o + 4 * PK)); }
      bf16* dC = (bf16*)(ws + WS_DC) + ((size_t)(u * 4 + h) * 256 + 32 * eb + i32) * 256 + 4 * hi;
      for (int db = 0; db < 8; ++db) { f32x16 acc = {};
#pragma unroll
          for (int ks = 0; ks < 4; ++ks) { const int o = tr_off(PK, 16 * ks + 8 * hi, 32 * db, lane); const bf16x8 bfr = mk8(tr_rd(lds + MA_K + o), tr_rd(lds + MA_K + o + 4 * PK));
              acc = __builtin_amdgcn_mfma_f32_32x32x16_bf16(bfr, af[ks], acc, 0, 0, 0); }
#pragma unroll
          for (int g4 = 0; g4 < 4; ++g4) { u32x2 o; o.x = pk2(acc[4 * g4], acc[4 * g4 + 1]); o.y = pk2(acc[4 * g4 + 2], acc[4 * g4 + 3]); *(u32x2*)(dC + 32 * db + 8 * g4) = o; } } }
    if (tid < 256) { float a = 0.f;
        for (int s = 0; s < 64; ++s) a += wl[s] * bf2f(*(LAS const unsigned short*)(lds + MA_K + s * PK + tid * 2));
        ((float*)(ws + WS_DN))[(size_t)(u * 4 + h) * 256 + tid] = a; }
    __syncthreads();
}
__device__ __forceinline__ void mlstm_phaseB(ArgsP A, LAS unsigned char* lds, int tid, int wave, int lane) {
    unsigned char* ws = A->ws; const float* SC = (const float*)(ws + WS_SCAL); float* MPREV = (float*)(ws + WS_SCAL) + 1280;
    const bf16* DC = (const bf16*)(ws + WS_DC); bf16* CP = (bf16*)(ws + WS_CPREV); const float* DN = (const float*)(ws + WS_DN); float* NP = (float*)(ws + WS_NPREV);
    const int gid = blockIdx.x * NT + tid, gsz = gridDim.x * NT;
    LAS float* AL = (LAS float*)lds; LAS float* BE = AL + 512;
    if (wave < 4) { const int h = wave; const float g0 = SC[lane * 4 + h], g1 = SC[(64 + lane) * 4 + h], l0 = SC[640 + lane * 4 + h], l1 = SC[640 + (64 + lane) * 4 + h];
        float m = 0.f;
        for (int c = 0; c < 128; ++c) { const float G = lane_get((c < 64) ? g0 : g1, c & 63), ml = lane_get((c < 64) ? l0 : l1, c & 63);
            const float mn = fmaxf(G + m, ml);
            if (lane == 0) { AL[h * 128 + c] = __expf(G + m - mn); BE[h * 128 + c] = __expf(ml - mn); if (blockIdx.x == 0) MPREV[c * 4 + h] = m; }
            m = mn; }
        if (blockIdx.x == 0 && lane == 0) A->out[O_MPO + h] = m; }
    __syncthreads();
    for (int idx = gid; idx < 4 * 32768; idx += gsz) { const int h = idx >> 15, el = (idx & 32767) * 2;
        float c0 = 0.f, c1 = 0.f;
        for (int cb = 0; cb < 128; cb += 32) { unsigned d[32];
#pragma unroll
            for (int j = 0; j < 32; ++j) d[j] = *(const unsigned*)(DC + ((size_t)((cb + j) * 4 + h) << 16) + el);
#pragma unroll
            for (int j = 0; j < 32; ++j) { const int c = cb + j; const float al = AL[h * 128 + c], be = BE[h * 128 + c];
                *(unsigned*)(CP + ((size_t)(c * 4 + h) << 16) + el) = pk2(c0, c1);
                c0 = al * c0 + be * __uint_as_float(d[j] << 16); c1 = al * c1 + be * __uint_as_float(d[j] & 0xffff0000u); } }
        *(f32x2_t*)(A->out + O_CP + ((size_t)h << 16) + el) = (f32x2_t){c0, c1}; }
    for (int idx = gid; idx < 4 * 256; idx += gsz) { const int h = idx >> 8, d = idx & 255; float n = 0.f;
        for (int cb = 0; cb < 128; cb += 32) { float dn[32];
#pragma unroll
            for (int j = 0; j < 32; ++j) dn[j] = DN[(size_t)((cb + j) * 4 + h) * 256 + d];
#pragma unroll
            for (int j = 0; j < 32; ++j) { const int c = cb + j; NP[(size_t)(c * 4 + h) * 256 + d] = n; n = AL[h * 128 + c] * n + BE[h * 128 + c] * dn[j]; } }
        A->out[O_NP + h * 256 + d] = n; }
    const float* C0 = A->in[5]; const float* N0 = A->in[6]; const float* M0 = A->in[7];
    for (int i0 = gid; i0 < 128 * 32768; i0 += 8 * gsz) {
        f32x2_t c[8]; unsigned d[8]; float m[8], G[8], ml[8];
#pragma unroll
        for (int k = 0; k < 8; ++k) { const int idx = i0 + k * gsz; if (idx < 128 * 32768) { const int bh = idx >> 15, el = (idx & 32767) * 2, ui = (128 + (bh >> 2)) * 4 + (bh & 3);
            m[k] = M0[bh]; G[k] = SC[ui]; ml[k] = SC[640 + ui]; c[k] = *(const f32x2_t*)(C0 + ((size_t)bh << 16) + el); d[k] = *(const unsigned*)(DC + ((size_t)ui << 16) + el); } }
#pragma unroll
        for (int k = 0; k < 8; ++k) { const int idx = i0 + k * gsz; if (idx < 128 * 32768) { const int bh = idx >> 15, el = (idx & 32767) * 2, ui = (128 + (bh >> 2)) * 4 + (bh & 3);
            const float mn = fmaxf(G[k] + m[k], ml[k]); const float al = __expf(G[k] + m[k] - mn), be = __expf(ml[k] - mn);
            *(unsigned*)(CP + ((size_t)ui << 16) + el) = pk2(c[k].x, c[k].y);
            *(f32x2_t*)(A->out + O_CS + ((size_t)bh << 16) + el) = (f32x2_t){al * c[k].x + be * __uint_as_float(d[k] << 16), al * c[k].y + be * __uint_as_float(d[k] & 0xffff0000u)};
            if (el == 0) { MPREV[ui] = m[k]; A->out[O_MSO + bh] = mn; } } } }
    for (int idx = gid; idx < 128 * 256; idx += gsz) { const int bh = idx >> 8, d = idx & 255, ui = (128 + (bh >> 2)) * 4 + (bh & 3);
        const float m = M0[bh], G = SC[ui], ml = SC[640 + ui]; const float mn = fmaxf(G + m, ml); const float al = __expf(G + m - mn), be = __expf(ml - mn);
        const float n = N0[idx]; NP[(size_t)ui * 256 + d] = n; A->out[O_NS + idx] = al * n + be * DN[(size_t)ui * 256 + d]; }
}
constexpr int MC_Q = 0, MC_K = 33792, MC_V = 67584, MC_S = 104448, MC_F = 113664;
constexpr int PQ = 528, PS = 144;
__device__ __forceinline__ void mlstm_phaseC(ArgsP A, LAS unsigned char* lds, int u, int h, int tid, int wave, int lane) {
    unsigned char* ws = A->ws; const bf16* PROJ = (const bf16*)(ws + WS_PROJ);
    const int L = (u < 128) ? 64 : 16, r0 = unit_row0(u), uh = u * 4 + h;
    LAS float* F = (LAS float*)(lds + MC_F);
    LAS float* rt = F, *gg = F + 64, *winter = F + 128, *eden = F + 192, *nq = F + 256, *denp = F + 320, *ssq = F + 448;
    const int i32 = lane & 31, hi = lane >> 5;
    if (wave == 0) {
        float ig, lf; load_gates(PROJ, A->in[21], A->in[22], u, h, lane, ig, lf);
        const float b = scan_add(lf, lane); const float g = (lane < L) ? ig - b : -INFINITY; const float cm = scan_max(g, lane);
        const float mprev = ((const float*)(ws + WS_SCAL))[1280 + uh]; const float mx = fmaxf(mprev, cm);
        rt[lane] = -mx; gg[lane] = g; winter[lane] = __expf(mprev - mx); eden[lane] = __expf(-(b + mx));
    }
    { const int s = tid >> 3, dg = tid & 7;
#pragma unroll
      for (int i = 0; i < 4; ++i) { const int c8 = 32 * dg + 8 * i; u32x4 qo = {0u, 0u, 0u, 0u}, ko = qo, vo = qo;
          if (s < L) { float t8[8]; conv8(PROJ, A->in[4], A->in[19], A->in[20], u, s, h * 256 + c8, t8); qo = pack8(t8, 1.f);
              conv8(PROJ, A->in[4], A->in[19], A->in[20], u, s, 1024 + h * 256 + c8, t8); ko = pack8(t8, 0.0625f);
              vo = *(const u32x4*)(PROJ + (size_t)(r0 + s) * NINP + C_VM + h * 256 + c8); }
          *(LAS u32x4*)(lds + MC_Q + s * PQ + c8 * 2) = qo; *(LAS u32x4*)(lds + MC_K + s * PQ + c8 * 2) = ko; *(LAS u32x4*)(lds + MC_V + s * PK + c8 * 2) = vo; } }
    bf16x8 ca[16];
    { const bf16* Cp = (const bf16*)(ws + WS_CPREV) + ((size_t)uh * 256 + 32 * wave + i32) * 256 + 8 * hi;
#pragma unroll
      for (int kk = 0; kk < 16; ++kk) ca[kk] = *(const bf16x8*)(Cp + 16 * kk); }
    __syncthreads();
    if (wave < 3) {
        const int tt = (wave > 0) ? 1 : 0, st = (wave == 2) ? 1 : 0;
        f32x16 acc = {};
#pragma unroll 4
        for (int kk = 0; kk < 16; ++kk) { const bf16x8 a = *(LAS const bf16x8*)(lds + MC_K + (32 * st + i32) * PQ + (16 * kk + 8 * hi) * 2), b = *(LAS const bf16x8*)(lds + MC_Q + (32 * tt + i32) * PQ + (16 * kk + 8 * hi) * 2);
            acc = __builtin_amdgcn_mfma_f32_32x32x16_bf16(a, b, acc, 0, 0, 0); }
        const int t = 32 * tt + i32; const float rtt = rt[t]; float rs = 0.f;
#pragma unroll
        for (int g4 = 0; g4 < 4; ++g4) { const int s0 = 32 * st + 8 * g4 + 4 * hi; float v[4];
#pragma unroll
            for (int j = 0; j < 4; ++j) { const int s = s0 + j; const float e = __expf(rtt + gg[s]) * acc[4 * g4 + j]; v[j] = (s <= t) ? e : 0.f; rs += v[j]; }
            u32x2 o; o.x = pk2(v[0], v[1]); o.y = pk2(v[2], v[3]); *(LAS u32x2*)(lds + MC_S + t * PS + s0 * 2) = o; }
        rs = xhalf_sum(rs);
        if (hi == 0) { denp[st * 64 + t] = rs; if (wave == 0) denp[64 + t] = 0.f; }
    } else if (wave == 3) {
        const float* np = (const float*)(ws + WS_NPREV) + (size_t)uh * 256 + 8 * hi;
#pragma unroll
        for (int tt = 0; tt < 2; ++tt) { f32x16 acc = {};
#pragma unroll 4
            for (int kk = 0; kk < 16; ++kk) { u32x4 aw = {0u, 0u, 0u, 0u};
                if (i32 == 0) { const f32x4 n0 = *(const f32x4*)(np + 16 * kk), n1 = *(const f32x4*)(np + 16 * kk + 4); aw.x = pk2(n0[0], n0[1]); aw.y = pk2(n0[2], n0[3]); aw.z = pk2(n1[0], n1[1]); aw.w = pk2(n1[2], n1[3]); }
                const bf16x8 b = *(LAS const bf16x8*)(lds + MC_Q + (32 * tt + i32) * PQ + (16 * kk + 8 * hi) * 2);
                acc = __builtin_amdgcn_mfma_f32_32x32x16_bf16(__builtin_bit_cast(bf16x8, aw), b, acc, 0, 0, 0); }
            if (hi == 0) nq[32 * tt + i32] = acc[0]; }
    }
    __syncthreads();
    const int eb = wave, ntt = (L > 32) ? 2 : 1;
    bf16x8 va[4];
#pragma unroll
    for (int ks = 0; ks < 4; ++ks) { const int o = tr_off(PK, 16 * ks + 8 * hi, 32 * eb, lane); va[ks] = mk8(tr_rd(lds + MC_V + o), tr_rd(lds + MC_V + o + 4 * PK)); }
    f32x16 hv[2];
#pragma unroll
    for (int tt = 0; tt < 2; ++tt) { f32x16 acc = {};
        if (tt < ntt) { const int t = 32 * tt + i32;
#pragma unroll
            for (int kk = 0; kk < 16; ++kk) { const bf16x8 b = *(LAS const bf16x8*)(lds + MC_Q + t * PQ + (16 * kk + 8 * hi) * 2);
                acc = __builtin_amdgcn_mfma_f32_32x32x16_bf16(ca[kk], b, acc, 0, 0, 0); }
            const float wi = winter[t];
#pragma unroll
            for (int r = 0; r < 16; ++r) acc[r] *= wi;
#pragma unroll
            for (int ks = 0; ks < 4; ++ks) if (ks < 2 * (tt + 1)) { const bf16x8 b = *(LAS const bf16x8*)(lds + MC_S + t * PS + (16 * ks + 8 * hi) * 2);
                acc = __builtin_amdgcn_mfma_f32_32x32x16_bf16(va[ks], b, acc, 0, 0, 0); }
            const float den = wi * nq[t] + denp[t] + denp[64 + t]; const float inv = 1.f / fmaxf(fabsf(den), eden[t]); float sq = 0.f;
#pragma unroll
            for (int r = 0; r < 16; ++r) { acc[r] *= inv; sq += acc[r] * acc[r]; }
            sq = xhalf_sum(sq); if (hi == 0) ssq[wave * 64 + t] = sq; }
        hv[tt] = acc; }
    __syncthreads();
    bf16* MIX = (bf16*)(ws + WS_MIX); const float* gm = A->in[23] + h * 256;
#pragma unroll
    for (int tt = 0; tt < 2; ++tt) if (tt < ntt) { const int t = 32 * tt + i32;
        if (t < L) { float tot = 0.f;
#pragma unroll
            for (int w = 0; w < 8; ++w) tot += ssq[w * 64 + t];
            const float rstd = 1.f / sqrtf(tot * (1.f / 256.f) + EPS); const size_t row = (size_t)(r0 + t);
#pragma unroll
            for (int g4 = 0; g4 < 4; ++g4) { const int e = 32 * eb + 8 * g4 + 4 * hi; const f32x4 g = *(const f32x4*)(gm + e);
                const u32x2 ov = *(const u32x2*)(PROJ + row * NINP + C_OM + h * 256 + e);
                const float o0 = sigmoid_f(__uint_as_float(ov.x << 16)), o1 = sigmoid_f(__uint_as_float(ov.x & 0xffff0000u)), o2 = sigmoid_f(__uint_as_float(ov.y << 16)), o3 = sigmoid_f(__uint_as_float(ov.y & 0xffff0000u));
                u32x2 w; w.x = pk2(hv[tt][4 * g4] * rstd * g[0] * o0, hv[tt][4 * g4 + 1] * rstd * g[1] * o1); w.y = pk2(hv[tt][4 * g4 + 2] * rstd * g[2] * o2, hv[tt][4 * g4 + 3] * rstd * g[3] * o3);
                *(u32x2*)(MIX + row * DM + 1024 + h * 256 + e) = w; } } }
    __syncthreads();
}
constexpr int AT_PKT = 272, AT_PVT = 320, AT_V = 17408, AT_BUF = 37888;
struct AttnState { f32x16 o[4]; bf16x8 pf[4]; float m, l; };
__device__ __forceinline__ float xhalf_max(float v) { auto rr = __builtin_amdgcn_permlane32_swap(__float_as_uint(v), __float_as_uint(v), false, false); return fmaxf(__uint_as_float(rr[0]), __uint_as_float(rr[1])); }
constexpr float ATT_THR = 6.0f;
__device__ __forceinline__ void attn_qk(LAS const unsigned char* kt, int map, const bf16x8 (&qf)[4], const AttnState& S, f32x16 (&p)[2], int lane) {
    const int i32 = lane & 31, hi = lane >> 5;
#pragma unroll
    for (int kb = 0; kb < 2; ++kb) { f32x16 acc = {};
#pragma unroll
        for (int d0 = 0; d0 < 4; ++d0) { const bf16x8 a = *(LAS const bf16x8*)(kt + (32 * kb + i32) * AT_PKT + (64 * map + 16 * d0 + 8 * hi) * 2);
            acc = __builtin_amdgcn_mfma_f32_32x32x16_bf16(a, qf[d0], acc, 0, 0, 0); }
        p[kb] = acc; }
}
__device__ __forceinline__ void attn_pv(LAS const unsigned char* vt, AttnState& S, int lane) {
    const int hi = lane >> 5;
    LAS const unsigned char* base = vt + tr_off(AT_PVT, 4 * hi, 0, lane);
#pragma unroll
    for (int st = 0; st < 4; ++st) { s16x4 lo[4], hh[4];
#pragma unroll
        for (int eb = 0; eb < 4; ++eb) { lo[eb] = tr_rd(base + st * 16 * AT_PVT + eb * 64); hh[eb] = tr_rd(base + st * 16 * AT_PVT + eb * 64 + 8 * AT_PVT); }
#pragma unroll
        for (int eb = 0; eb < 4; ++eb) S.o[eb] = __builtin_amdgcn_mfma_f32_32x32x16_bf16(mk8(lo[eb], hh[eb]), S.pf[st], S.o[eb], 0, 0, 0);
    }
}
__device__ __forceinline__ void attn_softmax(f32x16 (&p)[2], AttnState& S, int nvalid, int lane) {
    const int hi = lane >> 5;
    if (nvalid < 64) {
#pragma unroll
        for (int kb = 0; kb < 2; ++kb)
#pragma unroll
            for (int r = 0; r < 16; ++r) if (32 * kb + crow(r, hi) >= nvalid) p[kb][r] = -INFINITY; }
    float ma = fmaxf(fmaxf(p[0][0], p[0][1]), p[1][0]), mb = fmaxf(fmaxf(p[0][2], p[0][3]), p[1][1]);
    ma = fmaxf(fmaxf(ma, p[1][2]), p[1][3]);
#pragma unroll
    for (int r = 4; r < 16; r += 4) { ma = fmaxf(fmaxf(ma, p[0][r]), p[0][r + 1]); mb = fmaxf(fmaxf(mb, p[0][r + 2]), p[0][r + 3]); ma = fmaxf(fmaxf(ma, p[1][r]), p[1][r + 1]); mb = fmaxf(fmaxf(mb, p[1][r + 2]), p[1][r + 3]); }
    const float mref = S.m; const float mx = xhalf_max(fmaxf(ma, mb)) - mref;
#pragma unroll
    for (int kb = 0; kb < 2; ++kb)
#pragma unroll
        for (int r = 0; r < 16; ++r) p[kb][r] = __builtin_amdgcn_exp2f(p[kb][r] - mref);
    if (__any(mx > ATT_THR)) {
        const float dl = fmaxf(mx, 0.f); S.m += dl;
        const float f = __builtin_amdgcn_exp2f(-dl); S.l *= f;
#pragma unroll
        for (int kb = 0; kb < 2; ++kb)
#pragma unroll
            for (int r = 0; r < 16; ++r) p[kb][r] *= f;
#pragma unroll
        for (int eb = 0; eb < 4; ++eb)
#pragma unroll
            for (int r = 0; r < 16; ++r) S.o[eb][r] *= f;
    }
    float sa = 0.f, sb = 0.f;
#pragma unroll
    for (int kb = 0; kb < 2; ++kb)
#pragma unroll
        for (int r = 0; r < 16; r += 2) { sa += p[kb][r]; sb += p[kb][r + 1]; }
    S.l += sa + sb;
#pragma unroll
    for (int kb = 0; kb < 2; ++kb)
#pragma unroll
        for (int ks = 0; ks < 2; ++ks) { u32x4 pw; pw.x = pk2(p[kb][8 * ks], p[kb][8 * ks + 1]); pw.y = pk2(p[kb][8 * ks + 2], p[kb][8 * ks + 3]); pw.z = pk2(p[kb][8 * ks + 4], p[kb][8 * ks + 5]); pw.w = pk2(p[kb][8 * ks + 6], p[kb][8 * ks + 7]);
            S.pf[2 * kb + ks] = __builtin_bit_cast(bf16x8, pw); }
}
__device__ __forceinline__ void attn_step(LAS const unsigned char* ktn, LAS const unsigned char* vtc, int map, const bf16x8 (&qf)[4], AttnState& S, int lane) {
    const int i32 = lane & 31, hi = lane >> 5;
    f32x16 p[2];
    LAS const unsigned char* base = vtc + tr_off(AT_PVT, 4 * hi, 0, lane);
    s16x4 lo[2][4], hh[2][4];
#pragma unroll
    for (int eb = 0; eb < 4; ++eb) { lo[0][eb] = tr_rd(base + eb * 64); hh[0][eb] = tr_rd(base + eb * 64 + 8 * AT_PVT); }
#pragma unroll
    for (int kb = 0; kb < 2; ++kb) { f32x16 acc = {};
#pragma unroll
        for (int d0 = 0; d0 < 4; ++d0) { const bf16x8 a = *(LAS const bf16x8*)(ktn + (32 * kb + i32) * AT_PKT + (64 * map + 16 * d0 + 8 * hi) * 2);
            acc = __builtin_amdgcn_mfma_f32_32x32x16_bf16(a, qf[d0], acc, 0, 0, 0); }
        p[kb] = acc; }
    const float mref = S.m;
    __builtin_amdgcn_sched_barrier(0);
#pragma unroll
    for (int st = 0; st < 4; ++st) {
        if (st < 3) {
#pragma unroll
            for (int eb = 0; eb < 4; ++eb) { lo[(st + 1) & 1][eb] = tr_rd(base + (st + 1) * 16 * AT_PVT + eb * 64); hh[(st + 1) & 1][eb] = tr_rd(base + (st + 1) * 16 * AT_PVT + eb * 64 + 8 * AT_PVT); } }
        __builtin_amdgcn_sched_barrier(0);
#pragma unroll
        for (int eb = 0; eb < 4; ++eb) {
            S.o[eb] = __builtin_amdgcn_mfma_f32_32x32x16_bf16(mk8(lo[st & 1][eb], hh[st & 1][eb]), S.pf[st], S.o[eb], 0, 0, 0);
            const int e0 = 2 * (4 * st + eb);
            p[e0 >> 4][e0 & 15] = __builtin_amdgcn_exp2f(p[e0 >> 4][e0 & 15] - mref); p[e0 >> 4][(e0 & 15) + 1] = __builtin_amdgcn_exp2f(p[e0 >> 4][(e0 & 15) + 1] - mref);
            __builtin_amdgcn_sched_barrier(0);
        }
    }
    float ma = fmaxf(fmaxf(p[0][0], p[0][1]), p[1][0]), mb = fmaxf(fmaxf(p[0][2], p[0][3]), p[1][1]);
    ma = fmaxf(fmaxf(ma, p[1][2]), p[1][3]);
#pragma unroll
    for (int r = 4; r < 16; r += 4) { ma = fmaxf(fmaxf(ma, p[0][r]), p[0][r + 1]); mb = fmaxf(fmaxf(mb, p[0][r + 2]), p[0][r + 3]); ma = fmaxf(fmaxf(ma, p[1][r]), p[1][r + 1]); mb = fmaxf(fmaxf(mb, p[1][r + 2]), p[1][r + 3]); }
    const float emx = xhalf_max(fmaxf(ma, mb));
    if (__any(emx > 64.0f)) {
        const float dl = fmaxf(__builtin_amdgcn_logf(emx), 0.f);
        S.m += dl;
        const float f = __builtin_amdgcn_exp2f(-dl); S.l *= f;
#pragma unroll
        for (int kb = 0; kb < 2; ++kb)
#pragma unroll
            for (int r = 0; r < 16; ++r) p[kb][r] *= f;
#pragma unroll
        for (int eb = 0; eb < 4; ++eb)
#pragma unroll
            for (int r = 0; r < 16; ++r) S.o[eb][r] *= f;
    }
    float sa = 0.f, sb = 0.f;
#pragma unroll
    for (int kb = 0; kb < 2; ++kb)
#pragma unroll
        for (int r = 0; r < 16; r += 2) { sa += p[kb][r]; sb += p[kb][r + 1]; }
    S.l += sa + sb;
#pragma unroll
    for (int kb = 0; kb < 2; ++kb)
#pragma unroll
        for (int ks = 0; ks < 2; ++ks) { u32x4 pw; pw.x = pk2(p[kb][8 * ks], p[kb][8 * ks + 1]); pw.y = pk2(p[kb][8 * ks + 2], p[kb][8 * ks + 3]); pw.z = pk2(p[kb][8 * ks + 4], p[kb][8 * ks + 5]); pw.w = pk2(p[kb][8 * ks + 6], p[kb][8 * ks + 7]);
            S.pf[2 * kb + ks] = __builtin_bit_cast(bf16x8, pw); }
}
__device__ __forceinline__ void attn_tile(LAS const unsigned char* kt, LAS const unsigned char* vt, int map, const bf16x8 (&qf)[4], AttnState& S, int nvalid, int lane) {
    f32x16 p[2]; attn_qk(kt, map, qf, S, p, lane); attn_softmax(p, S, nvalid, lane); attn_pv(vt, S, lane);
}
__device__ __forceinline__ void attn_finish(ArgsP A, LAS unsigned char* lds, AttnState& S, int map, int g, int h, size_t row_base, int nrows, float lam, int lane) {
    const int i32 = lane & 31, hi = lane >> 5;
    const float lt = xhalf_sum(S.l); const float inv = 1.f / lt;
    LAS float* X = (LAS float*)lds + g * 4096;
    __syncthreads();
    if (map == 1) {
#pragma unroll
        for (int eb = 0; eb < 4; ++eb)
#pragma unroll
            for (int r = 0; r < 16; ++r) X[(32 * eb + crow(r, hi)) * 32 + i32] = S.o[eb][r] * inv; }
    __syncthreads();
    if (map == 0) { float sq = 0.f;
#pragma unroll
        for (int eb = 0; eb < 4; ++eb)
#pragma unroll
            for (int r = 0; r < 16; ++r) { const float v = S.o[eb][r] * inv - lam * X[(32 * eb + crow(r, hi)) * 32 + i32]; S.o[eb][r] = v; sq += v * v; }
        sq = xhalf_sum(sq);
        const float rstd = (1.f - LAM_INIT) / sqrtf(sq * (1.f / 128.f) + EPS);
        if (i32 < nrows) { bf16* mp = (bf16*)(A->ws + WS_MIX) + (row_base + i32) * DM + h * 128; const float* gs = A->in[18] + h * 128;
#pragma unroll
            for (int eb = 0; eb < 4; ++eb)
#pragma unroll
                for (int g4 = 0; g4 < 4; ++g4) { const int e = 32 * eb + 8 * g4 + 4 * hi; const f32x4 gv = *(const f32x4*)(gs + e);
                    u32x2 w; w.x = pk2(S.o[eb][4 * g4] * rstd * gv[0], S.o[eb][4 * g4 + 1] * rstd * gv[1]); w.y = pk2(S.o[eb][4 * g4 + 2] * rstd * gv[2], S.o[eb][4 * g4 + 3] * rstd * gv[3]);
                    *(u32x2*)(mp + e) = w; } } }
    __syncthreads();
}
__device__ __forceinline__ void attn_prompt_unit(ArgsP A, LAS unsigned char* lds, int h, int qb, float lam, int tid, int wave, int lane) {
    unsigned char* ws = A->ws; const bf16* QA = (const bf16*)(ws + WS_QA); const bf16* KA = (const bf16*)(ws + WS_KA); const bf16* PROJ = (const bf16*)(ws + WS_PROJ);
    const int map = wave & 1, g = wave >> 1, i32 = lane & 31, hi = lane >> 5;
    const int ntiles = 2 * qb + 2, mytiles = 2 * qb + (g >> 1) + 1;
    bf16x8 qf[4];
    { const bf16* qp = QA + (size_t)(128 * qb + 32 * g + i32) * 1024 + h * 128 + 64 * map + 8 * hi;
#pragma unroll
      for (int d0 = 0; d0 < 4; ++d0) qf[d0] = *(const bf16x8*)(qp + 16 * d0); }
    AttnState S; S.m = 0.f; S.l = 0.f;
#pragma unroll
    for (int i = 0; i < 4; ++i) S.pf[i] = (bf16x8){0, 0, 0, 0, 0, 0, 0, 0};
#pragma unroll
    for (int eb = 0; eb < 4; ++eb) S.o[eb] = (f32x16){};
    const int key = tid >> 3, seg = tid & 7;
    const bf16* kp = KA + (size_t)key * 1024 + h * 128 + 16 * seg; const bf16* vp = PROJ + (size_t)key * NINP + C_VA + h * 128 + 16 * seg;
    const int ko = key * AT_PKT + seg * 32, vo = AT_V + key * AT_PVT + seg * 32;
    { u32x4 k0 = *(const u32x4*)kp, k1 = *(const u32x4*)(kp + 8), v0 = *(const u32x4*)vp, v1 = *(const u32x4*)(vp + 8);
      const bf16* kq = kp + (size_t)64 * 1024; const bf16* vq = vp + (size_t)64 * NINP;
      u32x4 k2 = *(const u32x4*)kq, k3 = *(const u32x4*)(kq + 8), v2 = *(const u32x4*)vq, v3 = *(const u32x4*)(vq + 8);
      *(LAS u32x4*)(lds + ko) = k0; *(LAS u32x4*)(lds + ko + 16) = k1; *(LAS u32x4*)(lds + vo) = v0; *(LAS u32x4*)(lds + vo + 16) = v1;
      *(LAS u32x4*)(lds + AT_BUF + ko) = k2; *(LAS u32x4*)(lds + AT_BUF + ko + 16) = k3; *(LAS u32x4*)(lds + AT_BUF + vo) = v2; *(LAS u32x4*)(lds + AT_BUF + vo + 16) = v3; }
    __syncthreads();
    { f32x16 p[2]; attn_qk(lds, map, qf, S, p, lane); attn_softmax(p, S, 64, lane); }
    int bc = 0, bn = AT_BUF, bw = 2 * AT_BUF;
    for (int j = 0; j < ntiles; ++j) {
        const bool more = (j + 2 < ntiles);
        u32x4 k0, k1, v0, v1;
        if (more) { const bf16* kq = kp + (size_t)(j + 2) * 64 * 1024; const bf16* vq = vp + (size_t)(j + 2) * 64 * NINP;
            k0 = *(const u32x4*)kq; k1 = *(const u32x4*)(kq + 8); v0 = *(const u32x4*)vq; v1 = *(const u32x4*)(vq + 8); }
        if (j + 1 < mytiles) attn_step(lds + bn, lds + bc + AT_V, map, qf, S, lane);
        else if (j < mytiles) attn_pv(lds + bc + AT_V, S, lane);
        if (more) { LAS unsigned char* w = lds + bw; *(LAS u32x4*)(w + ko) = k0; *(LAS u32x4*)(w + ko + 16) = k1; *(LAS u32x4*)(w + vo) = v0; *(LAS u32x4*)(w + vo + 16) = v1; }
        __syncthreads();
        const int t = bc; bc = bn; bn = bw; bw = t;
    }
    attn_finish(A, lds, S, map, g, h, (size_t)(128 * qb + 32 * g), 32, lam, lane);
}
__device__ __forceinline__ void attn_sample_unit(ArgsP A, LAS unsigned char* lds, int b, int h, float lam, int tid, int wave, int lane) {
    unsigned char* ws = A->ws; const bf16* QA = (const bf16*)(ws + WS_QA); const bf16* KA = (const bf16*)(ws + WS_KA); const bf16* PROJ = (const bf16*)(ws + WS_PROJ);
    const int map = wave & 1, i32 = lane & 31, hi = lane >> 5; const bool comp = wave < 2;
    bf16x8 qf[4];
#pragma unroll
    for (int d0 = 0; d0 < 4; ++d0) qf[d0] = (bf16x8){0, 0, 0, 0, 0, 0, 0, 0};
    if (i32 < 16) { const bf16* qp = QA + (size_t)(MP + 16 * b + i32) * 1024 + h * 128 + 64 * map + 8 * hi;
#pragma unroll
      for (int d0 = 0; d0 < 4; ++d0) qf[d0] = *(const bf16x8*)(qp + 16 * d0); }
    AttnState S; S.m = 0.f; S.l = 0.f;
#pragma unroll
    for (int i = 0; i < 4; ++i) S.pf[i] = (bf16x8){0, 0, 0, 0, 0, 0, 0, 0};
#pragma unroll
    for (int eb = 0; eb < 4; ++eb) S.o[eb] = (f32x16){};
    const int key = tid >> 3, seg = tid & 7;
    const float* kc = A->in[2] + (((size_t)b * PAST + key) * 8 + h) * 128 + 16 * seg; const float* vc = A->in[3] + (((size_t)b * PAST + key) * 8 + h) * 128 + 16 * seg;
    const int ko = key * AT_PKT + seg * 32, vo = AT_V + key * AT_PVT + seg * 32;
    f32x4 kr[4], vr[4];
#pragma unroll
    for (int i = 0; i < 4; ++i) { kr[i] = *(const f32x4*)(kc + 4 * i); vr[i] = *(const f32x4*)(vc + 4 * i); }
    for (int j = 0; j < 17; ++j) {
        LAS unsigned char* nb = lds + (j & 1) * AT_BUF;
        if (j < 16) { u32x4 a, c;
            a.x = pk2(kr[0][0], kr[0][1]); a.y = pk2(kr[0][2], kr[0][3]); a.z = pk2(kr[1][0], kr[1][1]); a.w = pk2(kr[1][2], kr[1][3]);
            c.x = pk2(kr[2][0], kr[2][1]); c.y = pk2(kr[2][2], kr[2][3]); c.z = pk2(kr[3][0], kr[3][1]); c.w = pk2(kr[3][2], kr[3][3]);
            *(LAS u32x4*)(nb + ko) = a; *(LAS u32x4*)(nb + ko + 16) = c;
            a.x = pk2(vr[0][0], vr[0][1]); a.y = pk2(vr[0][2], vr[0][3]); a.z = pk2(vr[1][0], vr[1][1]); a.w = pk2(vr[1][2], vr[1][3]);
            c.x = pk2(vr[2][0], vr[2][1]); c.y = pk2(vr[2][2], vr[2][3]); c.z = pk2(vr[3][0], vr[3][1]); c.w = pk2(vr[3][2], vr[3][3]);
            *(LAS u32x4*)(nb + vo) = a; *(LAS u32x4*)(nb + vo + 16) = c;
        } else { u32x4 a = {0u, 0u, 0u, 0u}, c = a, d = a, e = a;
            if (key < 16) { const bf16* kq = KA + (size_t)(MP + 16 * b + key) * 1024 + h * 128 + 16 * seg; const bf16* vq = PROJ + (size_t)(MP + 16 * b + key) * NINP + C_VA + h * 128 + 16 * seg;
                a = *(const u32x4*)kq; c = *(const u32x4*)(kq + 8); d = *(const u32x4*)vq; e = *(const u32x4*)(vq + 8); }
            *(LAS u32x4*)(nb + ko) = a; *(LAS u32x4*)(nb + ko + 16) = c; *(LAS u32x4*)(nb + vo) = d; *(LAS u32x4*)(nb + vo + 16) = e; }
        if (j + 1 < 16) {
#pragma unroll
            for (int i = 0; i < 4; ++i) { kr[i] = *(const f32x4*)(kc + (size_t)(j + 1) * 64 * 1024 + 4 * i); vr[i] = *(const f32x4*)(vc + (size_t)(j + 1) * 64 * 1024 + 4 * i); } }
        __syncthreads();
        if (comp) attn_tile(nb, nb + AT_V, map, qf, S, (j < 16) ? 64 : 16, lane);
    }
    attn_finish(A, lds, S, comp ? map : 2, 0, h, (size_t)(MP + 16 * b), 16, lam, lane);
}
template <int NPART> __device__ __forceinline__ void final_norm_rows(float* y, const float* __restrict__ g, int wave, int lane, const float* x1S, const bf16* part, const float* gate) {
    const int gw = blockIdx.x * NW + wave, NGW = gridDim.x * NW;
    for (int r = gw; r < MTOK; r += NGW) { float* yr = y + (size_t)r * DM; f32x4 v[8]; float s = 0.f;
        if (r < MP) {
#pragma unroll
            for (int j = 0; j < 8; ++j) v[j] = *(const f32x4*)(yr + 256 * j + 4 * lane);
        } else {
            const float* gr = gate + (size_t)(1 + ((r - MP) >> 4)) * 12288;
#pragma unroll
            for (int j = 0; j < 8; ++j) { const int c = 256 * j + 4 * lane; f32x4 a = {0.f, 0.f, 0.f, 0.f};
                f32x4 t[NPART];
#pragma unroll
                for (int p = 0; p < NPART; ++p) t[p] = ld_bf4(part + ((size_t)p * MS + (r - MP)) * DM + c);
#pragma unroll
                for (int p = 0; p < NPART; ++p) a += t[p];
                v[j] = *(const f32x4*)(x1S + (size_t)(r - MP) * DM + c) + *(const f32x4*)(gr + c) * a; } }
#pragma unroll
        for (int j = 0; j < 8; ++j) s += (v[j].x * v[j].x + v[j].y * v[j].y) + (v[j].z * v[j].z + v[j].w * v[j].w);
        const float rstd = 1.f / sqrtf(wave_sum(s, lane) * (1.f / DM) + EPS);
#pragma unroll
        for (int j = 0; j < 8; ++j) { const f32x4 gg = *(const f32x4*)(g + 256 * j + 4 * lane); *(f32x4*)(yr + 256 * j + 4 * lane) = v[j] * rstd * gg; } }
}
__global__ void __launch_bounds__(NT, 2) fwd_megakernel(Args A_) {
    extern __shared__ __attribute__((aligned(16))) unsigned char lds_raw[];
    LAS unsigned char* lds = (LAS unsigned char*)lds_raw;
    cg::grid_group grid = cg::this_grid();
    int tid, lane, wave;
#define FRESH_TID() do { tid = threadIdx.x; asm volatile("" : "+v"(tid)); lane = tid & 63; wave = __builtin_amdgcn_readfirstlane(tid >> 6); } while (0)
    FRESH_TID();
    ArgsP A = FRESH_ARGS();
    unsigned char* ws = A->ws;
    float* mod = (float*)(ws + WS_MOD);
    const int G = gridDim.x, bid = blockIdx.x;
    A = FRESH_ARGS(); ws = A->ws; mod = (float*)(ws + WS_MOD); FRESH_TID();
    if (bid == 0) for (int i = tid; i < 8192; i += NT) ((unsigned*)(ws + WS_FLAG))[i] = 0u;
    if (tid < 2) ((volatile LAS unsigned*)(lds + LDS_BYTES - 16))[tid] = 0u;
#ifndef NO_P0
    p0_prologue(A, lds, tid, wave, lane);
#endif
    grid.sync();
    XcdBarrier xb = xcd_barrier_post((unsigned*)(ws + WS_FLAG) + 1024, (volatile LAS unsigned*)(lds + LDS_BYTES - 16));
    A = FRESH_ARGS(); ws = A->ws; mod = (float*)(ws + WS_MOD); FRESH_TID();
    norm_mod_rows<0>(A->in[0], A->in[1], A->in[12], mod, 0, 2048, (bf16*)(ws + WS_XN), wave, lane);
    xcd_barrier(xb);
    A = FRESH_ARGS(); ws = A->ws; mod = (float*)(ws + WS_MOD); FRESH_TID();
    { pg8::Gemm g{(const pg8::bf16_t*)(ws + WS_XN), (const pg8::bf16_t*)(ws + WS_WIN), MTOK, NINP, DM, DM}; pg8::StaticOrder S; S.init(MTOK, NINP, G, bid);
      pg8::EpiStore<0> E{(pg8::bf16_t*)(ws + WS_PROJ), NINP};
      pg8::gemm_phase<pg8::EpiStore<0>, pg8::StaticOrder, true, true>(lds, g, S, E); }
    xcd_barrier(xb);
    A = FRESH_ARGS(); ws = A->ws; mod = (float*)(ws + WS_MOD); FRESH_TID();
#ifndef NO_P3
    p3_post(A, tid);
#endif
#ifndef NO_PA
    for (int i = bid; i < NCH * 4; i += G) mlstm_phaseA(A, lds, i >> 2, i & 3, tid, wave, lane);
#endif
    xcd_barrier(xb);
    A = FRESH_ARGS(); ws = A->ws; mod = (float*)(ws + WS_MOD); FRESH_TID();
#ifndef NO_PB
    mlstm_phaseB(A, lds, tid, wave, lane);
#endif
    xcd_barrier(xb);
    A = FRESH_ARGS(); ws = A->ws; mod = (float*)(ws + WS_MOD); FRESH_TID();
    { const float s1 = wave_sum(A->in[14][lane] * A->in[15][lane], lane), s2 = wave_sum(A->in[16][lane] * A->in[17][lane], lane);
      const float lam = __expf(s1) - __expf(s2) + LAM_INIT;
      for (int i = bid; i < 256; i += G) { const int h = i & 7, p = i >> 3;
#ifndef NO_AP
          attn_prompt_unit(A, lds, h, 63 - p, lam, tid, wave, lane);
          attn_prompt_unit(A, lds, h, p, lam, tid, wave, lane);
#endif
#ifndef NO_AS
          attn_sample_unit(A, lds, i >> 3, i & 7, lam, tid, wave, lane);
#endif
      }
      FRESH_TID();
#ifndef NO_PC
      for (int i = bid; i < NCH * 4; i += G) mlstm_phaseC(A, lds, i >> 2, i & 3, tid, wave, lane);
#endif
    }
    xcd_barrier(xb);
    A = FRESH_ARGS(); ws = A->ws; mod = (float*)(ws + WS_MOD); FRESH_TID();
    { pg8::Gemm g{(const pg8::bf16_t*)(ws + WS_MIX), (const pg8::bf16_t*)(ws + WS_WOUT), MP, DM, DM, DM}; pg8::StaticOrder S; S.init(MP, DM, G, bid);
      pg8::EpiResid E{A->in[0], A->in[1], mod + 4096, (float*)(ws + WS_X1)};
      pg8::gemm_phase<pg8::EpiResid, pg8::StaticOrder, true, true>(lds, g, S, E); }
    for (int un = bid; un < 128; un += G) { const int tile = un >> 3, kc = un & 7;
      pg8::Gemm g{(const pg8::bf16_t*)(ws + WS_MIX) + 256 * kc, (const pg8::bf16_t*)(ws + WS_WOUT) + 256 * kc, MTOK, DM, 256, DM}; pg8::OneUnit S{{32 + (tile >> 3), tile & 7}};
      pg8::EpiPart E{(pg8::bf16_t*)(ws + WS_PART6) + (size_t)kc * MS * DM, DM};
      pg8::gemm_phase<pg8::EpiPart, pg8::OneUnit, false, true>(lds, g, S, E); }
    xcd_barrier(xb);
    A = FRESH_ARGS(); ws = A->ws; mod = (float*)(ws + WS_MOD); FRESH_TID();
    norm_mod_rows<8>((const float*)(ws + WS_X1), A->in[1], A->in[25], mod, 6144, 8192, (bf16*)(ws + WS_XN), wave, lane, (const bf16*)(ws + WS_PART6), 4096, (float*)(ws + WS_X1) + (size_t)MP * DM);
    xcd_barrier(xb);
    A = FRESH_ARGS(); ws = A->ws; mod = (float*)(ws + WS_MOD); FRESH_TID();
    { pg8::Gemm g{(const pg8::bf16_t*)(ws + WS_XN), (const pg8::bf16_t*)(ws + WS_WUP), MP, DFF, DM, DM}; pg8::StaticOrder S; S.init(MP, DFF, G, bid);
      pg8::EpiStore<2> E{(pg8::bf16_t*)(ws + WS_H), DFF};
      pg8::gemm_phase<pg8::EpiStore<2>, pg8::StaticOrder, true, true>(lds, g, S, E); }
    for (int un = bid; un < 256; un += G) { const int tile = un >> 2, kq = un & 3;
      pg8::Gemm g{(const pg8::bf16_t*)(ws + WS_XN) + 512 * kq, (const pg8::bf16_t*)(ws + WS_WUP) + 512 * kq, MTOK, DFF, 512, DM}; pg8::OneUnit S{{32 + (tile >> 5), tile & 31}};
      pg8::EpiPart E{(pg8::bf16_t*)(ws + WS_PART8) + (size_t)kq * MS * DFF, DFF};
      pg8::gemm_phase<pg8::EpiPart, pg8::OneUnit, false, true>(lds, g, S, E); }
    xcd_barrier(xb);
    A = FRESH_ARGS(); ws = A->ws; mod = (float*)(ws + WS_MOD); FRESH_TID();
    { const bf16* P8 = (const bf16*)(ws + WS_PART8); bf16* H = (bf16*)(ws + WS_H);
      for (int r = bid; r < MS; r += G)
          for (int c = 4 * tid; c < DFF; c += 4 * NT) { f32x4 a = ld_bf4(P8 + (size_t)r * DFF + c);
#pragma unroll
              for (int p = 1; p < 4; ++p) a += ld_bf4(P8 + ((size_t)p * MS + r) * DFF + c);
              a.x = fmaxf(a.x, 0.f); a.y = fmaxf(a.y, 0.f); a.z = fmaxf(a.z, 0.f); a.w = fmaxf(a.w, 0.f);
              u32x2 o; o.x = pk2(a.x * a.x, a.y * a.y); o.y = pk2(a.z * a.z, a.w * a.w); *(u32x2*)(H + (size_t)(MP + r) * DFF + c) = o; }
      __threadfence(); __syncthreads();
      if (tid == 0) __hip_atomic_fetch_add((unsigned*)(ws + WS_FLAG), 1u, __ATOMIC_RELEASE, __HIP_MEMORY_SCOPE_AGENT); }
    { pg8::Gemm g{(const pg8::bf16_t*)(ws + WS_H), (const pg8::bf16_t*)(ws + WS_WDN), MP, DM, DFF, DFF}; pg8::StaticOrder S; S.init(MP, DM, G, bid);
      pg8::EpiResid E{(const float*)(ws + WS_X1), (const float*)(ws + WS_X1) + (size_t)MP * DM, mod + 10240, A->out};
      pg8::gemm_phase<pg8::EpiResid, pg8::StaticOrder, true, true>(lds, g, S, E); }
    { if (tid == 0) { while (__hip_atomic_load((unsigned*)(ws + WS_FLAG), __ATOMIC_ACQUIRE, __HIP_MEMORY_SCOPE_AGENT) < (unsigned)G) __builtin_amdgcn_s_sleep(8); }
      __syncthreads(); __builtin_amdgcn_fence(__ATOMIC_ACQUIRE, "agent"); }
    for (int un = bid; un < 256; un += G) { const int tile = un >> 4, kc = un & 15;
      pg8::Gemm g{(const pg8::bf16_t*)(ws + WS_H) + 512 * kc, (const pg8::bf16_t*)(ws + WS_WDN) + 512 * kc, MTOK, DM, 512, DFF}; pg8::OneUnit S{{32 + (tile >> 3), tile & 7}};
      pg8::EpiPart E{(pg8::bf16_t*)(ws + WS_PART9) + (size_t)kc * MS * DM, DM};
      pg8::gemm_phase<pg8::EpiPart, pg8::OneUnit, false, true>(lds, g, S, E); }
    xcd_barrier(xb);
    A = FRESH_ARGS(); ws = A->ws; mod = (float*)(ws + WS_MOD); FRESH_TID();
    final_norm_rows<16>(A->out, A->in[28], wave, lane, (const float*)(ws + WS_X1) + (size_t)MP * DM, (const bf16*)(ws + WS_PART9), mod + 10240);
}

extern "C" void kernel_launch(void* const* d_in, const int* in_sizes, int n_in, void* d_out, int out_size, void* d_ws, size_t ws_size, hipStream_t stream) {
    static int grid = 0;
    if (grid == 0) {
        if (n_in != 29 || ws_size < WS_END) { fprintf(stderr, "kernel_launch: unexpected n_in %d / ws %zu\n", n_in, ws_size); grid = -1; return; }
        int dev = 0, cus = 0, per_cu = 0;
        (void)hipGetDevice(&dev); (void)hipDeviceGetAttribute(&cus, hipDeviceAttributeMultiprocessorCount, dev);
        (void)hipFuncSetAttribute((const void*)fwd_megakernel, hipFuncAttributeMaxDynamicSharedMemorySize, LDS_BYTES);
        (void)hipOccupancyMaxActiveBlocksPerMultiprocessor(&per_cu, (const void*)fwd_megakernel, NT, LDS_BYTES);
        (void)hipGetLastError();
        grid = cus;
    }
    if (grid < 0) return;
    Args a{};
    for (int i = 0; i < 29; ++i) a.in[i] = (const float*)d_in[i];
    a.out = (float*)d_out; a.ws = (unsigned char*)d_ws;
    void* args[] = {&a};
    hipError_t e = hipLaunchCooperativeKernel((void*)fwd_megakernel, dim3(grid), dim3(NT), args, LDS_BYTES, stream);
    if (e != hipSuccess) fprintf(stderr, "cooperative launch failed: %s (grid %d)\n", hipGetErrorString(e), grid);
}
```

```cpp
#include <hip/hip_runtime.h>
#include <hip/hip_cooperative_groups.h>
#include <cstdio>
#include <cstdint>
namespace cg = cooperative_groups;
namespace pg8 {
#define PG8_LAS __attribute__((address_space(3)))
typedef unsigned short bf16_t;
typedef short bf16x8 __attribute__((ext_vector_type(8)));
typedef float f32x4 __attribute__((ext_vector_type(4)));
typedef unsigned u32x4 __attribute__((ext_vector_type(4)));
constexpr int BM = 256, BK = 64, HALF = 128, HTB = HALF * BK * 2  , STAGE_BYTES = 8 * HTB, NXCD = 8, WGM = 8;

__host__ __device__ __forceinline__ int lds_byte(int r, int c) { const int st = (r >> 4) * 2 + (c >> 5), rr = r & 15, cc = c & 31, ob = rr * 64 + cc * 2; return st * 1024 + (ob ^ (((ob >> 9) & 1) << 5)); }
__host__ __device__ __forceinline__ void stage_rc(int b, int& R, int& C) { const int st = b / 1024, sb = b % 1024, swz = sb ^ (((sb >> 9) & 1) << 5); R = (st >> 1) * 16 + swz / 64; C = (st & 1) * 32 + (swz % 64) / 2; }
__host__ __device__ __forceinline__ int perm32(int rho) { const int n = rho >> 4, i = rho & 15; return 8 * (i >> 2) + 4 * n + (i & 3); }

struct Unit { int pm, pn; };
struct Gemm { const bf16_t* A; const bf16_t* Bt; int M, N, K, ld; };

struct StaticOrder {
    int nM, nN, nwg, G, c;
    __host__ __device__ void init(int M, int N, int G_, int c_) { nM = M / BM; nN = N / BM; nwg = nM * nN; G = G_; c = c_; }
    __host__ __device__ bool next(int i, Unit& u) const {
        const long L = (long)i * G + c; if (L >= nwg) return false;
        int wgid = (int)L; { const int q = nwg / NXCD, r = nwg % NXCD, xcd = wgid % NXCD, off = wgid / NXCD; wgid = (xcd < r ? xcd * (q + 1) : r * (q + 1) + (xcd - r) * q) + off; }
        const int nig = WGM * nN, gid = wgid / nig, fm = gid * WGM, gsz = (nM - fm) < WGM ? (nM - fm) : WGM;
        u.pm = fm + ((wgid % nig) % gsz); u.pn = (wgid % nig) / gsz; return true;
    }
    __device__ __forceinline__ void a_ready(const Unit&) const {}
    __device__ __forceinline__ void done(const Unit&) const {}
};

typedef float f32x2_t __attribute__((ext_vector_type(2)));
typedef __bf16 bf16x2_t __attribute__((ext_vector_type(2)));
__device__ __forceinline__ unsigned cvt_pk_bf16(float lo, float hi) { f32x2_t v = {lo, hi}; bf16x2_t b = __builtin_convertvector(v, bf16x2_t); return __builtin_bit_cast(unsigned, b); }
template <int ACT  > struct EpiStore {
    static constexpr bool PERM = true, AFTER_DRAIN = false;
    bf16_t* O; int ldc;
    __device__ __forceinline__ void operator()(const f32x4 (&acc)[2][2][4][2], const Unit& u, int wr, int wc, int fr, int fq) const {
        const int row0 = u.pm * BM + wr * 64 + fr; const int col0 = u.pn * BM + wc * 32 + 8 * fq;
#pragma unroll
        for (int ai = 0; ai < 2; ++ai)
#pragma unroll
            for (int m = 0; m < 4; ++m) { bf16_t* rowp = O + (size_t)(row0 + ai * HALF + m * 16) * ldc + col0;
#pragma unroll
                for (int bj = 0; bj < 2; ++bj) { f32x4 v0 = acc[ai][bj][m][0], v1 = acc[ai][bj][m][1];
                    if (ACT == 2) {
#pragma unroll
                        for (int j = 0; j < 4; ++j) { float a = fmaxf(v0[j], 0.f), b = fmaxf(v1[j], 0.f); v0[j] = a * a; v1[j] = b * b; } }
                    u32x4 w; w.x = cvt_pk_bf16(v0[0], v0[1]); w.y = cvt_pk_bf16(v0[2], v0[3]); w.z = cvt_pk_bf16(v1[0], v1[1]); w.w = cvt_pk_bf16(v1[2], v1[3]);
                    *(u32x4*)(rowp + bj * HALF) = w; } }
    }
};
struct EpiResid {
    static constexpr bool PERM = true, AFTER_DRAIN = false;
    const float* baseP; const float* baseS; const float* gate; float* out;
    __device__ __forceinline__ void operator()(const f32x4 (&acc)[2][2][4][2], const Unit& u, int wr, int wc, int fr, int fq) const {
        const int row0 = u.pm * BM + wr * 64 + fr; const int col0 = u.pn * BM + wc * 32 + 8 * fq;
#pragma unroll
        for (int ai = 0; ai < 2; ++ai)
#pragma unroll
            for (int m = 0; m < 4; ++m) { const int r = row0 + ai * HALF + m * 16;
                const float* bp = (r < 8192) ? baseP + (size_t)r * 2048 : baseS + (size_t)(r - 8192) * 2048;
                const float* gp = gate + (size_t)((r < 8192) ? 0 : 1 + ((r - 8192) >> 4)) * 12288;
                float* op = out + (size_t)r * 2048;
#pragma unroll
                for (int bj = 0; bj < 2; ++bj) { const int c = col0 + bj * HALF;
#pragma unroll
                    for (int n = 0; n < 2; ++n) { const f32x4 b = *(const f32x4*)(bp + c + 4 * n), g = *(const f32x4*)(gp + c + 4 * n);
                        *(f32x4*)(op + c + 4 * n) = b + g * acc[ai][bj][m][n]; } }
                asm volatile("" ::: "memory"); }
    }
};

struct EpiPart {
    static constexpr bool PERM = true, AFTER_DRAIN = false;
    bf16_t* out; int ldc;
    __device__ __forceinline__ void operator()(const f32x4 (&acc)[2][2][4][2], const Unit& u, int wr, int wc, int fr, int fq) const {
        const int row0 = u.pm * BM + wr * 64 + fr - 8192; const int col0 = u.pn * BM + wc * 32 + 8 * fq;
#pragma unroll
        for (int ai = 0; ai < 2; ++ai)
#pragma unroll
            for (int m = 0; m < 4; ++m) { bf16_t* op = out + (size_t)(row0 + ai * HALF + m * 16) * ldc + col0;
#pragma unroll
                for (int bj = 0; bj < 2; ++bj) { const f32x4 v0 = acc[ai][bj][m][0], v1 = acc[ai][bj][m][1];
                    u32x4 w; w.x = cvt_pk_bf16(v0[0], v0[1]); w.y = cvt_pk_bf16(v0[2], v0[3]); w.z = cvt_pk_bf16(v1[0], v1[1]); w.w = cvt_pk_bf16(v1[2], v1[3]);
                    *(u32x4*)(op + bj * HALF) = w; } }
    }
};
struct OneUnit { Unit u;
    __device__ __forceinline__ bool next(int i, Unit& o) const { if (i != 0) return false; o = u; return true; }
    __device__ __forceinline__ void a_ready(const Unit&) const {}
    __device__ __forceinline__ void done(const Unit&) const {}
};
template <class Epi, class Sched, bool ALIGN_EPI = false, bool SP2 = false>
__device__ __forceinline__ void gemm_phase(PG8_LAS unsigned char* lds, const Gemm g, const Sched& S, const Epi& E) {
    int tid_ = threadIdx.x; asm volatile("" : "+v"(tid_));
    const int tid = tid_, wid = __builtin_amdgcn_readfirstlane(tid >> 6), lane = tid & 63, wr = wid >> 2, wc = wid & 3, fr = lane & 15, fq = lane >> 4;
    const int K = g.ld, nt = g.K / BK;
    unsigned voffA[2], voffB[2];
#pragma unroll
    for (int i = 0; i < 2; ++i) { int R, C; stage_rc(tid * 16 + i * 8192, R, C); const int Rb = Epi::PERM ? ((R & ~31) + perm32(R & 31)) : R;
        voffA[i] = (unsigned)(R * K + C) * 2u; voffB[i] = (unsigned)(Rb * K + C) * 2u; }
    const size_t kstep = (size_t)(BK * 2);
    const size_t hstep = (size_t)HALF * K * 2;
    const size_t tstep = 2 * hstep;
    const unsigned ldsw = (unsigned)wid * 1024u;
    const int aoff = lds_byte(wr * 64 + fr, fq * 8), boff = lds_byte(wc * 32 + fr, fq * 8);
#define PG8_SA(b, h) (((b) * 2 + (h)) * HTB)
#define PG8_SB(b, h) ((4 + (b) * 2 + (h)) * HTB)
#define PG8_STAGE(bufoff, gbase, voff) do { _Pragma("unroll") for (int _i = 0; _i < 2; ++_i) \
        __builtin_amdgcn_global_load_lds((const unsigned*)((const char*)(gbase) + (voff)[_i]), (PG8_LAS unsigned*)(lds + (bufoff) + ldsw + _i * 8192), 16, 0, 0); } while (0)
#define PG8_LDA(dst, b, h) do { _Pragma("unroll") for (int m = 0; m < 4; ++m) _Pragma("unroll") for (int k = 0; k < 2; ++k) dst[m][k] = *(const PG8_LAS bf16x8*)(lds + PG8_SA(b, h) + aoff + m * 2048 + k * 1024); } while (0)
#define PG8_LDB(dst, b, h) do { _Pragma("unroll") for (int n = 0; n < 2; ++n) _Pragma("unroll") for (int k = 0; k < 2; ++k) dst[n][k] = *(const PG8_LAS bf16x8*)(lds + PG8_SB(b, h) + boff + n * 2048 + k * 1024); } while (0)
#define PG8_MMA(ai, bj, At, Bt) do { __builtin_amdgcn_s_setprio(1); _Pragma("unroll") for (int m = 0; m < 4; ++m) _Pragma("unroll") for (int n = 0; n < 2; ++n) _Pragma("unroll") for (int k = 0; k < 2; ++k) \
        acc[ai][bj][m][n] = __builtin_amdgcn_mfma_f32_16x16x32_bf16(Bt[n][k], At[m][k], acc[ai][bj][m][n], 0, 0, 0); __builtin_amdgcn_s_setprio(0); } while (0)
#define PG8_WAIT_V(n) asm volatile("s_waitcnt vmcnt(" #n ")" ::: "memory")
#define PG8_WAIT_L(n) asm volatile("s_waitcnt lgkmcnt(" #n ")" ::: "memory")
#define PG8_BAR __builtin_amdgcn_s_barrier()
#define PG8_SCHED __builtin_amdgcn_sched_barrier(0)
    Unit cur, nxt; int ui = 0;
    if (!S.next(0, cur)) return;
    f32x4 acc[2][2][4][2];
#pragma unroll
    for (int a = 0; a < 2; ++a)
#pragma unroll
        for (int b = 0; b < 2; ++b)
#pragma unroll
            for (int m = 0; m < 4; ++m)
#pragma unroll
                for (int n = 0; n < 2; ++n) acc[a][b][m][n] = (f32x4){0.f, 0.f, 0.f, 0.f};
    bf16x8 At[4][2], B0[2][2], B1[2][2];
    const char* cA = (const char*)g.A + (size_t)cur.pm * tstep; const char* cB = (const char*)g.Bt + (size_t)cur.pn * tstep;
    S.a_ready(cur);
    if constexpr (SP2) {
        PG8_STAGE(PG8_SB(0, 0), cB, voffB); PG8_STAGE(PG8_SB(0, 1), cB + hstep, voffB); PG8_STAGE(PG8_SA(0, 0), cA, voffA); PG8_STAGE(PG8_SA(0, 1), cA + hstep, voffA);
        if (wr == 1) PG8_BAR;
        PG8_WAIT_V(2); PG8_BAR;
        PG8_STAGE(PG8_SB(1, 0), cB + kstep, voffB); PG8_STAGE(PG8_SA(1, 0), cA + kstep, voffA); PG8_STAGE(PG8_SB(1, 1), cB + hstep + kstep, voffB);
        PG8_WAIT_V(6); PG8_BAR;
    } else {
        PG8_STAGE(PG8_SB(0, 0), cB, voffB); PG8_STAGE(PG8_SA(0, 0), cA, voffA); PG8_STAGE(PG8_SB(0, 1), cB + hstep, voffB); PG8_STAGE(PG8_SA(0, 1), cA + hstep, voffA);
        if (wr == 1) PG8_BAR;
        PG8_WAIT_V(4); PG8_BAR;
        PG8_STAGE(PG8_SB(1, 0), cB + kstep, voffB); PG8_STAGE(PG8_SA(1, 0), cA + kstep, voffA); PG8_STAGE(PG8_SB(1, 1), cB + hstep + kstep, voffB);
        PG8_WAIT_V(6); PG8_BAR;
    }
    for (;;) {
        const bool has_next = S.next(ui + 1, nxt);
        const char* nA = has_next ? (const char*)g.A + (size_t)nxt.pm * tstep : cA; const char* nB = has_next ? (const char*)g.Bt + (size_t)nxt.pn * tstep : cB;
        for (int t = 0; t < nt; t += 2) {
            const bool last = (t == nt - 2);
            const char* a1 = cA + (size_t)(t + 1) * kstep;
            const char* a2 = last ? nA : cA + (size_t)(t + 2) * kstep; const char* b2 = last ? nB : cB + (size_t)(t + 2) * kstep;
            const char* a3 = a2 + kstep; const char* b3 = b2 + kstep;
            if (last && has_next) S.a_ready(nxt);
            if constexpr (SP2) {
            PG8_LDB(B0, 0, 0); PG8_LDB(B1, 0, 1); PG8_SCHED; PG8_LDA(At, 0, 0); PG8_STAGE(PG8_SA(1, 1), a1 + hstep, voffA);
            PG8_WAIT_V(8); PG8_WAIT_L(0); PG8_BAR; PG8_MMA(0, 0, At, B0); PG8_MMA(0, 1, At, B1); PG8_BAR; PG8_SCHED;
            PG8_LDA(At, 0, 1); PG8_STAGE(PG8_SB(0, 0), b2, voffB); PG8_STAGE(PG8_SB(0, 1), b2 + hstep, voffB); PG8_STAGE(PG8_SA(0, 0), a2, voffA);
            PG8_WAIT_V(8); PG8_WAIT_L(0); PG8_BAR; PG8_MMA(1, 0, At, B0); PG8_MMA(1, 1, At, B1); PG8_BAR; PG8_SCHED;
            PG8_LDB(B0, 1, 0); PG8_LDB(B1, 1, 1); PG8_SCHED; PG8_LDA(At, 1, 0); PG8_STAGE(PG8_SA(0, 1), a2 + hstep, voffA);
            PG8_WAIT_V(8); PG8_WAIT_L(0); PG8_BAR; PG8_MMA(0, 0, At, B0); PG8_MMA(0, 1, At, B1); PG8_BAR; PG8_SCHED;
            PG8_LDA(At, 1, 1); PG8_STAGE(PG8_SB(1, 0), b3, voffB); PG8_STAGE(PG8_SB(1, 1), b3 + hstep, voffB); PG8_STAGE(PG8_SA(1, 0), a3, voffA);
            PG8_WAIT_V(8); PG8_WAIT_L(0); PG8_BAR; PG8_MMA(1, 0, At, B0); PG8_MMA(1, 1, At, B1); PG8_BAR; PG8_SCHED;
            } else {
            PG8_LDB(B0, 0, 0); PG8_SCHED; PG8_LDA(At, 0, 0); PG8_STAGE(PG8_SA(1, 1), a1 + hstep, voffA);
            PG8_WAIT_L(8); PG8_BAR; PG8_WAIT_L(0); PG8_MMA(0, 0, At, B0); PG8_BAR; PG8_SCHED;
            PG8_LDB(B1, 0, 1); PG8_STAGE(PG8_SB(0, 0), b2, voffB);
            PG8_BAR; PG8_WAIT_L(0); PG8_MMA(0, 1, At, B1); PG8_BAR;
            PG8_LDA(At, 0, 1); PG8_STAGE(PG8_SA(0, 0), a2, voffA);
            PG8_BAR; PG8_WAIT_L(0); PG8_MMA(1, 0, At, B0); PG8_BAR; PG8_SCHED;
            PG8_STAGE(PG8_SB(0, 1), b2 + hstep, voffB);
            PG8_WAIT_V(6); PG8_BAR; PG8_MMA(1, 1, At, B1); PG8_BAR;
            PG8_LDB(B0, 1, 0); PG8_SCHED; PG8_LDA(At, 1, 0); PG8_STAGE(PG8_SA(0, 1), a2 + hstep, voffA);
            PG8_WAIT_L(8); PG8_BAR; PG8_WAIT_L(0); PG8_MMA(0, 0, At, B0); PG8_BAR; PG8_SCHED;
            PG8_LDB(B1, 1, 1); PG8_STAGE(PG8_SB(1, 0), b3, voffB);
            PG8_BAR; PG8_WAIT_L(0); PG8_MMA(0, 1, At, B1); PG8_BAR;
            PG8_LDA(At, 1, 1); PG8_STAGE(PG8_SA(1, 0), a3, voffA);
            PG8_BAR; PG8_WAIT_L(0); PG8_MMA(1, 0, At, B0); PG8_BAR; PG8_SCHED;
            PG8_STAGE(PG8_SB(1, 1), b3 + hstep, voffB);
            PG8_WAIT_V(6); PG8_BAR; PG8_MMA(1, 1, At, B1); PG8_BAR;
            }
        }
        if constexpr (ALIGN_EPI) { if (wr == 0) PG8_BAR; }
        if constexpr (!Epi::AFTER_DRAIN) { E(acc, cur, wr, wc, fr, fq); S.done(cur); }
        if (!has_next) break;
#pragma unroll
        for (int a = 0; a < 2; ++a)
#pragma unroll
            for (int b = 0; b < 2; ++b)
#pragma unroll
                for (int m = 0; m < 4; ++m)
#pragma unroll
                    for (int n = 0; n < 2; ++n) acc[a][b][m][n] = (f32x4){0.f, 0.f, 0.f, 0.f};
        cur = nxt; cA = nA; cB = nB; ++ui;
        if constexpr (ALIGN_EPI) { if (wr == 1) PG8_BAR; }
    }
    PG8_WAIT_V(0);
    if constexpr (!ALIGN_EPI) { if (wr == 0) PG8_BAR; }
    PG8_BAR;
    if constexpr (Epi::AFTER_DRAIN) { E.fused(acc, cur, wr, wc, fr, fq, lds, wid, lane); S.done(cur); }
#undef PG8_SA
#undef PG8_SB
#undef PG8_STAGE
#undef PG8_LDA
#undef PG8_LDB
#undef PG8_MMA
#undef PG8_WAIT_V
#undef PG8_WAIT_L
#undef PG8_BAR
#undef PG8_SCHED
}
}
#define GAS __attribute__((address_space(1)))
#define LAS __attribute__((address_space(3)))
typedef unsigned short bf16;
typedef unsigned u32x4 __attribute__((ext_vector_type(4)));
typedef unsigned u32x2 __attribute__((ext_vector_type(2)));
typedef float f32x4 __attribute__((ext_vector_type(4)));
typedef float f32x16 __attribute__((ext_vector_type(16)));
typedef short bf16x8 __attribute__((ext_vector_type(8)));
typedef short s16x4 __attribute__((ext_vector_type(4)));
typedef float f32x2_t __attribute__((ext_vector_type(2)));
constexpr int NW = 8, NT = 512;
constexpr int MTOK = 8704, MP = 8192, MS = 512, DM = 2048, NIN = 7176, NINP = 7424, DFF = 8192;
constexpr int NSEQ = 33;
constexpr int PAST = 1024;
constexpr int C_QA = 0, C_KA = 1024, C_VA = 2048, C_QM = 3072, C_KM = 4096, C_VM = 5120, C_OM = 6144, C_IG = 7168, C_FG = 7172;
constexpr int NCH = 160;
constexpr float EPS = 1e-6f;
constexpr float LAM_INIT = 0.2f;
constexpr float QSCALE = 0.125f * 1.4426950408889634f;
constexpr size_t O_YP = 0, O_YS = 16777216, O_KP = 17825792, O_VP = 26214400, O_CVP = 34603008, O_CP = 34609152, O_NP = 34871296, O_MPO = 34872320,
                 O_KS = 34872324, O_VS = 35396612, O_CVS = 35920900, O_CS = 36117508, O_NS = 44506116, O_MSO = 44538884;
constexpr size_t MiB = 1u << 20;
constexpr size_t WS_MOD = 1 * MiB;
constexpr size_t WS_ROPE = 3 * MiB;
constexpr size_t WS_SCAL = 4 * MiB;
constexpr size_t WS_DN = 5 * MiB;
constexpr size_t WS_NPREV = 6 * MiB;
constexpr size_t WS_WIN = 8 * MiB;
constexpr size_t WS_WOUT = 40 * MiB;
constexpr size_t WS_WUP = 48 * MiB;
constexpr size_t WS_WDN = 80 * MiB;
constexpr size_t WS_XN = 112 * MiB;
constexpr size_t WS_PROJ = 148 * MiB;
constexpr size_t WS_QA = 272 * MiB;
constexpr size_t WS_KA = 289 * MiB;
constexpr size_t WS_VT = 306 * MiB;
constexpr size_t WS_DC = 322 * MiB;
constexpr size_t WS_CPREV = 482 * MiB;
constexpr size_t WS_MIX = 562 * MiB;
constexpr size_t WS_END = 596 * MiB;
constexpr size_t WS_H = WS_PROJ;
constexpr size_t WS_X1 = WS_DC;
constexpr size_t WS_PART6 = 390 * MiB;
constexpr size_t WS_PART8 = 422 * MiB;
constexpr size_t WS_PART9 = 486 * MiB;
constexpr size_t WS_FLAG = 0;
static_assert(WS_H + (size_t)MTOK * DFF * 2 <= WS_VT + 16 * MiB && WS_X1 + (size_t)MTOK * DM * 4 <= WS_CPREV, "overlays");

constexpr int LDS_BYTES = 147456;

__device__ __forceinline__ f32x4 ld_bf4(const bf16* p) { const u32x2 w = *(const u32x2*)p; return (f32x4){__uint_as_float(w.x << 16), __uint_as_float(w.x & 0xffff0000u), __uint_as_float(w.y << 16), __uint_as_float(w.y & 0xffff0000u)}; }
__device__ __forceinline__ float bf2f(unsigned short u) { return __uint_as_float((unsigned)u << 16); }
__device__ __forceinline__ unsigned pk2(float lo, float hi) { return pg8::cvt_pk_bf16(lo, hi); }
__device__ __forceinline__ float lane_get(float v, int src_lane) { return __int_as_float(__builtin_amdgcn_ds_bpermute(src_lane << 2, __float_as_int(v))); }
__device__ __forceinline__ float xhalf_other(float v) { auto rr = __builtin_amdgcn_permlane32_swap(__float_as_uint(v), __float_as_uint(v), false, false); return __uint_as_float(rr[0]) + __uint_as_float(rr[1]) - v; }
__device__ __forceinline__ float xhalf_sum(float v) { auto rr = __builtin_amdgcn_permlane32_swap(__float_as_uint(v), __float_as_uint(v), false, false); return __uint_as_float(rr[0]) + __uint_as_float(rr[1]); }
__device__ __forceinline__ float wave_sum(float v, int lane) {
#pragma unroll
    for (int o = 1; o < 32; o <<= 1) v += lane_get(v, lane ^ o);
    return xhalf_sum(v);
}
__device__ __forceinline__ float wave_max(float v, int lane) {
#pragma unroll
    for (int o = 1; o < 64; o <<= 1) v = fmaxf(v, lane_get(v, lane ^ o));
    return v;
}
__device__ __forceinline__ float silu_f(float x) { return x / (1.f + __expf(-x)); }
__device__ __forceinline__ float sigmoid_f(float x) { return 1.f / (1.f + __expf(-x)); }
__device__ __forceinline__ int crow(int r, int hi) { return (r & 3) + 8 * (r >> 2) + 4 * hi; }
#define LDS_WAIT() asm volatile("s_waitcnt lgkmcnt(0)" ::: "memory")

struct Args {
    const float* in[29]; float* out; unsigned char* ws;
};
typedef const __attribute__((address_space(4))) Args* ArgsP;
#define FRESH_ARGS() ({ ArgsP p_ = (ArgsP)__builtin_amdgcn_kernarg_segment_ptr(); asm volatile("" : "+s"(p_)); p_; })

__device__ __forceinline__ void p0_transpose_item(const float* __restrict__ W, int K, int N, int Npad, bf16* WT, LAS float* T, int item, int tid, int wave, int lane) {
    const int nblk = Npad / 256, kb = item / nblk, nb = item % nblk, k0 = 64 * kb, n0 = 256 * nb;
    const int n = n0 + 4 * lane;
    f32x4 v[8];
#pragma unroll
    for (int i = 0; i < 8; ++i) v[i] = (n < N) ? *(const f32x4*)(W + (size_t)(k0 + 8 * wave + i) * N + n) : (f32x4){0.f, 0.f, 0.f, 0.f};
#pragma unroll
    for (int i = 0; i < 8; ++i) *(LAS f32x4*)(T + (8 * wave + i) * 260 + 4 * lane) = v[i];
    __syncthreads();
#pragma unroll
    for (int j = 0; j < 4; ++j) { const int q = tid + NT * j, nn = q >> 3, c = q & 7; const LAS float* s = T + (8 * c) * 260 + nn;
        u32x4 o; o.x = pk2(s[0], s[260]); o.y = pk2(s[2 * 260], s[3 * 260]); o.z = pk2(s[4 * 260], s[5 * 260]); o.w = pk2(s[6 * 260], s[7 * 260]);
        *(u32x4*)(WT + (size_t)(n0 + nn) * K + k0 + 8 * c) = o; }
    __syncthreads();
}

__device__ __forceinline__ void p0_ada_item(const float* __restrict__ cP, const float* __restrict__ cS, const float* __restrict__ Wada, const float* __restrict__ bada,
                                            float* mod, LAS float* red, int jb, int wave, int lane, int tid) {
    const int i32 = lane & 31, hi = lane >> 5;
    f32x16 acc[4]; f32x4 accp = {0.f, 0.f, 0.f, 0.f};
#pragma unroll
    for (int c = 0; c < 4; ++c) acc[c] = (f32x16){};
    const float* wp = Wada + (size_t)128 * jb + 4 * i32;
    for (int st = 0; st < 16; ++st) {
        const int k0 = 256 * wave + 16 * st + 8 * hi;
        f32x4 w[8];
#pragma unroll
        for (int i = 0; i < 8; ++i) w[i] = *(const f32x4*)(wp + (size_t)(k0 + i) * 12288);
        const f32x4 c0 = *(const f32x4*)(cS + (size_t)i32 * DM + k0), c1 = *(const f32x4*)(cS + (size_t)i32 * DM + k0 + 4);
        const f32x4 p0 = *(const f32x4*)(cP + k0), p1 = *(const f32x4*)(cP + k0 + 4);
        u32x4 a;
        a.x = pk2(silu_f(c0[0]), silu_f(c0[1])); a.y = pk2(silu_f(c0[2]), silu_f(c0[3])); a.z = pk2(silu_f(c1[0]), silu_f(c1[1])); a.w = pk2(silu_f(c1[2]), silu_f(c1[3]));
#pragma unroll
        for (int i = 0; i < 4; ++i) { accp += w[i] * silu_f(p0[i]); accp += w[4 + i] * silu_f(p1[i]); }
#pragma unroll
        for (int c = 0; c < 4; ++c) { u32x4 b; b.x = pk2(w[0][c], w[1][c]); b.y = pk2(w[2][c], w[3][c]); b.z = pk2(w[4][c], w[5][c]); b.w = pk2(w[6][c], w[7][c]);
            acc[c] = __builtin_amdgcn_mfma_f32_32x32x16_bf16(__builtin_bit_cast(bf16x8, a), __builtin_bit_cast(bf16x8, b), acc[c], 0, 0, 0); }
    }
    accp = (f32x4){xhalf_sum(accp[0]), xhalf_sum(accp[1]), xhalf_sum(accp[2]), xhalf_sum(accp[3])};
    LAS float* rp = red + 16384;
    if (hi == 0) *(LAS f32x4*)(rp + wave * 128 + 4 * i32) = accp;
#pragma unroll
    for (int half = 4; half >= 1; half >>= 1) {
        if (wave >= half && wave < 2 * half) { LAS float* dst = red + (wave - half) * 4096;
#pragma unroll
            for (int r = 0; r < 16; ++r) *(LAS f32x4*)(dst + crow(r, hi) * 128 + 4 * i32) = (f32x4){acc[0][r], acc[1][r], acc[2][r], acc[3][r]}; }
        __syncthreads();
        if (wave < half) { const LAS float* src = red + wave * 4096;
#pragma unroll
            for (int r = 0; r < 16; ++r) { const f32x4 t = *(const LAS f32x4*)(src + crow(r, hi) * 128 + 4 * i32); acc[0][r] += t[0]; acc[1][r] += t[1]; acc[2][r] += t[2]; acc[3][r] += t[3]; } }
        __syncthreads();
    }
    if (wave == 0) { const f32x4 bv = *(const f32x4*)(bada + 128 * jb + 4 * i32);
#pragma unroll
        for (int r = 0; r < 16; ++r) *(f32x4*)(mod + (size_t)(1 + crow(r, hi)) * 12288 + 128 * jb + 4 * i32) = (f32x4){acc[0][r], acc[1][r], acc[2][r], acc[3][r]} + bv; }
    if (wave == 1 && hi == 0) { f32x4 t = *(const f32x4*)(bada + 128 * jb + 4 * i32);
#pragma unroll
        for (int w = 0; w < 8; ++w) t += *(const LAS f32x4*)(rp + w * 128 + 4 * i32);
        *(f32x4*)(mod + 128 * jb + 4 * i32) = t; }
    __syncthreads();
}

__constant__ double INV_FREQ_TURNS[8] = {
    1.0 / 6.283185307179586, 0.19392274474868576 / 6.283185307179586, 0.03760603093086393 / 6.283185307179586, 0.007292664737217109 / 6.283185307179586,
    0.001414213562373095 / 6.283185307179586, 0.0002742481756762073 / 6.283185307179586, 5.318295896944988e-05 / 6.283185307179586, 1.031338537721246e-05 / 6.283185307179586 };

__device__ __forceinline__ void p0_prologue(ArgsP A, LAS unsigned char* lds, int tid, int wave, int lane) {
    unsigned char* ws = A->ws;
    const int G = gridDim.x, bid = blockIdx.x;
    for (int jb = bid; jb < 96; jb += G)
        p0_ada_item(A->in[8], A->in[9], A->in[10], A->in[11], (float*)(ws + WS_MOD), (LAS float*)lds, jb, wave, lane, tid);
    constexpr int I_IN = 32 * (NINP / 256), I_OUT = 32 * 8, I_UP = 32 * 32, I_DN = 128 * 8, I_ALL = I_IN + I_OUT + I_UP + I_DN;
    const bool split = (G > 128);
    const int nfree = split ? G - 96 : G, first = split ? 14 * nfree : 0;
    for (int pass = 0; pass < 2; ++pass) {
        int it, step, end;
        if (pass == 0) { if (!split || bid < 96) continue; it = bid - 96; step = nfree; end = (first < I_ALL) ? first : I_ALL; }
        else { it = first + bid; step = G; end = I_ALL; }
        for (; it < end; it += step) { int r = it;
            if (r < I_IN) { p0_transpose_item(A->in[13], DM, NIN, NINP, (bf16*)(ws + WS_WIN), (LAS float*)lds, r, tid, wave, lane); continue; } r -= I_IN;
            if (r < I_OUT) { p0_transpose_item(A->in[24], DM, DM, DM, (bf16*)(ws + WS_WOUT), (LAS float*)lds, r, tid, wave, lane); continue; } r -= I_OUT;
            if (r < I_UP) { p0_transpose_item(A->in[26], DM, DFF, DFF, (bf16*)(ws + WS_WUP), (LAS float*)lds, r, tid, wave, lane); continue; } r -= I_UP;
            p0_transpose_item(A->in[27], DFF, DM, DM, (bf16*)(ws + WS_WDN), (LAS float*)lds, r, tid, wave, lane); }
    }
    for (int idx = blockIdx.x * NT + tid; idx < 8192 * 8; idx += gridDim.x * NT) {
        const int pos = idx >> 3, i = idx & 7;
        const double t = (double)pos * INV_FREQ_TURNS[i]; const float fr = (float)(t - __builtin_rint(t));
        float* tab = (float*)(ws + WS_ROPE) + (size_t)pos * 16;
        tab[i] = __builtin_amdgcn_cosf(fr); tab[8 + i] = __builtin_amdgcn_sinf(fr);
    }
}

template <int NPART> __device__ __forceinline__ void norm_mod_rows(const float* xP, const float* xS, const float* __restrict__ g, const float* __restrict__ mod, int sh_off, int sc_off, bf16* out, int wave, int lane,
                                              const bf16* part = nullptr, int gate_off = 0, float* x1S = nullptr) {
    const int gw = blockIdx.x * NW + wave, NGW = gridDim.x * NW;
    for (int r = gw; r < MTOK; r += NGW) {
        const float* xr = (r < MP) ? xP + (size_t)r * DM : xS + (size_t)(r - MP) * DM;
        const float* mr = mod + (size_t)((r < MP) ? 0 : 1 + ((r - MP) >> 4)) * 12288;
        f32x4 v[8]; float s = 0.f;
#pragma unroll
        for (int j = 0; j < 8; ++j) v[j] = *(const f32x4*)(xr + 256 * j + 4 * lane);
        if (NPART > 0 && r >= MP) {
#pragma unroll
            for (int j = 0; j < 8; ++j) { const int c = 256 * j + 4 * lane; f32x4 a = {0.f, 0.f, 0.f, 0.f};
                f32x4 t[NPART > 0 ? NPART : 1];
#pragma unroll
                for (int p = 0; p < NPART; ++p) t[p] = ld_bf4(part + ((size_t)p * MS + (r - MP)) * DM + c);
#pragma unroll
                for (int p = 0; p < NPART; ++p) a += t[p];
                v[j] += *(const f32x4*)(mr + gate_off + c) * a; *(f32x4*)(x1S + (size_t)(r - MP) * DM + c) = v[j]; } }
#pragma unroll
        for (int j = 0; j < 8; ++j) s += (v[j].x * v[j].x + v[j].y * v[j].y) + (v[j].z * v[j].z + v[j].w * v[j].w);
        const float rstd = 1.f / sqrtf(wave_sum(s, lane) * (1.f / DM) + EPS);
#pragma unroll
        for (int j = 0; j < 8; ++j) { const int c = 256 * j + 4 * lane;
            const f32x4 gg = *(const f32x4*)(g + c), sc = *(const f32x4*)(mr + sc_off + c), sh = *(const f32x4*)(mr + sh_off + c);
            const f32x4 y = v[j] * rstd * gg * (sc + 1.f) + sh;
            u32x2 o; o.x = pk2(y.x, y.y); o.y = pk2(y.z, y.w);
            *(u32x2*)(out + (size_t)r * DM + c) = o; }
    }
}
#define XB_TMO      128
#define XB_XCNT(j)  (256  + 64 * (j))
#define XB_XSUB(j)  (1280 + 64 * (j))
#define XB_XGEN(j)  (2304 + 64 * (j))
#define XB_TOP      3328
#define XB_TOPGEN   3392
#define XCD_BAR_WORDS 3456
#define XB_SPIN_CAP (1u << 18)

__device__ __forceinline__ unsigned xb_ld(unsigned* p)              { return __hip_atomic_load(p, __ATOMIC_RELAXED, __HIP_MEMORY_SCOPE_AGENT); }
__device__ __forceinline__ unsigned xb_add(unsigned* p, unsigned v) { return __hip_atomic_fetch_add(p, v, __ATOMIC_RELAXED, __HIP_MEMORY_SCOPE_AGENT); }
__device__ __forceinline__ unsigned xb_xcc_id() { return (unsigned)__builtin_amdgcn_s_getreg((3 << 11) | 20) & 0xFu; }
#define XB_SPIN(cond, bar) do { unsigned _sp = 0; while (cond) { __builtin_amdgcn_s_sleep(1); \
    if ((++_sp & 255u) == 0u) { if (xb_ld(&(bar)[XB_TMO])) break; if (_sp > XB_SPIN_CAP) { atomicAdd(&(bar)[XB_TMO], 1u); break; } } } } while (0)

struct XcdBarrier {
    unsigned* bar; unsigned x;
    volatile LAS unsigned* st;
};

__device__ __forceinline__ XcdBarrier xcd_barrier_post(unsigned* bar, volatile LAS unsigned* st) {
    XcdBarrier b; b.bar = bar; b.x = xb_xcc_id(); b.st = st;
    if (threadIdx.x == 0) (void)xb_add(&bar[XB_XCNT(b.x)], 1u);
    return b;
}
__device__ __forceinline__ void xcd_barrier_complete(unsigned* bar, unsigned x, unsigned& nloc, unsigned& nx) {
    const unsigned G = gridDim.x * gridDim.y * gridDim.z;
    unsigned sum, cnt, mine, sp = 0u;
    for (;;) {
        sum = 0u; cnt = 0u; mine = 0u;
#pragma unroll
        for (unsigned j = 0; j < 16; ++j) { const unsigned c = xb_ld(&bar[XB_XCNT(j)]); sum += c; cnt += (c > 0u) ? 1u : 0u; mine = (j == x) ? c : mine; }
        if (sum == G) break;
        __builtin_amdgcn_s_sleep(1);
        if ((++sp & 255u) == 0u) { if (xb_ld(&bar[XB_TMO])) break; if (sp > XB_SPIN_CAP) { atomicAdd(&bar[XB_TMO], 1u); break; } }
    }
    nloc = mine > 0u ? mine : 1u; nx = cnt > 0u ? cnt : 1u;
}

__device__ __forceinline__ void xcd_barrier(const XcdBarrier& b) {
    asm volatile("s_waitcnt vmcnt(0)" ::: "memory");
    __syncthreads();
    if (threadIdx.x == 0) {
        unsigned* bar = b.bar;
        __builtin_amdgcn_s_waitcnt(0);
        unsigned nloc = b.st[0], nx = b.st[1];
        if (nloc == 0u) { xcd_barrier_complete(bar, b.x, nloc, nx); b.st[0] = nloc; b.st[1] = nx; }
        const unsigned old = xb_add(&bar[XB_XSUB(b.x)], 1u);
        const unsigned gen = old / nloc;
        if (old + 1u == (gen + 1u) * nloc) {
            __builtin_amdgcn_fence(__ATOMIC_RELEASE, "agent");
            asm volatile("s_waitcnt vmcnt(0)" ::: "memory");
            const unsigned og = xb_add(&bar[XB_TOP], 1u);
            const unsigned tg = og / nx;
            if (og + 1u == (tg + 1u) * nx) xb_add(&bar[XB_TOPGEN], 1u);
            else XB_SPIN(xb_ld(&bar[XB_TOPGEN]) == tg, bar);
            __builtin_amdgcn_fence(__ATOMIC_ACQUIRE, "agent");
            xb_add(&bar[XB_XGEN(b.x)], 1u);
            asm volatile("s_waitcnt vmcnt(0)" ::: "memory");
        } else {
            XB_SPIN(xb_ld(&bar[XB_XGEN(b.x)]) == gen, bar);
            __builtin_amdgcn_fence(__ATOMIC_ACQUIRE, "agent");
            asm volatile("s_waitcnt vmcnt(0)" ::: "memory");
        }
    }
    __syncthreads();
}
__device__ __forceinline__ void unpack16(const u32x4 a, const u32x4 b, float* v) {
#pragma unroll
    for (int i = 0; i < 4; ++i) { v[2 * i] = __uint_as_float(a[i] << 16); v[2 * i + 1] = __uint_as_float(a[i] & 0xffff0000u); v[8 + 2 * i] = __uint_as_float(b[i] << 16); v[8 + 2 * i + 1] = __uint_as_float(b[i] & 0xffff0000u); }
}
__device__ __forceinline__ void p3_post(ArgsP A, int tid) {
    unsigned char* ws = A->ws;
    const bf16* PROJ = (const bf16*)(ws + WS_PROJ); bf16* QA = (bf16*)(ws + WS_QA); bf16* KA = (bf16*)(ws + WS_KA);
    const float* rope = (const float*)(ws + WS_ROPE);
    for (int it = blockIdx.x * NT + tid; it < MTOK * 64; it += gridDim.x * NT) {
        const int r = it >> 6, cg16 = it & 63;
        const int pos = (r < MP) ? r : PAST + ((r - MP) & 15);
        const bf16* pr = PROJ + (size_t)r * NINP + 16 * cg16;
        float q[16], k[16], v[16];
        unpack16(*(const u32x4*)(pr + C_QA), *(const u32x4*)(pr + C_QA + 8), q);
        unpack16(*(const u32x4*)(pr + C_KA), *(const u32x4*)(pr + C_KA + 8), k);
        unpack16(*(const u32x4*)(pr + C_VA), *(const u32x4*)(pr + C_VA + 8), v);
        if ((cg16 & 3) == 0) {
            const float* tb = rope + (size_t)pos * 16;
#pragma unroll
            for (int i = 0; i < 8; ++i) { const float c = tb[i], s = tb[8 + i];
                const float q1 = q[i], q2 = q[8 + i]; q[i] = q1 * c - q2 * s; q[8 + i] = q2 * c + q1 * s;
                const float k1 = k[i], k2 = k[8 + i]; k[i] = k1 * c - k2 * s; k[8 + i] = k2 * c + k1 * s; }
        }
        u32x4 o0, o1;
#pragma unroll
        for (int i = 0; i < 4; ++i) { o0[i] = pk2(q[2 * i] * QSCALE, q[2 * i + 1] * QSCALE); o1[i] = pk2(q[8 + 2 * i] * QSCALE, q[8 + 2 * i + 1] * QSCALE); }
        *(u32x4*)(QA + (size_t)r * 1024 + 16 * cg16) = o0; *(u32x4*)(QA + (size_t)r * 1024 + 16 * cg16 + 8) = o1;
#pragma unroll
        for (int i = 0; i < 4; ++i) { o0[i] = pk2(k[2 * i], k[2 * i + 1]); o1[i] = pk2(k[8 + 2 * i], k[8 + 2 * i + 1]); }
        *(u32x4*)(KA + (size_t)r * 1024 + 16 * cg16) = o0; *(u32x4*)(KA + (size_t)r * 1024 + 16 * cg16 + 8) = o1;
        float* ko = A->out + ((r < MP) ? O_KP + (size_t)r * 1024 : O_KS + (size_t)(r - MP) * 1024) + 16 * cg16;
        float* vo = A->out + ((r < MP) ? O_VP + (size_t)r * 1024 : O_VS + (size_t)(r - MP) * 1024) + 16 * cg16;
#pragma unroll
        for (int i = 0; i < 4; ++i) { *(f32x4*)(ko + 4 * i) = (f32x4){k[4 * i], k[4 * i + 1], k[4 * i + 2], k[4 * i + 3]}; *(f32x4*)(vo + 4 * i) = (f32x4){v[4 * i], v[4 * i + 1], v[4 * i + 2], v[4 * i + 3]}; }
    }
    for (int it = blockIdx.x * NT + tid; it < 33 * 3 * 2048; it += gridDim.x * NT) {
        const int ch = it & 2047, j = (it >> 11) % 3, sq = it / (3 * 2048);
        const int r = (sq == 0) ? (MP - 3 + j) : (MP + 16 * (sq - 1) + 13 + j);
        const float val = bf2f(PROJ[(size_t)r * NINP + C_QM + ch]);
        if (sq == 0) A->out[O_CVP + (size_t)j * 2048 + ch] = val; else A->out[O_CVS + ((size_t)(sq - 1) * 3 + j) * 2048 + ch] = val;
    }
}
typedef short v4i16_t __attribute__((ext_vector_type(4)));
__device__ __forceinline__ s16x4 tr_rd(LAS const unsigned char* p) { return __builtin_bit_cast(s16x4, __builtin_amdgcn_ds_read_tr16_b64_v4i16((LAS v4i16_t*)p)); }
__device__ __forceinline__ bf16x8 mk8(s16x4 a, s16x4 b) { return (bf16x8){a[0], a[1], a[2], a[3], b[0], b[1], b[2], b[3]}; }
__device__ __forceinline__ int tr_off(int pitch, int krow, int colbase, int lane) { return (krow + ((lane & 15) >> 2)) * pitch + (colbase + 16 * ((lane >> 4) & 1) + 4 * (lane & 3)) * 2; }
__device__ __forceinline__ void unpack8(const u32x4 a, float* v) {
#pragma unroll
    for (int i = 0; i < 4; ++i) { v[2 * i] = __uint_as_float(a[i] << 16); v[2 * i + 1] = __uint_as_float(a[i] & 0xffff0000u); }
}
__device__ __forceinline__ int unit_row0(int u) { return (u < 128) ? 64 * u : MP + 16 * (u - 128); }
__device__ __forceinline__ void conv8(const bf16* PROJ, const float* __restrict__ stconv, const float* __restrict__ wconv, const float* __restrict__ bconv, int u, int s, int ch0, float* o) {
    const int r0 = unit_row0(u);
    f32x4 a0 = *(const f32x4*)(bconv + ch0), a1 = *(const f32x4*)(bconv + ch0 + 4);
#pragma unroll
    for (int j = 0; j < 4; ++j) { const int tau = s - 3 + j; float x[8];
        if (tau >= 0 || (u > 0 && u < 128)) unpack8(*(const u32x4*)(PROJ + (size_t)(r0 + tau) * NINP + C_QM + ch0), x);
        else if (u >= 128) { const float* p = stconv + ((size_t)(u - 128) * 3 + (3 + tau)) * 2048 + ch0; const f32x4 y0 = *(const f32x4*)p, y1 = *(const f32x4*)(p + 4);
            x[0] = y0[0]; x[1] = y0[1]; x[2] = y0[2]; x[3] = y0[3]; x[4] = y1[0]; x[5] = y1[1]; x[6] = y1[2]; x[7] = y1[3]; }
        else {
#pragma unroll
            for (int i = 0; i < 8; ++i) x[i] = 0.f; }
        const f32x4 w0 = *(const f32x4*)(wconv + j * 2048 + ch0), w1 = *(const f32x4*)(wconv + j * 2048 + ch0 + 4);
        a0 += (f32x4){x[0], x[1], x[2], x[3]} * w0; a1 += (f32x4){x[4], x[5], x[6], x[7]} * w1; }
#pragma unroll
    for (int i = 0; i < 4; ++i) { o[i] = silu_f(a0[i]); o[4 + i] = silu_f(a1[i]); }
}
__device__ __forceinline__ void conv_rows4(const bf16* PROJ, const float* __restrict__ stconv, const float* __restrict__ wconv, const float* __restrict__ bconv, int u, int L, int s0, int ch0, float sc, u32x4* o) {
    const int r0 = unit_row0(u);
    f32x4 w0[4], w1[4];
#pragma unroll
    for (int j = 0; j < 4; ++j) { w0[j] = *(const f32x4*)(wconv + j * 2048 + ch0); w1[j] = *(const f32x4*)(wconv + j * 2048 + ch0 + 4); }
    const f32x4 b0 = *(const f32x4*)(bconv + ch0), b1 = *(const f32x4*)(bconv + ch0 + 4);
    f32x4 x0[7], x1[7];
#pragma unroll
    for (int i = 0; i < 7; ++i) { const int tau = s0 - 3 + i; x0[i] = (f32x4){0.f, 0.f, 0.f, 0.f}; x1[i] = x0[i];
        if (tau >= 0 ? (tau < L) : (u > 0 && u < 128)) { float t[8]; unpack8(*(const u32x4*)(PROJ + (size_t)(r0 + tau) * NINP + C_QM + ch0), t); x0[i] = (f32x4){t[0], t[1], t[2], t[3]}; x1[i] = (f32x4){t[4], t[5], t[6], t[7]}; }
        else if (tau < 0 && u >= 128) { const float* p = stconv + ((size_t)(u - 128) * 3 + (3 + tau)) * 2048 + ch0; x0[i] = *(const f32x4*)p; x1[i] = *(const f32x4*)(p + 4); } }
#pragma unroll
    for (int r = 0; r < 4; ++r) { f32x4 a0 = b0, a1 = b1;
#pragma unroll
        for (int j = 0; j < 4; ++j) { a0 += x0[r + j] * w0[j]; a1 += x1[r + j] * w1[j]; }
        u32x4 q = {0u, 0u, 0u, 0u};
        if (s0 + r < L) { q.x = pk2(silu_f(a0[0]) * sc, silu_f(a0[1]) * sc); q.y = pk2(silu_f(a0[2]) * sc, silu_f(a0[3]) * sc); q.z = pk2(silu_f(a1[0]) * sc, silu_f(a1[1]) * sc); q.w = pk2(silu_f(a1[2]) * sc, silu_f(a1[3]) * sc); }
        o[r] = q; }
}
__device__ __forceinline__ u32x4 pack8(const float* v, float sc) { u32x4 o; o.x = pk2(v[0] * sc, v[1] * sc); o.y = pk2(v[2] * sc, v[3] * sc); o.z = pk2(v[4] * sc, v[5] * sc); o.w = pk2(v[6] * sc, v[7] * sc); return o; }
__device__ __forceinline__ float logsigmoid_f(float f) { return fminf(f, 0.f) - log1pf(__expf(-fabsf(f))); }
__device__ __forceinline__ void load_gates(const bf16* PROJ, const float* bi, const float* bfg, int u, int h, int t, float& ig, float& lf) {
    const int L = (u < 128) ? 64 : 16; const int r = unit_row0(u) + t;
    ig = -INFINITY; lf = 0.f;
    if (t < L) { ig = bf2f(PROJ[(size_t)r * NINP + C_IG + h]) + bi[h]; lf = logsigmoid_f(bf2f(PROJ[(size_t)r * NINP + C_FG + h]) + bfg[h]); }
}
__device__ __forceinline__ float scan_add(float v, int lane) {
#pragma unroll
    for (int o = 1; o < 64; o <<= 1) { const float x = lane_get(v, lane - o); if (lane >= o) v += x; }
    return v;
}
__device__ __forceinline__ float scan_max(float v, int lane) {
#pragma unroll
    for (int o = 1; o < 64; o <<= 1) { const float x = lane_get(v, lane - o); if (lane >= o) v = fmaxf(v, x); }
    return v;
}
constexpr int MA_K = 0, MA_V = 36864, MA_W = 73728;
constexpr int PK = 576;
__device__ __forceinline__ void mlstm_phaseA(ArgsP A, LAS unsigned char* lds, int u, int h, int tid, int wave, int lane) {
    unsigned char* ws = A->ws; const bf16* PROJ = (const bf16*)(ws + WS_PROJ);
    float* SC = (float*)(ws + WS_SCAL);
    LAS float* wl = (LAS float*)(lds + MA_W);
    const int L = (u < 128) ? 64 : 16, r0 = unit_row0(u);
    if (wave == 0) {
        float ig, lf; load_gates(PROJ, A->in[21], A->in[22], u, h, lane, ig, lf);
        const float b = scan_add(lf, lane); const float G = lane_get(b, 63);
        const float uu = (lane < L) ? G - b + ig : -INFINITY; const float mloc = wave_max(uu, lane);
        wl[lane] = (lane < L) ? __expf(uu - mloc) : 0.f;
        if (lane == 0) { SC[u * 4 + h] = G; SC[640 + u * 4 + h] = mloc; }
    }
    { const int c8 = 8 * (tid & 31), s0 = 4 * (tid >> 5);
      u32x4 ko[4]; conv_rows4(PROJ, A->in[4], A->in[19], A->in[20], u, L, s0, 1024 + h * 256 + c8, 0.0625f, ko);
      u32x4 vr[4];
#pragma unroll
      for (int r = 0; r < 4; ++r) { vr[r] = (u32x4){0u, 0u, 0u, 0u}; if (s0 + r < L) vr[r] = *(const u32x4*)(PROJ + (size_t)(r0 + s0 + r) * NINP + C_VM + h * 256 + c8); }
#pragma unroll
      for (int r = 0; r < 4; ++r) *(LAS u32x4*)(lds + MA_K + (s0 + r) * PK + c8 * 2) = ko[r];
      __syncthreads();
#pragma unroll
      for (int r = 0; r < 4; ++r) { float v[8]; unpack8(vr[r], v); *(LAS u32x4*)(lds + MA_V + (s0 + r) * PK + c8 * 2) = pack8(v, wl[s0 + r]); } }
    __syncthreads();
    { const int i32 = lane & 31, hi = lane >> 5, eb = wave;
      bf16x8 af[4];
#pragma unroll
      for (int ks = 0; ks < 4; ++ks) { const int o = tr_off(PK, 16 * ks + 8 * hi, 32 * eb, lane); af[ks] = mk8(tr_rd(lds + MA_V + o), tr_rd(lds + MA_V + o + 4 * PK)); }
      bf16* dC = (bf16*)(ws + WS_DC) + ((size_t)(u * 4 + h) * 256 + 32 * eb + i32) * 256 + 4 * hi;
      for (int db = 0; db < 8; ++db) { f32x16 acc = {};
#pragma unroll
          for (int ks = 0; ks < 4; ++ks) { const int o = tr_off(PK, 16 * ks + 8 * hi, 32 * db, lane); const bf16x8 bfr = mk8(tr_rd(lds + MA_K + o), tr_rd(lds + MA_K + o + 4 * PK));
              acc = __builtin_amdgcn_mfma_f32_32x32x16_bf16(bfr, af[ks], acc, 0, 0, 0); }
#pragma unroll
          for (int g4 = 0; g4 < 4; ++g4) { u32x2 o; o.x = pk2(acc[4 * g4], acc[4 * g4 + 1]); o.y = pk2(acc[4 * g4 + 2], acc[4 * g4 + 3]); *(u32x2*)(dC + 32 * db + 8 * g4) = o; } } }
    if (tid < 256) { float a = 0.f;
        for (int s = 0; s < 64; ++s) a += wl[s] * bf2f(*(LAS const unsigned short*)(lds + MA_K + s * PK + tid * 2));
        ((float*)(ws + WS_DN))[(size_t)(u * 4 + h) * 256 + tid] = a; }
    __syncthreads();
}
__device__ __forceinline__ void mlstm_phaseB(ArgsP A, LAS unsigned char* lds, int tid, int wave, int lane) {
    unsigned char* ws = A->ws; const float* SC = (const float*)(ws + WS_SCAL); float* MPREV = (float*)(ws + WS_SCAL) + 1280;
    const bf16* DC = (const bf16*)(ws + WS_DC); bf16* CP = (bf16*)(ws + WS_CPREV); const float* DN = (const float*)(ws + WS_DN); float* NP = (float*)(ws + WS_NPREV);
    const int gid = blockIdx.x * NT + tid, gsz = gridDim.x * NT;
    LAS float* AL = (LAS float*)lds; LAS float* BE = AL + 512;
    if (wave < 4) { const int h = wave; const float g0 = SC[lane * 4 + h], g1 = SC[(64 + lane) * 4 + h], l0 = SC[640 + lane * 4 + h], l1 = SC[640 + (64 + lane) * 4 + h];
        float m = 0.f;
        for (int c = 0; c < 128; ++c) { const float G = lane_get((c < 64) ? g0 : g1, c & 63), ml = lane_get((c < 64) ? l0 : l1, c & 63);
            const float mn = fmaxf(G + m, ml);
            if (lane == 0) { AL[h * 128 + c] = __expf(G + m - mn); BE[h * 128 + c] = __expf(ml - mn); if (blockIdx.x == 0) MPREV[c * 4 + h] = m; }
            m = mn; }
        if (blockIdx.x == 0 && lane == 0) A->out[O_MPO + h] = m; }
    __syncthreads();
    for (int idx = gid; idx < 4 * 32768; idx += gsz) { const int h = idx >> 15, el = (idx & 32767) * 2;
        float c0 = 0.f, c1 = 0.f;
        for (int cb = 0; cb < 128; cb += 32) { unsigned d[32];
#pragma unroll
            for (int j = 0; j < 32; ++j) d[j] = *(const unsigned*)(DC + ((size_t)((cb + j) * 4 + h) << 16) + el);
#pragma unroll
            for (int j = 0; j < 32; ++j) { const int c = cb + j; const float al = AL[h * 128 + c], be = BE[h * 128 + c];
                *(unsigned*)(CP + ((size_t)(c * 4 + h) << 16) + el) = pk2(c0, c1);
                c0 = al * c0 + be * __uint_as_float(d[j] << 16); c1 = al * c1 + be * __uint_as_float(d[j] & 0xffff0000u); } }
        *(f32x2_t*)(A->out + O_CP + ((size_t)h << 16) + el) = (f32x2_t){c0, c1}; }
    for (int idx = gid; idx < 4 * 256; idx += gsz) { const int h = idx >> 8, d = idx & 255; float n = 0.f;
        for (int cb = 0; cb < 128; cb += 32) { float dn[32];
#pragma unroll
            for (int j = 0; j < 32; ++j) dn[j] = DN[(size_t)((cb + j) * 4 + h) * 256 + d];
#pragma unroll
            for (int j = 0; j < 32; ++j) { const int c = cb + j; NP[(size_t)(c * 4 + h) * 256 + d] = n; n = AL[h * 128 + c] * n + BE[h * 128 + c] * dn[j]; } }
        A->out[O_NP + h * 256 + d] = n; }
    const float* C0 = A->in[5]; const float* N0 = A->in[6]; const float* M0 = A->in[7];
    for (int i0 = gid; i0 < 128 * 32768; i0 += 8 * gsz) {
        f32x2_t c[8]; unsigned d[8]; float m[8], G[8], ml[8];
#pragma unroll
        for (int k = 0; k < 8; ++k) { const int idx = i0 + k * gsz; if (idx < 128 * 32768) { const int bh = idx >> 15, el = (idx & 32767) * 2, ui = (128 + (bh >> 2)) * 4 + (bh & 3);
            m[k] = M0[bh]; G[k] = SC[ui]; ml[k] = SC[640 + ui]; c[k] = *(const f32x2_t*)(C0 + ((size_t)bh << 16) + el); d[k] = *(const unsigned*)(DC + ((size_t)ui << 16) + el); } }
#pragma unroll
        for (int k = 0; k < 8; ++k) { const int idx = i0 + k * gsz; if (idx < 128 * 32768) { const int bh = idx >> 15, el = (idx & 32767) * 2, ui = (128 + (bh >> 2)) * 4 + (bh & 3);
            const float mn = fmaxf(G[k] + m[k], ml[k]); const float al = __expf(G[k] + m[k] - mn), be = __expf(ml[k] - mn);
            *(unsigned*)(CP + ((size_t)ui << 16) + el) = pk2(c[k].x, c[k].y);
            *(f32x2_t*)(A->out + O_CS + ((size_t)bh << 16) + el) = (f32x2_t){al * c[k].x + be * __uint_as_float(d[k] << 16), al * c[k].y + be * __uint_as_float(d[k] & 0xffff0000u)};
            if (el == 0) { MPREV[ui] = m[k]; A->out[O_MSO + bh] = mn; } } } }
    for (int idx = gid; idx < 128 * 256; idx += gsz) { const int bh = idx >> 8, d = idx & 255, ui = (128 + (bh >> 2)) * 4 + (bh & 3);
        const float m = M0[bh], G = SC[ui], ml = SC[640 + ui]; const float mn = fmaxf(G + m, ml); const float al = __expf(G + m - mn), be = __expf(ml - mn);
        const float n = N0[idx]; NP[(size_t)ui * 256 + d] = n; A->out[O_NS + idx] = al * n + be * DN[(size_t)ui * 256 + d]; }
}
constexpr int MC_Q = 0, MC_K = 33792, MC_V = 67584, MC_S = 104448, MC_F = 113664;
constexpr int PQ = 528, PS = 144;
__device__ __forceinline__ void mlstm_phaseC(ArgsP A, LAS unsigned char* lds, int u, int h, int tid, int wave, int lane) {
    unsigned char* ws = A->ws; const bf16* PROJ = (const bf16*)(ws + WS_PROJ);
    const int L = (u < 128) ? 64 : 16, r0 = unit_row0(u), uh = u * 4 + h;
    LAS float* F = (LAS float*)(lds + MC_F);
    LAS float* rt = F, *gg = F + 64, *winter = F + 128, *eden = F + 192, *nq = F + 256, *denp = F + 320, *ssq = F + 448;
    const int i32 = lane & 31, hi = lane >> 5;
    if (wave == 0) {
        float ig, lf; load_gates(PROJ, A->in[21], A->in[22], u, h, lane, ig, lf);
        const float b = scan_add(lf, lane); const float g = (lane < L) ? ig - b : -INFINITY; const float cm = scan_max(g, lane);
        const float mprev = ((const float*)(ws + WS_SCAL))[1280 + uh]; const float mx = fmaxf(mprev, cm);
        rt[lane] = -mx; gg[lane] = g; winter[lane] = __expf(mprev - mx); eden[lane] = __expf(-(b + mx));
    }
    { const int c8 = 8 * (tid & 31), s0 = 4 * (tid >> 5);
      u32x4 qo[4], ko[4], vo[4];
      conv_rows4(PROJ, A->in[4], A->in[19], A->in[20], u, L, s0, h * 256 + c8, 1.f, qo);
      conv_rows4(PROJ, A->in[4], A->in[19], A->in[20], u, L, s0, 1024 + h * 256 + c8, 0.0625f, ko);
#pragma unroll
      for (int r = 0; r < 4; ++r) { vo[r] = (u32x4){0u, 0u, 0u, 0u}; if (s0 + r < L) vo[r] = *(const u32x4*)(PROJ + (size_t)(r0 + s0 + r) * NINP + C_VM + h * 256 + c8); }
#pragma unroll
      for (int r = 0; r < 4; ++r) { *(LAS u32x4*)(lds + MC_Q + (s0 + r) * PQ + c8 * 2) = qo[r]; *(LAS u32x4*)(lds + MC_K + (s0 + r) * PQ + c8 * 2) = ko[r]; *(LAS u32x4*)(lds + MC_V + (s0 + r) * PK + c8 * 2) = vo[r]; } }
    bf16x8 ca[16];
    { const bf16* Cp = (const bf16*)(ws + WS_CPREV) + ((size_t)uh * 256 + 32 * wave + i32) * 256 + 8 * hi;
#pragma unroll
      for (int kk = 0; kk < 16; ++kk) ca[kk] = *(const bf16x8*)(Cp + 16 * kk); }
    __syncthreads();
    if (wave < 3) {
        const int tt = (wave > 0) ? 1 : 0, st = (wave == 2) ? 1 : 0;
        f32x16 acc = {};
#pragma unroll 4
        for (int kk = 0; kk < 16; ++kk) { const bf16x8 a = *(LAS const bf16x8*)(lds + MC_K + (32 * st + i32) * PQ + (16 * kk + 8 * hi) * 2), b = *(LAS const bf16x8*)(lds + MC_Q + (32 * tt + i32) * PQ + (16 * kk + 8 * hi) * 2);
            acc = __builtin_amdgcn_mfma_f32_32x32x16_bf16(a, b, acc, 0, 0, 0); }
        const int t = 32 * tt + i32; const float rtt = rt[t]; float rs = 0.f;
#pragma unroll
        for (int g4 = 0; g4 < 4; ++g4) { const int s0 = 32 * st + 8 * g4 + 4 * hi; float v[4];
#pragma unroll
            for (int j = 0; j < 4; ++j) { const int s = s0 + j; const float e = __expf(rtt + gg[s]) * acc[4 * g4 + j]; v[j] = (s <= t) ? e : 0.f; rs += v[j]; }
            u32x2 o; o.x = pk2(v[0], v[1]); o.y = pk2(v[2], v[3]); *(LAS u32x2*)(lds + MC_S + t * PS + s0 * 2) = o; }
        rs = xhalf_sum(rs);
        if (hi == 0) { denp[st * 64 + t] = rs; if (wave == 0) denp[64 + t] = 0.f; }
    } else if (wave == 3) {
        const float* np = (const float*)(ws + WS_NPREV) + (size_t)uh * 256 + 8 * hi;
#pragma unroll
        for (int tt = 0; tt < 2; ++tt) { f32x16 acc = {};
#pragma unroll 4
            for (int kk = 0; kk < 16; ++kk) { u32x4 aw = {0u, 0u, 0u, 0u};
                if (i32 == 0) { const f32x4 n0 = *(const f32x4*)(np + 16 * kk), n1 = *(const f32x4*)(np + 16 * kk + 4); aw.x = pk2(n0[0], n0[1]); aw.y = pk2(n0[2], n0[3]); aw.z = pk2(n1[0], n1[1]); aw.w = pk2(n1[2], n1[3]); }
                const bf16x8 b = *(LAS const bf16x8*)(lds + MC_Q + (32 * tt + i32) * PQ + (16 * kk + 8 * hi) * 2);
                acc = __builtin_amdgcn_mfma_f32_32x32x16_bf16(__builtin_bit_cast(bf16x8, aw), b, acc, 0, 0, 0); }
            if (hi == 0) nq[32 * tt + i32] = acc[0]; }
    }
    __syncthreads();
    const int eb = wave, ntt = (L > 32) ? 2 : 1;
    bf16x8 va[4];
#pragma unroll
    for (int ks = 0; ks < 4; ++ks) { const int o = tr_off(PK, 16 * ks + 8 * hi, 32 * eb, lane); va[ks] = mk8(tr_rd(lds + MC_V + o), tr_rd(lds + MC_V + o + 4 * PK)); }
    f32x16 hv[2];
#pragma unroll
    for (int tt = 0; tt < 2; ++tt) { f32x16 acc = {};
        if (tt < ntt) { const int t = 32 * tt + i32;
#pragma unroll
            for (int kk = 0; kk < 16; ++kk) { const bf16x8 b = *(LAS const bf16x8*)(lds + MC_Q + t * PQ + (16 * kk + 8 * hi) * 2);
                acc = __builtin_amdgcn_mfma_f32_32x32x16_bf16(ca[kk], b, acc, 0, 0, 0); }
            const float wi = winter[t];
#pragma unroll
            for (int r = 0; r < 16; ++r) acc[r] *= wi;
#pragma unroll
            for (int ks = 0; ks < 4; ++ks) if (ks < 2 * (tt + 1)) { const bf16x8 b = *(LAS const bf16x8*)(lds + MC_S + t * PS + (16 * ks + 8 * hi) * 2);
                acc = __builtin_amdgcn_mfma_f32_32x32x16_bf16(va[ks], b, acc, 0, 0, 0); }
            const float den = wi * nq[t] + denp[t] + denp[64 + t]; const float inv = 1.f / fmaxf(fabsf(den), eden[t]); float sq = 0.f;
#pragma unroll
            for (int r = 0; r < 16; ++r) { acc[r] *= inv; sq += acc[r] * acc[r]; }
            sq = xhalf_sum(sq); if (hi == 0) ssq[wave * 64 + t] = sq; }
        hv[tt] = acc; }
    __syncthreads();
    bf16* MIX = (bf16*)(ws + WS_MIX); const float* gm = A->in[23] + h * 256;
#pragma unroll
    for (int tt = 0; tt < 2; ++tt) if (tt < ntt) { const int t = 32 * tt + i32;
        if (t < L) { float tot = 0.f;
#pragma unroll
            for (int w = 0; w < 8; ++w) tot += ssq[w * 64 + t];
            const float rstd = 1.f / sqrtf(tot * (1.f / 256.f) + EPS); const size_t row = (size_t)(r0 + t);
#pragma unroll
            for (int g4 = 0; g4 < 4; ++g4) { const int e = 32 * eb + 8 * g4 + 4 * hi; const f32x4 g = *(const f32x4*)(gm + e);
                const u32x2 ov = *(const u32x2*)(PROJ + row * NINP + C_OM + h * 256 + e);
                const float o0 = sigmoid_f(__uint_as_float(ov.x << 16)), o1 = sigmoid_f(__uint_as_float(ov.x & 0xffff0000u)), o2 = sigmoid_f(__uint_as_float(ov.y << 16)), o3 = sigmoid_f(__uint_as_float(ov.y & 0xffff0000u));
                u32x2 w; w.x = pk2(hv[tt][4 * g4] * rstd * g[0] * o0, hv[tt][4 * g4 + 1] * rstd * g[1] * o1); w.y = pk2(hv[tt][4 * g4 + 2] * rstd * g[2] * o2, hv[tt][4 * g4 + 3] * rstd * g[3] * o3);
                *(u32x2*)(MIX + row * DM + 1024 + h * 256 + e) = w; } } }
    __syncthreads();
}
constexpr int AT_PKT = 272, AT_PVT = 320, AT_V = 17408, AT_BUF = 37888;
struct AttnState { f32x16 o[4]; bf16x8 pf[4]; float m, l; };
__device__ __forceinline__ float xhalf_max(float v) { auto rr = __builtin_amdgcn_permlane32_swap(__float_as_uint(v), __float_as_uint(v), false, false); return fmaxf(__uint_as_float(rr[0]), __uint_as_float(rr[1])); }
constexpr float ATT_THR = 6.0f;
__device__ __forceinline__ void attn_qk(LAS const unsigned char* kt, int map, const bf16x8 (&qf)[4], const AttnState& S, f32x16 (&p)[2], int lane) {
    const int i32 = lane & 31, hi = lane >> 5;
#pragma unroll
    for (int kb = 0; kb < 2; ++kb) { f32x16 acc = {};
#pragma unroll
        for (int d0 = 0; d0 < 4; ++d0) { const bf16x8 a = *(LAS const bf16x8*)(kt + (32 * kb + i32) * AT_PKT + (64 * map + 16 * d0 + 8 * hi) * 2);
            acc = __builtin_amdgcn_mfma_f32_32x32x16_bf16(a, qf[d0], acc, 0, 0, 0); }
        p[kb] = acc; }
}
__device__ __forceinline__ void attn_pv(LAS const unsigned char* vt, AttnState& S, int lane) {
    const int hi = lane >> 5;
    LAS const unsigned char* base = vt + tr_off(AT_PVT, 4 * hi, 0, lane);
#pragma unroll
    for (int st = 0; st < 4; ++st) { s16x4 lo[4], hh[4];
#pragma unroll
        for (int eb = 0; eb < 4; ++eb) { lo[eb] = tr_rd(base + st * 16 * AT_PVT + eb * 64); hh[eb] = tr_rd(base + st * 16 * AT_PVT + eb * 64 + 8 * AT_PVT); }
#pragma unroll
        for (int eb = 0; eb < 4; ++eb) S.o[eb] = __builtin_amdgcn_mfma_f32_32x32x16_bf16(mk8(lo[eb], hh[eb]), S.pf[st], S.o[eb], 0, 0, 0);
    }
}
__device__ __forceinline__ void attn_softmax(f32x16 (&p)[2], AttnState& S, int nvalid, int lane) {
    const int hi = lane >> 5;
    if (nvalid < 64) {
#pragma unroll
        for (int kb = 0; kb < 2; ++kb)
#pragma unroll
            for (int r = 0; r < 16; ++r) if (32 * kb + crow(r, hi) >= nvalid) p[kb][r] = -INFINITY; }
    float ma = fmaxf(fmaxf(p[0][0], p[0][1]), p[1][0]), mb = fmaxf(fmaxf(p[0][2], p[0][3]), p[1][1]);
    ma = fmaxf(fmaxf(ma, p[1][2]), p[1][3]);
#pragma unroll
    for (int r = 4; r < 16; r += 4) { ma = fmaxf(fmaxf(ma, p[0][r]), p[0][r + 1]); mb = fmaxf(fmaxf(mb, p[0][r + 2]), p[0][r + 3]); ma = fmaxf(fmaxf(ma, p[1][r]), p[1][r + 1]); mb = fmaxf(fmaxf(mb, p[1][r + 2]), p[1][r + 3]); }
    const float mref = S.m; const float mx = xhalf_max(fmaxf(ma, mb)) - mref;
#pragma unroll
    for (int kb = 0; kb < 2; ++kb)
#pragma unroll
        for (int r = 0; r < 16; ++r) p[kb][r] = __builtin_amdgcn_exp2f(p[kb][r] - mref);
    if (__any(mx > ATT_THR)) {
        const float dl = fmaxf(mx, 0.f); S.m += dl;
        const float f = __builtin_amdgcn_exp2f(-dl); S.l *= f;
#pragma unroll
        for (int kb = 0; kb < 2; ++kb)
#pragma unroll
            for (int r = 0; r < 16; ++r) p[kb][r] *= f;
#pragma unroll
        for (int eb = 0; eb < 4; ++eb)
#pragma unroll
            for (int r = 0; r < 16; ++r) S.o[eb][r] *= f;
    }
    float sa = 0.f, sb = 0.f;
#pragma unroll
    for (int kb = 0; kb < 2; ++kb)
#pragma unroll
        for (int r = 0; r < 16; r += 2) { sa += p[kb][r]; sb += p[kb][r + 1]; }
    S.l += sa + sb;
#pragma unroll
    for (int kb = 0; kb < 2; ++kb)
#pragma unroll
        for (int ks = 0; ks < 2; ++ks) { u32x4 pw; pw.x = pk2(p[kb][8 * ks], p[kb][8 * ks + 1]); pw.y = pk2(p[kb][8 * ks + 2], p[kb][8 * ks + 3]); pw.z = pk2(p[kb][8 * ks + 4], p[kb][8 * ks + 5]); pw.w = pk2(p[kb][8 * ks + 6], p[kb][8 * ks + 7]);
            S.pf[2 * kb + ks] = __builtin_bit_cast(bf16x8, pw); }
}
__device__ __forceinline__ void attn_step(LAS const unsigned char* ktn, LAS const unsigned char* vtc, int map, const bf16x8 (&qf)[4], AttnState& S, int lane) {
    const int i32 = lane & 31, hi = lane >> 5;
    f32x16 p[2];
    LAS const unsigned char* base = vtc + tr_off(AT_PVT, 4 * hi, 0, lane);
    s16x4 lo[2][4], hh[2][4];
#pragma unroll
    for (int eb = 0; eb < 4; ++eb) { lo[0][eb] = tr_rd(base + eb * 64); hh[0][eb] = tr_rd(base + eb * 64 + 8 * AT_PVT); }
#pragma unroll
    for (int kb = 0; kb < 2; ++kb) { f32x16 acc = {};
#pragma unroll
        for (int d0 = 0; d0 < 4; ++d0) { const bf16x8 a = *(LAS const bf16x8*)(ktn + (32 * kb + i32) * AT_PKT + (64 * map + 16 * d0 + 8 * hi) * 2);
            acc = __builtin_amdgcn_mfma_f32_32x32x16_bf16(a, qf[d0], acc, 0, 0, 0); }
        p[kb] = acc; }
    const float mref = S.m;
    __builtin_amdgcn_sched_barrier(0);
#pragma unroll
    for (int st = 0; st < 4; ++st) {
        if (st < 3) {
#pragma unroll
            for (int eb = 0; eb < 4; ++eb) { lo[(st + 1) & 1][eb] = tr_rd(base + (st + 1) * 16 * AT_PVT + eb * 64); hh[(st + 1) & 1][eb] = tr_rd(base + (st + 1) * 16 * AT_PVT + eb * 64 + 8 * AT_PVT); } }
        __builtin_amdgcn_sched_barrier(0);
#pragma unroll
        for (int eb = 0; eb < 4; ++eb) {
            S.o[eb] = __builtin_amdgcn_mfma_f32_32x32x16_bf16(mk8(lo[st & 1][eb], hh[st & 1][eb]), S.pf[st], S.o[eb], 0, 0, 0);
            const int e0 = 2 * (4 * st + eb);
            p[e0 >> 4][e0 & 15] = __builtin_amdgcn_exp2f(p[e0 >> 4][e0 & 15] - mref); p[e0 >> 4][(e0 & 15) + 1] = __builtin_amdgcn_exp2f(p[e0 >> 4][(e0 & 15) + 1] - mref);
            __builtin_amdgcn_sched_barrier(0);
        }
    }
    float ma = fmaxf(fmaxf(p[0][0], p[0][1]), p[1][0]), mb = fmaxf(fmaxf(p[0][2], p[0][3]), p[1][1]);
    ma = fmaxf(fmaxf(ma, p[1][2]), p[1][3]);
#pragma unroll
    for (int r = 4; r < 16; r += 4) { ma = fmaxf(fmaxf(ma, p[0][r]), p[0][r + 1]); mb = fmaxf(fmaxf(mb, p[0][r + 2]), p[0][r + 3]); ma = fmaxf(fmaxf(ma, p[1][r]), p[1][r + 1]); mb = fmaxf(fmaxf(mb, p[1][r + 2]), p[1][r + 3]); }
    const float emx = xhalf_max(fmaxf(ma, mb));
    if (__any(emx > 64.0f)) {
        const float dl = fmaxf(__builtin_amdgcn_logf(emx), 0.f);
        S.m += dl;
        const float f = __builtin_amdgcn_exp2f(-dl); S.l *= f;
#pragma unroll
        for (int kb = 0; kb < 2; ++kb)
#pragma unroll
            for (int r = 0; r < 16; ++r) p[kb][r] *= f;
#pragma unroll
        for (int eb = 0; eb < 4; ++eb)
#pragma unroll
            for (int r = 0; r < 16; ++r) S.o[eb][r] *= f;
    }
    float sa = 0.f, sb = 0.f;
#pragma unroll
    for (int kb = 0; kb < 2; ++kb)
#pragma unroll
        for (int r = 0; r < 16; r += 2) { sa += p[kb][r]; sb += p[kb][r + 1]; }
    S.l += sa + sb;
#pragma unroll
    for (int kb = 0; kb < 2; ++kb)
#pragma unroll
        for (int ks = 0; ks < 2; ++ks) { u32x4 pw; pw.x = pk2(p[kb][8 * ks], p[kb][8 * ks + 1]); pw.y = pk2(p[kb][8 * ks + 2], p[kb][8 * ks + 3]); pw.z = pk2(p[kb][8 * ks + 4], p[kb][8 * ks + 5]); pw.w = pk2(p[kb][8 * ks + 6], p[kb][8 * ks + 7]);
            S.pf[2 * kb + ks] = __builtin_bit_cast(bf16x8, pw); }
}
__device__ __forceinline__ void attn_tile(LAS const unsigned char* kt, LAS const unsigned char* vt, int map, const bf16x8 (&qf)[4], AttnState& S, int nvalid, int lane) {
    f32x16 p[2]; attn_qk(kt, map, qf, S, p, lane); attn_softmax(p, S, nvalid, lane); attn_pv(vt, S, lane);
}
__device__ __forceinline__ void attn_finish(ArgsP A, LAS unsigned char* lds, AttnState& S, int map, int g, int h, size_t row_base, int nrows, float lam, int lane) {
    const int i32 = lane & 31, hi = lane >> 5;
    const float lt = xhalf_sum(S.l); const float inv = 1.f / lt;
    LAS float* X = (LAS float*)lds + g * 4096;
    __syncthreads();
    if (map == 1) {
#pragma unroll
        for (int eb = 0; eb < 4; ++eb)
#pragma unroll
            for (int r = 0; r < 16; ++r) X[(32 * eb + crow(r, hi)) * 32 + i32] = S.o[eb][r] * inv; }
    __syncthreads();
    if (map == 0) { float sq = 0.f;
#pragma unroll
        for (int eb = 0; eb < 4; ++eb)
#pragma unroll
            for (int r = 0; r < 16; ++r) { const float v = S.o[eb][r] * inv - lam * X[(32 * eb + crow(r, hi)) * 32 + i32]; S.o[eb][r] = v; sq += v * v; }
        sq = xhalf_sum(sq);
        const float rstd = (1.f - LAM_INIT) / sqrtf(sq * (1.f / 128.f) + EPS);
        if (i32 < nrows) { bf16* mp = (bf16*)(A->ws + WS_MIX) + (row_base + i32) * DM + h * 128; const float* gs = A->in[18] + h * 128;
#pragma unroll
            for (int eb = 0; eb < 4; ++eb)
#pragma unroll
                for (int g4 = 0; g4 < 4; ++g4) { const int e = 32 * eb + 8 * g4 + 4 * hi; const f32x4 gv = *(const f32x4*)(gs + e);
                    u32x2 w; w.x = pk2(S.o[eb][4 * g4] * rstd * gv[0], S.o[eb][4 * g4 + 1] * rstd * gv[1]); w.y = pk2(S.o[eb][4 * g4 + 2] * rstd * gv[2], S.o[eb][4 * g4 + 3] * rstd * gv[3]);
                    *(u32x2*)(mp + e) = w; } } }
    __syncthreads();
}
__device__ __forceinline__ void attn_prompt_unit(ArgsP A, LAS unsigned char* lds, int h, int qb, float lam, int tid, int wave, int lane) {
    unsigned char* ws = A->ws; const bf16* QA = (const bf16*)(ws + WS_QA); const bf16* KA = (const bf16*)(ws + WS_KA); const bf16* PROJ = (const bf16*)(ws + WS_PROJ);
    const int map = wave & 1, g = wave >> 1, i32 = lane & 31, hi = lane >> 5;
    const int ntiles = 2 * qb + 2, mytiles = 2 * qb + (g >> 1) + 1;
    bf16x8 qf[4];
    { const bf16* qp = QA + (size_t)(128 * qb + 32 * g + i32) * 1024 + h * 128 + 64 * map + 8 * hi;
#pragma unroll
      for (int d0 = 0; d0 < 4; ++d0) qf[d0] = *(const bf16x8*)(qp + 16 * d0); }
    AttnState S; S.m = 0.f; S.l = 0.f;
#pragma unroll
    for (int i = 0; i < 4; ++i) S.pf[i] = (bf16x8){0, 0, 0, 0, 0, 0, 0, 0};
#pragma unroll
    for (int eb = 0; eb < 4; ++eb) S.o[eb] = (f32x16){};
    const int key = tid >> 3, seg = tid & 7;
    const bf16* kp = KA + (size_t)key * 1024 + h * 128 + 16 * seg; const bf16* vp = PROJ + (size_t)key * NINP + C_VA + h * 128 + 16 * seg;
    const int ko = key * AT_PKT + seg * 32, vo = AT_V + key * AT_PVT + seg * 32;
    { u32x4 k0 = *(const u32x4*)kp, k1 = *(const u32x4*)(kp + 8), v0 = *(const u32x4*)vp, v1 = *(const u32x4*)(vp + 8);
      const bf16* kq = kp + (size_t)64 * 1024; const bf16* vq = vp + (size_t)64 * NINP;
      u32x4 k2 = *(const u32x4*)kq, k3 = *(const u32x4*)(kq + 8), v2 = *(const u32x4*)vq, v3 = *(const u32x4*)(vq + 8);
      *(LAS u32x4*)(lds + ko) = k0; *(LAS u32x4*)(lds + ko + 16) = k1; *(LAS u32x4*)(lds + vo) = v0; *(LAS u32x4*)(lds + vo + 16) = v1;
      *(LAS u32x4*)(lds + AT_BUF + ko) = k2; *(LAS u32x4*)(lds + AT_BUF + ko + 16) = k3; *(LAS u32x4*)(lds + AT_BUF + vo) = v2; *(LAS u32x4*)(lds + AT_BUF + vo + 16) = v3; }
    __syncthreads();
    { f32x16 p[2]; attn_qk(lds, map, qf, S, p, lane); attn_softmax(p, S, 64, lane); }
    int bc = 0, bn = AT_BUF, bw = 2 * AT_BUF;
    for (int j = 0; j < ntiles; ++j) {
        const bool more = (j + 2 < ntiles);
        u32x4 k0, k1, v0, v1;
        if (more) { const bf16* kq = kp + (size_t)(j + 2) * 64 * 1024; const bf16* vq = vp + (size_t)(j + 2) * 64 * NINP;
            k0 = *(const u32x4*)kq; k1 = *(const u32x4*)(kq + 8); v0 = *(const u32x4*)vq; v1 = *(const u32x4*)(vq + 8); }
        if (j + 1 < mytiles) attn_step(lds + bn, lds + bc + AT_V, map, qf, S, lane);
        else if (j < mytiles) attn_pv(lds + bc + AT_V, S, lane);
        if (more) { LAS unsigned char* w = lds + bw; *(LAS u32x4*)(w + ko) = k0; *(LAS u32x4*)(w + ko + 16) = k1; *(LAS u32x4*)(w + vo) = v0; *(LAS u32x4*)(w + vo + 16) = v1; }
        __syncthreads();
        const int t = bc; bc = bn; bn = bw; bw = t;
    }
    attn_finish(A, lds, S, map, g, h, (size_t)(128 * qb + 32 * g), 32, lam, lane);
}
__device__ __forceinline__ void attn_sample_unit(ArgsP A, LAS unsigned char* lds, int b, int h, float lam, int tid, int wave, int lane) {
    unsigned char* ws = A->ws; const bf16* QA = (const bf16*)(ws + WS_QA); const bf16* KA = (const bf16*)(ws + WS_KA); const bf16* PROJ = (const bf16*)(ws + WS_PROJ);
    const int map = wave & 1, i32 = lane & 31, hi = lane >> 5; const bool comp = wave < 2;
    bf16x8 qf[4];
#pragma unroll
    for (int d0 = 0; d0 < 4; ++d0) qf[d0] = (bf16x8){0, 0, 0, 0, 0, 0, 0, 0};
    if (i32 < 16) { const bf16* qp = QA + (size_t)(MP + 16 * b + i32) * 1024 + h * 128 + 64 * map + 8 * hi;
#pragma unroll
      for (int d0 = 0; d0 < 4; ++d0) qf[d0] = *(const bf16x8*)(qp + 16 * d0); }
    AttnState S; S.m = 0.f; S.l = 0.f;
#pragma unroll
    for (int i = 0; i < 4; ++i) S.pf[i] = (bf16x8){0, 0, 0, 0, 0, 0, 0, 0};
#pragma unroll
    for (int eb = 0; eb < 4; ++eb) S.o[eb] = (f32x16){};
    const int key = tid >> 3, seg = tid & 7;
    const float* kc = A->in[2] + (((size_t)b * PAST + key) * 8 + h) * 128 + 16 * seg; const float* vc = A->in[3] + (((size_t)b * PAST + key) * 8 + h) * 128 + 16 * seg;
    const int ko = key * AT_PKT + seg * 32, vo = AT_V + key * AT_PVT + seg * 32;
    f32x4 kr[4], vr[4];
#pragma unroll
    for (int i = 0; i < 4; ++i) { kr[i] = *(const f32x4*)(kc + 4 * i); vr[i] = *(const f32x4*)(vc + 4 * i); }
    for (int j = 0; j < 17; ++j) {
        LAS unsigned char* nb = lds + (j & 1) * AT_BUF;
        if (j < 16) { u32x4 a, c;
            a.x = pk2(kr[0][0], kr[0][1]); a.y = pk2(kr[0][2], kr[0][3]); a.z = pk2(kr[1][0], kr[1][1]); a.w = pk2(kr[1][2], kr[1][3]);
            c.x = pk2(kr[2][0], kr[2][1]); c.y = pk2(kr[2][2], kr[2][3]); c.z = pk2(kr[3][0], kr[3][1]); c.w = pk2(kr[3][2], kr[3][3]);
            *(LAS u32x4*)(nb + ko) = a; *(LAS u32x4*)(nb + ko + 16) = c;
            a.x = pk2(vr[0][0], vr[0][1]); a.y = pk2(vr[0][2], vr[0][3]); a.z = pk2(vr[1][0], vr[1][1]); a.w = pk2(vr[1][2], vr[1][3]);
            c.x = pk2(vr[2][0], vr[2][1]); c.y = pk2(vr[2][2], vr[2][3]); c.z = pk2(vr[3][0], vr[3][1]); c.w = pk2(vr[3][2], vr[3][3]);
            *(LAS u32x4*)(nb + vo) = a; *(LAS u32x4*)(nb + vo + 16) = c;
        } else { u32x4 a = {0u, 0u, 0u, 0u}, c = a, d = a, e = a;
            if (key < 16) { const bf16* kq = KA + (size_t)(MP + 16 * b + key) * 1024 + h * 128 + 16 * seg; const bf16* vq = PROJ + (size_t)(MP + 16 * b + key) * NINP + C_VA + h * 128 + 16 * seg;
                a = *(const u32x4*)kq; c = *(const u32x4*)(kq + 8); d = *(const u32x4*)vq; e = *(const u32x4*)(vq + 8); }
            *(LAS u32x4*)(nb + ko) = a; *(LAS u32x4*)(nb + ko + 16) = c; *(LAS u32x4*)(nb + vo) = d; *(LAS u32x4*)(nb + vo + 16) = e; }
        if (j + 1 < 16) {
#pragma unroll
            for (int i = 0; i < 4; ++i) { kr[i] = *(const f32x4*)(kc + (size_t)(j + 1) * 64 * 1024 + 4 * i); vr[i] = *(const f32x4*)(vc + (size_t)(j + 1) * 64 * 1024 + 4 * i); } }
        __syncthreads();
        if (comp) attn_tile(nb, nb + AT_V, map, qf, S, (j < 16) ? 64 : 16, lane);
    }
    attn_finish(A, lds, S, comp ? map : 2, 0, h, (size_t)(MP + 16 * b), 16, lam, lane);
}
template <int NPART> __device__ __forceinline__ void final_norm_rows(float* y, const float* __restrict__ g, int wave, int lane, const float* x1S, const bf16* part, const float* gate) {
    const int gw = blockIdx.x * NW + wave, NGW = gridDim.x * NW;
    for (int r = gw; r < MTOK; r += NGW) { float* yr = y + (size_t)r * DM; f32x4 v[8]; float s = 0.f;
        if (r < MP) {
#pragma unroll
            for (int j = 0; j < 8; ++j) v[j] = *(const f32x4*)(yr + 256 * j + 4 * lane);
        } else {
            const float* gr = gate + (size_t)(1 + ((r - MP) >> 4)) * 12288;
#pragma unroll
            for (int j = 0; j < 8; ++j) { const int c = 256 * j + 4 * lane; f32x4 a = {0.f, 0.f, 0.f, 0.f};
                f32x4 t[NPART];
#pragma unroll
                for (int p = 0; p < NPART; ++p) t[p] = ld_bf4(part + ((size_t)p * MS + (r - MP)) * DM + c);
#pragma unroll
                for (int p = 0; p < NPART; ++p) a += t[p];
                v[j] = *(const f32x4*)(x1S + (size_t)(r - MP) * DM + c) + *(const f32x4*)(gr + c) * a; } }
#pragma unroll
        for (int j = 0; j < 8; ++j) s += (v[j].x * v[j].x + v[j].y * v[j].y) + (v[j].z * v[j].z + v[j].w * v[j].w);
        const float rstd = 1.f / sqrtf(wave_sum(s, lane) * (1.f / DM) + EPS);
#pragma unroll
        for (int j = 0; j < 8; ++j) { const f32x4 gg = *(const f32x4*)(g + 256 * j + 4 * lane); *(f32x4*)(yr + 256 * j + 4 * lane) = v[j] * rstd * gg; } }
}
__global__ void __launch_bounds__(NT, 2) fwd_megakernel(Args A_) {
    extern __shared__ __attribute__((aligned(16))) unsigned char lds_raw[];
    LAS unsigned char* lds = (LAS unsigned char*)lds_raw;
    cg::grid_group grid = cg::this_grid();
    int tid, lane, wave;
#define FRESH_TID() do { tid = threadIdx.x; asm volatile("" : "+v"(tid)); lane = tid & 63; wave = __builtin_amdgcn_readfirstlane(tid >> 6); } while (0)
    FRESH_TID();
    ArgsP A = FRESH_ARGS();
    unsigned char* ws = A->ws;
    float* mod = (float*)(ws + WS_MOD);
    const int G = gridDim.x, bid = blockIdx.x;
    A = FRESH_ARGS(); ws = A->ws; mod = (float*)(ws + WS_MOD); FRESH_TID();
    if (bid == 0) for (int i = tid; i < 8192; i += NT) ((unsigned*)(ws + WS_FLAG))[i] = 0u;
    if (tid < 2) ((volatile LAS unsigned*)(lds + LDS_BYTES - 16))[tid] = 0u;
#ifndef NO_P0
    p0_prologue(A, lds, tid, wave, lane);
#endif
    grid.sync();
    XcdBarrier xb = xcd_barrier_post((unsigned*)(ws + WS_FLAG) + 1024, (volatile LAS unsigned*)(lds + LDS_BYTES - 16));
    A = FRESH_ARGS(); ws = A->ws; mod = (float*)(ws + WS_MOD); FRESH_TID();
    norm_mod_rows<0>(A->in[0], A->in[1], A->in[12], mod, 0, 2048, (bf16*)(ws + WS_XN), wave, lane);
    xcd_barrier(xb);
    A = FRESH_ARGS(); ws = A->ws; mod = (float*)(ws + WS_MOD); FRESH_TID();
    { pg8::Gemm g{(const pg8::bf16_t*)(ws + WS_XN), (const pg8::bf16_t*)(ws + WS_WIN), MTOK, NINP, DM, DM}; pg8::StaticOrder S; S.init(MTOK, NINP, G, bid);
      pg8::EpiStore<0> E{(pg8::bf16_t*)(ws + WS_PROJ), NINP};
      pg8::gemm_phase<pg8::EpiStore<0>, pg8::StaticOrder, true, true>(lds, g, S, E); }
    xcd_barrier(xb);
    A = FRESH_ARGS(); ws = A->ws; mod = (float*)(ws + WS_MOD); FRESH_TID();
#ifndef NO_P3
    p3_post(A, tid);
#endif
#ifndef NO_PA
    for (int i = bid; i < NCH * 4; i += G) mlstm_phaseA(A, lds, i >> 2, i & 3, tid, wave, lane);
#endif
    xcd_barrier(xb);
    A = FRESH_ARGS(); ws = A->ws; mod = (float*)(ws + WS_MOD); FRESH_TID();
#ifndef NO_PB
    mlstm_phaseB(A, lds, tid, wave, lane);
#endif
    xcd_barrier(xb);
    A = FRESH_ARGS(); ws = A->ws; mod = (float*)(ws + WS_MOD); FRESH_TID();
    { const float s1 = wave_sum(A->in[14][lane] * A->in[15][lane], lane), s2 = wave_sum(A->in[16][lane] * A->in[17][lane], lane);
      const float lam = __expf(s1) - __expf(s2) + LAM_INIT;
      for (int i = bid; i < 256; i += G) { const int h = i & 7, p = i >> 3;
#ifndef NO_AP
          attn_prompt_unit(A, lds, h, 63 - p, lam, tid, wave, lane);
          attn_prompt_unit(A, lds, h, p, lam, tid, wave, lane);
#endif
#ifndef NO_AS
          attn_sample_unit(A, lds, i >> 3, i & 7, lam, tid, wave, lane);
#endif
      }
      FRESH_TID();
#ifndef NO_PC
      for (int i = bid; i < NCH * 4; i += G) mlstm_phaseC(A, lds, i >> 2, i & 3, tid, wave, lane);
#endif
    }
    xcd_barrier(xb);
    A = FRESH_ARGS(); ws = A->ws; mod = (float*)(ws + WS_MOD); FRESH_TID();
    { pg8::Gemm g{(const pg8::bf16_t*)(ws + WS_MIX), (const pg8::bf16_t*)(ws + WS_WOUT), MP, DM, DM, DM}; pg8::StaticOrder S; S.init(MP, DM, G, bid);
      pg8::EpiResid E{A->in[0], A->in[1], mod + 4096, (float*)(ws + WS_X1)};
      pg8::gemm_phase<pg8::EpiResid, pg8::StaticOrder, true, true>(lds, g, S, E); }
    for (int un = bid; un < 128; un += G) { const int tile = un >> 3, kc = un & 7;
      pg8::Gemm g{(const pg8::bf16_t*)(ws + WS_MIX) + 256 * kc, (const pg8::bf16_t*)(ws + WS_WOUT) + 256 * kc, MTOK, DM, 256, DM}; pg8::OneUnit S{{32 + (tile >> 3), tile & 7}};
      pg8::EpiPart E{(pg8::bf16_t*)(ws + WS_PART6) + (size_t)kc * MS * DM, DM};
      pg8::gemm_phase<pg8::EpiPart, pg8::OneUnit, false, true>(lds, g, S, E); }
    xcd_barrier(xb);
    A = FRESH_ARGS(); ws = A->ws; mod = (float*)(ws + WS_MOD); FRESH_TID();
    norm_mod_rows<8>((const float*)(ws + WS_X1), A->in[1], A->in[25], mod, 6144, 8192, (bf16*)(ws + WS_XN), wave, lane, (const bf16*)(ws + WS_PART6), 4096, (float*)(ws + WS_X1) + (size_t)MP * DM);
    xcd_barrier(xb);
    A = FRESH_ARGS(); ws = A->ws; mod = (float*)(ws + WS_MOD); FRESH_TID();
    { pg8::Gemm g{(const pg8::bf16_t*)(ws + WS_XN), (const pg8::bf16_t*)(ws + WS_WUP), MP, DFF, DM, DM}; pg8::StaticOrder S; S.init(MP, DFF, G, bid);
      pg8::EpiStore<2> E{(pg8::bf16_t*)(ws + WS_H), DFF};
      pg8::gemm_phase<pg8::EpiStore<2>, pg8::StaticOrder, true, true>(lds, g, S, E); }
    for (int un = bid; un < 256; un += G) { const int tile = un >> 2, kq = un & 3;
      pg8::Gemm g{(const pg8::bf16_t*)(ws + WS_XN) + 512 * kq, (const pg8::bf16_t*)(ws + WS_WUP) + 512 * kq, MTOK, DFF, 512, DM}; pg8::OneUnit S{{32 + (tile >> 5), tile & 31}};
      pg8::EpiPart E{(pg8::bf16_t*)(ws + WS_PART8) + (size_t)kq * MS * DFF, DFF};
      pg8::gemm_phase<pg8::EpiPart, pg8::OneUnit, false, true>(lds, g, S, E); }
    xcd_barrier(xb);
    A = FRESH_ARGS(); ws = A->ws; mod = (float*)(ws + WS_MOD); FRESH_TID();
    { const bf16* P8 = (const bf16*)(ws + WS_PART8); bf16* H = (bf16*)(ws + WS_H);
      for (int r = bid; r < MS; r += G)
          for (int c = 4 * tid; c < DFF; c += 4 * NT) { f32x4 a = ld_bf4(P8 + (size_t)r * DFF + c);
#pragma unroll
              for (int p = 1; p < 4; ++p) a += ld_bf4(P8 + ((size_t)p * MS + r) * DFF + c);
              a.x = fmaxf(a.x, 0.f); a.y = fmaxf(a.y, 0.f); a.z = fmaxf(a.z, 0.f); a.w = fmaxf(a.w, 0.f);
              u32x2 o; o.x = pk2(a.x * a.x, a.y * a.y); o.y = pk2(a.z * a.z, a.w * a.w); *(u32x2*)(H + (size_t)(MP + r) * DFF + c) = o; }
      __threadfence(); __syncthreads();
      if (tid == 0) __hip_atomic_fetch_add((unsigned*)(ws + WS_FLAG), 1u, __ATOMIC_RELEASE, __HIP_MEMORY_SCOPE_AGENT); }
    { pg8::Gemm g{(const pg8::bf16_t*)(ws + WS_H), (const pg8::bf16_t*)(ws + WS_WDN), MP, DM, DFF, DFF}; pg8::StaticOrder S; S.init(MP, DM, G, bid);
      pg8::EpiResid E{(const float*)(ws + WS_X1), (const float*)(ws + WS_X1) + (size_t)MP * DM, mod + 10240, A->out};
      pg8::gemm_phase<pg8::EpiResid, pg8::StaticOrder, true, true>(lds, g, S, E); }
    { if (tid == 0) { while (__hip_atomic_load((unsigned*)(ws + WS_FLAG), __ATOMIC_ACQUIRE, __HIP_MEMORY_SCOPE_AGENT) < (unsigned)G) __builtin_amdgcn_s_sleep(8); }
      __syncthreads(); __builtin_amdgcn_fence(__ATOMIC_ACQUIRE, "agent"); }
    for (int un = bid; un < 256; un += G) { const int tile = un >> 4, kc = un & 15;
      pg8::Gemm g{(const pg8::bf16_t*)(ws + WS_H) + 512 * kc, (const pg8::bf16_t*)(ws + WS_WDN) + 512 * kc, MTOK, DM, 512, DFF}; pg8::OneUnit S{{32 + (tile >> 3), tile & 7}};
      pg8::EpiPart E{(pg8::bf16_t*)(ws + WS_PART9) + (size_t)kc * MS * DM, DM};
      pg8::gemm_phase<pg8::EpiPart, pg8::OneUnit, false, true>(lds, g, S, E); }
    xcd_barrier(xb);
    A = FRESH_ARGS(); ws = A->ws; mod = (float*)(ws + WS_MOD); FRESH_TID();
    final_norm_rows<16>(A->out, A->in[28], wave, lane, (const float*)(ws + WS_X1) + (size_t)MP * DM, (const bf16*)(ws + WS_PART9), mod + 10240);
}

extern "C" void kernel_launch(void* const* d_in, const int* in_sizes, int n_in, void* d_out, int out_size, void* d_ws, size_t ws_size, hipStream_t stream) {
    static int grid = 0;
    if (grid == 0) {
        if (n_in != 29 || ws_size < WS_END) { fprintf(stderr, "kernel_launch: unexpected n_in %d / ws %zu\n", n_in, ws_size); grid = -1; return; }
        int dev = 0, cus = 0, per_cu = 0;
        (void)hipGetDevice(&dev); (void)hipDeviceGetAttribute(&cus, hipDeviceAttributeMultiprocessorCount, dev);
        (void)hipFuncSetAttribute((const void*)fwd_megakernel, hipFuncAttributeMaxDynamicSharedMemorySize, LDS_BYTES);
        (void)hipOccupancyMaxActiveBlocksPerMultiprocessor(&per_cu, (const void*)fwd_megakernel, NT, LDS_BYTES);
        (void)hipGetLastError();
        grid = cus;
    }
    if (grid < 0) return;
    Args a{};
    for (int i = 0; i < 29; ++i) a.in[i] = (const float*)d_in[i];
    a.out = (float*)d_out; a.ws = (unsigned char*)d_ws;
    void* args[] = {&a};
    hipError_t e = hipLaunchCooperativeKernel((void*)fwd_megakernel, dim3(grid), dim3(NT), args, LDS_BYTES, stream);
    if (e != hipSuccess) fprintf(stderr, "cooperative launch failed: %s (grid %d)\n", hipGetErrorString(e), grid);
}
```

```cpp
#include <hip/hip_runtime.h>
#include <hip/hip_cooperative_groups.h>
#include <cstdio>
#include <cstdint>
namespace cg = cooperative_groups;
namespace pg8 {
#define PG8_LAS __attribute__((address_space(3)))
typedef unsigned short bf16_t;
typedef short bf16x8 __attribute__((ext_vector_type(8)));
typedef float f32x4 __attribute__((ext_vector_type(4)));
typedef unsigned u32x4 __attribute__((ext_vector_type(4)));
constexpr int BM = 256, BK = 64, HALF = 128, HTB = HALF * BK * 2  , STAGE_BYTES = 8 * HTB, NXCD = 8, WGM = 8;

__host__ __device__ __forceinline__ int lds_byte(int r, int c) { const int st = (r >> 4) * 2 + (c >> 5), rr = r & 15, cc = c & 31, ob = rr * 64 + cc * 2; return st * 1024 + (ob ^ (((ob >> 9) & 1) << 5)); }
__host__ __device__ __forceinline__ void stage_rc(int b, int& R, int& C) { const int st = b / 1024, sb = b % 1024, swz = sb ^ (((sb >> 9) & 1) << 5); R = (st >> 1) * 16 + swz / 64; C = (st & 1) * 32 + (swz % 64) / 2; }
__host__ __device__ __forceinline__ int perm32(int rho) { const int n = rho >> 4, i = rho & 15; return 8 * (i >> 2) + 4 * n + (i & 3); }

struct Unit { int pm, pn; };
struct Gemm { const bf16_t* A; const bf16_t* Bt; int M, N, K, ld; };

struct StaticOrder {
    int nM, nN, nwg, G, c;
    __host__ __device__ void init(int M, int N, int G_, int c_) { nM = M / BM; nN = N / BM; nwg = nM * nN; G = G_; c = c_; }
    __host__ __device__ bool next(int i, Unit& u) const {
        const long L = (long)i * G + c; if (L >= nwg) return false;
        int wgid = (int)L; { const int q = nwg / NXCD, r = nwg % NXCD, xcd = wgid % NXCD, off = wgid / NXCD; wgid = (xcd < r ? xcd * (q + 1) : r * (q + 1) + (xcd - r) * q) + off; }
        const int nig = WGM * nN, gid = wgid / nig, fm = gid * WGM, gsz = (nM - fm) < WGM ? (nM - fm) : WGM;
        u.pm = fm + ((wgid % nig) % gsz); u.pn = (wgid % nig) / gsz; return true;
    }
    __device__ __forceinline__ void a_ready(const Unit&) const {}
    __device__ __forceinline__ void done(const Unit&) const {}
};

typedef float f32x2_t __attribute__((ext_vector_type(2)));
typedef __bf16 bf16x2_t __attribute__((ext_vector_type(2)));
__device__ __forceinline__ unsigned cvt_pk_bf16(float lo, float hi) { f32x2_t v = {lo, hi}; bf16x2_t b = __builtin_convertvector(v, bf16x2_t); return __builtin_bit_cast(unsigned, b); }
template <int ACT  > struct EpiStore {
    static constexpr bool PERM = true, AFTER_DRAIN = false;
    bf16_t* O; int ldc;
    __device__ __forceinline__ void operator()(const f32x4 (&acc)[2][2][4][2], const Unit& u, int wr, int wc, int fr, int fq) const {
        const int row0 = u.pm * BM + wr * 64 + fr; const int col0 = u.pn * BM + wc * 32 + 8 * fq;
#pragma unroll
        for (int ai = 0; ai < 2; ++ai)
#pragma unroll
            for (int m = 0; m < 4; ++m) { bf16_t* rowp = O + (size_t)(row0 + ai * HALF + m * 16) * ldc + col0;
#pragma unroll
                for (int bj = 0; bj < 2; ++bj) { f32x4 v0 = acc[ai][bj][m][0], v1 = acc[ai][bj][m][1];
                    if (ACT == 2) {
#pragma unroll
                        for (int j = 0; j < 4; ++j) { float a = fmaxf(v0[j], 0.f), b = fmaxf(v1[j], 0.f); v0[j] = a * a; v1[j] = b * b; } }
                    u32x4 w; w.x = cvt_pk_bf16(v0[0], v0[1]); w.y = cvt_pk_bf16(v0[2], v0[3]); w.z = cvt_pk_bf16(v1[0], v1[1]); w.w = cvt_pk_bf16(v1[2], v1[3]);
                    *(u32x4*)(rowp + bj * HALF) = w; } }
    }
};
struct EpiResid {
    static constexpr bool PERM = true, AFTER_DRAIN = false;
    const float* baseP; const float* baseS; const float* gate; float* out;
    __device__ __forceinline__ void operator()(const f32x4 (&acc)[2][2][4][2], const Unit& u, int wr, int wc, int fr, int fq) const {
        const int row0 = u.pm * BM + wr * 64 + fr; const int col0 = u.pn * BM + wc * 32 + 8 * fq;
#pragma unroll
        for (int ai = 0; ai < 2; ++ai)
#pragma unroll
            for (int m = 0; m < 4; ++m) { const int r = row0 + ai * HALF + m * 16;
                const float* bp = (r < 8192) ? baseP + (size_t)r * 2048 : baseS + (size_t)(r - 8192) * 2048;
                const float* gp = gate + (size_t)((r < 8192) ? 0 : 1 + ((r - 8192) >> 4)) * 12288;
                float* op = out + (size_t)r * 2048;
#pragma unroll
                for (int bj = 0; bj < 2; ++bj) { const int c = col0 + bj * HALF;
#pragma unroll
                    for (int n = 0; n < 2; ++n) { const f32x4 b = *(const f32x4*)(bp + c + 4 * n), g = *(const f32x4*)(gp + c + 4 * n);
                        *(f32x4*)(op + c + 4 * n) = b + g * acc[ai][bj][m][n]; } }
                asm volatile("" ::: "memory"); }
    }
};

struct EpiPart {
    static constexpr bool PERM = true, AFTER_DRAIN = false;
    bf16_t* out; int ldc;
    __device__ __forceinline__ void operator()(const f32x4 (&acc)[2][2][4][2], const Unit& u, int wr, int wc, int fr, int fq) const {
        const int row0 = u.pm * BM + wr * 64 + fr - 8192; const int col0 = u.pn * BM + wc * 32 + 8 * fq;
#pragma unroll
        for (int ai = 0; ai < 2; ++ai)
#pragma unroll
            for (int m = 0; m < 4; ++m) { bf16_t* op = out + (size_t)(row0 + ai * HALF + m * 16) * ldc + col0;
#pragma unroll
                for (int bj = 0; bj < 2; ++bj) { const f32x4 v0 = acc[ai][bj][m][0], v1 = acc[ai][bj][m][1];
                    u32x4 w; w.x = cvt_pk_bf16(v0[0], v0[1]); w.y = cvt_pk_bf16(v0[2], v0[3]); w.z = cvt_pk_bf16(v1[0], v1[1]); w.w = cvt_pk_bf16(v1[2], v1[3]);
                    *(u32x4*)(op + bj * HALF) = w; } }
    }
};
struct OneUnit { Unit u;
    __device__ __forceinline__ bool next(int i, Unit& o) const { if (i != 0) return false; o = u; return true; }
    __device__ __forceinline__ void a_ready(const Unit&) const {}
    __device__ __forceinline__ void done(const Unit&) const {}
};
template <class Epi, class Sched, bool ALIGN_EPI = false, bool SP2 = false>
__device__ __forceinline__ void gemm_phase(PG8_LAS unsigned char* lds, const Gemm g, const Sched& S, const Epi& E) {
    int tid_ = threadIdx.x; asm volatile("" : "+v"(tid_));
    const int tid = tid_, wid = __builtin_amdgcn_readfirstlane(tid >> 6), lane = tid & 63, wr = wid >> 2, wc = wid & 3, fr = lane & 15, fq = lane >> 4;
    const int K = g.ld, nt = g.K / BK;
    unsigned voffA[2], voffB[2];
#pragma unroll
    for (int i = 0; i < 2; ++i) { int R, C; stage_rc(tid * 16 + i * 8192, R, C); const int Rb = Epi::PERM ? ((R & ~31) + perm32(R & 31)) : R;
        voffA[i] = (unsigned)(R * K + C) * 2u; voffB[i] = (unsigned)(Rb * K + C) * 2u; }
    const size_t kstep = (size_t)(BK * 2);
    const size_t hstep = (size_t)HALF * K * 2;
    const size_t tstep = 2 * hstep;
    const unsigned ldsw = (unsigned)wid * 1024u;
    const int aoff = lds_byte(wr * 64 + fr, fq * 8), boff = lds_byte(wc * 32 + fr, fq * 8);
#define PG8_SA(b, h) (((b) * 2 + (h)) * HTB)
#define PG8_SB(b, h) ((4 + (b) * 2 + (h)) * HTB)
#define PG8_STAGE(bufoff, gbase, voff) do { _Pragma("unroll") for (int _i = 0; _i < 2; ++_i) \
        __builtin_amdgcn_global_load_lds((const unsigned*)((const char*)(gbase) + (voff)[_i]), (PG8_LAS unsigned*)(lds + (bufoff) + ldsw + _i * 8192), 16, 0, 0); } while (0)
#define PG8_LDA(dst, b, h) do { _Pragma("unroll") for (int m = 0; m < 4; ++m) _Pragma("unroll") for (int k = 0; k < 2; ++k) dst[m][k] = *(const PG8_LAS bf16x8*)(lds + PG8_SA(b, h) + aoff + m * 2048 + k * 1024); } while (0)
#define PG8_LDB(dst, b, h) do { _Pragma("unroll") for (int n = 0; n < 2; ++n) _Pragma("unroll") for (int k = 0; k < 2; ++k) dst[n][k] = *(const PG8_LAS bf16x8*)(lds + PG8_SB(b, h) + boff + n * 2048 + k * 1024); } while (0)
#define PG8_MMA(ai, bj, At, Bt) do { __builtin_amdgcn_s_setprio(1); _Pragma("unroll") for (int m = 0; m < 4; ++m) _Pragma("unroll") for (int n = 0; n < 2; ++n) _Pragma("unroll") for (int k = 0; k < 2; ++k) \
        acc[ai][bj][m][n] = __builtin_amdgcn_mfma_f32_16x16x32_bf16(Bt[n][k], At[m][k], acc[ai][bj][m][n], 0, 0, 0); __builtin_amdgcn_s_setprio(0); } while (0)
#define PG8_WAIT_V(n) asm volatile("s_waitcnt vmcnt(" #n ")" ::: "memory")
#define PG8_WAIT_L(n) asm volatile("s_waitcnt lgkmcnt(" #n ")" ::: "memory")
#define PG8_BAR __builtin_amdgcn_s_barrier()
#define PG8_SCHED __builtin_amdgcn_sched_barrier(0)
    Unit cur, nxt; int ui = 0;
    if (!S.next(0, cur)) return;
    f32x4 acc[2][2][4][2];
#pragma unroll
    for (int a = 0; a < 2; ++a)
#pragma unroll
        for (int b = 0; b < 2; ++b)
#pragma unroll
            for (int m = 0; m < 4; ++m)
#pragma unroll
                for (int n = 0; n < 2; ++n) acc[a][b][m][n] = (f32x4){0.f, 0.f, 0.f, 0.f};
    bf16x8 At[4][2], B0[2][2], B1[2][2];
    const char* cA = (const char*)g.A + (size_t)cur.pm * tstep; const char* cB = (const char*)g.Bt + (size_t)cur.pn * tstep;
    S.a_ready(cur);
    if constexpr (SP2) {
        PG8_STAGE(PG8_SB(0, 0), cB, voffB); PG8_STAGE(PG8_SB(0, 1), cB + hstep, voffB); PG8_STAGE(PG8_SA(0, 0), cA, voffA); PG8_STAGE(PG8_SA(0, 1), cA + hstep, voffA);
        if (wr == 1) PG8_BAR;
        PG8_WAIT_V(2); PG8_BAR;
        PG8_STAGE(PG8_SB(1, 0), cB + kstep, voffB); PG8_STAGE(PG8_SA(1, 0), cA + kstep, voffA); PG8_STAGE(PG8_SB(1, 1), cB + hstep + kstep, voffB);
        PG8_WAIT_V(6); PG8_BAR;
    } else {
        PG8_STAGE(PG8_SB(0, 0), cB, voffB); PG8_STAGE(PG8_SA(0, 0), cA, voffA); PG8_STAGE(PG8_SB(0, 1), cB + hstep, voffB); PG8_STAGE(PG8_SA(0, 1), cA + hstep, voffA);
        if (wr == 1) PG8_BAR;
        PG8_WAIT_V(4); PG8_BAR;
        PG8_STAGE(PG8_SB(1, 0), cB + kstep, voffB); PG8_STAGE(PG8_SA(1, 0), cA + kstep, voffA); PG8_STAGE(PG8_SB(1, 1), cB + hstep + kstep, voffB);
        PG8_WAIT_V(6); PG8_BAR;
    }
    for (;;) {
        const bool has_next = S.next(ui + 1, nxt);
        const char* nA = has_next ? (const char*)g.A + (size_t)nxt.pm * tstep : cA; const char* nB = has_next ? (const char*)g.Bt + (size_t)nxt.pn * tstep : cB;
        for (int t = 0; t < nt; t += 2) {
            const bool last = (t == nt - 2);
            const char* a1 = cA + (size_t)(t + 1) * kstep;
            const char* a2 = last ? nA : cA + (size_t)(t + 2) * kstep; const char* b2 = last ? nB : cB + (size_t)(t + 2) * kstep;
            const char* a3 = a2 + kstep; const char* b3 = b2 + kstep;
            if (last && has_next) S.a_ready(nxt);
            if constexpr (SP2) {
            PG8_LDB(B0, 0, 0); PG8_LDB(B1, 0, 1); PG8_SCHED; PG8_LDA(At, 0, 0); PG8_STAGE(PG8_SA(1, 1), a1 + hstep, voffA);
            PG8_WAIT_V(8); PG8_WAIT_L(0); PG8_BAR; PG8_MMA(0, 0, At, B0); PG8_MMA(0, 1, At, B1); PG8_BAR; PG8_SCHED;
            PG8_LDA(At, 0, 1); PG8_STAGE(PG8_SB(0, 0), b2, voffB); PG8_STAGE(PG8_SB(0, 1), b2 + hstep, voffB); PG8_STAGE(PG8_SA(0, 0), a2, voffA);
            PG8_WAIT_V(8); PG8_WAIT_L(0); PG8_BAR; PG8_MMA(1, 0, At, B0); PG8_MMA(1, 1, At, B1); PG8_BAR; PG8_SCHED;
            PG8_LDB(B0, 1, 0); PG8_LDB(B1, 1, 1); PG8_SCHED; PG8_LDA(At, 1, 0); PG8_STAGE(PG8_SA(0, 1), a2 + hstep, voffA);
            PG8_WAIT_V(8); PG8_WAIT_L(0); PG8_BAR; PG8_MMA(0, 0, At, B0); PG8_MMA(0, 1, At, B1); PG8_BAR; PG8_SCHED;
            PG8_LDA(At, 1, 1); PG8_STAGE(PG8_SB(1, 0), b3, voffB); PG8_STAGE(PG8_SB(1, 1), b3 + hstep, voffB); PG8_STAGE(PG8_SA(1, 0), a3, voffA);
            PG8_WAIT_V(8); PG8_WAIT_L(0); PG8_BAR; PG8_MMA(1, 0, At, B0); PG8_MMA(1, 1, At, B1); PG8_BAR; PG8_SCHED;
            } else {
            PG8_LDB(B0, 0, 0); PG8_SCHED; PG8_LDA(At, 0, 0); PG8_STAGE(PG8_SA(1, 1), a1 + hstep, voffA);
            PG8_WAIT_L(8); PG8_BAR; PG8_WAIT_L(0); PG8_MMA(0, 0, At, B0); PG8_BAR; PG8_SCHED;
            PG8_LDB(B1, 0, 1); PG8_STAGE(PG8_SB(0, 0), b2, voffB);
            PG8_BAR; PG8_WAIT_L(0); PG8_MMA(0, 1, At, B1); PG8_BAR;
            PG8_LDA(At, 0, 1); PG8_STAGE(PG8_SA(0, 0), a2, voffA);
            PG8_BAR; PG8_WAIT_L(0); PG8_MMA(1, 0, At, B0); PG8_BAR; PG8_SCHED;
            PG8_STAGE(PG8_SB(0, 1), b2 + hstep, voffB);
            PG8_WAIT_V(6); PG8_BAR; PG8_MMA(1, 1, At, B1); PG8_BAR;
            PG8_LDB(B0, 1, 0); PG8_SCHED; PG8_LDA(At, 1, 0); PG8_STAGE(PG8_SA(0, 1), a2 + hstep, voffA);
            PG8_WAIT_L(8); PG8_BAR; PG8_WAIT_L(0); PG8_MMA(0, 0, At, B0); PG8_BAR; PG8_SCHED;
            PG8_LDB(B1, 1, 1); PG8_STAGE(PG8_SB(1, 0), b3, voffB);
            PG8_BAR; PG8_WAIT_L(0); PG8_MMA(0, 1, At, B1); PG8_BAR;
            PG8_LDA(At, 1, 1); PG8_STAGE(PG8_SA(1, 0), a3, voffA);
            PG8_BAR; PG8_WAIT_L(0); PG8_MMA(1, 0, At, B0); PG8_BAR; PG8_SCHED;
            PG8_STAGE(PG8_SB(1, 1), b3 + hstep, voffB);
            PG8_WAIT_V(6); PG8_BAR; PG8_MMA(1, 1, At, B1); PG8_BAR;
            }
        }
        if constexpr (ALIGN_EPI) { if (wr == 0) PG8_BAR; }
        if constexpr (!Epi::AFTER_DRAIN) { E(acc, cur, wr, wc, fr, fq); S.done(cur); }
        if (!has_next) break;
#pragma unroll
        for (int a = 0; a < 2; ++a)
#pragma unroll
            for (int b = 0; b < 2; ++b)
#pragma unroll
                for (int m = 0; m < 4; ++m)
#pragma unroll
                    for (int n = 0; n < 2; ++n) acc[a][b][m][n] = (f32x4){0.f, 0.f, 0.f, 0.f};
        cur = nxt; cA = nA; cB = nB; ++ui;
        if constexpr (ALIGN_EPI) { if (wr == 1) PG8_BAR; }
    }
    PG8_WAIT_V(0);
    if constexpr (!ALIGN_EPI) { if (wr == 0) PG8_BAR; }
    PG8_BAR;
    if constexpr (Epi::AFTER_DRAIN) { E.fused(acc, cur, wr, wc, fr, fq, lds, wid, lane); S.done(cur); }
#undef PG8_SA
#undef PG8_SB
#undef PG8_STAGE
#undef PG8_LDA
#undef PG8_LDB
#undef PG8_MMA
#undef PG8_WAIT_V
#undef PG8_WAIT_L
#undef PG8_BAR
#undef PG8_SCHED
}
}
#define GAS __attribute__((address_space(1)))
#define LAS __attribute__((address_space(3)))
typedef unsigned short bf16;
typedef unsigned u32x4 __attribute__((ext_vector_type(4)));
typedef unsigned u32x2 __attribute__((ext_vector_type(2)));
typedef float f32x4 __attribute__((ext_vector_type(4)));
typedef float f32x16 __attribute__((ext_vector_type(16)));
typedef short bf16x8 __attribute__((ext_vector_type(8)));
typedef short s16x4 __attribute__((ext_vector_type(4)));
typedef float f32x2_t __attribute__((ext_vector_type(2)));
constexpr int NW = 8, NT = 512;
constexpr int MTOK = 8704, MP = 8192, MS = 512, DM = 2048, NIN = 7176, NINP = 7424, DFF = 8192;
constexpr int NSEQ = 33;
constexpr int PAST = 1024;
constexpr int C_QA = 0, C_KA = 1024, C_VA = 2048, C_QM = 3072, C_KM = 4096, C_VM = 5120, C_OM = 6144, C_IG = 7168, C_FG = 7172;
constexpr int NCH = 160;
constexpr float EPS = 1e-6f;
constexpr float LAM_INIT = 0.2f;
constexpr float QSCALE = 0.125f * 1.4426950408889634f;
constexpr size_t O_YP = 0, O_YS = 16777216, O_KP = 17825792, O_VP = 26214400, O_CVP = 34603008, O_CP = 34609152, O_NP = 34871296, O_MPO = 34872320,
                 O_KS = 34872324, O_VS = 35396612, O_CVS = 35920900, O_CS = 36117508, O_NS = 44506116, O_MSO = 44538884;
constexpr size_t MiB = 1u << 20;
constexpr size_t WS_MOD = 1 * MiB;
constexpr size_t WS_ROPE = 3 * MiB;
constexpr size_t WS_SCAL = 4 * MiB;
constexpr size_t WS_DN = 5 * MiB;
constexpr size_t WS_NPREV = 6 * MiB;
constexpr size_t WS_WIN = 8 * MiB;
constexpr size_t WS_WOUT = 40 * MiB;
constexpr size_t WS_WUP = 48 * MiB;
constexpr size_t WS_WDN = 80 * MiB;
constexpr size_t WS_XN = 112 * MiB;
constexpr size_t WS_PROJ = 148 * MiB;
constexpr size_t WS_QA = 272 * MiB;
constexpr size_t WS_KA = 289 * MiB;
constexpr size_t WS_VT = 306 * MiB;
constexpr size_t WS_DC = 322 * MiB;
constexpr size_t WS_CPREV = 482 * MiB;
constexpr size_t WS_MIX = 562 * MiB;
constexpr size_t WS_END = 596 * MiB;
constexpr size_t WS_H = WS_PROJ;
constexpr size_t WS_X1 = WS_DC;
constexpr size_t WS_PART6 = 390 * MiB;
constexpr size_t WS_PART8 = 422 * MiB;
constexpr size_t WS_PART9 = 486 * MiB;
constexpr size_t WS_FLAG = 0;
static_assert(WS_H + (size_t)MTOK * DFF * 2 <= WS_VT + 16 * MiB && WS_X1 + (size_t)MTOK * DM * 4 <= WS_CPREV, "overlays");

constexpr int LDS_BYTES = 147456;

__device__ __forceinline__ f32x4 ld_bf4(const bf16* p) { const u32x2 w = *(const u32x2*)p; return (f32x4){__uint_as_float(w.x << 16), __uint_as_float(w.x & 0xffff0000u), __uint_as_float(w.y << 16), __uint_as_float(w.y & 0xffff0000u)}; }
__device__ __forceinline__ float bf2f(unsigned short u) { return __uint_as_float((unsigned)u << 16); }
__device__ __forceinline__ unsigned pk2(float lo, float hi) { return pg8::cvt_pk_bf16(lo, hi); }
__device__ __forceinline__ float lane_get(float v, int src_lane) { return __int_as_float(__builtin_amdgcn_ds_bpermute(src_lane << 2, __float_as_int(v))); }
__device__ __forceinline__ float xhalf_other(float v) { auto rr = __builtin_amdgcn_permlane32_swap(__float_as_uint(v), __float_as_uint(v), false, false); return __uint_as_float(rr[0]) + __uint_as_float(rr[1]) - v; }
__device__ __forceinline__ float xhalf_sum(float v) { auto rr = __builtin_amdgcn_permlane32_swap(__float_as_uint(v), __float_as_uint(v), false, false); return __uint_as_float(rr[0]) + __uint_as_float(rr[1]); }
__device__ __forceinline__ float wave_sum(float v, int lane) {
#pragma unroll
    for (int o = 1; o < 32; o <<= 1) v += lane_get(v, lane ^ o);
    return xhalf_sum(v);
}
__device__ __forceinline__ float wave_max(float v, int lane) {
#pragma unroll
    for (int o = 1; o < 64; o <<= 1) v = fmaxf(v, lane_get(v, lane ^ o));
    return v;
}
__device__ __forceinline__ float silu_f(float x) { return x / (1.f + __expf(-x)); }
__device__ __forceinline__ float sigmoid_f(float x) { return 1.f / (1.f + __expf(-x)); }
__device__ __forceinline__ int crow(int r, int hi) { return (r & 3) + 8 * (r >> 2) + 4 * hi; }
#define LDS_WAIT() asm volatile("s_waitcnt lgkmcnt(0)" ::: "memory")

struct Args {
    const float* in[29]; float* out; unsigned char* ws;
};
typedef const __attribute__((address_space(4))) Args* ArgsP;
#define FRESH_ARGS() ({ ArgsP p_ = (ArgsP)__builtin_amdgcn_kernarg_segment_ptr(); asm volatile("" : "+s"(p_)); p_; })

__device__ __forceinline__ void p0_transpose_item(const float* __restrict__ W, int K, int N, int Npad, bf16* WT, LAS float* T, int item, int tid, int wave, int lane) {
    const int nblk = Npad / 256, kb = item / nblk, nb = item % nblk, k0 = 64 * kb, n0 = 256 * nb;
    const int n = n0 + 4 * lane;
    f32x4 v[8];
#pragma unroll
    for (int i = 0; i < 8; ++i) v[i] = (n < N) ? *(const f32x4*)(W + (size_t)(k0 + 8 * wave + i) * N + n) : (f32x4){0.f, 0.f, 0.f, 0.f};
#pragma unroll
    for (int i = 0; i < 8; ++i) *(LAS f32x4*)(T + (8 * wave + i) * 260 + 4 * lane) = v[i];
    __syncthreads();
#pragma unroll
    for (int j = 0; j < 4; ++j) { const int q = tid + NT * j, nn = q >> 3, c = q & 7; const LAS float* s = T + (8 * c) * 260 + nn;
        u32x4 o; o.x = pk2(s[0], s[260]); o.y = pk2(s[2 * 260], s[3 * 260]); o.z = pk2(s[4 * 260], s[5 * 260]); o.w = pk2(s[6 * 260], s[7 * 260]);
        *(u32x4*)(WT + (size_t)(n0 + nn) * K + k0 + 8 * c) = o; }
    __syncthreads();
}

__device__ __forceinline__ void p0_ada_item(const float* __restrict__ cP, const float* __restrict__ cS, const float* __restrict__ Wada, const float* __restrict__ bada,
                                            float* mod, LAS float* red, int jb, int wave, int lane, int tid) {
    const int i32 = lane & 31, hi = lane >> 5;
    f32x16 acc[4]; f32x4 accp = {0.f, 0.f, 0.f, 0.f};
#pragma unroll
    for (int c = 0; c < 4; ++c) acc[c] = (f32x16){};
    const float* wp = Wada + (size_t)128 * jb + 4 * i32;
    for (int st = 0; st < 16; ++st) {
        const int k0 = 256 * wave + 16 * st + 8 * hi;
        f32x4 w[8];
#pragma unroll
        for (int i = 0; i < 8; ++i) w[i] = *(const f32x4*)(wp + (size_t)(k0 + i) * 12288);
        const f32x4 c0 = *(const f32x4*)(cS + (size_t)i32 * DM + k0), c1 = *(const f32x4*)(cS + (size_t)i32 * DM + k0 + 4);
        const f32x4 p0 = *(const f32x4*)(cP + k0), p1 = *(const f32x4*)(cP + k0 + 4);
        u32x4 a;
        a.x = pk2(silu_f(c0[0]), silu_f(c0[1])); a.y = pk2(silu_f(c0[2]), silu_f(c0[3])); a.z = pk2(silu_f(c1[0]), silu_f(c1[1])); a.w = pk2(silu_f(c1[2]), silu_f(c1[3]));
#pragma unroll
        for (int i = 0; i < 4; ++i) { accp += w[i] * silu_f(p0[i]); accp += w[4 + i] * silu_f(p1[i]); }
#pragma unroll
        for (int c = 0; c < 4; ++c) { u32x4 b; b.x = pk2(w[0][c], w[1][c]); b.y = pk2(w[2][c], w[3][c]); b.z = pk2(w[4][c], w[5][c]); b.w = pk2(w[6][c], w[7][c]);
            acc[c] = __builtin_amdgcn_mfma_f32_32x32x16_bf16(__builtin_bit_cast(bf16x8, a), __builtin_bit_cast(bf16x8, b), acc[c], 0, 0, 0); }
    }
    accp = (f32x4){xhalf_sum(accp[0]), xhalf_sum(accp[1]), xhalf_sum(accp[2]), xhalf_sum(accp[3])};
    LAS float* rp = red + 16384;
    if (hi == 0) *(LAS f32x4*)(rp + wave * 128 + 4 * i32) = accp;
#pragma unroll
    for (int half = 4; half >= 1; half >>= 1) {
        if (wave >= half && wave < 2 * half) { LAS float* dst = red + (wave - half) * 4096;
#pragma unroll
            for (int r = 0; r < 16; ++r) *(LAS f32x4*)(dst + crow(r, hi) * 128 + 4 * i32) = (f32x4){acc[0][r], acc[1][r], acc[2][r], acc[3][r]}; }
        __syncthreads();
        if (wave < half) { const LAS float* src = red + wave * 4096;
#pragma unroll
            for (int r = 0; r < 16; ++r) { const f32x4 t = *(const LAS f32x4*)(src + crow(r, hi) * 128 + 4 * i32); acc[0][r] += t[0]; acc[1][r] += t[1]; acc[2][r] += t[2]; acc[3][r] += t[3]; } }
        __syncthreads();
    }
    if (wave == 0) { const f32x4 bv = *(const f32x4*)(bada + 128 * jb + 4 * i32);
#pragma unroll
        for (int r = 0; r < 16; ++r) *(f32x4*)(mod + (size_t)(1 + crow(r, hi)) * 12288 + 128 * jb + 4 * i32) = (f32x4){acc[0][r], acc[1][r], acc[2][r], acc[3][r]} + bv; }
    if (wave == 1 && hi == 0) { f32x4 t = *(const f32x4*)(bada + 128 * jb + 4 * i32);
#pragma unroll
        for (int w = 0; w < 8; ++w) t += *(const LAS f32x4*)(rp + w * 128 + 4 * i32);
        *(f32x4*)(mod + 128 * jb + 4 * i32) = t; }
    __syncthreads();
}

__constant__ double INV_FREQ_TURNS[8] = {
    1.0 / 6.283185307179586, 0.19392274474868576 / 6.283185307179586, 0.03760603093086393 / 6.283185307179586, 0.007292664737217109 / 6.283185307179586,
    0.001414213562373095 / 6.283185307179586, 0.0002742481756762073 / 6.283185307179586, 5.318295896944988e-05 / 6.283185307179586, 1.031338537721246e-05 / 6.283185307179586 };

__device__ __forceinline__ void p0_prologue(ArgsP A, LAS unsigned char* lds, int tid, int wave, int lane) {
    unsigned char* ws = A->ws;
    const int G = gridDim.x, bid = blockIdx.x;
    for (int jb = bid; jb < 96; jb += G)
        p0_ada_item(A->in[8], A->in[9], A->in[10], A->in[11], (float*)(ws + WS_MOD), (LAS float*)lds, jb, wave, lane, tid);
    constexpr int I_IN = 32 * (NINP / 256), I_OUT = 32 * 8, I_UP = 32 * 32, I_DN = 128 * 8, I_ALL = I_IN + I_OUT + I_UP + I_DN;
    const bool split = (G > 128);
    const int nfree = split ? G - 96 : G, first = split ? 14 * nfree : 0;
    for (int pass = 0; pass < 2; ++pass) {
        int it, step, end;
        if (pass == 0) { if (!split || bid < 96) continue; it = bid - 96; step = nfree; end = (first < I_ALL) ? first : I_ALL; }
        else { it = first + bid; step = G; end = I_ALL; }
        for (; it < end; it += step) { int r = it;
            if (r < I_IN) { p0_transpose_item(A->in[13], DM, NIN, NINP, (bf16*)(ws + WS_WIN), (LAS float*)lds, r, tid, wave, lane); continue; } r -= I_IN;
            if (r < I_OUT) { p0_transpose_item(A->in[24], DM, DM, DM, (bf16*)(ws + WS_WOUT), (LAS float*)lds, r, tid, wave, lane); continue; } r -= I_OUT;
            if (r < I_UP) { p0_transpose_item(A->in[26], DM, DFF, DFF, (bf16*)(ws + WS_WUP), (LAS float*)lds, r, tid, wave, lane); continue; } r -= I_UP;
            p0_transpose_item(A->in[27], DFF, DM, DM, (bf16*)(ws + WS_WDN), (LAS float*)lds, r, tid, wave, lane); }
    }
    for (int idx = blockIdx.x * NT + tid; idx < 8192 * 8; idx += gridDim.x * NT) {
        const int pos = idx >> 3, i = idx & 7;
        const double t = (double)pos * INV_FREQ_TURNS[i]; const float fr = (float)(t - __builtin_rint(t));
        float* tab = (float*)(ws + WS_ROPE) + (size_t)pos * 16;
        tab[i] = __builtin_amdgcn_cosf(fr); tab[8 + i] = __builtin_amdgcn_sinf(fr);
    }
}

template <int NPART> __device__ __forceinline__ void norm_mod_rows(const float* xP, const float* xS, const float* __restrict__ g, const float* __restrict__ mod, int sh_off, int sc_off, bf16* out, int wave, int lane,
                                              const bf16* part = nullptr, int gate_off = 0, float* x1S = nullptr) {
    const int gw = blockIdx.x * NW + wave, NGW = gridDim.x * NW;
    for (int r = gw; r < MTOK; r += NGW) {
        const float* xr = (r < MP) ? xP + (size_t)r * DM : xS + (size_t)(r - MP) * DM;
        const float* mr = mod + (size_t)((r < MP) ? 0 : 1 + ((r - MP) >> 4)) * 12288;
        f32x4 v[8]; float s = 0.f;
#pragma unroll
        for (int j = 0; j < 8; ++j) v[j] = *(const f32x4*)(xr + 256 * j + 4 * lane);
        if (NPART > 0 && r >= MP) {
#pragma unroll
            for (int j = 0; j < 8; ++j) { const int c = 256 * j + 4 * lane; f32x4 a = {0.f, 0.f, 0.f, 0.f};
                f32x4 t[NPART > 0 ? NPART : 1];
#pragma unroll
                for (int p = 0; p < NPART; ++p) t[p] = ld_bf4(part + ((size_t)p * MS + (r - MP)) * DM + c);
#pragma unroll
                for (int p = 0; p < NPART; ++p) a += t[p];
                v[j] += *(const f32x4*)(mr + gate_off + c) * a; *(f32x4*)(x1S + (size_t)(r - MP) * DM + c) = v[j]; } }
#pragma unroll
        for (int j = 0; j < 8; ++j) s += (v[j].x * v[j].x + v[j].y * v[j].y) + (v[j].z * v[j].z + v[j].w * v[j].w);
        const float rstd = 1.f / sqrtf(wave_sum(s, lane) * (1.f / DM) + EPS);
#pragma unroll
        for (int j = 0; j < 8; ++j) { const int c = 256 * j + 4 * lane;
            const f32x4 gg = *(const f32x4*)(g + c), sc = *(const f32x4*)(mr + sc_off + c), sh = *(const f32x4*)(mr + sh_off + c);
            const f32x4 y = v[j] * rstd * gg * (sc + 1.f) + sh;
            u32x2 o; o.x = pk2(y.x, y.y); o.y = pk2(y.z, y.w);
            *(u32x2*)(out + (size_t)r * DM + c) = o; }
    }
}
#define XB_TMO      128
#define XB_XCNT(j)  (256  + 64 * (j))
#define XB_XSUB(j)  (1280 + 64 * (j))
#define XB_XGEN(j)  (2304 + 64 * (j))
#define XB_TOP      3328
#define XB_TOPGEN   3392
#define XCD_BAR_WORDS 3456
#define XB_SPIN_CAP (1u << 18)

__device__ __forceinline__ unsigned xb_ld(unsigned* p)              { return __hip_atomic_load(p, __ATOMIC_RELAXED, __HIP_MEMORY_SCOPE_AGENT); }
__device__ __forceinline__ unsigned xb_add(unsigned* p, unsigned v) { return __hip_atomic_fetch_add(p, v, __ATOMIC_RELAXED, __HIP_MEMORY_SCOPE_AGENT); }
__device__ __forceinline__ unsigned xb_xcc_id() { return (unsigned)__builtin_amdgcn_s_getreg((3 << 11) | 20) & 0xFu; }
#define XB_SPIN(cond, bar) do { unsigned _sp = 0; while (cond) { __builtin_amdgcn_s_sleep(1); \
    if ((++_sp & 255u) == 0u) { if (xb_ld(&(bar)[XB_TMO])) break; if (_sp > XB_SPIN_CAP) { atomicAdd(&(bar)[XB_TMO], 1u); break; } } } } while (0)

struct XcdBarrier {
    unsigned* bar; unsigned x;
    volatile LAS unsigned* st;
};

__device__ __forceinline__ XcdBarrier xcd_barrier_post(unsigned* bar, volatile LAS unsigned* st) {
    XcdBarrier b; b.bar = bar; b.x = xb_xcc_id(); b.st = st;
    if (threadIdx.x == 0) (void)xb_add(&bar[XB_XCNT(b.x)], 1u);
    return b;
}
__device__ __forceinline__ void xcd_barrier_complete(unsigned* bar, unsigned x, unsigned& nloc, unsigned& nx) {
    const unsigned G = gridDim.x * gridDim.y * gridDim.z;
    unsigned sum, cnt, mine, sp = 0u;
    for (;;) {
        sum = 0u; cnt = 0u; mine = 0u;
#pragma unroll
        for (unsigned j = 0; j < 16; ++j) { const unsigned c = xb_ld(&bar[XB_XCNT(j)]); sum += c; cnt += (c > 0u) ? 1u : 0u; mine = (j == x) ? c : mine; }
        if (sum == G) break;
        __builtin_amdgcn_s_sleep(1);
        if ((++sp & 255u) == 0u) { if (xb_ld(&bar[XB_TMO])) break; if (sp > XB_SPIN_CAP) { atomicAdd(&bar[XB_TMO], 1u); break; } }
    }
    nloc = mine > 0u ? mine : 1u; nx = cnt > 0u ? cnt : 1u;
}

__device__ __forceinline__ void xcd_barrier(const XcdBarrier& b) {
    asm volatile("s_waitcnt vmcnt(0)" ::: "memory");
    __syncthreads();
    if (threadIdx.x == 0) {
        unsigned* bar = b.bar;
        __builtin_amdgcn_s_waitcnt(0);
        unsigned nloc = b.st[0], nx = b.st[1];
        if (nloc == 0u) { xcd_barrier_complete(bar, b.x, nloc, nx); b.st[0] = nloc; b.st[1] = nx; }
        const unsigned old = xb_add(&bar[XB_XSUB(b.x)], 1u);
        const unsigned gen = old / nloc;
        if (old + 1u == (gen + 1u) * nloc) {
            __builtin_amdgcn_fence(__ATOMIC_RELEASE, "agent");
            asm volatile("s_waitcnt vmcnt(0)" ::: "memory");
            const unsigned og = xb_add(&bar[XB_TOP], 1u);
            const unsigned tg = og / nx;
            if (og + 1u == (tg + 1u) * nx) xb_add(&bar[XB_TOPGEN], 1u);
            else XB_SPIN(xb_ld(&bar[XB_TOPGEN]) == tg, bar);
            __builtin_amdgcn_fence(__ATOMIC_ACQUIRE, "agent");
            xb_add(&bar[XB_XGEN(b.x)], 1u);
            asm volatile("s_waitcnt vmcnt(0)" ::: "memory");
        } else {
            XB_SPIN(xb_ld(&bar[XB_XGEN(b.x)]) == gen, bar);
            __builtin_amdgcn_fence(__ATOMIC_ACQUIRE, "agent");
            asm volatile("s_waitcnt vmcnt(0)" ::: "memory");
        }
    }
    __syncthreads();
}
__device__ __forceinline__ void unpack16(const u32x4 a, const u32x4 b, float* v) {
#pragma unroll
    for (int i = 0; i < 4; ++i) { v[2 * i] = __uint_as_float(a[i] << 16); v[2 * i + 1] = __uint_as_float(a[i] & 0xffff0000u); v[8 + 2 * i] = __uint_as_float(b[i] << 16); v[8 + 2 * i + 1] = __uint_as_float(b[i] & 0xffff0000u); }
}
__device__ __forceinline__ void p3_post(ArgsP A, int tid) {
    unsigned char* ws = A->ws;
    const bf16* PROJ = (const bf16*)(ws + WS_PROJ); bf16* QA = (bf16*)(ws + WS_QA); bf16* KA = (bf16*)(ws + WS_KA);
    const float* rope = (const float*)(ws + WS_ROPE);
    for (int it = blockIdx.x * NT + tid; it < MTOK * 64; it += gridDim.x * NT) {
        const int r = it >> 6, cg16 = it & 63;
        const int pos = (r < MP) ? r : PAST + ((r - MP) & 15);
        const bf16* pr = PROJ + (size_t)r * NINP + 16 * cg16;
        float q[16], k[16], v[16];
        unpack16(*(const u32x4*)(pr + C_QA), *(const u32x4*)(pr + C_QA + 8), q);
        unpack16(*(const u32x4*)(pr + C_KA), *(const u32x4*)(pr + C_KA + 8), k);
        unpack16(*(const u32x4*)(pr + C_VA), *(const u32x4*)(pr + C_VA + 8), v);
        if ((cg16 & 3) == 0) {
            const float* tb = rope + (size_t)pos * 16;
#pragma unroll
            for (int i = 0; i < 8; ++i) { const float c = tb[i], s = tb[8 + i];
                const float q1 = q[i], q2 = q[8 + i]; q[i] = q1 * c - q2 * s; q[8 + i] = q2 * c + q1 * s;
                const float k1 = k[i], k2 = k[8 + i]; k[i] = k1 * c - k2 * s; k[8 + i] = k2 * c + k1 * s; }
        }
        u32x4 o0, o1;
#pragma unroll
        for (int i = 0; i < 4; ++i) { o0[i] = pk2(q[2 * i] * QSCALE, q[2 * i + 1] * QSCALE); o1[i] = pk2(q[8 + 2 * i] * QSCALE, q[8 + 2 * i + 1] * QSCALE); }
        *(u32x4*)(QA + (size_t)r * 1024 + 16 * cg16) = o0; *(u32x4*)(QA + (size_t)r * 1024 + 16 * cg16 + 8) = o1;
#pragma unroll
        for (int i = 0; i < 4; ++i) { o0[i] = pk2(k[2 * i], k[2 * i + 1]); o1[i] = pk2(k[8 + 2 * i], k[8 + 2 * i + 1]); }
        *(u32x4*)(KA + (size_t)r * 1024 + 16 * cg16) = o0; *(u32x4*)(KA + (size_t)r * 1024 + 16 * cg16 + 8) = o1;
        float* ko = A->out + ((r < MP) ? O_KP + (size_t)r * 1024 : O_KS + (size_t)(r - MP) * 1024) + 16 * cg16;
        float* vo = A->out + ((r < MP) ? O_VP + (size_t)r * 1024 : O_VS + (size_t)(r - MP) * 1024) + 16 * cg16;
#pragma unroll
        for (int i = 0; i < 4; ++i) { *(f32x4*)(ko + 4 * i) = (f32x4){k[4 * i], k[4 * i + 1], k[4 * i + 2], k[4 * i + 3]}; *(f32x4*)(vo + 4 * i) = (f32x4){v[4 * i], v[4 * i + 1], v[4 * i + 2], v[4 * i + 3]}; }
    }
    for (int it = blockIdx.x * NT + tid; it < 33 * 3 * 2048; it += gridDim.x * NT) {
        const int ch = it & 2047, j = (it >> 11) % 3, sq = it / (3 * 2048);
        const int r = (sq == 0) ? (MP - 3 + j) : (MP + 16 * (sq - 1) + 13 + j);
        const float val = bf2f(PROJ[(size_t)r * NINP + C_QM + ch]);
        if (sq == 0) A->out[O_CVP + (size_t)j * 2048 + ch] = val; else A->out[O_CVS + ((size_t)(sq - 1) * 3 + j) * 2048 + ch] = val;
    }
}
typedef short v4i16_t __attribute__((ext_vector_type(4)));
__device__ __forceinline__ s16x4 tr_rd(LAS const unsigned char* p) { return __builtin_bit_cast(s16x4, __builtin_amdgcn_ds_read_tr16_b64_v4i16((LAS v4i16_t*)p)); }
__device__ __forceinline__ bf16x8 mk8(s16x4 a, s16x4 b) { return (bf16x8){a[0], a[1], a[2], a[3], b[0], b[1], b[2], b[3]}; }
__device__ __forceinline__ int tr_off(int pitch, int krow, int colbase, int lane) { return (krow + ((lane & 15) >> 2)) * pitch + (colbase + 16 * ((lane >> 4) & 1) + 4 * (lane & 3)) * 2; }
__device__ __forceinline__ void unpack8(const u32x4 a, float* v) {
#pragma unroll
    for (int i = 0; i < 4; ++i) { v[2 * i] = __uint_as_float(a[i] << 16); v[2 * i + 1] = __uint_as_float(a[i] & 0xffff0000u); }
}
__device__ __forceinline__ int unit_row0(int u) { return (u < 128) ? 64 * u : MP + 16 * (u - 128); }
__device__ __forceinline__ void conv8(const bf16* PROJ, const float* __restrict__ stconv, const float* __restrict__ wconv, const float* __restrict__ bconv, int u, int s, int ch0, float* o) {
    const int r0 = unit_row0(u);
    f32x4 a0 = *(const f32x4*)(bconv + ch0), a1 = *(const f32x4*)(bconv + ch0 + 4);
#pragma unroll
    for (int j = 0; j < 4; ++j) { const int tau = s - 3 + j; float x[8];
        if (tau >= 0 || (u > 0 && u < 128)) unpack8(*(const u32x4*)(PROJ + (size_t)(r0 + tau) * NINP + C_QM + ch0), x);
        else if (u >= 128) { const float* p = stconv + ((size_t)(u - 128) * 3 + (3 + tau)) * 2048 + ch0; const f32x4 y0 = *(const f32x4*)p, y1 = *(const f32x4*)(p + 4);
            x[0] = y0[0]; x[1] = y0[1]; x[2] = y0[2]; x[3] = y0[3]; x[4] = y1[0]; x[5] = y1[1]; x[6] = y1[2]; x[7] = y1[3]; }
        else {
#pragma unroll
            for (int i = 0; i < 8; ++i) x[i] = 0.f; }
        const f32x4 w0 = *(const f32x4*)(wconv + j * 2048 + ch0), w1 = *(const f32x4*)(wconv + j * 2048 + ch0 + 4);
        a0 += (f32x4){x[0], x[1], x[2], x[3]} * w0; a1 += (f32x4){x[4], x[5], x[6], x[7]} * w1; }
#pragma unroll
    for (int i = 0; i < 4; ++i) { o[i] = silu_f(a0[i]); o[4 + i] = silu_f(a1[i]); }
}
__device__ __forceinline__ void conv_rows4(const bf16* PROJ, const float* __restrict__ stconv, const float* __restrict__ wconv, const float* __restrict__ bconv, int u, int L, int s0, int ch0, float sc, u32x4* o) {
    const int r0 = unit_row0(u);
    f32x4 w0[4], w1[4];
#pragma unroll
    for (int j = 0; j < 4; ++j) { w0[j] = *(const f32x4*)(wconv + j * 2048 + ch0); w1[j] = *(const f32x4*)(wconv + j * 2048 + ch0 + 4); }
    const f32x4 b0 = *(const f32x4*)(bconv + ch0), b1 = *(const f32x4*)(bconv + ch0 + 4);
    f32x4 x0[7], x1[7];
#pragma unroll
    for (int i = 0; i < 7; ++i) { const int tau = s0 - 3 + i; x0[i] = (f32x4){0.f, 0.f, 0.f, 0.f}; x1[i] = x0[i];
        if (tau >= 0 ? (tau < L) : (u > 0 && u < 128)) { float t[8]; unpack8(*(const u32x4*)(PROJ + (size_t)(r0 + tau) * NINP + C_QM + ch0), t); x0[i] = (f32x4){t[0], t[1], t[2], t[3]}; x1[i] = (f32x4){t[4], t[5], t[6], t[7]}; }
        else if (tau < 0 && u >= 128) { const float* p = stconv + ((size_t)(u - 128) * 3 + (3 + tau)) * 2048 + ch0; x0[i] = *(const f32x4*)p; x1[i] = *(const f32x4*)(p + 4); } }
#pragma unroll
    for (int r = 0; r < 4; ++r) { f32x4 a0 = b0, a1 = b1;
#pragma unroll
        for (int j = 0; j < 4; ++j) { a0 += x0[r + j] * w0[j]; a1 += x1[r + j] * w1[j]; }
        u32x4 q = {0u, 0u, 0u, 0u};
        if (s0 + r < L) { q.x = pk2(silu_f(a0[0]) * sc, silu_f(a0[1]) * sc); q.y = pk2(silu_f(a0[2]) * sc, silu_f(a0[3]) * sc); q.z = pk2(silu_f(a1[0]) * sc, silu_f(a1[1]) * sc); q.w = pk2(silu_f(a1[2]) * sc, silu_f(a1[3]) * sc); }
        o[r] = q; }
}
__device__ __forceinline__ u32x4 pack8(const float* v, float sc) { u32x4 o; o.x = pk2(v[0] * sc, v[1] * sc); o.y = pk2(v[2] * sc, v[3] * sc); o.z = pk2(v[4] * sc, v[5] * sc); o.w = pk2(v[6] * sc, v[7] * sc); return o; }
__device__ __forceinline__ float logsigmoid_f(float f) { return fminf(f, 0.f) - log1pf(__expf(-fabsf(f))); }
__device__ __forceinline__ void load_gates(const bf16* PROJ, const float* bi, const float* bfg, int u, int h, int t, float& ig, float& lf) {
    const int L = (u < 128) ? 64 : 16; const int r = unit_row0(u) + t;
    ig = -INFINITY; lf = 0.f;
    if (t < L) { ig = bf2f(PROJ[(size_t)r * NINP + C_IG + h]) + bi[h]; lf = logsigmoid_f(bf2f(PROJ[(size_t)r * NINP + C_FG + h]) + bfg[h]); }
}
__device__ __forceinline__ float scan_add(float v, int lane) {
#pragma unroll
    for (int o = 1; o < 64; o <<= 1) { const float x = lane_get(v, lane - o); if (lane >= o) v += x; }
    return v;
}
__device__ __forceinline__ float scan_max(float v, int lane) {
#pragma unroll
    for (int o = 1; o < 64; o <<= 1) { const float x = lane_get(v, lane - o); if (lane >= o) v = fmaxf(v, x); }
    return v;
}
constexpr int MA_K = 0, MA_V = 36864, MA_W = 73728;
constexpr int PK = 576;
__device__ __forceinline__ void mlstm_phaseA(ArgsP A, LAS unsigned char* lds, int u, int h, int tid, int wave, int lane) {
    unsigned char* ws = A->ws; const bf16* PROJ = (const bf16*)(ws + WS_PROJ);
    float* SC = (float*)(ws + WS_SCAL);
    LAS float* wl = (LAS float*)(lds + MA_W);
    const int L = (u < 128) ? 64 : 16, r0 = unit_row0(u);
    if (wave == 0) {
        float ig, lf; load_gates(PROJ, A->in[21], A->in[22], u, h, lane, ig, lf);
        const float b = scan_add(lf, lane); const float G = lane_get(b, 63);
        const float uu = (lane < L) ? G - b + ig : -INFINITY; const float mloc = wave_max(uu, lane);
        wl[lane] = (lane < L) ? __expf(uu - mloc) : 0.f;
        if (lane == 0) { SC[u * 4 + h] = G; SC[640 + u * 4 + h] = mloc; }
    }
    { const int c8 = 8 * (tid & 31), s0 = 4 * (tid >> 5);
      u32x4 ko[4]; conv_rows4(PROJ, A->in[4], A->in[19], A->in[20], u, L, s0, 1024 + h * 256 + c8, 0.0625f, ko);
      u32x4 vr[4];
#pragma unroll
      for (int r = 0; r < 4; ++r) { vr[r] = (u32x4){0u, 0u, 0u, 0u}; if (s0 + r < L) vr[r] = *(const u32x4*)(PROJ + (size_t)(r0 + s0 + r) * NINP + C_VM + h * 256 + c8); }
#pragma unroll
      for (int r = 0; r < 4; ++r) *(LAS u32x4*)(lds + MA_K + (s0 + r) * PK + c8 * 2) = ko[r];
      __syncthreads();
#pragma unroll
      for (int r = 0; r < 4; ++r) { float v[8]; unpack8(vr[r], v); *(LAS u32x4*)(lds + MA_V + (s0 + r) * PK + c8 * 2) = pack8(v, wl[s0 + r]); } }
    __syncthreads();
    { const int i32 = lane & 31, hi = lane >> 5, eb = wave;
      bf16x8 af[4];
#pragma unroll
      for (int ks = 0; ks < 4; ++ks) { const int o = tr_off(PK, 16 * ks + 8 * hi, 32 * eb, lane); af[ks] = mk8(tr_rd(lds + MA_V + o), tr_rd(lds + MA_V + o + 4 * PK)); }
      bf16* dC = (bf16*)(ws + WS_DC) + ((size_t)(u * 4 + h) * 256 + 32 * eb + i32) * 256 + 4 * hi;
      for (int db = 0; db < 8; ++db) { f32x16 acc = {};
#pragma unroll
          for (int ks = 0; ks < 4; ++ks) { const int o = tr_off(PK, 16 * ks + 8 * hi, 32 * db, lane); const bf16x8 bfr = mk8(tr_rd(lds + MA_K + o), tr_rd(lds + MA_K + o + 4 * PK));
              acc = __builtin_amdgcn_mfma_f32_32x32x16_bf16(bfr, af[ks], acc, 0, 0, 0); }
#pragma unroll
          for (int g4 = 0; g4 < 4; ++g4) { u32x2 o; o.x = pk2(acc[4 * g4], acc[4 * g4 + 1]); o.y = pk2(acc[4 * g4 + 2], acc[4 * g4 + 3]); *(u32x2*)(dC + 32 * db + 8 * g4) = o; } } }
    if (tid < 256) { float a = 0.f;
        for (int s = 0; s < 64; ++s) a += wl[s] * bf2f(*(LAS const unsigned short*)(lds + MA_K + s * PK + tid * 2));
        ((float*)(ws + WS_DN))[(size_t)(u * 4 + h) * 256 + tid] = a; }
    __syncthreads();
}
__device__ __forceinline__ void mlstm_phaseB(ArgsP A, LAS unsigned char* lds, int tid, int wave, int lane) {
    unsigned char* ws = A->ws; const float* SC = (const float*)(ws + WS_SCAL); float* MPREV = (float*)(ws + WS_SCAL) + 1280;
    const bf16* DC = (const bf16*)(ws + WS_DC); bf16* CP = (bf16*)(ws + WS_CPREV); const float* DN = (const float*)(ws + WS_DN); float* NP = (float*)(ws + WS_NPREV);
    const int gid = blockIdx.x * NT + tid, gsz = gridDim.x * NT;
    LAS float* AL = (LAS float*)lds; LAS float* BE = AL + 512;
    if (wave < 4) { const int h = wave; const float g0 = SC[lane * 4 + h], g1 = SC[(64 + lane) * 4 + h], l0 = SC[640 + lane * 4 + h], l1 = SC[640 + (64 + lane) * 4 + h];
        float m = 0.f;
        for (int c = 0; c < 128; ++c) { const float G = lane_get((c < 64) ? g0 : g1, c & 63), ml = lane_get((c < 64) ? l0 : l1, c & 63);
            const float mn = fmaxf(G + m, ml);
            if (lane == 0) { AL[h * 128 + c] = __expf(G + m - mn); BE[h * 128 + c] = __expf(ml - mn); if (blockIdx.x == 0) MPREV[c * 4 + h] = m; }
            m = mn; }
        if (blockIdx.x == 0 && lane == 0) A->out[O_MPO + h] = m; }
    __syncthreads();
    for (int idx = gid; idx < 4 * 32768; idx += gsz) { const int h = idx >> 15, el = (idx & 32767) * 2;
        float c0 = 0.f, c1 = 0.f;
        for (int cb = 0; cb < 128; cb += 32) { unsigned d[32];
#pragma unroll
            for (int j = 0; j < 32; ++j) d[j] = *(const unsigned*)(DC + ((size_t)((cb + j) * 4 + h) << 16) + el);
#pragma unroll
            for (int j = 0; j < 32; ++j) { const int c = cb + j; const float al = AL[h * 128 + c], be = BE[h * 128 + c];
                *(unsigned*)(CP + ((size_t)(c * 4 + h) << 16) + el) = pk2(c0, c1);
                c0 = al * c0 + be * __uint_as_float(d[j] << 16); c1 = al * c1 + be * __uint_as_float(d[j] & 0xffff0000u); } }
        *(f32x2_t*)(A->out + O_CP + ((size_t)h << 16) + el) = (f32x2_t){c0, c1}; }
    for (int idx = gid; idx < 4 * 256; idx += gsz) { const int h = idx >> 8, d = idx & 255; float n = 0.f;
        for (int cb = 0; cb < 128; cb += 32) { float dn[32];
#pragma unroll
            for (int j = 0; j < 32; ++j) dn[j] = DN[(size_t)((cb + j) * 4 + h) * 256 + d];
#pragma unroll
            for (int j = 0; j < 32; ++j) { const int c = cb + j; NP[(size_t)(c * 4 + h) * 256 + d] = n; n = AL[h * 128 + c] * n + BE[h * 128 + c] * dn[j]; } }
        A->out[O_NP + h * 256 + d] = n; }
    const float* C0 = A->in[5]; const float* N0 = A->in[6]; const float* M0 = A->in[7];
    for (int i0 = gid; i0 < 128 * 32768; i0 += 8 * gsz) {
        f32x2_t c[8]; unsigned d[8]; float m[8], G[8], ml[8];
#pragma unroll
        for (int k = 0; k < 8; ++k) { const int idx = i0 + k * gsz; if (idx < 128 * 32768) { const int bh = idx >> 15, el = (idx & 32767) * 2, ui = (128 + (bh >> 2)) * 4 + (bh & 3);
            m[k] = M0[bh]; G[k] = SC[ui]; ml[k] = SC[640 + ui]; c[k] = *(const f32x2_t*)(C0 + ((size_t)bh << 16) + el); d[k] = *(const unsigned*)(DC + ((size_t)ui << 16) + el); } }
#pragma unroll
        for (int k = 0; k < 8; ++k) { const int idx = i0 + k * gsz; if (idx < 128 * 32768) { const int bh = idx >> 15, el = (idx & 32767) * 2, ui = (128 + (bh >> 2)) * 4 + (bh & 3);
            const float mn = fmaxf(G[k] + m[k], ml[k]); const float al = __expf(G[k] + m[k] - mn), be = __expf(ml[k] - mn);
            *(unsigned*)(CP + ((size_t)ui << 16) + el) = pk2(c[k].x, c[k].y);
            *(f32x2_t*)(A->out + O_CS + ((size_t)bh << 16) + el) = (f32x2_t){al * c[k].x + be * __uint_as_float(d[k] << 16), al * c[k].y + be * __uint_as_float(d[k] & 0xffff0000u)};
            if (el == 0) { MPREV[ui] = m[k]; A->out[O_MSO + bh] = mn; } } } }
    for (int idx = gid; idx < 128 * 256; idx += gsz) { const int bh = idx >> 8, d = idx & 255, ui = (128 + (bh >> 2)) * 4 + (bh & 3);
        const float m = M0[bh], G = SC[ui], ml = SC[640 + ui]; const float mn = fmaxf(G + m, ml); const float al = __expf(G + m - mn), be = __expf(ml - mn);
        const float n = N0[idx]; NP[(size_t)ui * 256 + d] = n; A->out[O_NS + idx] = al * n + be * DN[(size_t)ui * 256 + d]; }
}
constexpr int MC_Q = 0, MC_K = 33792, MC_V = 67584, MC_S = 104448, MC_F = 113664;
constexpr int PQ = 528, PS = 144;
__device__ __forceinline__ void mlstm_phaseC(ArgsP A, LAS unsigned char* lds, int u, int h, int tid, int wave, int lane) {
    unsigned char* ws = A->ws; const bf16* PROJ = (const bf16*)(ws + WS_PROJ);
    const int L = (u < 128) ? 64 : 16, r0 = unit_row0(u), uh = u * 4 + h;
    LAS float* F = (LAS float*)(lds + MC_F);
    LAS float* rt = F, *gg = F + 64, *winter = F + 128, *eden = F + 192, *nq = F + 256, *denp = F + 320, *ssq = F + 448;
    const int i32 = lane & 31, hi = lane >> 5;
    LAS float* nl = F + 960;
    if (wave == 1) *(LAS f32x4*)(nl + 4 * lane) = *(const f32x4*)((const float*)(ws + WS_NPREV) + (size_t)uh * 256 + 4 * lane);
    if (wave == 0) {
        float ig, lf; load_gates(PROJ, A->in[21], A->in[22], u, h, lane, ig, lf);
        const float b = scan_add(lf, lane); const float g = (lane < L) ? ig - b : -INFINITY; const float cm = scan_max(g, lane);
        const float mprev = ((const float*)(ws + WS_SCAL))[1280 + uh]; const float mx = fmaxf(mprev, cm);
        rt[lane] = -mx; gg[lane] = g; winter[lane] = __expf(mprev - mx); eden[lane] = __expf(-(b + mx));
    }
    { const int c8 = 8 * (tid & 31), s0 = 4 * (tid >> 5);
      u32x4 qo[4], ko[4], vo[4];
      conv_rows4(PROJ, A->in[4], A->in[19], A->in[20], u, L, s0, h * 256 + c8, 1.f, qo);
      conv_rows4(PROJ, A->in[4], A->in[19], A->in[20], u, L, s0, 1024 + h * 256 + c8, 0.0625f, ko);
#pragma unroll
      for (int r = 0; r < 4; ++r) { vo[r] = (u32x4){0u, 0u, 0u, 0u}; if (s0 + r < L) vo[r] = *(const u32x4*)(PROJ + (size_t)(r0 + s0 + r) * NINP + C_VM + h * 256 + c8); }
#pragma unroll
      for (int r = 0; r < 4; ++r) { *(LAS u32x4*)(lds + MC_Q + (s0 + r) * PQ + c8 * 2) = qo[r]; *(LAS u32x4*)(lds + MC_K + (s0 + r) * PQ + c8 * 2) = ko[r]; *(LAS u32x4*)(lds + MC_V + (s0 + r) * PK + c8 * 2) = vo[r]; } }
    bf16x8 ca[16];
    { const bf16* Cp = (const bf16*)(ws + WS_CPREV) + ((size_t)uh * 256 + 32 * wave + i32) * 256 + 8 * hi;
#pragma unroll
      for (int kk = 0; kk < 16; ++kk) ca[kk] = *(const bf16x8*)(Cp + 16 * kk); }
    __syncthreads();
    if (wave < 3) {
        const int tt = (wave > 0) ? 1 : 0, st = (wave == 2) ? 1 : 0;
        f32x16 acc = {};
#pragma unroll 4
        for (int kk = 0; kk < 16; ++kk) { const bf16x8 a = *(LAS const bf16x8*)(lds + MC_K + (32 * st + i32) * PQ + (16 * kk + 8 * hi) * 2), b = *(LAS const bf16x8*)(lds + MC_Q + (32 * tt + i32) * PQ + (16 * kk + 8 * hi) * 2);
            acc = __builtin_amdgcn_mfma_f32_32x32x16_bf16(a, b, acc, 0, 0, 0); }
        const int t = 32 * tt + i32; const float rtt = rt[t]; float rs = 0.f;
#pragma unroll
        for (int g4 = 0; g4 < 4; ++g4) { const int s0 = 32 * st + 8 * g4 + 4 * hi; float v[4];
#pragma unroll
            for (int j = 0; j < 4; ++j) { const int s = s0 + j; const float e = __expf(rtt + gg[s]) * acc[4 * g4 + j]; v[j] = (s <= t) ? e : 0.f; rs += v[j]; }
            u32x2 o; o.x = pk2(v[0], v[1]); o.y = pk2(v[2], v[3]); *(LAS u32x2*)(lds + MC_S + t * PS + s0 * 2) = o; }
        rs = xhalf_sum(rs);
        if (hi == 0) { denp[st * 64 + t] = rs; if (wave == 0) denp[64 + t] = 0.f; }
    } else if (wave == 3) {
        const LAS float* np = nl + 8 * hi;
#pragma unroll
        for (int tt = 0; tt < 2; ++tt) { f32x16 acc = {};
#pragma unroll 4
            for (int kk = 0; kk < 16; ++kk) { u32x4 aw = {0u, 0u, 0u, 0u};
                if (i32 == 0) { const f32x4 n0 = *(const LAS f32x4*)(np + 16 * kk), n1 = *(const LAS f32x4*)(np + 16 * kk + 4); aw.x = pk2(n0[0], n0[1]); aw.y = pk2(n0[2], n0[3]); aw.z = pk2(n1[0], n1[1]); aw.w = pk2(n1[2], n1[3]); }
                const bf16x8 b = *(LAS const bf16x8*)(lds + MC_Q + (32 * tt + i32) * PQ + (16 * kk + 8 * hi) * 2);
                acc = __builtin_amdgcn_mfma_f32_32x32x16_bf16(__builtin_bit_cast(bf16x8, aw), b, acc, 0, 0, 0); }
            if (hi == 0) nq[32 * tt + i32] = acc[0]; }
    }
    __syncthreads();
    const int eb = wave, ntt = (L > 32) ? 2 : 1;
    u32x2 ovp[2][4]; f32x4 gmp[4];
#pragma unroll
    for (int g4 = 0; g4 < 4; ++g4) { const int e = 32 * eb + 8 * g4 + 4 * hi; gmp[g4] = *(const f32x4*)(A->in[23] + h * 256 + e);
#pragma unroll
        for (int tt = 0; tt < 2; ++tt) { const int t = 32 * tt + i32; ovp[tt][g4] = (u32x2){0u, 0u};
            if (t < L) ovp[tt][g4] = *(const u32x2*)(PROJ + (size_t)(r0 + t) * NINP + C_OM + h * 256 + e); } }
    bf16x8 va[4];
#pragma unroll
    for (int ks = 0; ks < 4; ++ks) { const int o = tr_off(PK, 16 * ks + 8 * hi, 32 * eb, lane); va[ks] = mk8(tr_rd(lds + MC_V + o), tr_rd(lds + MC_V + o + 4 * PK)); }
    f32x16 hv[2];
#pragma unroll
    for (int tt = 0; tt < 2; ++tt) { f32x16 acc = {};
        if (tt < ntt) { const int t = 32 * tt + i32;
#pragma unroll
            for (int kk = 0; kk < 16; ++kk) { const bf16x8 b = *(LAS const bf16x8*)(lds + MC_Q + t * PQ + (16 * kk + 8 * hi) * 2);
                acc = __builtin_amdgcn_mfma_f32_32x32x16_bf16(ca[kk], b, acc, 0, 0, 0); }
            const float wi = winter[t];
#pragma unroll
            for (int r = 0; r < 16; ++r) acc[r] *= wi;
#pragma unroll
            for (int ks = 0; ks < 4; ++ks) if (ks < 2 * (tt + 1)) { const bf16x8 b = *(LAS const bf16x8*)(lds + MC_S + t * PS + (16 * ks + 8 * hi) * 2);
                acc = __builtin_amdgcn_mfma_f32_32x32x16_bf16(va[ks], b, acc, 0, 0, 0); }
            const float den = wi * nq[t] + denp[t] + denp[64 + t]; const float inv = 1.f / fmaxf(fabsf(den), eden[t]); float sq = 0.f;
#pragma unroll
            for (int r = 0; r < 16; ++r) { acc[r] *= inv; sq += acc[r] * acc[r]; }
            sq = xhalf_sum(sq); if (hi == 0) ssq[wave * 64 + t] = sq; }
        hv[tt] = acc; }
    __syncthreads();
    bf16* MIX = (bf16*)(ws + WS_MIX);
#pragma unroll
    for (int tt = 0; tt < 2; ++tt) if (tt < ntt) { const int t = 32 * tt + i32;
        if (t < L) { float tot = 0.f;
#pragma unroll
            for (int w = 0; w < 8; ++w) tot += ssq[w * 64 + t];
            const float rstd = 1.f / sqrtf(tot * (1.f / 256.f) + EPS); const size_t row = (size_t)(r0 + t);
#pragma unroll
            for (int g4 = 0; g4 < 4; ++g4) { const int e = 32 * eb + 8 * g4 + 4 * hi; const f32x4 g = gmp[g4];
                const u32x2 ov = ovp[tt][g4];
                const float o0 = sigmoid_f(__uint_as_float(ov.x << 16)), o1 = sigmoid_f(__uint_as_float(ov.x & 0xffff0000u)), o2 = sigmoid_f(__uint_as_float(ov.y << 16)), o3 = sigmoid_f(__uint_as_float(ov.y & 0xffff0000u));
                u32x2 w; w.x = pk2(hv[tt][4 * g4] * rstd * g[0] * o0, hv[tt][4 * g4 + 1] * rstd * g[1] * o1); w.y = pk2(hv[tt][4 * g4 + 2] * rstd * g[2] * o2, hv[tt][4 * g4 + 3] * rstd * g[3] * o3);
                *(u32x2*)(MIX + row * DM + 1024 + h * 256 + e) = w; } } }
    __syncthreads();
}
constexpr int AT_PKT = 272, AT_PVT = 320, AT_V = 17408, AT_BUF = 37888;
struct AttnState { f32x16 o[4]; bf16x8 pf[4]; float m, l; };
__device__ __forceinline__ float xhalf_max(float v) { auto rr = __builtin_amdgcn_permlane32_swap(__float_as_uint(v), __float_as_uint(v), false, false); return fmaxf(__uint_as_float(rr[0]), __uint_as_float(rr[1])); }
constexpr float ATT_THR = 6.0f;
__device__ __forceinline__ void attn_qk(LAS const unsigned char* kt, int map, const bf16x8 (&qf)[4], const AttnState& S, f32x16 (&p)[2], int lane) {
    const int i32 = lane & 31, hi = lane >> 5;
#pragma unroll
    for (int kb = 0; kb < 2; ++kb) { f32x16 acc = {};
#pragma unroll
        for (int d0 = 0; d0 < 4; ++d0) { const bf16x8 a = *(LAS const bf16x8*)(kt + (32 * kb + i32) * AT_PKT + (64 * map + 16 * d0 + 8 * hi) * 2);
            acc = __builtin_amdgcn_mfma_f32_32x32x16_bf16(a, qf[d0], acc, 0, 0, 0); }
        p[kb] = acc; }
}
__device__ __forceinline__ void attn_pv(LAS const unsigned char* vt, AttnState& S, int lane) {
    const int hi = lane >> 5;
    LAS const unsigned char* base = vt + tr_off(AT_PVT, 4 * hi, 0, lane);
#pragma unroll
    for (int st = 0; st < 4; ++st) { s16x4 lo[4], hh[4];
#pragma unroll
        for (int eb = 0; eb < 4; ++eb) { lo[eb] = tr_rd(base + st * 16 * AT_PVT + eb * 64); hh[eb] = tr_rd(base + st * 16 * AT_PVT + eb * 64 + 8 * AT_PVT); }
#pragma unroll
        for (int eb = 0; eb < 4; ++eb) S.o[eb] = __builtin_amdgcn_mfma_f32_32x32x16_bf16(mk8(lo[eb], hh[eb]), S.pf[st], S.o[eb], 0, 0, 0);
    }
}
__device__ __forceinline__ void attn_softmax(f32x16 (&p)[2], AttnState& S, int nvalid, int lane) {
    const int hi = lane >> 5;
    if (nvalid < 64) {
#pragma unroll
        for (int kb = 0; kb < 2; ++kb)
#pragma unroll
            for (int r = 0; r < 16; ++r) if (32 * kb + crow(r, hi) >= nvalid) p[kb][r] = -INFINITY; }
    float ma = fmaxf(fmaxf(p[0][0], p[0][1]), p[1][0]), mb = fmaxf(fmaxf(p[0][2], p[0][3]), p[1][1]);
    ma = fmaxf(fmaxf(ma, p[1][2]), p[1][3]);
#pragma unroll
    for (int r = 4; r < 16; r += 4) { ma = fmaxf(fmaxf(ma, p[0][r]), p[0][r + 1]); mb = fmaxf(fmaxf(mb, p[0][r + 2]), p[0][r + 3]); ma = fmaxf(fmaxf(ma, p[1][r]), p[1][r + 1]); mb = fmaxf(fmaxf(mb, p[1][r + 2]), p[1][r + 3]); }
    const float mref = S.m; const float mx = xhalf_max(fmaxf(ma, mb)) - mref;
#pragma unroll
    for (int kb = 0; kb < 2; ++kb)
#pragma unroll
        for (int r = 0; r < 16; ++r) p[kb][r] = __builtin_amdgcn_exp2f(p[kb][r] - mref);
    if (__any(mx > ATT_THR)) {
        const float dl = fmaxf(mx, 0.f); S.m += dl;
        const float f = __builtin_amdgcn_exp2f(-dl); S.l *= f;
#pragma unroll
        for (int kb = 0; kb < 2; ++kb)
#pragma unroll
            for (int r = 0; r < 16; ++r) p[kb][r] *= f;
#pragma unroll
        for (int eb = 0; eb < 4; ++eb)
#pragma unroll
            for (int r = 0; r < 16; ++r) S.o[eb][r] *= f;
    }
    float sa = 0.f, sb = 0.f;
#pragma unroll
    for (int kb = 0; kb < 2; ++kb)
#pragma unroll
        for (int r = 0; r < 16; r += 2) { sa += p[kb][r]; sb += p[kb][r + 1]; }
    S.l += sa + sb;
#pragma unroll
    for (int kb = 0; kb < 2; ++kb)
#pragma unroll
        for (int ks = 0; ks < 2; ++ks) { u32x4 pw; pw.x = pk2(p[kb][8 * ks], p[kb][8 * ks + 1]); pw.y = pk2(p[kb][8 * ks + 2], p[kb][8 * ks + 3]); pw.z = pk2(p[kb][8 * ks + 4], p[kb][8 * ks + 5]); pw.w = pk2(p[kb][8 * ks + 6], p[kb][8 * ks + 7]);
            S.pf[2 * kb + ks] = __builtin_bit_cast(bf16x8, pw); }
}
__device__ __forceinline__ void attn_step(LAS const unsigned char* ktn, LAS const unsigned char* vtc, int map, const bf16x8 (&qf)[4], AttnState& S, int lane) {
    const int i32 = lane & 31, hi = lane >> 5;
    f32x16 p[2];
    LAS const unsigned char* base = vtc + tr_off(AT_PVT, 4 * hi, 0, lane);
    s16x4 lo[2][4], hh[2][4];
#pragma unroll
    for (int eb = 0; eb < 4; ++eb) { lo[0][eb] = tr_rd(base + eb * 64); hh[0][eb] = tr_rd(base + eb * 64 + 8 * AT_PVT); }
#pragma unroll
    for (int kb = 0; kb < 2; ++kb) { f32x16 acc = {};
#pragma unroll
        for (int d0 = 0; d0 < 4; ++d0) { const bf16x8 a = *(LAS const bf16x8*)(ktn + (32 * kb + i32) * AT_PKT + (64 * map + 16 * d0 + 8 * hi) * 2);
            acc = __builtin_amdgcn_mfma_f32_32x32x16_bf16(a, qf[d0], acc, 0, 0, 0); }
        p[kb] = acc; }
    const float mref = S.m;
    __builtin_amdgcn_sched_barrier(0);
#pragma unroll
    for (int st = 0; st < 4; ++st) {
        if (st < 3) {
#pragma unroll
            for (int eb = 0; eb < 4; ++eb) { lo[(st + 1) & 1][eb] = tr_rd(base + (st + 1) * 16 * AT_PVT + eb * 64); hh[(st + 1) & 1][eb] = tr_rd(base + (st + 1) * 16 * AT_PVT + eb * 64 + 8 * AT_PVT); } }
        __builtin_amdgcn_sched_barrier(0);
#pragma unroll
        for (int eb = 0; eb < 4; ++eb) {
            S.o[eb] = __builtin_amdgcn_mfma_f32_32x32x16_bf16(mk8(lo[st & 1][eb], hh[st & 1][eb]), S.pf[st], S.o[eb], 0, 0, 0);
            const int e0 = 2 * (4 * st + eb);
            p[e0 >> 4][e0 & 15] = __builtin_amdgcn_exp2f(p[e0 >> 4][e0 & 15] - mref); p[e0 >> 4][(e0 & 15) + 1] = __builtin_amdgcn_exp2f(p[e0 >> 4][(e0 & 15) + 1] - mref);
            __builtin_amdgcn_sched_barrier(0);
        }
    }
    float ma = fmaxf(fmaxf(p[0][0], p[0][1]), p[1][0]), mb = fmaxf(fmaxf(p[0][2], p[0][3]), p[1][1]);
    ma = fmaxf(fmaxf(ma, p[1][2]), p[1][3]);
#pragma unroll
    for (int r = 4; r < 16; r += 4) { ma = fmaxf(fmaxf(ma, p[0][r]), p[0][r + 1]); mb = fmaxf(fmaxf(mb, p[0][r + 2]), p[0][r + 3]); ma = fmaxf(fmaxf(ma, p[1][r]), p[1][r + 1]); mb = fmaxf(fmaxf(mb, p[1][r + 2]), p[1][r + 3]); }
    const float emx = xhalf_max(fmaxf(ma, mb));
    if (__any(emx > 64.0f)) {
        const float dl = fmaxf(__builtin_amdgcn_logf(emx), 0.f);
        S.m += dl;
        const float f = __builtin_amdgcn_exp2f(-dl); S.l *= f;
#pragma unroll
        for (int kb = 0; kb < 2; ++kb)
#pragma unroll
            for (int r = 0; r < 16; ++r) p[kb][r] *= f;
#pragma unroll
        for (int eb = 0; eb < 4; ++eb)
#pragma unroll
            for (int r = 0; r < 16; ++r) S.o[eb][r] *= f;
    }
    float sa = 0.f, sb = 0.f;
#pragma unroll
    for (int kb = 0; kb < 2; ++kb)
#pragma unroll
        for (int r = 0; r < 16; r += 2) { sa += p[kb][r]; sb += p[kb][r + 1]; }
    S.l += sa + sb;
#pragma unroll
    for (int kb = 0; kb < 2; ++kb)
#pragma unroll
        for (int ks = 0; ks < 2; ++ks) { u32x4 pw; pw.x = pk2(p[kb][8 * ks], p[kb][8 * ks + 1]); pw.y = pk2(p[kb][8 * ks + 2], p[kb][8 * ks + 3]); pw.z = pk2(p[kb][8 * ks + 4], p[kb][8 * ks + 5]); pw.w = pk2(p[kb][8 * ks + 6], p[kb][8 * ks + 7]);
            S.pf[2 * kb + ks] = __builtin_bit_cast(bf16x8, pw); }
}
__device__ __forceinline__ void attn_tile(LAS const unsigned char* kt, LAS const unsigned char* vt, int map, const bf16x8 (&qf)[4], AttnState& S, int nvalid, int lane) {
    f32x16 p[2]; attn_qk(kt, map, qf, S, p, lane); attn_softmax(p, S, nvalid, lane); attn_pv(vt, S, lane);
}
__device__ __forceinline__ void attn_finish(ArgsP A, LAS unsigned char* lds, AttnState& S, int map, int g, int h, size_t row_base, int nrows, float lam, int lane) {
    const int i32 = lane & 31, hi = lane >> 5;
    const float lt = xhalf_sum(S.l); const float inv = 1.f / lt;
    LAS float* X = (LAS float*)lds + g * 4096;
    __syncthreads();
    if (map == 1) {
#pragma unroll
        for (int eb = 0; eb < 4; ++eb)
#pragma unroll
            for (int r = 0; r < 16; ++r) X[(32 * eb + crow(r, hi)) * 32 + i32] = S.o[eb][r] * inv; }
    __syncthreads();
    if (map == 0) { float sq = 0.f;
#pragma unroll
        for (int eb = 0; eb < 4; ++eb)
#pragma unroll
            for (int r = 0; r < 16; ++r) { const float v = S.o[eb][r] * inv - lam * X[(32 * eb + crow(r, hi)) * 32 + i32]; S.o[eb][r] = v; sq += v * v; }
        sq = xhalf_sum(sq);
        const float rstd = (1.f - LAM_INIT) / sqrtf(sq * (1.f / 128.f) + EPS);
        if (i32 < nrows) { bf16* mp = (bf16*)(A->ws + WS_MIX) + (row_base + i32) * DM + h * 128; const float* gs = A->in[18] + h * 128;
#pragma unroll
            for (int eb = 0; eb < 4; ++eb)
#pragma unroll
                for (int g4 = 0; g4 < 4; ++g4) { const int e = 32 * eb + 8 * g4 + 4 * hi; const f32x4 gv = *(const f32x4*)(gs + e);
                    u32x2 w; w.x = pk2(S.o[eb][4 * g4] * rstd * gv[0], S.o[eb][4 * g4 + 1] * rstd * gv[1]); w.y = pk2(S.o[eb][4 * g4 + 2] * rstd * gv[2], S.o[eb][4 * g4 + 3] * rstd * gv[3]);
                    *(u32x2*)(mp + e) = w; } } }
    __syncthreads();
}
__device__ __forceinline__ void attn_prompt_unit(ArgsP A, LAS unsigned char* lds, int h, int qb, float lam, int tid, int wave, int lane) {
    unsigned char* ws = A->ws; const bf16* QA = (const bf16*)(ws + WS_QA); const bf16* KA = (const bf16*)(ws + WS_KA); const bf16* PROJ = (const bf16*)(ws + WS_PROJ);
    const int map = wave & 1, g = wave >> 1, i32 = lane & 31, hi = lane >> 5;
    const int ntiles = 2 * qb + 2, mytiles = 2 * qb + (g >> 1) + 1;
    bf16x8 qf[4];
    { const bf16* qp = QA + (size_t)(128 * qb + 32 * g + i32) * 1024 + h * 128 + 64 * map + 8 * hi;
#pragma unroll
      for (int d0 = 0; d0 < 4; ++d0) qf[d0] = *(const bf16x8*)(qp + 16 * d0); }
    AttnState S; S.m = 0.f; S.l = 0.f;
#pragma unroll
    for (int i = 0; i < 4; ++i) S.pf[i] = (bf16x8){0, 0, 0, 0, 0, 0, 0, 0};
#pragma unroll
    for (int eb = 0; eb < 4; ++eb) S.o[eb] = (f32x16){};
    const int key = tid >> 3, seg = tid & 7;
    const bf16* kp = KA + (size_t)key * 1024 + h * 128 + 16 * seg; const bf16* vp = PROJ + (size_t)key * NINP + C_VA + h * 128 + 16 * seg;
    const int ko = key * AT_PKT + seg * 32, vo = AT_V + key * AT_PVT + seg * 32;
    { u32x4 k0 = *(const u32x4*)kp, k1 = *(const u32x4*)(kp + 8), v0 = *(const u32x4*)vp, v1 = *(const u32x4*)(vp + 8);
      const bf16* kq = kp + (size_t)64 * 1024; const bf16* vq = vp + (size_t)64 * NINP;
      u32x4 k2 = *(const u32x4*)kq, k3 = *(const u32x4*)(kq + 8), v2 = *(const u32x4*)vq, v3 = *(const u32x4*)(vq + 8);
      *(LAS u32x4*)(lds + ko) = k0; *(LAS u32x4*)(lds + ko + 16) = k1; *(LAS u32x4*)(lds + vo) = v0; *(LAS u32x4*)(lds + vo + 16) = v1;
      *(LAS u32x4*)(lds + AT_BUF + ko) = k2; *(LAS u32x4*)(lds + AT_BUF + ko + 16) = k3; *(LAS u32x4*)(lds + AT_BUF + vo) = v2; *(LAS u32x4*)(lds + AT_BUF + vo + 16) = v3; }
    __syncthreads();
    { f32x16 p[2]; attn_qk(lds, map, qf, S, p, lane); attn_softmax(p, S, 64, lane); }
    int bc = 0, bn = AT_BUF, bw = 2 * AT_BUF;
    for (int j = 0; j < ntiles; ++j) {
        const bool more = (j + 2 < ntiles);
        u32x4 k0, k1, v0, v1;
        if (more) { const bf16* kq = kp + (size_t)(j + 2) * 64 * 1024; const bf16* vq = vp + (size_t)(j + 2) * 64 * NINP;
            k0 = *(const u32x4*)kq; k1 = *(const u32x4*)(kq + 8); v0 = *(const u32x4*)vq; v1 = *(const u32x4*)(vq + 8); }
        if (j + 1 < mytiles) attn_step(lds + bn, lds + bc + AT_V, map, qf, S, lane);
        else if (j < mytiles) attn_pv(lds + bc + AT_V, S, lane);
        if (more) { LAS unsigned char* w = lds + bw; *(LAS u32x4*)(w + ko) = k0; *(LAS u32x4*)(w + ko + 16) = k1; *(LAS u32x4*)(w + vo) = v0; *(LAS u32x4*)(w + vo + 16) = v1; }
        __syncthreads();
        const int t = bc; bc = bn; bn = bw; bw = t;
    }
    attn_finish(A, lds, S, map, g, h, (size_t)(128 * qb + 32 * g), 32, lam, lane);
}
__device__ __forceinline__ void attn_sample_unit(ArgsP A, LAS unsigned char* lds, int b, int h, float lam, int tid, int wave, int lane) {
    unsigned char* ws = A->ws; const bf16* QA = (const bf16*)(ws + WS_QA); const bf16* KA = (const bf16*)(ws + WS_KA); const bf16* PROJ = (const bf16*)(ws + WS_PROJ);
    const int map = wave & 1, i32 = lane & 31, hi = lane >> 5; const bool comp = wave < 2;
    bf16x8 qf[4];
#pragma unroll
    for (int d0 = 0; d0 < 4; ++d0) qf[d0] = (bf16x8){0, 0, 0, 0, 0, 0, 0, 0};
    if (i32 < 16) { const bf16* qp = QA + (size_t)(MP + 16 * b + i32) * 1024 + h * 128 + 64 * map + 8 * hi;
#pragma unroll
      for (int d0 = 0; d0 < 4; ++d0) qf[d0] = *(const bf16x8*)(qp + 16 * d0); }
    AttnState S; S.m = 0.f; S.l = 0.f;
#pragma unroll
    for (int i = 0; i < 4; ++i) S.pf[i] = (bf16x8){0, 0, 0, 0, 0, 0, 0, 0};
#pragma unroll
    for (int eb = 0; eb < 4; ++eb) S.o[eb] = (f32x16){};
    const int key = tid >> 3, seg = tid & 7;
    const float* kc = A->in[2] + (((size_t)b * PAST + key) * 8 + h) * 128 + 16 * seg; const float* vc = A->in[3] + (((size_t)b * PAST + key) * 8 + h) * 128 + 16 * seg;
    const int ko = key * AT_PKT + seg * 32, vo = AT_V + key * AT_PVT + seg * 32;
    f32x4 kr[4], vr[4];
#pragma unroll
    for (int i = 0; i < 4; ++i) { kr[i] = *(const f32x4*)(kc + 4 * i); vr[i] = *(const f32x4*)(vc + 4 * i); }
    for (int j = 0; j < 17; ++j) {
        LAS unsigned char* nb = lds + (j & 1) * AT_BUF;
        if (j < 16) { u32x4 a, c;
            a.x = pk2(kr[0][0], kr[0][1]); a.y = pk2(kr[0][2], kr[0][3]); a.z = pk2(kr[1][0], kr[1][1]); a.w = pk2(kr[1][2], kr[1][3]);
            c.x = pk2(kr[2][0], kr[2][1]); c.y = pk2(kr[2][2], kr[2][3]); c.z = pk2(kr[3][0], kr[3][1]); c.w = pk2(kr[3][2], kr[3][3]);
            *(LAS u32x4*)(nb + ko) = a; *(LAS u32x4*)(nb + ko + 16) = c;
            a.x = pk2(vr[0][0], vr[0][1]); a.y = pk2(vr[0][2], vr[0][3]); a.z = pk2(vr[1][0], vr[1][1]); a.w = pk2(vr[1][2], vr[1][3]);
            c.x = pk2(vr[2][0], vr[2][1]); c.y = pk2(vr[2][2], vr[2][3]); c.z = pk2(vr[3][0], vr[3][1]); c.w = pk2(vr[3][2], vr[3][3]);
            *(LAS u32x4*)(nb + vo) = a; *(LAS u32x4*)(nb + vo + 16) = c;
        } else { u32x4 a = {0u, 0u, 0u, 0u}, c = a, d = a, e = a;
            if (key < 16) { const bf16* kq = KA + (size_t)(MP + 16 * b + key) * 1024 + h * 128 + 16 * seg; const bf16* vq = PROJ + (size_t)(MP + 16 * b + key) * NINP + C_VA + h * 128 + 16 * seg;
                a = *(const u32x4*)kq; c = *(const u32x4*)(kq + 8); d = *(const u32x4*)vq; e = *(const u32x4*)(vq + 8); }
            *(LAS u32x4*)(nb + ko) = a; *(LAS u32x4*)(nb + ko + 16) = c; *(LAS u32x4*)(nb + vo) = d; *(LAS u32x4*)(nb + vo + 16) = e; }
        if (j + 1 < 16) {
#pragma unroll
            for (int i = 0; i < 4; ++i) { kr[i] = *(const f32x4*)(kc + (size_t)(j + 1) * 64 * 1024 + 4 * i); vr[i] = *(const f32x4*)(vc + (size_t)(j + 1) * 64 * 1024 + 4 * i); } }
        __syncthreads();
        if (comp) attn_tile(nb, nb + AT_V, map, qf, S, (j < 16) ? 64 : 16, lane);
    }
    attn_finish(A, lds, S, comp ? map : 2, 0, h, (size_t)(MP + 16 * b), 16, lam, lane);
}
template <int NPART> __device__ __forceinline__ void final_norm_rows(float* y, const float* __restrict__ g, int wave, int lane, const float* x1S, const bf16* part, const float* gate) {
    const int gw = blockIdx.x * NW + wave, NGW = gridDim.x * NW;
    for (int r = gw; r < MTOK; r += NGW) { float* yr = y + (size_t)r * DM; f32x4 v[8]; float s = 0.f;
        if (r < MP) {
#pragma unroll
            for (int j = 0; j < 8; ++j) v[j] = *(const f32x4*)(yr + 256 * j + 4 * lane);
        } else {
            const float* gr = gate + (size_t)(1 + ((r - MP) >> 4)) * 12288;
#pragma unroll
            for (int j = 0; j < 8; ++j) { const int c = 256 * j + 4 * lane; f32x4 a = {0.f, 0.f, 0.f, 0.f};
                f32x4 t[NPART];
#pragma unroll
                for (int p = 0; p < NPART; ++p) t[p] = ld_bf4(part + ((size_t)p * MS + (r - MP)) * DM + c);
#pragma unroll
                for (int p = 0; p < NPART; ++p) a += t[p];
                v[j] = *(const f32x4*)(x1S + (size_t)(r - MP) * DM + c) + *(const f32x4*)(gr + c) * a; } }
#pragma unroll
        for (int j = 0; j < 8; ++j) s += (v[j].x * v[j].x + v[j].y * v[j].y) + (v[j].z * v[j].z + v[j].w * v[j].w);
        const float rstd = 1.f / sqrtf(wave_sum(s, lane) * (1.f / DM) + EPS);
#pragma unroll
        for (int j = 0; j < 8; ++j) { const f32x4 gg = *(const f32x4*)(g + 256 * j + 4 * lane); *(f32x4*)(yr + 256 * j + 4 * lane) = v[j] * rstd * gg; } }
}
__global__ void __launch_bounds__(NT, 2) fwd_megakernel(Args A_) {
    extern __shared__ __attribute__((aligned(16))) unsigned char lds_raw[];
    LAS unsigned char* lds = (LAS unsigned char*)lds_raw;
    cg::grid_group grid = cg::this_grid();
    int tid, lane, wave;
#define FRESH_TID() do { tid = threadIdx.x; asm volatile("" : "+v"(tid)); lane = tid & 63; wave = __builtin_amdgcn_readfirstlane(tid >> 6); } while (0)
    FRESH_TID();
    ArgsP A = FRESH_ARGS();
    unsigned char* ws = A->ws;
    float* mod = (float*)(ws + WS_MOD);
    const int G = gridDim.x, bid = blockIdx.x;
    A = FRESH_ARGS(); ws = A->ws; mod = (float*)(ws + WS_MOD); FRESH_TID();
    if (bid == 0) for (int i = tid; i < 8192; i += NT) ((unsigned*)(ws + WS_FLAG))[i] = 0u;
    if (tid < 2) ((volatile LAS unsigned*)(lds + LDS_BYTES - 16))[tid] = 0u;
#ifndef NO_P0
    p0_prologue(A, lds, tid, wave, lane);
#endif
    grid.sync();
    XcdBarrier xb = xcd_barrier_post((unsigned*)(ws + WS_FLAG) + 1024, (volatile LAS unsigned*)(lds + LDS_BYTES - 16));
    A = FRESH_ARGS(); ws = A->ws; mod = (float*)(ws + WS_MOD); FRESH_TID();
    norm_mod_rows<0>(A->in[0], A->in[1], A->in[12], mod, 0, 2048, (bf16*)(ws + WS_XN), wave, lane);
    xcd_barrier(xb);
    A = FRESH_ARGS(); ws = A->ws; mod = (float*)(ws + WS_MOD); FRESH_TID();
    { pg8::Gemm g{(const pg8::bf16_t*)(ws + WS_XN), (const pg8::bf16_t*)(ws + WS_WIN), MTOK, NINP, DM, DM}; pg8::StaticOrder S; S.init(MTOK, NINP, G, bid);
      pg8::EpiStore<0> E{(pg8::bf16_t*)(ws + WS_PROJ), NINP};
      pg8::gemm_phase<pg8::EpiStore<0>, pg8::StaticOrder, true, true>(lds, g, S, E); }
    xcd_barrier(xb);
    A = FRESH_ARGS(); ws = A->ws; mod = (float*)(ws + WS_MOD); FRESH_TID();
#ifndef NO_P3
    p3_post(A, tid);
#endif
#ifndef NO_PA
    for (int i = bid; i < NCH * 4; i += G) mlstm_phaseA(A, lds, i >> 2, i & 3, tid, wave, lane);
#endif
    xcd_barrier(xb);
    A = FRESH_ARGS(); ws = A->ws; mod = (float*)(ws + WS_MOD); FRESH_TID();
#ifndef NO_PB
    mlstm_phaseB(A, lds, tid, wave, lane);
#endif
    xcd_barrier(xb);
    A = FRESH_ARGS(); ws = A->ws; mod = (float*)(ws + WS_MOD); FRESH_TID();
    { const float s1 = wave_sum(A->in[14][lane] * A->in[15][lane], lane), s2 = wave_sum(A->in[16][lane] * A->in[17][lane], lane);
      const float lam = __expf(s1) - __expf(s2) + LAM_INIT;
      for (int i = bid; i < 256; i += G) { const int h = i & 7, p = i >> 3;
#ifndef NO_AP
          attn_prompt_unit(A, lds, h, 63 - p, lam, tid, wave, lane);
          attn_prompt_unit(A, lds, h, p, lam, tid, wave, lane);
#endif
#ifndef NO_AS
          attn_sample_unit(A, lds, i >> 3, i & 7, lam, tid, wave, lane);
#endif
      }
      FRESH_TID();
#ifndef NO_PC
      for (int i = bid; i < NCH * 4; i += G) mlstm_phaseC(A, lds, i >> 2, i & 3, tid, wave, lane);
#endif
    }
    xcd_barrier(xb);
    A = FRESH_ARGS(); ws = A->ws; mod = (float*)(ws + WS_MOD); FRESH_TID();
    { pg8::Gemm g{(const pg8::bf16_t*)(ws + WS_MIX), (const pg8::bf16_t*)(ws + WS_WOUT), MP, DM, DM, DM}; pg8::StaticOrder S; S.init(MP, DM, G, bid);
      pg8::EpiResid E{A->in[0], A->in[1], mod + 4096, (float*)(ws + WS_X1)};
      pg8::gemm_phase<pg8::EpiResid, pg8::StaticOrder, true, true>(lds, g, S, E); }
    for (int un = bid; un < 128; un += G) { const int tile = un >> 3, kc = un & 7;
      pg8::Gemm g{(const pg8::bf16_t*)(ws + WS_MIX) + 256 * kc, (const pg8::bf16_t*)(ws + WS_WOUT) + 256 * kc, MTOK, DM, 256, DM}; pg8::OneUnit S{{32 + (tile >> 3), tile & 7}};
      pg8::EpiPart E{(pg8::bf16_t*)(ws + WS_PART6) + (size_t)kc * MS * DM, DM};
      pg8::gemm_phase<pg8::EpiPart, pg8::OneUnit, false, true>(lds, g, S, E); }
    xcd_barrier(xb);
    A = FRESH_ARGS(); ws = A->ws; mod = (float*)(ws + WS_MOD); FRESH_TID();
    norm_mod_rows<8>((const float*)(ws + WS_X1), A->in[1], A->in[25], mod, 6144, 8192, (bf16*)(ws + WS_XN), wave, lane, (const bf16*)(ws + WS_PART6), 4096, (float*)(ws + WS_X1) + (size_t)MP * DM);
    xcd_barrier(xb);
    A = FRESH_ARGS(); ws = A->ws; mod = (float*)(ws + WS_MOD); FRESH_TID();
    { pg8::Gemm g{(const pg8::bf16_t*)(ws + WS_XN), (const pg8::bf16_t*)(ws + WS_WUP), MP, DFF, DM, DM}; pg8::StaticOrder S; S.init(MP, DFF, G, bid);
      pg8::EpiStore<2> E{(pg8::bf16_t*)(ws + WS_H), DFF};
      pg8::gemm_phase<pg8::EpiStore<2>, pg8::StaticOrder, true, true>(lds, g, S, E); }
    for (int un = bid; un < 256; un += G) { const int tile = un >> 2, kq = un & 3;
      pg8::Gemm g{(const pg8::bf16_t*)(ws + WS_XN) + 512 * kq, (const pg8::bf16_t*)(ws + WS_WUP) + 512 * kq, MTOK, DFF, 512, DM}; pg8::OneUnit S{{32 + (tile >> 5), tile & 31}};
      pg8::EpiPart E{(pg8::bf16_t*)(ws + WS_PART8) + (size_t)kq * MS * DFF, DFF};
      pg8::gemm_phase<pg8::EpiPart, pg8::OneUnit, false, true>(lds, g, S, E); }
    xcd_barrier(xb);
    A = FRESH_ARGS(); ws = A->ws; mod = (float*)(ws + WS_MOD); FRESH_TID();
    { const bf16* P8 = (const bf16*)(ws + WS_PART8); bf16* H = (bf16*)(ws + WS_H);
      for (int r = bid; r < MS; r += G)
          for (int c = 4 * tid; c < DFF; c += 4 * NT) { f32x4 a = ld_bf4(P8 + (size_t)r * DFF + c);
#pragma unroll
              for (int p = 1; p < 4; ++p) a += ld_bf4(P8 + ((size_t)p * MS + r) * DFF + c);
              a.x = fmaxf(a.x, 0.f); a.y = fmaxf(a.y, 0.f); a.z = fmaxf(a.z, 0.f); a.w = fmaxf(a.w, 0.f);
              u32x2 o; o.x = pk2(a.x * a.x, a.y * a.y); o.y = pk2(a.z * a.z, a.w * a.w); *(u32x2*)(H + (size_t)(MP + r) * DFF + c) = o; }
      __threadfence(); __syncthreads();
      if (tid == 0) __hip_atomic_fetch_add((unsigned*)(ws + WS_FLAG), 1u, __ATOMIC_RELEASE, __HIP_MEMORY_SCOPE_AGENT); }
    { pg8::Gemm g{(const pg8::bf16_t*)(ws + WS_H), (const pg8::bf16_t*)(ws + WS_WDN), MP, DM, DFF, DFF}; pg8::StaticOrder S; S.init(MP, DM, G, bid);
      pg8::EpiResid E{(const float*)(ws + WS_X1), (const float*)(ws + WS_X1) + (size_t)MP * DM, mod + 10240, A->out};
      pg8::gemm_phase<pg8::EpiResid, pg8::StaticOrder, true, true>(lds, g, S, E); }
    { if (tid == 0) { while (__hip_atomic_load((unsigned*)(ws + WS_FLAG), __ATOMIC_ACQUIRE, __HIP_MEMORY_SCOPE_AGENT) < (unsigned)G) __builtin_amdgcn_s_sleep(8); }
      __syncthreads(); __builtin_amdgcn_fence(__ATOMIC_ACQUIRE, "agent"); }
    for (int un = bid; un < 256; un += G) { const int tile = un >> 4, kc = un & 15;
      pg8::Gemm g{(const pg8::bf16_t*)(ws + WS_H) + 512 * kc, (const pg8::bf16_t*)(ws + WS_WDN) + 512 * kc, MTOK, DM, 512, DFF}; pg8::OneUnit S{{32 + (tile >> 3), tile & 7}};
      pg8::EpiPart E{(pg8::bf16_t*)(ws + WS_PART9) + (size_t)kc * MS * DM, DM};
      pg8::gemm_phase<pg8::EpiPart, pg8::OneUnit, false, true>(lds, g, S, E); }
    xcd_barrier(xb);
    A = FRESH_ARGS(); ws = A->ws; mod = (float*)(ws + WS_MOD); FRESH_TID();
    final_norm_rows<16>(A->out, A->in[28], wave, lane, (const float*)(ws + WS_X1) + (size_t)MP * DM, (const bf16*)(ws + WS_PART9), mod + 10240);
}

extern "C" void kernel_launch(void* const* d_in, const int* in_sizes, int n_in, void* d_out, int out_size, void* d_ws, size_t ws_size, hipStream_t stream) {
    static int grid = 0;
    if (grid == 0) {
        if (n_in != 29 || ws_size < WS_END) { fprintf(stderr, "kernel_launch: unexpected n_in %d / ws %zu\n", n_in, ws_size); grid = -1; return; }
        int dev = 0, cus = 0, per_cu = 0;
        (void)hipGetDevice(&dev); (void)hipDeviceGetAttribute(&cus, hipDeviceAttributeMultiprocessorCount, dev);
        (void)hipFuncSetAttribute((const void*)fwd_megakernel, hipFuncAttributeMaxDynamicSharedMemorySize, LDS_BYTES);
        (void)hipOccupancyMaxActiveBlocksPerMultiprocessor(&per_cu, (const void*)fwd_megakernel, NT, LDS_BYTES);
        (void)hipGetLastError();
        grid = cus;
    }
    if (grid < 0) return;
    Args a{};
    for (int i = 0; i < 29; ++i) a.in[i] = (const float*)d_in[i];
    a.out = (float*)d_out; a.ws = (unsigned char*)d_ws;
    void* args[] = {&a};
    hipError_t e = hipLaunchCooperativeKernel((void*)fwd_megakernel, dim3(grid), dim3(NT), args, LDS_BYTES, stream);
    if (e != hipSuccess) fprintf(stderr, "cooperative launch failed: %s (grid %d)\n", hipGetErrorString(e), grid);
}
```

```cpp
#include <hip/hip_runtime.h>
#include <hip/hip_cooperative_groups.h>
#include <cstdio>
#include <cstdint>
namespace cg = cooperative_groups;
namespace pg8 {
#define PG8_LAS __attribute__((address_space(3)))
typedef unsigned short bf16_t;
typedef short bf16x8 __attribute__((ext_vector_type(8)));
typedef float f32x4 __attribute__((ext_vector_type(4)));
typedef unsigned u32x4 __attribute__((ext_vector_type(4)));
constexpr int BM = 256, BK = 64, HALF = 128, HTB = HALF * BK * 2  , STAGE_BYTES = 8 * HTB, NXCD = 8, WGM = 8;

__host__ __device__ __forceinline__ int lds_byte(int r, int c) { const int st = (r >> 4) * 2 + (c >> 5), rr = r & 15, cc = c & 31, ob = rr * 64 + cc * 2; return st * 1024 + (ob ^ (((ob >> 9) & 1) << 5)); }
__host__ __device__ __forceinline__ void stage_rc(int b, int& R, int& C) { const int st = b / 1024, sb = b % 1024, swz = sb ^ (((sb >> 9) & 1) << 5); R = (st >> 1) * 16 + swz / 64; C = (st & 1) * 32 + (swz % 64) / 2; }
__host__ __device__ __forceinline__ int perm32(int rho) { const int n = rho >> 4, i = rho & 15; return 8 * (i >> 2) + 4 * n + (i & 3); }

struct Unit { int pm, pn; };
struct Gemm { const bf16_t* A; const bf16_t* Bt; int M, N, K, ld; };

struct StaticOrder {
    int nM, nN, nwg, G, c;
    __host__ __device__ void init(int M, int N, int G_, int c_) { nM = M / BM; nN = N / BM; nwg = nM * nN; G = G_; c = c_; }
    __host__ __device__ bool next(int i, Unit& u) const {
        const long L = (long)i * G + c; if (L >= nwg) return false;
        int wgid = (int)L; { const int q = nwg / NXCD, r = nwg % NXCD, xcd = wgid % NXCD, off = wgid / NXCD; wgid = (xcd < r ? xcd * (q + 1) : r * (q + 1) + (xcd - r) * q) + off; }
        const int nig = WGM * nN, gid = wgid / nig, fm = gid * WGM, gsz = (nM - fm) < WGM ? (nM - fm) : WGM;
        u.pm = fm + ((wgid % nig) % gsz); u.pn = (wgid % nig) / gsz; return true;
    }
    __device__ __forceinline__ void a_ready(const Unit&) const {}
    __device__ __forceinline__ void done(const Unit&) const {}
};

typedef float f32x2_t __attribute__((ext_vector_type(2)));
typedef __bf16 bf16x2_t __attribute__((ext_vector_type(2)));
__device__ __forceinline__ unsigned cvt_pk_bf16(float lo, float hi) { f32x2_t v = {lo, hi}; bf16x2_t b = __builtin_convertvector(v, bf16x2_t); return __builtin_bit_cast(unsigned, b); }
template <int ACT  > struct EpiStore {
    static constexpr bool PERM = true, AFTER_DRAIN = false;
    bf16_t* O; int ldc;
    __device__ __forceinline__ void operator()(const f32x4 (&acc)[2][2][4][2], const Unit& u, int wr, int wc, int fr, int fq) const {
        const int row0 = u.pm * BM + wr * 64 + fr; const int col0 = u.pn * BM + wc * 32 + 8 * fq;
#pragma unroll
        for (int ai = 0; ai < 2; ++ai)
#pragma unroll
            for (int m = 0; m < 4; ++m) { bf16_t* rowp = O + (size_t)(row0 + ai * HALF + m * 16) * ldc + col0;
#pragma unroll
                for (int bj = 0; bj < 2; ++bj) { f32x4 v0 = acc[ai][bj][m][0], v1 = acc[ai][bj][m][1];
                    if (ACT == 2) {
#pragma unroll
                        for (int j = 0; j < 4; ++j) { float a = fmaxf(v0[j], 0.f), b = fmaxf(v1[j], 0.f); v0[j] = a * a; v1[j] = b * b; } }
                    u32x4 w; w.x = cvt_pk_bf16(v0[0], v0[1]); w.y = cvt_pk_bf16(v0[2], v0[3]); w.z = cvt_pk_bf16(v1[0], v1[1]); w.w = cvt_pk_bf16(v1[2], v1[3]);
                    *(u32x4*)(rowp + bj * HALF) = w; } }
    }
};
struct EpiResid {
    static constexpr bool PERM = true, AFTER_DRAIN = false;
    const float* baseP; const float* baseS; const float* gate; float* out;
    __device__ __forceinline__ void operator()(const f32x4 (&acc)[2][2][4][2], const Unit& u, int wr, int wc, int fr, int fq) const {
        const int row0 = u.pm * BM + wr * 64 + fr; const int col0 = u.pn * BM + wc * 32 + 8 * fq;
#pragma unroll
        for (int ai = 0; ai < 2; ++ai)
#pragma unroll
            for (int m = 0; m < 4; ++m) { const int r = row0 + ai * HALF + m * 16;
                const float* bp = (r < 8192) ? baseP + (size_t)r * 2048 : baseS + (size_t)(r - 8192) * 2048;
                const float* gp = gate + (size_t)((r < 8192) ? 0 : 1 + ((r - 8192) >> 4)) * 12288;
                float* op = out + (size_t)r * 2048;
#pragma unroll
                for (int bj = 0; bj < 2; ++bj) { const int c = col0 + bj * HALF;
#pragma unroll
                    for (int n = 0; n < 2; ++n) { const f32x4 b = *(const f32x4*)(bp + c + 4 * n), g = *(const f32x4*)(gp + c + 4 * n);
                        *(f32x4*)(op + c + 4 * n) = b + g * acc[ai][bj][m][n]; } }
                asm volatile("" ::: "memory"); }
    }
};

struct EpiPart {
    static constexpr bool PERM = true, AFTER_DRAIN = false;
    bf16_t* out; int ldc;
    __device__ __forceinline__ void operator()(const f32x4 (&acc)[2][2][4][2], const Unit& u, int wr, int wc, int fr, int fq) const {
        const int row0 = u.pm * BM + wr * 64 + fr - 8192; const int col0 = u.pn * BM + wc * 32 + 8 * fq;
#pragma unroll
        for (int ai = 0; ai < 2; ++ai)
#pragma unroll
            for (int m = 0; m < 4; ++m) { bf16_t* op = out + (size_t)(row0 + ai * HALF + m * 16) * ldc + col0;
#pragma unroll
                for (int bj = 0; bj < 2; ++bj) { const f32x4 v0 = acc[ai][bj][m][0], v1 = acc[ai][bj][m][1];
                    u32x4 w; w.x = cvt_pk_bf16(v0[0], v0[1]); w.y = cvt_pk_bf16(v0[2], v0[3]); w.z = cvt_pk_bf16(v1[0], v1[1]); w.w = cvt_pk_bf16(v1[2], v1[3]);
                    *(u32x4*)(op + bj * HALF) = w; } }
    }
};
struct OneUnit { Unit u;
    __device__ __forceinline__ bool next(int i, Unit& o) const { if (i != 0) return false; o = u; return true; }
    __device__ __forceinline__ void a_ready(const Unit&) const {}
    __device__ __forceinline__ void done(const Unit&) const {}
};
template <class Epi, class Sched, bool ALIGN_EPI = false, bool SP2 = false>
__device__ __forceinline__ void gemm_phase(PG8_LAS unsigned char* lds, const Gemm g, const Sched& S, const Epi& E) {
    int tid_ = threadIdx.x; asm volatile("" : "+v"(tid_));
    const int tid = tid_, wid = __builtin_amdgcn_readfirstlane(tid >> 6), lane = tid & 63, wr = wid >> 2, wc = wid & 3, fr = lane & 15, fq = lane >> 4;
    const int K = g.ld, nt = g.K / BK;
    unsigned voffA[2], voffB[2];
#pragma unroll
    for (int i = 0; i < 2; ++i) { int R, C; stage_rc(tid * 16 + i * 8192, R, C); const int Rb = Epi::PERM ? ((R & ~31) + perm32(R & 31)) : R;
        voffA[i] = (unsigned)(R * K + C) * 2u; voffB[i] = (unsigned)(Rb * K + C) * 2u; }
    const size_t kstep = (size_t)(BK * 2);
    const size_t hstep = (size_t)HALF * K * 2;
    const size_t tstep = 2 * hstep;
    const unsigned ldsw = (unsigned)wid * 1024u;
    const int aoff = lds_byte(wr * 64 + fr, fq * 8), boff = lds_byte(wc * 32 + fr, fq * 8);
#define PG8_SA(b, h) (((b) * 2 + (h)) * HTB)
#define PG8_SB(b, h) ((4 + (b) * 2 + (h)) * HTB)
#define PG8_STAGE(bufoff, gbase, voff) do { _Pragma("unroll") for (int _i = 0; _i < 2; ++_i) \
        __builtin_amdgcn_global_load_lds((const unsigned*)((const char*)(gbase) + (voff)[_i]), (PG8_LAS unsigned*)(lds + (bufoff) + ldsw + _i * 8192), 16, 0, 0); } while (0)
#define PG8_LDA(dst, b, h) do { _Pragma("unroll") for (int m = 0; m < 4; ++m) _Pragma("unroll") for (int k = 0; k < 2; ++k) dst[m][k] = *(const PG8_LAS bf16x8*)(lds + PG8_SA(b, h) + aoff + m * 2048 + k * 1024); } while (0)
#define PG8_LDB(dst, b, h) do { _Pragma("unroll") for (int n = 0; n < 2; ++n) _Pragma("unroll") for (int k = 0; k < 2; ++k) dst[n][k] = *(const PG8_LAS bf16x8*)(lds + PG8_SB(b, h) + boff + n * 2048 + k * 1024); } while (0)
#define PG8_MMA(ai, bj, At, Bt) do { __builtin_amdgcn_s_setprio(1); _Pragma("unroll") for (int m = 0; m < 4; ++m) _Pragma("unroll") for (int n = 0; n < 2; ++n) _Pragma("unroll") for (int k = 0; k < 2; ++k) \
        acc[ai][bj][m][n] = __builtin_amdgcn_mfma_f32_16x16x32_bf16(Bt[n][k], At[m][k], acc[ai][bj][m][n], 0, 0, 0); __builtin_amdgcn_s_setprio(0); } while (0)
#define PG8_WAIT_V(n) asm volatile("s_waitcnt vmcnt(" #n ")" ::: "memory")
#define PG8_WAIT_L(n) asm volatile("s_waitcnt lgkmcnt(" #n ")" ::: "memory")
#define PG8_BAR __builtin_amdgcn_s_barrier()
#define PG8_SCHED __builtin_amdgcn_sched_barrier(0)
    Unit cur, nxt; int ui = 0;
    if (!S.next(0, cur)) return;
    f32x4 acc[2][2][4][2];
#pragma unroll
    for (int a = 0; a < 2; ++a)
#pragma unroll
        for (int b = 0; b < 2; ++b)
#pragma unroll
            for (int m = 0; m < 4; ++m)
#pragma unroll
                for (int n = 0; n < 2; ++n) acc[a][b][m][n] = (f32x4){0.f, 0.f, 0.f, 0.f};
    bf16x8 At[4][2], B0[2][2], B1[2][2];
    const char* cA = (const char*)g.A + (size_t)cur.pm * tstep; const char* cB = (const char*)g.Bt + (size_t)cur.pn * tstep;
    S.a_ready(cur);
    if constexpr (SP2) {
        PG8_STAGE(PG8_SB(0, 0), cB, voffB); PG8_STAGE(PG8_SB(0, 1), cB + hstep, voffB); PG8_STAGE(PG8_SA(0, 0), cA, voffA); PG8_STAGE(PG8_SA(0, 1), cA + hstep, voffA);
        if (wr == 1) PG8_BAR;
        PG8_WAIT_V(2); PG8_BAR;
        PG8_STAGE(PG8_SB(1, 0), cB + kstep, voffB); PG8_STAGE(PG8_SA(1, 0), cA + kstep, voffA); PG8_STAGE(PG8_SB(1, 1), cB + hstep + kstep, voffB);
        PG8_WAIT_V(6); PG8_BAR;
    } else {
        PG8_STAGE(PG8_SB(0, 0), cB, voffB); PG8_STAGE(PG8_SA(0, 0), cA, voffA); PG8_STAGE(PG8_SB(0, 1), cB + hstep, voffB); PG8_STAGE(PG8_SA(0, 1), cA + hstep, voffA);
        if (wr == 1) PG8_BAR;
        PG8_WAIT_V(4); PG8_BAR;
        PG8_STAGE(PG8_SB(1, 0), cB + kstep, voffB); PG8_STAGE(PG8_SA(1, 0), cA + kstep, voffA); PG8_STAGE(PG8_SB(1, 1), cB + hstep + kstep, voffB);
        PG8_WAIT_V(6); PG8_BAR;
    }
    for (;;) {
        const bool has_next = S.next(ui + 1, nxt);
        const char* nA = has_next ? (const char*)g.A + (size_t)nxt.pm * tstep : cA; const char* nB = has_next ? (const char*)g.Bt + (size_t)nxt.pn * tstep : cB;
        for (int t = 0; t < nt; t += 2) {
            const bool last = (t == nt - 2);
            const char* a1 = cA + (size_t)(t + 1) * kstep;
            const char* a2 = last ? nA : cA + (size_t)(t + 2) * kstep; const char* b2 = last ? nB : cB + (size_t)(t + 2) * kstep;
            const char* a3 = a2 + kstep; const char* b3 = b2 + kstep;
            if (last && has_next) S.a_ready(nxt);
            if constexpr (SP2) {
            PG8_LDB(B0, 0, 0); PG8_LDB(B1, 0, 1); PG8_SCHED; PG8_LDA(At, 0, 0); PG8_STAGE(PG8_SA(1, 1), a1 + hstep, voffA);
            PG8_WAIT_V(8); PG8_WAIT_L(0); PG8_BAR; PG8_MMA(0, 0, At, B0); PG8_MMA(0, 1, At, B1); PG8_BAR; PG8_SCHED;
            PG8_LDA(At, 0, 1); PG8_STAGE(PG8_SB(0, 0), b2, voffB); PG8_STAGE(PG8_SB(0, 1), b2 + hstep, voffB); PG8_STAGE(PG8_SA(0, 0), a2, voffA);
            PG8_WAIT_V(8); PG8_WAIT_L(0); PG8_BAR; PG8_MMA(1, 0, At, B0); PG8_MMA(1, 1, At, B1); PG8_BAR; PG8_SCHED;
            PG8_LDB(B0, 1, 0); PG8_LDB(B1, 1, 1); PG8_SCHED; PG8_LDA(At, 1, 0); PG8_STAGE(PG8_SA(0, 1), a2 + hstep, voffA);
            PG8_WAIT_V(8); PG8_WAIT_L(0); PG8_BAR; PG8_MMA(0, 0, At, B0); PG8_MMA(0, 1, At, B1); PG8_BAR; PG8_SCHED;
            PG8_LDA(At, 1, 1); PG8_STAGE(PG8_SB(1, 0), b3, voffB); PG8_STAGE(PG8_SB(1, 1), b3 + hstep, voffB); PG8_STAGE(PG8_SA(1, 0), a3, voffA);
            PG8_WAIT_V(8); PG8_WAIT_L(0); PG8_BAR; PG8_MMA(1, 0, At, B0); PG8_MMA(1, 1, At, B1); PG8_BAR; PG8_SCHED;
            } else {
            PG8_LDB(B0, 0, 0); PG8_SCHED; PG8_LDA(At, 0, 0); PG8_STAGE(PG8_SA(1, 1), a1 + hstep, voffA);
            PG8_WAIT_L(8); PG8_BAR; PG8_WAIT_L(0); PG8_MMA(0, 0, At, B0); PG8_BAR; PG8_SCHED;
            PG8_LDB(B1, 0, 1); PG8_STAGE(PG8_SB(0, 0), b2, voffB);
            PG8_BAR; PG8_WAIT_L(0); PG8_MMA(0, 1, At, B1); PG8_BAR;
            PG8_LDA(At, 0, 1); PG8_STAGE(PG8_SA(0, 0), a2, voffA);
            PG8_BAR; PG8_WAIT_L(0); PG8_MMA(1, 0, At, B0); PG8_BAR; PG8_SCHED;
            PG8_STAGE(PG8_SB(0, 1), b2 + hstep, voffB);
            PG8_WAIT_V(6); PG8_BAR; PG8_MMA(1, 1, At, B1); PG8_BAR;
            PG8_LDB(B0, 1, 0); PG8_SCHED; PG8_LDA(At, 1, 0); PG8_STAGE(PG8_SA(0, 1), a2 + hstep, voffA);
            PG8_WAIT_L(8); PG8_BAR; PG8_WAIT_L(0); PG8_MMA(0, 0, At, B0); PG8_BAR; PG8_SCHED;
            PG8_LDB(B1, 1, 1); PG8_STAGE(PG8_SB(1, 0), b3, voffB);
            PG8_BAR; PG8_WAIT_L(0); PG8_MMA(0, 1, At, B1); PG8_BAR;
            PG8_LDA(At, 1, 1); PG8_STAGE(PG8_SA(1, 0), a3, voffA);
            PG8_BAR; PG8_WAIT_L(0); PG8_MMA(1, 0, At, B0); PG8_BAR; PG8_SCHED;
            PG8_STAGE(PG8_SB(1, 1), b3 + hstep, voffB);
            PG8_WAIT_V(6); PG8_BAR; PG8_MMA(1, 1, At, B1); PG8_BAR;
            }
        }
        if constexpr (ALIGN_EPI) { if (wr == 0) PG8_BAR; }
        if constexpr (!Epi::AFTER_DRAIN) { E(acc, cur, wr, wc, fr, fq); S.done(cur); }
        if (!has_next) break;
#pragma unroll
        for (int a = 0; a < 2; ++a)
#pragma unroll
            for (int b = 0; b < 2; ++b)
#pragma unroll
                for (int m = 0; m < 4; ++m)
#pragma unroll
                    for (int n = 0; n < 2; ++n) acc[a][b][m][n] = (f32x4){0.f, 0.f, 0.f, 0.f};
        cur = nxt; cA = nA; cB = nB; ++ui;
        if constexpr (ALIGN_EPI) { if (wr == 1) PG8_BAR; }
    }
    PG8_WAIT_V(0);
    if constexpr (!ALIGN_EPI) { if (wr == 0) PG8_BAR; }
    PG8_BAR;
    if constexpr (Epi::AFTER_DRAIN) { E.fused(acc, cur, wr, wc, fr, fq, lds, wid, lane); S.done(cur); }
#undef PG8_SA
#undef PG8_SB
#undef PG8_STAGE
#undef PG8_LDA
#undef PG8_LDB
#undef PG8_MMA
#undef PG8_WAIT_V
#undef PG8_WAIT_L
#undef PG8_BAR
#undef PG8_SCHED
}
}
#define GAS __attribute__((address_space(1)))
#define LAS __attribute__((address_space(3)))
typedef unsigned short bf16;
typedef unsigned u32x4 __attribute__((ext_vector_type(4)));
typedef unsigned u32x2 __attribute__((ext_vector_type(2)));
typedef float f32x4 __attribute__((ext_vector_type(4)));
typedef float f32x16 __attribute__((ext_vector_type(16)));
typedef short bf16x8 __attribute__((ext_vector_type(8)));
typedef short s16x4 __attribute__((ext_vector_type(4)));
typedef float f32x2_t __attribute__((ext_vector_type(2)));
constexpr int NW = 8, NT = 512;
constexpr int MTOK = 8704, MP = 8192, MS = 512, DM = 2048, NIN = 7176, NINP = 7424, DFF = 8192;
constexpr int NSEQ = 33;
constexpr int PAST = 1024;
constexpr int C_QA = 0, C_KA = 1024, C_VA = 2048, C_QM = 3072, C_KM = 4096, C_VM = 5120, C_OM = 6144, C_IG = 7168, C_FG = 7172;
constexpr int NCH = 160;
constexpr float EPS = 1e-6f;
constexpr float LAM_INIT = 0.2f;
constexpr float QSCALE = 0.125f * 1.4426950408889634f;
constexpr size_t O_YP = 0, O_YS = 16777216, O_KP = 17825792, O_VP = 26214400, O_CVP = 34603008, O_CP = 34609152, O_NP = 34871296, O_MPO = 34872320,
                 O_KS = 34872324, O_VS = 35396612, O_CVS = 35920900, O_CS = 36117508, O_NS = 44506116, O_MSO = 44538884;
constexpr size_t MiB = 1u << 20;
constexpr size_t WS_MOD = 1 * MiB;
constexpr size_t WS_ROPE = 3 * MiB;
constexpr size_t WS_SCAL = 4 * MiB;
constexpr size_t WS_DN = 5 * MiB;
constexpr size_t WS_NPREV = 6 * MiB;
constexpr size_t WS_WIN = 8 * MiB;
constexpr size_t WS_WOUT = 40 * MiB;
constexpr size_t WS_WUP = 48 * MiB;
constexpr size_t WS_WDN = 80 * MiB;
constexpr size_t WS_XN = 112 * MiB;
constexpr size_t WS_PROJ = 148 * MiB;
constexpr size_t WS_QA = 272 * MiB;
constexpr size_t WS_KA = 289 * MiB;
constexpr size_t WS_VT = 306 * MiB;
constexpr size_t WS_DC = 322 * MiB;
constexpr size_t WS_CPREV = 482 * MiB;
constexpr size_t WS_MIX = 562 * MiB;
constexpr size_t WS_END = 596 * MiB;
constexpr size_t WS_H = WS_PROJ;
constexpr size_t WS_X1 = WS_DC;
constexpr size_t WS_PART6 = 390 * MiB;
constexpr size_t WS_PART8 = 422 * MiB;
constexpr size_t WS_PART9 = 486 * MiB;
constexpr size_t WS_FLAG = 0;
static_assert(WS_H + (size_t)MTOK * DFF * 2 <= WS_VT + 16 * MiB && WS_X1 + (size_t)MTOK * DM * 4 <= WS_CPREV, "overlays");

constexpr int LDS_BYTES = 147456;

__device__ __forceinline__ f32x4 ld_bf4(const bf16* p) { const u32x2 w = *(const u32x2*)p; return (f32x4){__uint_as_float(w.x << 16), __uint_as_float(w.x & 0xffff0000u), __uint_as_float(w.y << 16), __uint_as_float(w.y & 0xffff0000u)}; }
__device__ __forceinline__ float bf2f(unsigned short u) { return __uint_as_float((unsigned)u << 16); }
__device__ __forceinline__ unsigned pk2(float lo, float hi) { return pg8::cvt_pk_bf16(lo, hi); }
__device__ __forceinline__ float lane_get(float v, int src_lane) { return __int_as_float(__builtin_amdgcn_ds_bpermute(src_lane << 2, __float_as_int(v))); }
__device__ __forceinline__ float xhalf_other(float v) { auto rr = __builtin_amdgcn_permlane32_swap(__float_as_uint(v), __float_as_uint(v), false, false); return __uint_as_float(rr[0]) + __uint_as_float(rr[1]) - v; }
__device__ __forceinline__ float xhalf_sum(float v) { auto rr = __builtin_amdgcn_permlane32_swap(__float_as_uint(v), __float_as_uint(v), false, false); return __uint_as_float(rr[0]) + __uint_as_float(rr[1]); }
__device__ __forceinline__ float wave_sum(float v, int lane) {
#pragma unroll
    for (int o = 1; o < 32; o <<= 1) v += lane_get(v, lane ^ o);
    return xhalf_sum(v);
}
__device__ __forceinline__ float wave_max(float v, int lane) {
#pragma unroll
    for (int o = 1; o < 64; o <<= 1) v = fmaxf(v, lane_get(v, lane ^ o));
    return v;
}
__device__ __forceinline__ float silu_f(float x) { return x / (1.f + __expf(-x)); }
__device__ __forceinline__ float sigmoid_f(float x) { return 1.f / (1.f + __expf(-x)); }
__device__ __forceinline__ int crow(int r, int hi) { return (r & 3) + 8 * (r >> 2) + 4 * hi; }
#define LDS_WAIT() asm volatile("s_waitcnt lgkmcnt(0)" ::: "memory")

struct Args {
    const float* in[29]; float* out; unsigned char* ws;
};
typedef const __attribute__((address_space(4))) Args* ArgsP;
#define FRESH_ARGS() ({ ArgsP p_ = (ArgsP)__builtin_amdgcn_kernarg_segment_ptr(); asm volatile("" : "+s"(p_)); p_; })

__device__ __forceinline__ void p0_transpose_item(const float* __restrict__ W, int K, int N, int Npad, bf16* WT, LAS float* T, int item, int tid, int wave, int lane) {
    const int nblk = Npad / 256, kb = item / nblk, nb = item % nblk, k0 = 64 * kb, n0 = 256 * nb;
    const int n = n0 + 4 * lane;
    f32x4 v[8];
#pragma unroll
    for (int i = 0; i < 8; ++i) v[i] = (n < N) ? *(const f32x4*)(W + (size_t)(k0 + 8 * wave + i) * N + n) : (f32x4){0.f, 0.f, 0.f, 0.f};
#pragma unroll
    for (int i = 0; i < 8; ++i) *(LAS f32x4*)(T + (8 * wave + i) * 260 + 4 * lane) = v[i];
    __syncthreads();
#pragma unroll
    for (int j = 0; j < 4; ++j) { const int q = tid + NT * j, nn = q >> 3, c = q & 7; const LAS float* s = T + (8 * c) * 260 + nn;
        u32x4 o; o.x = pk2(s[0], s[260]); o.y = pk2(s[2 * 260], s[3 * 260]); o.z = pk2(s[4 * 260], s[5 * 260]); o.w = pk2(s[6 * 260], s[7 * 260]);
        *(u32x4*)(WT + (size_t)(n0 + nn) * K + k0 + 8 * c) = o; }
    __syncthreads();
}

__device__ __forceinline__ void p0_ada_item(const float* __restrict__ cP, const float* __restrict__ cS, const float* __restrict__ Wada, const float* __restrict__ bada,
                                            float* mod, LAS float* red, int jb, int wave, int lane, int tid) {
    const int i32 = lane & 31, hi = lane >> 5;
    f32x16 acc[4]; f32x4 accp = {0.f, 0.f, 0.f, 0.f};
#pragma unroll
    for (int c = 0; c < 4; ++c) acc[c] = (f32x16){};
    const float* wp = Wada + (size_t)128 * jb + 4 * i32;
    for (int st = 0; st < 16; ++st) {
        const int k0 = 256 * wave + 16 * st + 8 * hi;
        f32x4 w[8];
#pragma unroll
        for (int i = 0; i < 8; ++i) w[i] = *(const f32x4*)(wp + (size_t)(k0 + i) * 12288);
        const f32x4 c0 = *(const f32x4*)(cS + (size_t)i32 * DM + k0), c1 = *(const f32x4*)(cS + (size_t)i32 * DM + k0 + 4);
        const f32x4 p0 = *(const f32x4*)(cP + k0), p1 = *(const f32x4*)(cP + k0 + 4);
        u32x4 a;
        a.x = pk2(silu_f(c0[0]), silu_f(c0[1])); a.y = pk2(silu_f(c0[2]), silu_f(c0[3])); a.z = pk2(silu_f(c1[0]), silu_f(c1[1])); a.w = pk2(silu_f(c1[2]), silu_f(c1[3]));
#pragma unroll
        for (int i = 0; i < 4; ++i) { accp += w[i] * silu_f(p0[i]); accp += w[4 + i] * silu_f(p1[i]); }
#pragma unroll
        for (int c = 0; c < 4; ++c) { u32x4 b; b.x = pk2(w[0][c], w[1][c]); b.y = pk2(w[2][c], w[3][c]); b.z = pk2(w[4][c], w[5][c]); b.w = pk2(w[6][c], w[7][c]);
            acc[c] = __builtin_amdgcn_mfma_f32_32x32x16_bf16(__builtin_bit_cast(bf16x8, a), __builtin_bit_cast(bf16x8, b), acc[c], 0, 0, 0); }
    }
    accp = (f32x4){xhalf_sum(accp[0]), xhalf_sum(accp[1]), xhalf_sum(accp[2]), xhalf_sum(accp[3])};
    LAS float* rp = red + 16384;
    if (hi == 0) *(LAS f32x4*)(rp + wave * 128 + 4 * i32) = accp;
#pragma unroll
    for (int half = 4; half >= 1; half >>= 1) {
        if (wave >= half && wave < 2 * half) { LAS float* dst = red + (wave - half) * 4096;
#pragma unroll
            for (int r = 0; r < 16; ++r) *(LAS f32x4*)(dst + crow(r, hi) * 128 + 4 * i32) = (f32x4){acc[0][r], acc[1][r], acc[2][r], acc[3][r]}; }
        __syncthreads();
        if (wave < half) { const LAS float* src = red + wave * 4096;
#pragma unroll
            for (int r = 0; r < 16; ++r) { const f32x4 t = *(const LAS f32x4*)(src + crow(r, hi) * 128 + 4 * i32); acc[0][r] += t[0]; acc[1][r] += t[1]; acc[2][r] += t[2]; acc[3][r] += t[3]; } }
        __syncthreads();
    }
    if (wave == 0) { const f32x4 bv = *(const f32x4*)(bada + 128 * jb + 4 * i32);
#pragma unroll
        for (int r = 0; r < 16; ++r) *(f32x4*)(mod + (size_t)(1 + crow(r, hi)) * 12288 + 128 * jb + 4 * i32) = (f32x4){acc[0][r], acc[1][r], acc[2][r], acc[3][r]} + bv; }
    if (wave == 1 && hi == 0) { f32x4 t = *(const f32x4*)(bada + 128 * jb + 4 * i32);
#pragma unroll
        for (int w = 0; w < 8; ++w) t += *(const LAS f32x4*)(rp + w * 128 + 4 * i32);
        *(f32x4*)(mod + 128 * jb + 4 * i32) = t; }
    __syncthreads();
}

__constant__ double INV_FREQ_TURNS[8] = {
    1.0 / 6.283185307179586, 0.19392274474868576 / 6.283185307179586, 0.03760603093086393 / 6.283185307179586, 0.007292664737217109 / 6.283185307179586,
    0.001414213562373095 / 6.283185307179586, 0.0002742481756762073 / 6.283185307179586, 5.318295896944988e-05 / 6.283185307179586, 1.031338537721246e-05 / 6.283185307179586 };

__device__ __forceinline__ void p0_prologue(ArgsP A, LAS unsigned char* lds, int tid, int wave, int lane) {
    unsigned char* ws = A->ws;
    const int G = gridDim.x, bid = blockIdx.x;
    for (int jb = bid; jb < 96; jb += G)
        p0_ada_item(A->in[8], A->in[9], A->in[10], A->in[11], (float*)(ws + WS_MOD), (LAS float*)lds, jb, wave, lane, tid);
    constexpr int I_IN = 32 * (NINP / 256), I_OUT = 32 * 8, I_UP = 32 * 32, I_DN = 128 * 8, I_ALL = I_IN + I_OUT + I_UP + I_DN;
    const bool split = (G > 128);
    const int nfree = split ? G - 96 : G, first = split ? 14 * nfree : 0;
    for (int pass = 0; pass < 2; ++pass) {
        int it, step, end;
        if (pass == 0) { if (!split || bid < 96) continue; it = bid - 96; step = nfree; end = (first < I_ALL) ? first : I_ALL; }
        else { it = first + bid; step = G; end = I_ALL; }
        for (; it < end; it += step) { int r = it;
            if (r < I_IN) { p0_transpose_item(A->in[13], DM, NIN, NINP, (bf16*)(ws + WS_WIN), (LAS float*)lds, r, tid, wave, lane); continue; } r -= I_IN;
            if (r < I_OUT) { p0_transpose_item(A->in[24], DM, DM, DM, (bf16*)(ws + WS_WOUT), (LAS float*)lds, r, tid, wave, lane); continue; } r -= I_OUT;
            if (r < I_UP) { p0_transpose_item(A->in[26], DM, DFF, DFF, (bf16*)(ws + WS_WUP), (LAS float*)lds, r, tid, wave, lane); continue; } r -= I_UP;
            p0_transpose_item(A->in[27], DFF, DM, DM, (bf16*)(ws + WS_WDN), (LAS float*)lds, r, tid, wave, lane); }
    }
    for (int idx = blockIdx.x * NT + tid; idx < 8192 * 8; idx += gridDim.x * NT) {
        const int pos = idx >> 3, i = idx & 7;
        const double t = (double)pos * INV_FREQ_TURNS[i]; const float fr = (float)(t - __builtin_rint(t));
        float* tab = (float*)(ws + WS_ROPE) + (size_t)pos * 16;
        tab[i] = __builtin_amdgcn_cosf(fr); tab[8 + i] = __builtin_amdgcn_sinf(fr);
    }
}

template <int NPART> __device__ __forceinline__ void norm_mod_rows(const float* xP, const float* xS, const float* __restrict__ g, const float* __restrict__ mod, int sh_off, int sc_off, bf16* out, int wave, int lane,
                                              const bf16* part = nullptr, int gate_off = 0, float* x1S = nullptr) {
    const int gw = blockIdx.x * NW + wave, NGW = gridDim.x * NW;
    for (int r = gw; r < MTOK; r += NGW) {
        const float* xr = (r < MP) ? xP + (size_t)r * DM : xS + (size_t)(r - MP) * DM;
        const float* mr = mod + (size_t)((r < MP) ? 0 : 1 + ((r - MP) >> 4)) * 12288;
        f32x4 v[8]; float s = 0.f;
#pragma unroll
        for (int j = 0; j < 8; ++j) v[j] = *(const f32x4*)(xr + 256 * j + 4 * lane);
        if (NPART > 0 && r >= MP) {
#pragma unroll
            for (int j = 0; j < 8; ++j) { const int c = 256 * j + 4 * lane; f32x4 a = {0.f, 0.f, 0.f, 0.f};
                f32x4 t[NPART > 0 ? NPART : 1];
#pragma unroll
                for (int p = 0; p < NPART; ++p) t[p] = ld_bf4(part + ((size_t)p * MS + (r - MP)) * DM + c);
#pragma unroll
                for (int p = 0; p < NPART; ++p) a += t[p];
                v[j] += *(const f32x4*)(mr + gate_off + c) * a; *(f32x4*)(x1S + (size_t)(r - MP) * DM + c) = v[j]; } }
#pragma unroll
        for (int j = 0; j < 8; ++j) s += (v[j].x * v[j].x + v[j].y * v[j].y) + (v[j].z * v[j].z + v[j].w * v[j].w);
        const float rstd = 1.f / sqrtf(wave_sum(s, lane) * (1.f / DM) + EPS);
#pragma unroll
        for (int j = 0; j < 8; ++j) { const int c = 256 * j + 4 * lane;
            const f32x4 gg = *(const f32x4*)(g + c), sc = *(const f32x4*)(mr + sc_off + c), sh = *(const f32x4*)(mr + sh_off + c);
            const f32x4 y = v[j] * rstd * gg * (sc + 1.f) + sh;
            u32x2 o; o.x = pk2(y.x, y.y); o.y = pk2(y.z, y.w);
            *(u32x2*)(out + (size_t)r * DM + c) = o; }
    }
}
#define XB_TMO      128
#define XB_XCNT(j)  (256  + 64 * (j))
#define XB_XSUB(j)  (1280 + 64 * (j))
#define XB_XGEN(j)  (2304 + 64 * (j))
#define XB_TOP      3328
#define XB_TOPGEN   3392
#define XCD_BAR_WORDS 3456
#define XB_SPIN_CAP (1u << 18)

__device__ __forceinline__ unsigned xb_ld(unsigned* p)              { return __hip_atomic_load(p, __ATOMIC_RELAXED, __HIP_MEMORY_SCOPE_AGENT); }
__device__ __forceinline__ unsigned xb_add(unsigned* p, unsigned v) { return __hip_atomic_fetch_add(p, v, __ATOMIC_RELAXED, __HIP_MEMORY_SCOPE_AGENT); }
__device__ __forceinline__ unsigned xb_xcc_id() { return (unsigned)__builtin_amdgcn_s_getreg((3 << 11) | 20) & 0xFu; }
#define XB_SPIN(cond, bar) do { unsigned _sp = 0; while (cond) { __builtin_amdgcn_s_sleep(1); \
    if ((++_sp & 255u) == 0u) { if (xb_ld(&(bar)[XB_TMO])) break; if (_sp > XB_SPIN_CAP) { atomicAdd(&(bar)[XB_TMO], 1u); break; } } } } while (0)

struct XcdBarrier {
    unsigned* bar; unsigned x;
    volatile LAS unsigned* st;
};

__device__ __forceinline__ XcdBarrier xcd_barrier_post(unsigned* bar, volatile LAS unsigned* st) {
    XcdBarrier b; b.bar = bar; b.x = xb_xcc_id(); b.st = st;
    if (threadIdx.x == 0) (void)xb_add(&bar[XB_XCNT(b.x)], 1u);
    return b;
}
__device__ __forceinline__ void xcd_barrier_complete(unsigned* bar, unsigned x, unsigned& nloc, unsigned& nx) {
    const unsigned G = gridDim.x * gridDim.y * gridDim.z;
    unsigned sum, cnt, mine, sp = 0u;
    for (;;) {
        sum = 0u; cnt = 0u; mine = 0u;
#pragma unroll
        for (unsigned j = 0; j < 16; ++j) { const unsigned c = xb_ld(&bar[XB_XCNT(j)]); sum += c; cnt += (c > 0u) ? 1u : 0u; mine = (j == x) ? c : mine; }
        if (sum == G) break;
        __builtin_amdgcn_s_sleep(1);
        if ((++sp & 255u) == 0u) { if (xb_ld(&bar[XB_TMO])) break; if (sp > XB_SPIN_CAP) { atomicAdd(&bar[XB_TMO], 1u); break; } }
    }
    nloc = mine > 0u ? mine : 1u; nx = cnt > 0u ? cnt : 1u;
}

__device__ __forceinline__ void xcd_barrier(const XcdBarrier& b) {
    asm volatile("s_waitcnt vmcnt(0)" ::: "memory");
    __syncthreads();
    if (threadIdx.x == 0) {
        unsigned* bar = b.bar;
        __builtin_amdgcn_s_waitcnt(0);
        unsigned nloc = b.st[0], nx = b.st[1];
        if (nloc == 0u) { xcd_barrier_complete(bar, b.x, nloc, nx); b.st[0] = nloc; b.st[1] = nx; }
        const unsigned old = xb_add(&bar[XB_XSUB(b.x)], 1u);
        const unsigned gen = old / nloc;
        if (old + 1u == (gen + 1u) * nloc) {
            __builtin_amdgcn_fence(__ATOMIC_RELEASE, "agent");
            asm volatile("s_waitcnt vmcnt(0)" ::: "memory");
            const unsigned og = xb_add(&bar[XB_TOP], 1u);
            const unsigned tg = og / nx;
            if (og + 1u == (tg + 1u) * nx) xb_add(&bar[XB_TOPGEN], 1u);
            else XB_SPIN(xb_ld(&bar[XB_TOPGEN]) == tg, bar);
            __builtin_amdgcn_fence(__ATOMIC_ACQUIRE, "agent");
            xb_add(&bar[XB_XGEN(b.x)], 1u);
            asm volatile("s_waitcnt vmcnt(0)" ::: "memory");
        } else {
            XB_SPIN(xb_ld(&bar[XB_XGEN(b.x)]) == gen, bar);
            __builtin_amdgcn_fence(__ATOMIC_ACQUIRE, "agent");
            asm volatile("s_waitcnt vmcnt(0)" ::: "memory");
        }
    }
    __syncthreads();
}
__device__ __forceinline__ void unpack16(const u32x4 a, const u32x4 b, float* v) {
#pragma unroll
    for (int i = 0; i < 4; ++i) { v[2 * i] = __uint_as_float(a[i] << 16); v[2 * i + 1] = __uint_as_float(a[i] & 0xffff0000u); v[8 + 2 * i] = __uint_as_float(b[i] << 16); v[8 + 2 * i + 1] = __uint_as_float(b[i] & 0xffff0000u); }
}
__device__ __forceinline__ void p3_post(ArgsP A, int tid) {
    unsigned char* ws = A->ws;
    const bf16* PROJ = (const bf16*)(ws + WS_PROJ); bf16* QA = (bf16*)(ws + WS_QA); bf16* KA = (bf16*)(ws + WS_KA);
    const float* rope = (const float*)(ws + WS_ROPE);
    for (int it = blockIdx.x * NT + tid; it < MTOK * 64; it += gridDim.x * NT) {
        const int r = it >> 6, cg16 = it & 63;
        const int pos = (r < MP) ? r : PAST + ((r - MP) & 15);
        const bf16* pr = PROJ + (size_t)r * NINP + 16 * cg16;
        float q[16], k[16], v[16];
        unpack16(*(const u32x4*)(pr + C_QA), *(const u32x4*)(pr + C_QA + 8), q);
        unpack16(*(const u32x4*)(pr + C_KA), *(const u32x4*)(pr + C_KA + 8), k);
        unpack16(*(const u32x4*)(pr + C_VA), *(const u32x4*)(pr + C_VA + 8), v);
        if ((cg16 & 3) == 0) {
            const float* tb = rope + (size_t)pos * 16;
#pragma unroll
            for (int i = 0; i < 8; ++i) { const float c = tb[i], s = tb[8 + i];
                const float q1 = q[i], q2 = q[8 + i]; q[i] = q1 * c - q2 * s; q[8 + i] = q2 * c + q1 * s;
                const float k1 = k[i], k2 = k[8 + i]; k[i] = k1 * c - k2 * s; k[8 + i] = k2 * c + k1 * s; }
        }
        u32x4 o0, o1;
#pragma unroll
        for (int i = 0; i < 4; ++i) { o0[i] = pk2(q[2 * i] * QSCALE, q[2 * i + 1] * QSCALE); o1[i] = pk2(q[8 + 2 * i] * QSCALE, q[8 + 2 * i + 1] * QSCALE); }
        *(u32x4*)(QA + (size_t)r * 1024 + 16 * cg16) = o0; *(u32x4*)(QA + (size_t)r * 1024 + 16 * cg16 + 8) = o1;
#pragma unroll
        for (int i = 0; i < 4; ++i) { o0[i] = pk2(k[2 * i], k[2 * i + 1]); o1[i] = pk2(k[8 + 2 * i], k[8 + 2 * i + 1]); }
        *(u32x4*)(KA + (size_t)r * 1024 + 16 * cg16) = o0; *(u32x4*)(KA + (size_t)r * 1024 + 16 * cg16 + 8) = o1;
        float* ko = A->out + ((r < MP) ? O_KP + (size_t)r * 1024 : O_KS + (size_t)(r - MP) * 1024) + 16 * cg16;
        float* vo = A->out + ((r < MP) ? O_VP + (size_t)r * 1024 : O_VS + (size_t)(r - MP) * 1024) + 16 * cg16;
#pragma unroll
        for (int i = 0; i < 4; ++i) { *(f32x4*)(ko + 4 * i) = (f32x4){k[4 * i], k[4 * i + 1], k[4 * i + 2], k[4 * i + 3]}; *(f32x4*)(vo + 4 * i) = (f32x4){v[4 * i], v[4 * i + 1], v[4 * i + 2], v[4 * i + 3]}; }
    }
    for (int it = blockIdx.x * NT + tid; it < 33 * 3 * 2048; it += gridDim.x * NT) {
        const int ch = it & 2047, j = (it >> 11) % 3, sq = it / (3 * 2048);
        const int r = (sq == 0) ? (MP - 3 + j) : (MP + 16 * (sq - 1) + 13 + j);
        const float val = bf2f(PROJ[(size_t)r * NINP + C_QM + ch]);
        if (sq == 0) A->out[O_CVP + (size_t)j * 2048 + ch] = val; else A->out[O_CVS + ((size_t)(sq - 1) * 3 + j) * 2048 + ch] = val;
    }
}
typedef short v4i16_t __attribute__((ext_vector_type(4)));
__device__ __forceinline__ s16x4 tr_rd(LAS const unsigned char* p) { return __builtin_bit_cast(s16x4, __builtin_amdgcn_ds_read_tr16_b64_v4i16((LAS v4i16_t*)p)); }
__device__ __forceinline__ bf16x8 mk8(s16x4 a, s16x4 b) { return (bf16x8){a[0], a[1], a[2], a[3], b[0], b[1], b[2], b[3]}; }
__device__ __forceinline__ int tr_off(int pitch, int krow, int colbase, int lane) { return (krow + ((lane & 15) >> 2)) * pitch + (colbase + 16 * ((lane >> 4) & 1) + 4 * (lane & 3)) * 2; }
__device__ __forceinline__ void unpack8(const u32x4 a, float* v) {
#pragma unroll
    for (int i = 0; i < 4; ++i) { v[2 * i] = __uint_as_float(a[i] << 16); v[2 * i + 1] = __uint_as_float(a[i] & 0xffff0000u); }
}
__device__ __forceinline__ int unit_row0(int u) { return (u < 128) ? 64 * u : MP + 16 * (u - 128); }
__device__ __forceinline__ void conv8(const bf16* PROJ, const float* __restrict__ stconv, const float* __restrict__ wconv, const float* __restrict__ bconv, int u, int s, int ch0, float* o) {
    const int r0 = unit_row0(u);
    f32x4 a0 = *(const f32x4*)(bconv + ch0), a1 = *(const f32x4*)(bconv + ch0 + 4);
#pragma unroll
    for (int j = 0; j < 4; ++j) { const int tau = s - 3 + j; float x[8];
        if (tau >= 0 || (u > 0 && u < 128)) unpack8(*(const u32x4*)(PROJ + (size_t)(r0 + tau) * NINP + C_QM + ch0), x);
        else if (u >= 128) { const float* p = stconv + ((size_t)(u - 128) * 3 + (3 + tau)) * 2048 + ch0; const f32x4 y0 = *(const f32x4*)p, y1 = *(const f32x4*)(p + 4);
            x[0] = y0[0]; x[1] = y0[1]; x[2] = y0[2]; x[3] = y0[3]; x[4] = y1[0]; x[5] = y1[1]; x[6] = y1[2]; x[7] = y1[3]; }
        else {
#pragma unroll
            for (int i = 0; i < 8; ++i) x[i] = 0.f; }
        const f32x4 w0 = *(const f32x4*)(wconv + j * 2048 + ch0), w1 = *(const f32x4*)(wconv + j * 2048 + ch0 + 4);
        a0 += (f32x4){x[0], x[1], x[2], x[3]} * w0; a1 += (f32x4){x[4], x[5], x[6], x[7]} * w1; }
#pragma unroll
    for (int i = 0; i < 4; ++i) { o[i] = silu_f(a0[i]); o[4 + i] = silu_f(a1[i]); }
}
__device__ __forceinline__ void conv_rows4(const bf16* PROJ, const float* __restrict__ stconv, const float* __restrict__ wconv, const float* __restrict__ bconv, int u, int L, int s0, int ch0, float sc, u32x4* o) {
    const int r0 = unit_row0(u);
    f32x4 w0[4], w1[4];
#pragma unroll
    for (int j = 0; j < 4; ++j) { w0[j] = *(const f32x4*)(wconv + j * 2048 + ch0); w1[j] = *(const f32x4*)(wconv + j * 2048 + ch0 + 4); }
    const f32x4 b0 = *(const f32x4*)(bconv + ch0), b1 = *(const f32x4*)(bconv + ch0 + 4);
    f32x4 x0[7], x1[7];
#pragma unroll
    for (int i = 0; i < 7; ++i) { const int tau = s0 - 3 + i; x0[i] = (f32x4){0.f, 0.f, 0.f, 0.f}; x1[i] = x0[i];
        if (tau >= 0 ? (tau < L) : (u > 0 && u < 128)) { float t[8]; unpack8(*(const u32x4*)(PROJ + (size_t)(r0 + tau) * NINP + C_QM + ch0), t); x0[i] = (f32x4){t[0], t[1], t[2], t[3]}; x1[i] = (f32x4){t[4], t[5], t[6], t[7]}; }
        else if (tau < 0 && u >= 128) { const float* p = stconv + ((size_t)(u - 128) * 3 + (3 + tau)) * 2048 + ch0; x0[i] = *(const f32x4*)p; x1[i] = *(const f32x4*)(p + 4); } }
#pragma unroll
    for (int r = 0; r < 4; ++r) { f32x4 a0 = b0, a1 = b1;
#pragma unroll
        for (int j = 0; j < 4; ++j) { a0 += x0[r + j] * w0[j]; a1 += x1[r + j] * w1[j]; }
        u32x4 q = {0u, 0u, 0u, 0u};
        if (s0 + r < L) { q.x = pk2(silu_f(a0[0]) * sc, silu_f(a0[1]) * sc); q.y = pk2(silu_f(a0[2]) * sc, silu_f(a0[3]) * sc); q.z = pk2(silu_f(a1[0]) * sc, silu_f(a1[1]) * sc); q.w = pk2(silu_f(a1[2]) * sc, silu_f(a1[3]) * sc); }
        o[r] = q; }
}
__device__ __forceinline__ u32x4 pack8(const float* v, float sc) { u32x4 o; o.x = pk2(v[0] * sc, v[1] * sc); o.y = pk2(v[2] * sc, v[3] * sc); o.z = pk2(v[4] * sc, v[5] * sc); o.w = pk2(v[6] * sc, v[7] * sc); return o; }
__device__ __forceinline__ float logsigmoid_f(float f) { return fminf(f, 0.f) - log1pf(__expf(-fabsf(f))); }
__device__ __forceinline__ void load_gates(const bf16* PROJ, const float* bi, const float* bfg, int u, int h, int t, float& ig, float& lf) {
    const int L = (u < 128) ? 64 : 16; const int r = unit_row0(u) + t;
    ig = -INFINITY; lf = 0.f;
    if (t < L) { ig = bf2f(PROJ[(size_t)r * NINP + C_IG + h]) + bi[h]; lf = logsigmoid_f(bf2f(PROJ[(size_t)r * NINP + C_FG + h]) + bfg[h]); }
}
__device__ __forceinline__ float scan_add(float v, int lane) {
#pragma unroll
    for (int o = 1; o < 64; o <<= 1) { const float x = lane_get(v, lane - o); if (lane >= o) v += x; }
    return v;
}
__device__ __forceinline__ float scan_max(float v, int lane) {
#pragma unroll
    for (int o = 1; o < 64; o <<= 1) { const float x = lane_get(v, lane - o); if (lane >= o) v = fmaxf(v, x); }
    return v;
}
constexpr int MA_K = 0, MA_V = 36864, MA_W = 73728;
constexpr int PK = 576;
__device__ __forceinline__ void mlstm_phaseA(ArgsP A, LAS unsigned char* lds, int u, int h, int tid, int wave, int lane) {
    unsigned char* ws = A->ws; const bf16* PROJ = (const bf16*)(ws + WS_PROJ);
    float* SC = (float*)(ws + WS_SCAL);
    LAS float* wl = (LAS float*)(lds + MA_W);
    const int L = (u < 128) ? 64 : 16, r0 = unit_row0(u);
    if (wave == 0) {
        float ig, lf; load_gates(PROJ, A->in[21], A->in[22], u, h, lane, ig, lf);
        const float b = scan_add(lf, lane); const float G = lane_get(b, 63);
        const float uu = (lane < L) ? G - b + ig : -INFINITY; const float mloc = wave_max(uu, lane);
        wl[lane] = (lane < L) ? __expf(uu - mloc) : 0.f;
        if (lane == 0) { SC[u * 4 + h] = G; SC[640 + u * 4 + h] = mloc; }
    }
    { const int c8 = 8 * (tid & 31), s0 = 4 * (tid >> 5);
      u32x4 ko[4]; conv_rows4(PROJ, A->in[4], A->in[19], A->in[20], u, L, s0, 1024 + h * 256 + c8, 0.0625f, ko);
      u32x4 vr[4];
#pragma unroll
      for (int r = 0; r < 4; ++r) { vr[r] = (u32x4){0u, 0u, 0u, 0u}; if (s0 + r < L) vr[r] = *(const u32x4*)(PROJ + (size_t)(r0 + s0 + r) * NINP + C_VM + h * 256 + c8); }
#pragma unroll
      for (int r = 0; r < 4; ++r) *(LAS u32x4*)(lds + MA_K + (s0 + r) * PK + c8 * 2) = ko[r];
      __syncthreads();
#pragma unroll
      for (int r = 0; r < 4; ++r) { float v[8]; unpack8(vr[r], v); *(LAS u32x4*)(lds + MA_V + (s0 + r) * PK + c8 * 2) = pack8(v, wl[s0 + r]); } }
    __syncthreads();
    { const int i32 = lane & 31, hi = lane >> 5, eb = wave;
      bf16x8 af[4];
#pragma unroll
      for (int ks = 0; ks < 4; ++ks) { const int o = tr_off(PK, 16 * ks + 8 * hi, 32 * eb, lane); af[ks] = mk8(tr_rd(lds + MA_V + o), tr_rd(lds + MA_V + o + 4 * PK)); }
      bf16* dC = (bf16*)(ws + WS_DC) + ((size_t)(u * 4 + h) * 256 + 32 * eb + i32) * 256 + 4 * hi;
      for (int db = 0; db < 8; ++db) { f32x16 acc = {};
#pragma unroll
          for (int ks = 0; ks < 4; ++ks) { const int o = tr_off(PK, 16 * ks + 8 * hi, 32 * db, lane); const bf16x8 bfr = mk8(tr_rd(lds + MA_K + o), tr_rd(lds + MA_K + o + 4 * PK));
              acc = __builtin_amdgcn_mfma_f32_32x32x16_bf16(bfr, af[ks], acc, 0, 0, 0); }
#pragma unroll
          for (int g4 = 0; g4 < 4; ++g4) { u32x2 o; o.x = pk2(acc[4 * g4], acc[4 * g4 + 1]); o.y = pk2(acc[4 * g4 + 2], acc[4 * g4 + 3]); *(u32x2*)(dC + 32 * db + 8 * g4) = o; } } }
    if (tid < 256) { float a = 0.f;
        for (int s = 0; s < 64; ++s) a += wl[s] * bf2f(*(LAS const unsigned short*)(lds + MA_K + s * PK + tid * 2));
        ((float*)(ws + WS_DN))[(size_t)(u * 4 + h) * 256 + tid] = a; }
    __syncthreads();
}
__device__ __forceinline__ void mlstm_phaseB(ArgsP A, LAS unsigned char* lds, int tid, int wave, int lane) {
    unsigned char* ws = A->ws; const float* SC = (const float*)(ws + WS_SCAL); float* MPREV = (float*)(ws + WS_SCAL) + 1280;
    const bf16* DC = (const bf16*)(ws + WS_DC); bf16* CP = (bf16*)(ws + WS_CPREV); const float* DN = (const float*)(ws + WS_DN); float* NP = (float*)(ws + WS_NPREV);
    const int gid = blockIdx.x * NT + tid, gsz = gridDim.x * NT;
    LAS float* AL = (LAS float*)lds; LAS float* BE = AL + 512;
    if (wave < 4) { const int h = wave; const float g0 = SC[lane * 4 + h], g1 = SC[(64 + lane) * 4 + h], l0 = SC[640 + lane * 4 + h], l1 = SC[640 + (64 + lane) * 4 + h];
        float m = 0.f;
        for (int c = 0; c < 128; ++c) { const float G = lane_get((c < 64) ? g0 : g1, c & 63), ml = lane_get((c < 64) ? l0 : l1, c & 63);
            const float mn = fmaxf(G + m, ml);
            if (lane == 0) { AL[h * 128 + c] = __expf(G + m - mn); BE[h * 128 + c] = __expf(ml - mn); if (blockIdx.x == 0) MPREV[c * 4 + h] = m; }
            m = mn; }
        if (blockIdx.x == 0 && lane == 0) A->out[O_MPO + h] = m; }
    __syncthreads();
    for (int idx = gid; idx < 4 * 32768; idx += gsz) { const int h = idx >> 15, el = (idx & 32767) * 2;
        float c0 = 0.f, c1 = 0.f;
        for (int cb = 0; cb < 128; cb += 32) { unsigned d[32];
#pragma unroll
            for (int j = 0; j < 32; ++j) d[j] = *(const unsigned*)(DC + ((size_t)((cb + j) * 4 + h) << 16) + el);
#pragma unroll
            for (int j = 0; j < 32; ++j) { const int c = cb + j; const float al = AL[h * 128 + c], be = BE[h * 128 + c];
                *(unsigned*)(CP + ((size_t)(c * 4 + h) << 16) + el) = pk2(c0, c1);
                c0 = al * c0 + be * __uint_as_float(d[j] << 16); c1 = al * c1 + be * __uint_as_float(d[j] & 0xffff0000u); } }
        *(f32x2_t*)(A->out + O_CP + ((size_t)h << 16) + el) = (f32x2_t){c0, c1}; }
    for (int idx = gid; idx < 4 * 256; idx += gsz) { const int h = idx >> 8, d = idx & 255; float n = 0.f;
        for (int cb = 0; cb < 128; cb += 32) { float dn[32];
#pragma unroll
            for (int j = 0; j < 32; ++j) dn[j] = DN[(size_t)((cb + j) * 4 + h) * 256 + d];
#pragma unroll
            for (int j = 0; j < 32; ++j) { const int c = cb + j; NP[(size_t)(c * 4 + h) * 256 + d] = n; n = AL[h * 128 + c] * n + BE[h * 128 + c] * dn[j]; } }
        A->out[O_NP + h * 256 + d] = n; }
    const float* C0 = A->in[5]; const float* N0 = A->in[6]; const float* M0 = A->in[7];
    for (int i0 = gid; i0 < 128 * 32768; i0 += 8 * gsz) {
        f32x2_t c[8]; unsigned d[8]; float m[8], G[8], ml[8];
#pragma unroll
        for (int k = 0; k < 8; ++k) { const int idx = i0 + k * gsz; if (idx < 128 * 32768) { const int bh = idx >> 15, el = (idx & 32767) * 2, ui = (128 + (bh >> 2)) * 4 + (bh & 3);
            m[k] = M0[bh]; G[k] = SC[ui]; ml[k] = SC[640 + ui]; c[k] = *(const f32x2_t*)(C0 + ((size_t)bh << 16) + el); d[k] = *(const unsigned*)(DC + ((size_t)ui << 16) + el); } }
#pragma unroll
        for (int k = 0; k < 8; ++k) { const int idx = i0 + k * gsz; if (idx < 128 * 32768) { const int bh = idx >> 15, el = (idx & 32767) * 2, ui = (128 + (bh >> 2)) * 4 + (bh & 3);
            const float mn = fmaxf(G[k] + m[k], ml[k]); const float al = __expf(G[k] + m[k] - mn), be = __expf(ml[k] - mn);
            *(unsigned*)(CP + ((size_t)ui << 16) + el) = pk2(c[k].x, c[k].y);
            *(f32x2_t*)(A->out + O_CS + ((size_t)bh << 16) + el) = (f32x2_t){al * c[k].x + be * __uint_as_float(d[k] << 16), al * c[k].y + be * __uint_as_float(d[k] & 0xffff0000u)};
            if (el == 0) { MPREV[ui] = m[k]; A->out[O_MSO + bh] = mn; } } } }
    for (int idx = gid; idx < 128 * 256; idx += gsz) { const int bh = idx >> 8, d = idx & 255, ui = (128 + (bh >> 2)) * 4 + (bh & 3);
        const float m = M0[bh], G = SC[ui], ml = SC[640 + ui]; const float mn = fmaxf(G + m, ml); const float al = __expf(G + m - mn), be = __expf(ml - mn);
        const float n = N0[idx]; NP[(size_t)ui * 256 + d] = n; A->out[O_NS + idx] = al * n + be * DN[(size_t)ui * 256 + d]; }
}
constexpr int MC_Q = 0, MC_K = 33792, MC_V = 67584, MC_S = 104448, MC_F = 113664;
constexpr int PQ = 528, PS = 144;
__device__ __forceinline__ void mlstm_phaseC(ArgsP A, LAS unsigned char* lds, int u, int h, int tid, int wave, int lane) {
    unsigned char* ws = A->ws; const bf16* PROJ = (const bf16*)(ws + WS_PROJ);
    const int L = (u < 128) ? 64 : 16, r0 = unit_row0(u), uh = u * 4 + h;
    LAS float* F = (LAS float*)(lds + MC_F);
    LAS float* rt = F, *gg = F + 64, *winter = F + 128, *eden = F + 192, *nq = F + 256, *denp = F + 320, *ssq = F + 448;
    const int i32 = lane & 31, hi = lane >> 5;
    LAS float* nl = F + 960;
    if (wave == 1) *(LAS f32x4*)(nl + 4 * lane) = *(const f32x4*)((const float*)(ws + WS_NPREV) + (size_t)uh * 256 + 4 * lane);
    if (wave == 0) {
        float ig, lf; load_gates(PROJ, A->in[21], A->in[22], u, h, lane, ig, lf);
        const float b = scan_add(lf, lane); const float g = (lane < L) ? ig - b : -INFINITY; const float cm = scan_max(g, lane);
        const float mprev = ((const float*)(ws + WS_SCAL))[1280 + uh]; const float mx = fmaxf(mprev, cm);
        rt[lane] = -mx; gg[lane] = g; winter[lane] = __expf(mprev - mx); eden[lane] = __expf(-(b + mx));
    }
    { const int c8 = 8 * (tid & 31), s0 = 4 * (tid >> 5);
      u32x4 qo[4], ko[4], vo[4];
      conv_rows4(PROJ, A->in[4], A->in[19], A->in[20], u, L, s0, h * 256 + c8, 1.f, qo);
      conv_rows4(PROJ, A->in[4], A->in[19], A->in[20], u, L, s0, 1024 + h * 256 + c8, 0.0625f, ko);
#pragma unroll
      for (int r = 0; r < 4; ++r) { vo[r] = (u32x4){0u, 0u, 0u, 0u}; if (s0 + r < L) vo[r] = *(const u32x4*)(PROJ + (size_t)(r0 + s0 + r) * NINP + C_VM + h * 256 + c8); }
#pragma unroll
      for (int r = 0; r < 4; ++r) { *(LAS u32x4*)(lds + MC_Q + (s0 + r) * PQ + c8 * 2) = qo[r]; *(LAS u32x4*)(lds + MC_K + (s0 + r) * PQ + c8 * 2) = ko[r]; *(LAS u32x4*)(lds + MC_V + (s0 + r) * PK + c8 * 2) = vo[r]; } }
    bf16x8 ca[16];
    { const bf16* Cp = (const bf16*)(ws + WS_CPREV) + ((size_t)uh * 256 + 32 * wave + i32) * 256 + 8 * hi;
#pragma unroll
      for (int kk = 0; kk < 16; ++kk) ca[kk] = *(const bf16x8*)(Cp + 16 * kk); }
    __syncthreads();
    if (wave < 3) {
        const int tt = (wave > 0) ? 1 : 0, st = (wave == 2) ? 1 : 0;
        f32x16 acc = {};
#pragma unroll 4
        for (int kk = 0; kk < 16; ++kk) { const bf16x8 a = *(LAS const bf16x8*)(lds + MC_K + (32 * st + i32) * PQ + (16 * kk + 8 * hi) * 2), b = *(LAS const bf16x8*)(lds + MC_Q + (32 * tt + i32) * PQ + (16 * kk + 8 * hi) * 2);
            acc = __builtin_amdgcn_mfma_f32_32x32x16_bf16(a, b, acc, 0, 0, 0); }
        const int t = 32 * tt + i32; const float rtt = rt[t]; float rs = 0.f;
#pragma unroll
        for (int g4 = 0; g4 < 4; ++g4) { const int s0 = 32 * st + 8 * g4 + 4 * hi; float v[4];
#pragma unroll
            for (int j = 0; j < 4; ++j) { const int s = s0 + j; const float e = __expf(rtt + gg[s]) * acc[4 * g4 + j]; v[j] = (s <= t) ? e : 0.f; rs += v[j]; }
            u32x2 o; o.x = pk2(v[0], v[1]); o.y = pk2(v[2], v[3]); *(LAS u32x2*)(lds + MC_S + t * PS + s0 * 2) = o; }
        rs = xhalf_sum(rs);
        if (hi == 0) { denp[st * 64 + t] = rs; if (wave == 0) denp[64 + t] = 0.f; }
    } else if (wave == 3) {
        const LAS float* np = nl + 8 * hi;
#pragma unroll
        for (int tt = 0; tt < 2; ++tt) { f32x16 acc = {};
#pragma unroll 4
            for (int kk = 0; kk < 16; ++kk) { u32x4 aw = {0u, 0u, 0u, 0u};
                if (i32 == 0) { const f32x4 n0 = *(const LAS f32x4*)(np + 16 * kk), n1 = *(const LAS f32x4*)(np + 16 * kk + 4); aw.x = pk2(n0[0], n0[1]); aw.y = pk2(n0[2], n0[3]); aw.z = pk2(n1[0], n1[1]); aw.w = pk2(n1[2], n1[3]); }
                const bf16x8 b = *(LAS const bf16x8*)(lds + MC_Q + (32 * tt + i32) * PQ + (16 * kk + 8 * hi) * 2);
                acc = __builtin_amdgcn_mfma_f32_32x32x16_bf16(__builtin_bit_cast(bf16x8, aw), b, acc, 0, 0, 0); }
            if (hi == 0) nq[32 * tt + i32] = acc[0]; }
    }
    __syncthreads();
    const int eb = wave, ntt = (L > 32) ? 2 : 1;
    u32x2 ovp[2][4]; f32x4 gmp[4];
#pragma unroll
    for (int g4 = 0; g4 < 4; ++g4) { const int e = 32 * eb + 8 * g4 + 4 * hi; gmp[g4] = *(const f32x4*)(A->in[23] + h * 256 + e);
#pragma unroll
        for (int tt = 0; tt < 2; ++tt) { const int t = 32 * tt + i32; ovp[tt][g4] = (u32x2){0u, 0u};
            if (t < L) ovp[tt][g4] = *(const u32x2*)(PROJ + (size_t)(r0 + t) * NINP + C_OM + h * 256 + e); } }
    bf16x8 va[4];
#pragma unroll
    for (int ks = 0; ks < 4; ++ks) { const int o = tr_off(PK, 16 * ks + 8 * hi, 32 * eb, lane); va[ks] = mk8(tr_rd(lds + MC_V + o), tr_rd(lds + MC_V + o + 4 * PK)); }
    f32x16 hv[2];
#pragma unroll
    for (int tt = 0; tt < 2; ++tt) { f32x16 acc = {};
        if (tt < ntt) { const int t = 32 * tt + i32;
#pragma unroll
            for (int kk = 0; kk < 16; ++kk) { const bf16x8 b = *(LAS const bf16x8*)(lds + MC_Q + t * PQ + (16 * kk + 8 * hi) * 2);
                acc = __builtin_amdgcn_mfma_f32_32x32x16_bf16(ca[kk], b, acc, 0, 0, 0); }
            const float wi = winter[t];
#pragma unroll
            for (int r = 0; r < 16; ++r) acc[r] *= wi;
#pragma unroll
            for (int ks = 0; ks < 4; ++ks) if (ks < 2 * (tt + 1)) { const bf16x8 b = *(LAS const bf16x8*)(lds + MC_S + t * PS + (16 * ks + 8 * hi) * 2);
                acc = __builtin_amdgcn_mfma_f32_32x32x16_bf16(va[ks], b, acc, 0, 0, 0); }
            const float den = wi * nq[t] + denp[t] + denp[64 + t]; const float inv = 1.f / fmaxf(fabsf(den), eden[t]); float sq = 0.f;
#pragma unroll
            for (int r = 0; r < 16; ++r) { acc[r] *= inv; sq += acc[r] * acc[r]; }
            sq = xhalf_sum(sq); if (hi == 0) ssq[wave * 64 + t] = sq; }
        hv[tt] = acc; }
    __syncthreads();
    bf16* MIX = (bf16*)(ws + WS_MIX);
#pragma unroll
    for (int tt = 0; tt < 2; ++tt) if (tt < ntt) { const int t = 32 * tt + i32;
        if (t < L) { float tot = 0.f;
#pragma unroll
            for (int w = 0; w < 8; ++w) tot += ssq[w * 64 + t];
            const float rstd = 1.f / sqrtf(tot * (1.f / 256.f) + EPS); const size_t row = (size_t)(r0 + t);
#pragma unroll
            for (int g4 = 0; g4 < 4; ++g4) { const int e = 32 * eb + 8 * g4 + 4 * hi; const f32x4 g = gmp[g4];
                const u32x2 ov = ovp[tt][g4];
                const float o0 = sigmoid_f(__uint_as_float(ov.x << 16)), o1 = sigmoid_f(__uint_as_float(ov.x & 0xffff0000u)), o2 = sigmoid_f(__uint_as_float(ov.y << 16)), o3 = sigmoid_f(__uint_as_float(ov.y & 0xffff0000u));
                u32x2 w; w.x = pk2(hv[tt][4 * g4] * rstd * g[0] * o0, hv[tt][4 * g4 + 1] * rstd * g[1] * o1); w.y = pk2(hv[tt][4 * g4 + 2] * rstd * g[2] * o2, hv[tt][4 * g4 + 3] * rstd * g[3] * o3);
                *(u32x2*)(MIX + row * DM + 1024 + h * 256 + e) = w; } } }
    __syncthreads();
}
constexpr int AT_PKT = 272, AT_PVT = 320, AT_V = 17408, AT_BUF = 37888;
struct AttnState { f32x16 o[4]; bf16x8 pf[4]; float m, l; };
__device__ __forceinline__ float xhalf_max(float v) { auto rr = __builtin_amdgcn_permlane32_swap(__float_as_uint(v), __float_as_uint(v), false, false); return fmaxf(__uint_as_float(rr[0]), __uint_as_float(rr[1])); }
constexpr float ATT_THR = 6.0f;
__device__ __forceinline__ void attn_qk(LAS const unsigned char* kt, int map, const bf16x8 (&qf)[4], const AttnState& S, f32x16 (&p)[2], int lane) {
    const int i32 = lane & 31, hi = lane >> 5;
#pragma unroll
    for (int kb = 0; kb < 2; ++kb) { f32x16 acc = {};
#pragma unroll
        for (int d0 = 0; d0 < 4; ++d0) { const bf16x8 a = *(LAS const bf16x8*)(kt + (32 * kb + i32) * AT_PKT + (64 * map + 16 * d0 + 8 * hi) * 2);
            acc = __builtin_amdgcn_mfma_f32_32x32x16_bf16(a, qf[d0], acc, 0, 0, 0); }
        p[kb] = acc; }
}
__device__ __forceinline__ void attn_pv(LAS const unsigned char* vt, AttnState& S, int lane) {
    const int hi = lane >> 5;
    LAS const unsigned char* base = vt + tr_off(AT_PVT, 4 * hi, 0, lane);
#pragma unroll
    for (int st = 0; st < 4; ++st) { s16x4 lo[4], hh[4];
#pragma unroll
        for (int eb = 0; eb < 4; ++eb) { lo[eb] = tr_rd(base + st * 16 * AT_PVT + eb * 64); hh[eb] = tr_rd(base + st * 16 * AT_PVT + eb * 64 + 8 * AT_PVT); }
#pragma unroll
        for (int eb = 0; eb < 4; ++eb) S.o[eb] = __builtin_amdgcn_mfma_f32_32x32x16_bf16(mk8(lo[eb], hh[eb]), S.pf[st], S.o[eb], 0, 0, 0);
    }
}
__device__ __forceinline__ void attn_softmax(f32x16 (&p)[2], AttnState& S, int nvalid, int lane) {
    const int hi = lane >> 5;
    if (nvalid < 64) {
#pragma unroll
        for (int kb = 0; kb < 2; ++kb)
#pragma unroll
            for (int r = 0; r < 16; ++r) if (32 * kb + crow(r, hi) >= nvalid) p[kb][r] = -INFINITY; }
    float ma = fmaxf(fmaxf(p[0][0], p[0][1]), p[1][0]), mb = fmaxf(fmaxf(p[0][2], p[0][3]), p[1][1]);
    ma = fmaxf(fmaxf(ma, p[1][2]), p[1][3]);
#pragma unroll
    for (int r = 4; r < 16; r += 4) { ma = fmaxf(fmaxf(ma, p[0][r]), p[0][r + 1]); mb = fmaxf(fmaxf(mb, p[0][r + 2]), p[0][r + 3]); ma = fmaxf(fmaxf(ma, p[1][r]), p[1][r + 1]); mb = fmaxf(fmaxf(mb, p[1][r + 2]), p[1][r + 3]); }
    const float mref = S.m; const float mx = xhalf_max(fmaxf(ma, mb)) - mref;
#pragma unroll
    for (int kb = 0; kb < 2; ++kb)
#pragma unroll
        for (int r = 0; r < 16; ++r) p[kb][r] = __builtin_amdgcn_exp2f(p[kb][r] - mref);
    if (__any(mx > ATT_THR)) {
        const float dl = fmaxf(mx, 0.f); S.m += dl;
        const float f = __builtin_amdgcn_exp2f(-dl); S.l *= f;
#pragma unroll
        for (int kb = 0; kb < 2; ++kb)
#pragma unroll
            for (int r = 0; r < 16; ++r) p[kb][r] *= f;
#pragma unroll
        for (int eb = 0; eb < 4; ++eb)
#pragma unroll
            for (int r = 0; r < 16; ++r) S.o[eb][r] *= f;
    }
    float sa = 0.f, sb = 0.f;
#pragma unroll
    for (int kb = 0; kb < 2; ++kb)
#pragma unroll
        for (int r = 0; r < 16; r += 2) { sa += p[kb][r]; sb += p[kb][r + 1]; }
    S.l += sa + sb;
#pragma unroll
    for (int kb = 0; kb < 2; ++kb)
#pragma unroll
        for (int ks = 0; ks < 2; ++ks) { u32x4 pw; pw.x = pk2(p[kb][8 * ks], p[kb][8 * ks + 1]); pw.y = pk2(p[kb][8 * ks + 2], p[kb][8 * ks + 3]); pw.z = pk2(p[kb][8 * ks + 4], p[kb][8 * ks + 5]); pw.w = pk2(p[kb][8 * ks + 6], p[kb][8 * ks + 7]);
            S.pf[2 * kb + ks] = __builtin_bit_cast(bf16x8, pw); }
}
__device__ __forceinline__ void attn_step(LAS const unsigned char* ktn, LAS const unsigned char* vtc, int map, const bf16x8 (&qf)[4], AttnState& S, int lane) {
    const int i32 = lane & 31, hi = lane >> 5;
    f32x16 p[2];
    LAS const unsigned char* base = vtc + tr_off(AT_PVT, 4 * hi, 0, lane);
    s16x4 lo[2][4], hh[2][4];
#pragma unroll
    for (int eb = 0; eb < 4; ++eb) { lo[0][eb] = tr_rd(base + eb * 64); hh[0][eb] = tr_rd(base + eb * 64 + 8 * AT_PVT); }
#pragma unroll
    for (int kb = 0; kb < 2; ++kb) { f32x16 acc = {};
#pragma unroll
        for (int d0 = 0; d0 < 4; ++d0) { const bf16x8 a = *(LAS const bf16x8*)(ktn + (32 * kb + i32) * AT_PKT + (64 * map + 16 * d0 + 8 * hi) * 2);
            acc = __builtin_amdgcn_mfma_f32_32x32x16_bf16(a, qf[d0], acc, 0, 0, 0); }
        p[kb] = acc; }
    const float mref = S.m;
    __builtin_amdgcn_sched_barrier(0);
#pragma unroll
    for (int st = 0; st < 4; ++st) {
        if (st < 3) {
#pragma unroll
            for (int eb = 0; eb < 4; ++eb) { lo[(st + 1) & 1][eb] = tr_rd(base + (st + 1) * 16 * AT_PVT + eb * 64); hh[(st + 1) & 1][eb] = tr_rd(base + (st + 1) * 16 * AT_PVT + eb * 64 + 8 * AT_PVT); } }
        __builtin_amdgcn_sched_barrier(0);
#pragma unroll
        for (int eb = 0; eb < 4; ++eb) {
            S.o[eb] = __builtin_amdgcn_mfma_f32_32x32x16_bf16(mk8(lo[st & 1][eb], hh[st & 1][eb]), S.pf[st], S.o[eb], 0, 0, 0);
            const int e0 = 2 * (4 * st + eb);
            p[e0 >> 4][e0 & 15] = __builtin_amdgcn_exp2f(p[e0 >> 4][e0 & 15] - mref); p[e0 >> 4][(e0 & 15) + 1] = __builtin_amdgcn_exp2f(p[e0 >> 4][(e0 & 15) + 1] - mref);
            __builtin_amdgcn_sched_barrier(0);
        }
    }
    float ma = fmaxf(fmaxf(p[0][0], p[0][1]), p[1][0]), mb = fmaxf(fmaxf(p[0][2], p[0][3]), p[1][1]);
    ma = fmaxf(fmaxf(ma, p[1][2]), p[1][3]);
#pragma unroll
    for (int r = 4; r < 16; r += 4) { ma = fmaxf(fmaxf(ma, p[0][r]), p[0][r + 1]); mb = fmaxf(fmaxf(mb, p[0][r + 2]), p[0][r + 3]); ma = fmaxf(fmaxf(ma, p[1][r]), p[1][r + 1]); mb = fmaxf(fmaxf(mb, p[1][r + 2]), p[1][r + 3]); }
    const float emx = xhalf_max(fmaxf(ma, mb));
    if (__any(emx > 64.0f)) {
        const float dl = fmaxf(__builtin_amdgcn_logf(emx), 0.f);
        S.m += dl;
        const float f = __builtin_amdgcn_exp2f(-dl); S.l *= f;
#pragma unroll
        for (int kb = 0; kb < 2; ++kb)
#pragma unroll
            for (int r = 0; r < 16; ++r) p[kb][r] *= f;
#pragma unroll
        for (int eb = 0; eb < 4; ++eb)
#pragma unroll
            for (int r = 0; r < 16; ++r) S.o[eb][r] *= f;
    }
    float sa = 0.f, sb = 0.f;
#pragma unroll
    for (int kb = 0; kb < 2; ++kb)
#pragma unroll
        for (int r = 0; r < 16; r += 2) { sa += p[kb][r]; sb += p[kb][r + 1]; }
    S.l += sa + sb;
#pragma unroll
    for (int kb = 0; kb < 2; ++kb)
#pragma unroll
        for (int ks = 0; ks < 2; ++ks) { u32x4 pw; pw.x = pk2(p[kb][8 * ks], p[kb][8 * ks + 1]); pw.y = pk2(p[kb][8 * ks + 2], p[kb][8 * ks + 3]); pw.z = pk2(p[kb][8 * ks + 4], p[kb][8 * ks + 5]); pw.w = pk2(p[kb][8 * ks + 6], p[kb][8 * ks + 7]);
            S.pf[2 * kb + ks] = __builtin_bit_cast(bf16x8, pw); }
}
__device__ __forceinline__ void attn_tile(LAS const unsigned char* kt, LAS const unsigned char* vt, int map, const bf16x8 (&qf)[4], AttnState& S, int nvalid, int lane) {
    f32x16 p[2]; attn_qk(kt, map, qf, S, p, lane); attn_softmax(p, S, nvalid, lane); attn_pv(vt, S, lane);
}
__device__ __forceinline__ void attn_finish(ArgsP A, LAS unsigned char* lds, AttnState& S, int map, int g, int h, size_t row_base, int nrows, float lam, int lane) {
    const int i32 = lane & 31, hi = lane >> 5;
    const float lt = xhalf_sum(S.l); const float inv = 1.f / lt;
    LAS float* X = (LAS float*)lds + g * 4096;
    __syncthreads();
    if (map == 1) {
#pragma unroll
        for (int eb = 0; eb < 4; ++eb)
#pragma unroll
            for (int r = 0; r < 16; ++r) X[(32 * eb + crow(r, hi)) * 32 + i32] = S.o[eb][r] * inv; }
    __syncthreads();
    if (map == 0) { float sq = 0.f;
#pragma unroll
        for (int eb = 0; eb < 4; ++eb)
#pragma unroll
            for (int r = 0; r < 16; ++r) { const float v = S.o[eb][r] * inv - lam * X[(32 * eb + crow(r, hi)) * 32 + i32]; S.o[eb][r] = v; sq += v * v; }
        sq = xhalf_sum(sq);
        const float rstd = (1.f - LAM_INIT) / sqrtf(sq * (1.f / 128.f) + EPS);
        if (i32 < nrows) { bf16* mp = (bf16*)(A->ws + WS_MIX) + (row_base + i32) * DM + h * 128; const float* gs = A->in[18] + h * 128;
#pragma unroll
            for (int eb = 0; eb < 4; ++eb)
#pragma unroll
                for (int g4 = 0; g4 < 4; ++g4) { const int e = 32 * eb + 8 * g4 + 4 * hi; const f32x4 gv = *(const f32x4*)(gs + e);
                    u32x2 w; w.x = pk2(S.o[eb][4 * g4] * rstd * gv[0], S.o[eb][4 * g4 + 1] * rstd * gv[1]); w.y = pk2(S.o[eb][4 * g4 + 2] * rstd * gv[2], S.o[eb][4 * g4 + 3] * rstd * gv[3]);
                    *(u32x2*)(mp + e) = w; } } }
    __syncthreads();
}
__device__ __forceinline__ void attn_prompt_unit(ArgsP A, LAS unsigned char* lds, int h, int qb, float lam, int tid, int wave, int lane) {
    unsigned char* ws = A->ws; const bf16* QA = (const bf16*)(ws + WS_QA); const bf16* KA = (const bf16*)(ws + WS_KA); const bf16* PROJ = (const bf16*)(ws + WS_PROJ);
    const int map = wave & 1, g = wave >> 1, i32 = lane & 31, hi = lane >> 5;
    const int ntiles = 2 * qb + 2, mytiles = 2 * qb + (g >> 1) + 1;
    bf16x8 qf[4];
    { const bf16* qp = QA + (size_t)(128 * qb + 32 * g + i32) * 1024 + h * 128 + 64 * map + 8 * hi;
#pragma unroll
      for (int d0 = 0; d0 < 4; ++d0) qf[d0] = *(const bf16x8*)(qp + 16 * d0); }
    AttnState S; S.m = 0.f; S.l = 0.f;
#pragma unroll
    for (int i = 0; i < 4; ++i) S.pf[i] = (bf16x8){0, 0, 0, 0, 0, 0, 0, 0};
#pragma unroll
    for (int eb = 0; eb < 4; ++eb) S.o[eb] = (f32x16){};
    const int key = tid >> 3, seg = tid & 7;
    const bf16* kp = KA + (size_t)key * 1024 + h * 128 + 16 * seg; const bf16* vp = PROJ + (size_t)key * NINP + C_VA + h * 128 + 16 * seg;
    const int ko = key * AT_PKT + seg * 32, vo = AT_V + key * AT_PVT + seg * 32;
    { u32x4 k0 = *(const u32x4*)kp, k1 = *(const u32x4*)(kp + 8), v0 = *(const u32x4*)vp, v1 = *(const u32x4*)(vp + 8);
      const bf16* kq = kp + (size_t)64 * 1024; const bf16* vq = vp + (size_t)64 * NINP;
      u32x4 k2 = *(const u32x4*)kq, k3 = *(const u32x4*)(kq + 8), v2 = *(const u32x4*)vq, v3 = *(const u32x4*)(vq + 8);
      *(LAS u32x4*)(lds + ko) = k0; *(LAS u32x4*)(lds + ko + 16) = k1; *(LAS u32x4*)(lds + vo) = v0; *(LAS u32x4*)(lds + vo + 16) = v1;
      *(LAS u32x4*)(lds + AT_BUF + ko) = k2; *(LAS u32x4*)(lds + AT_BUF + ko + 16) = k3; *(LAS u32x4*)(lds + AT_BUF + vo) = v2; *(LAS u32x4*)(lds + AT_BUF + vo + 16) = v3; }
    __syncthreads();
    { f32x16 p[2]; attn_qk(lds, map, qf, S, p, lane); attn_softmax(p, S, 64, lane); }
    int bc = 0, bn = AT_BUF, bw = 2 * AT_BUF;
    for (int j = 0; j < ntiles; ++j) {
        const bool more = (j + 2 < ntiles);
        u32x4 k0, k1, v0, v1;
        if (more) { const bf16* kq = kp + (size_t)(j + 2) * 64 * 1024; const bf16* vq = vp + (size_t)(j + 2) * 64 * NINP;
            k0 = *(const u32x4*)kq; k1 = *(const u32x4*)(kq + 8); v0 = *(const u32x4*)vq; v1 = *(const u32x4*)(vq + 8); }
        if (j + 1 < mytiles) attn_step(lds + bn, lds + bc + AT_V, map, qf, S, lane);
        else if (j < mytiles) attn_pv(lds + bc + AT_V, S, lane);
        if (more) { LAS unsigned char* w = lds + bw; *(LAS u32x4*)(w + ko) = k0; *(LAS u32x4*)(w + ko + 16) = k1; *(LAS u32x4*)(w + vo) = v0; *(LAS u32x4*)(w + vo + 16) = v1; }
        __syncthreads();
        const int t = bc; bc = bn; bn = bw; bw = t;
    }
    attn_finish(A, lds, S, map, g, h, (size_t)(128 * qb + 32 * g), 32, lam, lane);
}
__device__ __forceinline__ void attn_sample_unit(ArgsP A, LAS unsigned char* lds, int b, int h, float lam, int tid, int wave, int lane) {
    unsigned char* ws = A->ws; const bf16* QA = (const bf16*)(ws + WS_QA); const bf16* KA = (const bf16*)(ws + WS_KA); const bf16* PROJ = (const bf16*)(ws + WS_PROJ);
    const int map = wave & 1, i32 = lane & 31, hi = lane >> 5; const bool comp = wave < 2;
    bf16x8 qf[4];
#pragma unroll
    for (int d0 = 0; d0 < 4; ++d0) qf[d0] = (bf16x8){0, 0, 0, 0, 0, 0, 0, 0};
    if (i32 < 16) { const bf16* qp = QA + (size_t)(MP + 16 * b + i32) * 1024 + h * 128 + 64 * map + 8 * hi;
#pragma unroll
      for (int d0 = 0; d0 < 4; ++d0) qf[d0] = *(const bf16x8*)(qp + 16 * d0); }
    AttnState S; S.m = 0.f; S.l = 0.f;
#pragma unroll
    for (int i = 0; i < 4; ++i) S.pf[i] = (bf16x8){0, 0, 0, 0, 0, 0, 0, 0};
#pragma unroll
    for (int eb = 0; eb < 4; ++eb) S.o[eb] = (f32x16){};
    const int key = tid >> 3, seg = tid & 7;
    const float* kc = A->in[2] + (((size_t)b * PAST + key) * 8 + h) * 128 + 16 * seg; const float* vc = A->in[3] + (((size_t)b * PAST + key) * 8 + h) * 128 + 16 * seg;
    const int ko = key * AT_PKT + seg * 32, vo = AT_V + key * AT_PVT + seg * 32;
    f32x4 kr[4], vr[4];
#pragma unroll
    for (int i = 0; i < 4; ++i) { kr[i] = *(const f32x4*)(kc + 4 * i); vr[i] = *(const f32x4*)(vc + 4 * i); }
    for (int j = 0; j < 17; ++j) {
        LAS unsigned char* nb = lds + (j & 1) * AT_BUF;
        if (j < 16) { u32x4 a, c;
            a.x = pk2(kr[0][0], kr[0][1]); a.y = pk2(kr[0][2], kr[0][3]); a.z = pk2(kr[1][0], kr[1][1]); a.w = pk2(kr[1][2], kr[1][3]);
            c.x = pk2(kr[2][0], kr[2][1]); c.y = pk2(kr[2][2], kr[2][3]); c.z = pk2(kr[3][0], kr[3][1]); c.w = pk2(kr[3][2], kr[3][3]);
            *(LAS u32x4*)(nb + ko) = a; *(LAS u32x4*)(nb + ko + 16) = c;
            a.x = pk2(vr[0][0], vr[0][1]); a.y = pk2(vr[0][2], vr[0][3]); a.z = pk2(vr[1][0], vr[1][1]); a.w = pk2(vr[1][2], vr[1][3]);
            c.x = pk2(vr[2][0], vr[2][1]); c.y = pk2(vr[2][2], vr[2][3]); c.z = pk2(vr[3][0], vr[3][1]); c.w = pk2(vr[3][2], vr[3][3]);
            *(LAS u32x4*)(nb + vo) = a; *(LAS u32x4*)(nb + vo + 16) = c;
        } else { u32x4 a = {0u, 0u, 0u, 0u}, c = a, d = a, e = a;
            if (key < 16) { const bf16* kq = KA + (size_t)(MP + 16 * b + key) * 1024 + h * 128 + 16 * seg; const bf16* vq = PROJ + (size_t)(MP + 16 * b + key) * NINP + C_VA + h * 128 + 16 * seg;
                a = *(const u32x4*)kq; c = *(const u32x4*)(kq + 8); d = *(const u32x4*)vq; e = *(const u32x4*)(vq + 8); }
            *(LAS u32x4*)(nb + ko) = a; *(LAS u32x4*)(nb + ko + 16) = c; *(LAS u32x4*)(nb + vo) = d; *(LAS u32x4*)(nb + vo + 16) = e; }
        if (j + 1 < 16) {
#pragma unroll
            for (int i = 0; i < 4; ++i) { kr[i] = *(const f32x4*)(kc + (size_t)(j + 1) * 64 * 1024 + 4 * i); vr[i] = *(const f32x4*)(vc + (size_t)(j + 1) * 64 * 1024 + 4 * i); } }
        __syncthreads();
        if (comp) attn_tile(nb, nb + AT_V, map, qf, S, (j < 16) ? 64 : 16, lane);
    }
    attn_finish(A, lds, S, comp ? map : 2, 0, h, (size_t)(MP + 16 * b), 16, lam, lane);
}
template <int NPART> __device__ __forceinline__ void final_norm_rows(float* y, const float* __restrict__ g, int wave, int lane, const float* x1S, const bf16* part, const float* gate) {
    const int gw = blockIdx.x * NW + wave, NGW = gridDim.x * NW;
    for (int r = gw; r < MTOK; r += NGW) { float* yr = y + (size_t)r * DM; f32x4 v[8]; float s = 0.f;
        if (r < MP) {
#pragma unroll
            for (int j = 0; j < 8; ++j) v[j] = *(const f32x4*)(yr + 256 * j + 4 * lane);
        } else {
            const float* gr = gate + (size_t)(1 + ((r - MP) >> 4)) * 12288;
#pragma unroll
            for (int j = 0; j < 8; ++j) { const int c = 256 * j + 4 * lane; f32x4 a = {0.f, 0.f, 0.f, 0.f};
                f32x4 t[NPART];
#pragma unroll
                for (int p = 0; p < NPART; ++p) t[p] = ld_bf4(part + ((size_t)p * MS + (r - MP)) * DM + c);
#pragma unroll
                for (int p = 0; p < NPART; ++p) a += t[p];
                v[j] = *(const f32x4*)(x1S + (size_t)(r - MP) * DM + c) + *(const f32x4*)(gr + c) * a; } }
#pragma unroll
        for (int j = 0; j < 8; ++j) s += (v[j].x * v[j].x + v[j].y * v[j].y) + (v[j].z * v[j].z + v[j].w * v[j].w);
        const float rstd = 1.f / sqrtf(wave_sum(s, lane) * (1.f / DM) + EPS);
#pragma unroll
        for (int j = 0; j < 8; ++j) { const f32x4 gg = *(const f32x4*)(g + 256 * j + 4 * lane); *(f32x4*)(yr + 256 * j + 4 * lane) = v[j] * rstd * gg; } }
}
__global__ void __launch_bounds__(NT, 2) fwd_megakernel(Args A_) {
    extern __shared__ __attribute__((aligned(16))) unsigned char lds_raw[];
    LAS unsigned char* lds = (LAS unsigned char*)lds_raw;
    cg::grid_group grid = cg::this_grid();
    int tid, lane, wave;
#define FRESH_TID() do { tid = threadIdx.x; asm volatile("" : "+v"(tid)); lane = tid & 63; wave = __builtin_amdgcn_readfirstlane(tid >> 6); } while (0)
    FRESH_TID();
    ArgsP A = FRESH_ARGS();
    unsigned char* ws = A->ws;
    float* mod = (float*)(ws + WS_MOD);
    const int G = gridDim.x, bid = blockIdx.x;
    A = FRESH_ARGS(); ws = A->ws; mod = (float*)(ws + WS_MOD); FRESH_TID();
    if (tid < 2) ((volatile LAS unsigned*)(lds + LDS_BYTES - 16))[tid] = 0u;
    __syncthreads();
    XcdBarrier xb = xcd_barrier_post((unsigned*)(ws + WS_FLAG) + 1024, (volatile LAS unsigned*)(lds + LDS_BYTES - 16));
    if (ws == nullptr) grid.sync();
#ifndef NO_P0
    p0_prologue(A, lds, tid, wave, lane);
#endif
    xcd_barrier(xb);
    A = FRESH_ARGS(); ws = A->ws; mod = (float*)(ws + WS_MOD); FRESH_TID();
    norm_mod_rows<0>(A->in[0], A->in[1], A->in[12], mod, 0, 2048, (bf16*)(ws + WS_XN), wave, lane);
    xcd_barrier(xb);
    A = FRESH_ARGS(); ws = A->ws; mod = (float*)(ws + WS_MOD); FRESH_TID();
    { pg8::Gemm g{(const pg8::bf16_t*)(ws + WS_XN), (const pg8::bf16_t*)(ws + WS_WIN), MTOK, NINP, DM, DM}; pg8::StaticOrder S; S.init(MTOK, NINP, G, bid);
      pg8::EpiStore<0> E{(pg8::bf16_t*)(ws + WS_PROJ), NINP};
      pg8::gemm_phase<pg8::EpiStore<0>, pg8::StaticOrder, true, true>(lds, g, S, E); }
    xcd_barrier(xb);
    A = FRESH_ARGS(); ws = A->ws; mod = (float*)(ws + WS_MOD); FRESH_TID();
#ifndef NO_P3
    p3_post(A, tid);
#endif
#ifndef NO_PA
    for (int i = bid; i < NCH * 4; i += G) mlstm_phaseA(A, lds, i >> 2, i & 3, tid, wave, lane);
#endif
    xcd_barrier(xb);
    A = FRESH_ARGS(); ws = A->ws; mod = (float*)(ws + WS_MOD); FRESH_TID();
#ifndef NO_PB
    mlstm_phaseB(A, lds, tid, wave, lane);
#endif
    xcd_barrier(xb);
    A = FRESH_ARGS(); ws = A->ws; mod = (float*)(ws + WS_MOD); FRESH_TID();
    { const float s1 = wave_sum(A->in[14][lane] * A->in[15][lane], lane), s2 = wave_sum(A->in[16][lane] * A->in[17][lane], lane);
      const float lam = __expf(s1) - __expf(s2) + LAM_INIT;
      for (int i = bid; i < 256; i += G) { const int h = i & 7, p = i >> 3;
#ifndef NO_AP
          attn_prompt_unit(A, lds, h, 63 - p, lam, tid, wave, lane);
          attn_prompt_unit(A, lds, h, p, lam, tid, wave, lane);
#endif
#ifndef NO_AS
          attn_sample_unit(A, lds, i >> 3, i & 7, lam, tid, wave, lane);
#endif
      }
      FRESH_TID();
#ifndef NO_PC
      for (int i = bid; i < NCH * 4; i += G) mlstm_phaseC(A, lds, i >> 2, i & 3, tid, wave, lane);
#endif
    }
    xcd_barrier(xb);
    A = FRESH_ARGS(); ws = A->ws; mod = (float*)(ws + WS_MOD); FRESH_TID();
    { pg8::Gemm g{(const pg8::bf16_t*)(ws + WS_MIX), (const pg8::bf16_t*)(ws + WS_WOUT), MP, DM, DM, DM}; pg8::StaticOrder S; S.init(MP, DM, G, bid);
      pg8::EpiResid E{A->in[0], A->in[1], mod + 4096, (float*)(ws + WS_X1)};
      pg8::gemm_phase<pg8::EpiResid, pg8::StaticOrder, true, true>(lds, g, S, E); }
    for (int un = bid; un < 128; un += G) { const int tile = un >> 3, kc = un & 7;
      pg8::Gemm g{(const pg8::bf16_t*)(ws + WS_MIX) + 256 * kc, (const pg8::bf16_t*)(ws + WS_WOUT) + 256 * kc, MTOK, DM, 256, DM}; pg8::OneUnit S{{32 + (tile >> 3), tile & 7}};
      pg8::EpiPart E{(pg8::bf16_t*)(ws + WS_PART6) + (size_t)kc * MS * DM, DM};
      pg8::gemm_phase<pg8::EpiPart, pg8::OneUnit, false, true>(lds, g, S, E); }
    xcd_barrier(xb);
    A = FRESH_ARGS(); ws = A->ws; mod = (float*)(ws + WS_MOD); FRESH_TID();
    norm_mod_rows<8>((const float*)(ws + WS_X1), A->in[1], A->in[25], mod, 6144, 8192, (bf16*)(ws + WS_XN), wave, lane, (const bf16*)(ws + WS_PART6), 4096, (float*)(ws + WS_X1) + (size_t)MP * DM);
    xcd_barrier(xb);
    A = FRESH_ARGS(); ws = A->ws; mod = (float*)(ws + WS_MOD); FRESH_TID();
    { pg8::Gemm g{(const pg8::bf16_t*)(ws + WS_XN), (const pg8::bf16_t*)(ws + WS_WUP), MP, DFF, DM, DM}; pg8::StaticOrder S; S.init(MP, DFF, G, bid);
      pg8::EpiStore<2> E{(pg8::bf16_t*)(ws + WS_H), DFF};
      pg8::gemm_phase<pg8::EpiStore<2>, pg8::StaticOrder, true, true>(lds, g, S, E); }
    for (int un = bid; un < 256; un += G) { const int tile = un >> 2, kq = un & 3;
      pg8::Gemm g{(const pg8::bf16_t*)(ws + WS_XN) + 512 * kq, (const pg8::bf16_t*)(ws + WS_WUP) + 512 * kq, MTOK, DFF, 512, DM}; pg8::OneUnit S{{32 + (tile >> 5), tile & 31}};
      pg8::EpiPart E{(pg8::bf16_t*)(ws + WS_PART8) + (size_t)kq * MS * DFF, DFF};
      pg8::gemm_phase<pg8::EpiPart, pg8::OneUnit, false, true>(lds, g, S, E); }
    xcd_barrier(xb);
    A = FRESH_ARGS(); ws = A->ws; mod = (float*)(ws + WS_MOD); FRESH_TID();
    { const bf16* P8 = (const bf16*)(ws + WS_PART8); bf16* H = (bf16*)(ws + WS_H);
      for (int r = bid; r < MS; r += G)
          for (int c = 4 * tid; c < DFF; c += 4 * NT) { f32x4 a = ld_bf4(P8 + (size_t)r * DFF + c);
#pragma unroll
              for (int p = 1; p < 4; ++p) a += ld_bf4(P8 + ((size_t)p * MS + r) * DFF + c);
              a.x = fmaxf(a.x, 0.f); a.y = fmaxf(a.y, 0.f); a.z = fmaxf(a.z, 0.f); a.w = fmaxf(a.w, 0.f);
              u32x2 o; o.x = pk2(a.x * a.x, a.y * a.y); o.y = pk2(a.z * a.z, a.w * a.w); *(u32x2*)(H + (size_t)(MP + r) * DFF + c) = o; }
      __threadfence(); __syncthreads();
      if (tid == 0) __hip_atomic_fetch_add((unsigned*)(ws + WS_FLAG), 1u, __ATOMIC_RELEASE, __HIP_MEMORY_SCOPE_AGENT); }
    { pg8::Gemm g{(const pg8::bf16_t*)(ws + WS_H), (const pg8::bf16_t*)(ws + WS_WDN), MP, DM, DFF, DFF}; pg8::StaticOrder S; S.init(MP, DM, G, bid);
      pg8::EpiResid E{(const float*)(ws + WS_X1), (const float*)(ws + WS_X1) + (size_t)MP * DM, mod + 10240, A->out};
      pg8::gemm_phase<pg8::EpiResid, pg8::StaticOrder, true, true>(lds, g, S, E); }
    { if (tid == 0) { while (__hip_atomic_load((unsigned*)(ws + WS_FLAG), __ATOMIC_ACQUIRE, __HIP_MEMORY_SCOPE_AGENT) < (unsigned)G) __builtin_amdgcn_s_sleep(8); }
      __syncthreads(); __builtin_amdgcn_fence(__ATOMIC_ACQUIRE, "agent"); }
    for (int un = bid; un < 256; un += G) { const int tile = un >> 4, kc = un & 15;
      pg8::Gemm g{(const pg8::bf16_t*)(ws + WS_H) + 512 * kc, (const pg8::bf16_t*)(ws + WS_WDN) + 512 * kc, MTOK, DM, 512, DFF}; pg8::OneUnit S{{32 + (tile >> 3), tile & 7}};
      pg8::EpiPart E{(pg8::bf16_t*)(ws + WS_PART9) + (size_t)kc * MS * DM, DM};
      pg8::gemm_phase<pg8::EpiPart, pg8::OneUnit, false, true>(lds, g, S, E); }
    xcd_barrier(xb);
    A = FRESH_ARGS(); ws = A->ws; mod = (float*)(ws + WS_MOD); FRESH_TID();
    final_norm_rows<16>(A->out, A->in[28], wave, lane, (const float*)(ws + WS_X1) + (size_t)MP * DM, (const bf16*)(ws + WS_PART9), mod + 10240);
}

extern "C" void kernel_launch(void* const* d_in, const int* in_sizes, int n_in, void* d_out, int out_size, void* d_ws, size_t ws_size, hipStream_t stream) {
    static int grid = 0;
    if (grid == 0) {
        if (n_in != 29 || ws_size < WS_END) { fprintf(stderr, "kernel_launch: unexpected n_in %d / ws %zu\n", n_in, ws_size); grid = -1; return; }
        int dev = 0, cus = 0, per_cu = 0;
        (void)hipGetDevice(&dev); (void)hipDeviceGetAttribute(&cus, hipDeviceAttributeMultiprocessorCount, dev);
        (void)hipFuncSetAttribute((const void*)fwd_megakernel, hipFuncAttributeMaxDynamicSharedMemorySize, LDS_BYTES);
        (void)hipOccupancyMaxActiveBlocksPerMultiprocessor(&per_cu, (const void*)fwd_megakernel, NT, LDS_BYTES);
        (void)hipGetLastError();
        grid = cus;
    }
    if (grid < 0) return;
    (void)hipMemsetAsync((char*)d_ws + WS_FLAG, 0, 32768, stream);
    Args a{};
    for (int i = 0; i < 29; ++i) a.in[i] = (const float*)d_in[i];
    a.out = (float*)d_out; a.ws = (unsigned char*)d_ws;
    void* args[] = {&a};
    hipError_t e = hipLaunchCooperativeKernel((void*)fwd_megakernel, dim3(grid), dim3(NT), args, LDS_BYTES, stream);
    if (e != hipSuccess) fprintf(stderr, "cooperative launch failed: %s (grid %d)\n", hipGetErrorString(e), grid);
}
```

```cpp
#include <hip/hip_runtime.h>
#include <hip/hip_cooperative_groups.h>
#include <cstdio>
#include <cstdint>
namespace cg = cooperative_groups;
namespace pg8 {
#define PG8_LAS __attribute__((address_space(3)))
typedef unsigned short bf16_t;
typedef short bf16x8 __attribute__((ext_vector_type(8)));
typedef float f32x4 __attribute__((ext_vector_type(4)));
typedef unsigned u32x4 __attribute__((ext_vector_type(4)));
constexpr int BM = 256, BK = 64, HALF = 128, HTB = HALF * BK * 2  , STAGE_BYTES = 8 * HTB, NXCD = 8, WGM = 8;

__host__ __device__ __forceinline__ int lds_byte(int r, int c) { const int st = (r >> 4) * 2 + (c >> 5), rr = r & 15, cc = c & 31, ob = rr * 64 + cc * 2; return st * 1024 + (ob ^ (((ob >> 9) & 1) << 5)); }
__host__ __device__ __forceinline__ void stage_rc(int b, int& R, int& C) { const int st = b / 1024, sb = b % 1024, swz = sb ^ (((sb >> 9) & 1) << 5); R = (st >> 1) * 16 + swz / 64; C = (st & 1) * 32 + (swz % 64) / 2; }
__host__ __device__ __forceinline__ int perm32(int rho) { const int n = rho >> 4, i = rho & 15; return 8 * (i >> 2) + 4 * n + (i & 3); }

struct Unit { int pm, pn; };
struct Gemm { const bf16_t* A; const bf16_t* Bt; int M, N, K, ld; };

struct StaticOrder {
    int nM, nN, nwg, G, c;
    __host__ __device__ void init(int M, int N, int G_, int c_) { nM = M / BM; nN = N / BM; nwg = nM * nN; G = G_; c = c_; }
    __host__ __device__ bool next(int i, Unit& u) const {
        const long L = (long)i * G + c; if (L >= nwg) return false;
        int wgid = (int)L; { const int q = nwg / NXCD, r = nwg % NXCD, xcd = wgid % NXCD, off = wgid / NXCD; wgid = (xcd < r ? xcd * (q + 1) : r * (q + 1) + (xcd - r) * q) + off; }
        const int nig = WGM * nN, gid = wgid / nig, fm = gid * WGM, gsz = (nM - fm) < WGM ? (nM - fm) : WGM;
        u.pm = fm + ((wgid % nig) % gsz); u.pn = (wgid % nig) / gsz; return true;
    }
    __device__ __forceinline__ void a_ready(const Unit&) const {}
    __device__ __forceinline__ void done(const Unit&) const {}
};

typedef float f32x2_t __attribute__((ext_vector_type(2)));
typedef __bf16 bf16x2_t __attribute__((ext_vector_type(2)));
__device__ __forceinline__ unsigned cvt_pk_bf16(float lo, float hi) { f32x2_t v = {lo, hi}; bf16x2_t b = __builtin_convertvector(v, bf16x2_t); return __builtin_bit_cast(unsigned, b); }
template <int ACT  > struct EpiStore {
    static constexpr bool PERM = true, AFTER_DRAIN = false;
    bf16_t* O; int ldc;
    __device__ __forceinline__ void operator()(const f32x4 (&acc)[2][2][4][2], const Unit& u, int wr, int wc, int fr, int fq) const {
        const int row0 = u.pm * BM + wr * 64 + fr; const int col0 = u.pn * BM + wc * 32 + 8 * fq;
#pragma unroll
        for (int ai = 0; ai < 2; ++ai)
#pragma unroll
            for (int m = 0; m < 4; ++m) { bf16_t* rowp = O + (size_t)(row0 + ai * HALF + m * 16) * ldc + col0;
#pragma unroll
                for (int bj = 0; bj < 2; ++bj) { f32x4 v0 = acc[ai][bj][m][0], v1 = acc[ai][bj][m][1];
                    if (ACT == 2) {
#pragma unroll
                        for (int j = 0; j < 4; ++j) { float a = fmaxf(v0[j], 0.f), b = fmaxf(v1[j], 0.f); v0[j] = a * a; v1[j] = b * b; } }
                    u32x4 w; w.x = cvt_pk_bf16(v0[0], v0[1]); w.y = cvt_pk_bf16(v0[2], v0[3]); w.z = cvt_pk_bf16(v1[0], v1[1]); w.w = cvt_pk_bf16(v1[2], v1[3]);
                    *(u32x4*)(rowp + bj * HALF) = w; } }
    }
};
struct EpiResid {
    static constexpr bool PERM = true, AFTER_DRAIN = false;
    const float* baseP; const float* baseS; const float* gate; float* out;
    __device__ __forceinline__ void operator()(const f32x4 (&acc)[2][2][4][2], const Unit& u, int wr, int wc, int fr, int fq) const {
        const int row0 = u.pm * BM + wr * 64 + fr; const int col0 = u.pn * BM + wc * 32 + 8 * fq;
#pragma unroll
        for (int ai = 0; ai < 2; ++ai)
#pragma unroll
            for (int m = 0; m < 4; ++m) { const int r = row0 + ai * HALF + m * 16;
                const float* bp = (r < 8192) ? baseP + (size_t)r * 2048 : baseS + (size_t)(r - 8192) * 2048;
                const float* gp = gate + (size_t)((r < 8192) ? 0 : 1 + ((r - 8192) >> 4)) * 12288;
                float* op = out + (size_t)r * 2048;
#pragma unroll
                for (int bj = 0; bj < 2; ++bj) { const int c = col0 + bj * HALF;
#pragma unroll
                    for (int n = 0; n < 2; ++n) { const f32x4 b = *(const f32x4*)(bp + c + 4 * n), g = *(const f32x4*)(gp + c + 4 * n);
                        *(f32x4*)(op + c + 4 * n) = b + g * acc[ai][bj][m][n]; } }
                asm volatile("" ::: "memory"); }
    }
};

struct EpiPart {
    static constexpr bool PERM = true, AFTER_DRAIN = false;
    bf16_t* out; int ldc;
    __device__ __forceinline__ void operator()(const f32x4 (&acc)[2][2][4][2], const Unit& u, int wr, int wc, int fr, int fq) const {
        const int row0 = u.pm * BM + wr * 64 + fr - 8192; const int col0 = u.pn * BM + wc * 32 + 8 * fq;
#pragma unroll
        for (int ai = 0; ai < 2; ++ai)
#pragma unroll
            for (int m = 0; m < 4; ++m) { bf16_t* op = out + (size_t)(row0 + ai * HALF + m * 16) * ldc + col0;
#pragma unroll
                for (int bj = 0; bj < 2; ++bj) { const f32x4 v0 = acc[ai][bj][m][0], v1 = acc[ai][bj][m][1];
                    u32x4 w; w.x = cvt_pk_bf16(v0[0], v0[1]); w.y = cvt_pk_bf16(v0[2], v0[3]); w.z = cvt_pk_bf16(v1[0], v1[1]); w.w = cvt_pk_bf16(v1[2], v1[3]);
                    *(u32x4*)(op + bj * HALF) = w; } }
    }
};
struct OneUnit { Unit u;
    __device__ __forceinline__ bool next(int i, Unit& o) const { if (i != 0) return false; o = u; return true; }
    __device__ __forceinline__ void a_ready(const Unit&) const {}
    __device__ __forceinline__ void done(const Unit&) const {}
};
template <class Epi, class Sched, bool ALIGN_EPI = false, bool SP2 = false>
__device__ __forceinline__ void gemm_phase(PG8_LAS unsigned char* lds, const Gemm g, const Sched& S, const Epi& E) {
    int tid_ = threadIdx.x; asm volatile("" : "+v"(tid_));
    const int tid = tid_, wid = __builtin_amdgcn_readfirstlane(tid >> 6), lane = tid & 63, wr = wid >> 2, wc = wid & 3, fr = lane & 15, fq = lane >> 4;
    const int K = g.ld, nt = g.K / BK;
    unsigned voffA[2], voffB[2];
#pragma unroll
    for (int i = 0; i < 2; ++i) { int R, C; stage_rc(tid * 16 + i * 8192, R, C); const int Rb = Epi::PERM ? ((R & ~31) + perm32(R & 31)) : R;
        voffA[i] = (unsigned)(R * K + C) * 2u; voffB[i] = (unsigned)(Rb * K + C) * 2u; }
    const size_t kstep = (size_t)(BK * 2);
    const size_t hstep = (size_t)HALF * K * 2;
    const size_t tstep = 2 * hstep;
    const unsigned ldsw = (unsigned)wid * 1024u;
    const int aoff = lds_byte(wr * 64 + fr, fq * 8), boff = lds_byte(wc * 32 + fr, fq * 8);
#define PG8_SA(b, h) (((b) * 2 + (h)) * HTB)
#define PG8_SB(b, h) ((4 + (b) * 2 + (h)) * HTB)
#define PG8_STAGE(bufoff, gbase, voff) do { _Pragma("unroll") for (int _i = 0; _i < 2; ++_i) \
        __builtin_amdgcn_global_load_lds((const unsigned*)((const char*)(gbase) + (voff)[_i]), (PG8_LAS unsigned*)(lds + (bufoff) + ldsw + _i * 8192), 16, 0, 0); } while (0)
#define PG8_LDA(dst, b, h) do { _Pragma("unroll") for (int m = 0; m < 4; ++m) _Pragma("unroll") for (int k = 0; k < 2; ++k) dst[m][k] = *(const PG8_LAS bf16x8*)(lds + PG8_SA(b, h) + aoff + m * 2048 + k * 1024); } while (0)
#define PG8_LDB(dst, b, h) do { _Pragma("unroll") for (int n = 0; n < 2; ++n) _Pragma("unroll") for (int k = 0; k < 2; ++k) dst[n][k] = *(const PG8_LAS bf16x8*)(lds + PG8_SB(b, h) + boff + n * 2048 + k * 1024); } while (0)
#define PG8_MMA(ai, bj, At, Bt) do { __builtin_amdgcn_s_setprio(1); _Pragma("unroll") for (int m = 0; m < 4; ++m) _Pragma("unroll") for (int n = 0; n < 2; ++n) _Pragma("unroll") for (int k = 0; k < 2; ++k) \
        acc[ai][bj][m][n] = __builtin_amdgcn_mfma_f32_16x16x32_bf16(Bt[n][k], At[m][k], acc[ai][bj][m][n], 0, 0, 0); __builtin_amdgcn_s_setprio(0); } while (0)
#define PG8_WAIT_V(n) asm volatile("s_waitcnt vmcnt(" #n ")" ::: "memory")
#define PG8_WAIT_L(n) asm volatile("s_waitcnt lgkmcnt(" #n ")" ::: "memory")
#define PG8_BAR __builtin_amdgcn_s_barrier()
#define PG8_SCHED __builtin_amdgcn_sched_barrier(0)
    Unit cur, nxt; int ui = 0;
    if (!S.next(0, cur)) return;
    f32x4 acc[2][2][4][2];
#pragma unroll
    for (int a = 0; a < 2; ++a)
#pragma unroll
        for (int b = 0; b < 2; ++b)
#pragma unroll
            for (int m = 0; m < 4; ++m)
#pragma unroll
                for (int n = 0; n < 2; ++n) acc[a][b][m][n] = (f32x4){0.f, 0.f, 0.f, 0.f};
    bf16x8 At[4][2], B0[2][2], B1[2][2];
    const char* cA = (const char*)g.A + (size_t)cur.pm * tstep; const char* cB = (const char*)g.Bt + (size_t)cur.pn * tstep;
    S.a_ready(cur);
    if constexpr (SP2) {
        PG8_STAGE(PG8_SB(0, 0), cB, voffB); PG8_STAGE(PG8_SB(0, 1), cB + hstep, voffB); PG8_STAGE(PG8_SA(0, 0), cA, voffA); PG8_STAGE(PG8_SA(0, 1), cA + hstep, voffA);
        if (wr == 1) PG8_BAR;
        PG8_WAIT_V(2); PG8_BAR;
        PG8_STAGE(PG8_SB(1, 0), cB + kstep, voffB); PG8_STAGE(PG8_SA(1, 0), cA + kstep, voffA); PG8_STAGE(PG8_SB(1, 1), cB + hstep + kstep, voffB);
        PG8_WAIT_V(6); PG8_BAR;
    } else {
        PG8_STAGE(PG8_SB(0, 0), cB, voffB); PG8_STAGE(PG8_SA(0, 0), cA, voffA); PG8_STAGE(PG8_SB(0, 1), cB + hstep, voffB); PG8_STAGE(PG8_SA(0, 1), cA + hstep, voffA);
        if (wr == 1) PG8_BAR;
        PG8_WAIT_V(4); PG8_BAR;
        PG8_STAGE(PG8_SB(1, 0), cB + kstep, voffB); PG8_STAGE(PG8_SA(1, 0), cA + kstep, voffA); PG8_STAGE(PG8_SB(1, 1), cB + hstep + kstep, voffB);
        PG8_WAIT_V(6); PG8_BAR;
    }
    for (;;) {
        const bool has_next = S.next(ui + 1, nxt);
        const char* nA = has_next ? (const char*)g.A + (size_t)nxt.pm * tstep : cA; const char* nB = has_next ? (const char*)g.Bt + (size_t)nxt.pn * tstep : cB;
        for (int t = 0; t < nt; t += 2) {
            const bool last = (t == nt - 2);
            const char* a1 = cA + (size_t)(t + 1) * kstep;
            const char* a2 = last ? nA : cA + (size_t)(t + 2) * kstep; const char* b2 = last ? nB : cB + (size_t)(t + 2) * kstep;
            const char* a3 = a2 + kstep; const char* b3 = b2 + kstep;
            if (last && has_next) S.a_ready(nxt);
            if constexpr (SP2) {
            PG8_LDB(B0, 0, 0); PG8_LDB(B1, 0, 1); PG8_SCHED; PG8_LDA(At, 0, 0); PG8_STAGE(PG8_SA(1, 1), a1 + hstep, voffA);
            PG8_WAIT_V(8); PG8_WAIT_L(0); PG8_BAR; PG8_MMA(0, 0, At, B0); PG8_MMA(0, 1, At, B1); PG8_BAR; PG8_SCHED;
            PG8_LDA(At, 0, 1); PG8_STAGE(PG8_SB(0, 0), b2, voffB); PG8_STAGE(PG8_SB(0, 1), b2 + hstep, voffB); PG8_STAGE(PG8_SA(0, 0), a2, voffA);
            PG8_WAIT_V(8); PG8_WAIT_L(0); PG8_BAR; PG8_MMA(1, 0, At, B0); PG8_MMA(1, 1, At, B1); PG8_BAR; PG8_SCHED;
            PG8_LDB(B0, 1, 0); PG8_LDB(B1, 1, 1); PG8_SCHED; PG8_LDA(At, 1, 0); PG8_STAGE(PG8_SA(0, 1), a2 + hstep, voffA);
            PG8_WAIT_V(8); PG8_WAIT_L(0); PG8_BAR; PG8_MMA(0, 0, At, B0); PG8_MMA(0, 1, At, B1); PG8_BAR; PG8_SCHED;
            PG8_LDA(At, 1, 1); PG8_STAGE(PG8_SB(1, 0), b3, voffB); PG8_STAGE(PG8_SB(1, 1), b3 + hstep, voffB); PG8_STAGE(PG8_SA(1, 0), a3, voffA);
            PG8_WAIT_V(8); PG8_WAIT_L(0); PG8_BAR; PG8_MMA(1, 0, At, B0); PG8_MMA(1, 1, At, B1); PG8_BAR; PG8_SCHED;
            } else {
            PG8_LDB(B0, 0, 0); PG8_SCHED; PG8_LDA(At, 0, 0); PG8_STAGE(PG8_SA(1, 1), a1 + hstep, voffA);
            PG8_WAIT_L(8); PG8_BAR; PG8_WAIT_L(0); PG8_MMA(0, 0, At, B0); PG8_BAR; PG8_SCHED;
            PG8_LDB(B1, 0, 1); PG8_STAGE(PG8_SB(0, 0), b2, voffB);
            PG8_BAR; PG8_WAIT_L(0); PG8_MMA(0, 1, At, B1); PG8_BAR;
            PG8_LDA(At, 0, 1); PG8_STAGE(PG8_SA(0, 0), a2, voffA);
            PG8_BAR; PG8_WAIT_L(0); PG8_MMA(1, 0, At, B0); PG8_BAR; PG8_SCHED;
            PG8_STAGE(PG8_SB(0, 1), b2 + hstep, voffB);
            PG8_WAIT_V(6); PG8_BAR; PG8_MMA(1, 1, At, B1); PG8_BAR;
            PG8_LDB(B0, 1, 0); PG8_SCHED; PG8_LDA(At, 1, 0); PG8_STAGE(PG8_SA(0, 1), a2 + hstep, voffA);
            PG8_WAIT_L(8); PG8_BAR; PG8_WAIT_L(0); PG8_MMA(0, 0, At, B0); PG8_BAR; PG8_SCHED;
            PG8_LDB(B1, 1, 1); PG8_STAGE(PG8_SB(1, 0), b3, voffB);
            PG8_BAR; PG8_WAIT_L(0); PG8_MMA(0, 1, At, B1); PG8_BAR;
            PG8_LDA(At, 1, 1); PG8_STAGE(PG8_SA(1, 0), a3, voffA);
            PG8_BAR; PG8_WAIT_L(0); PG8_MMA(1, 0, At, B0); PG8_BAR; PG8_SCHED;
            PG8_STAGE(PG8_SB(1, 1), b3 + hstep, voffB);
            PG8_WAIT_V(6); PG8_BAR; PG8_MMA(1, 1, At, B1); PG8_BAR;
            }
        }
        if constexpr (ALIGN_EPI) { if (wr == 0) PG8_BAR; }
        if constexpr (!Epi::AFTER_DRAIN) { E(acc, cur, wr, wc, fr, fq); S.done(cur); }
        if (!has_next) break;
#pragma unroll
        for (int a = 0; a < 2; ++a)
#pragma unroll
            for (int b = 0; b < 2; ++b)
#pragma unroll
                for (int m = 0; m < 4; ++m)
#pragma unroll
                    for (int n = 0; n < 2; ++n) acc[a][b][m][n] = (f32x4){0.f, 0.f, 0.f, 0.f};
        cur = nxt; cA = nA; cB = nB; ++ui;
        if constexpr (ALIGN_EPI) { if (wr == 1) PG8_BAR; }
    }
    PG8_WAIT_V(0);
    if constexpr (!ALIGN_EPI) { if (wr == 0) PG8_BAR; }
    PG8_BAR;
    if constexpr (Epi::AFTER_DRAIN) { E.fused(acc, cur, wr, wc, fr, fq, lds, wid, lane); S.done(cur); }
#undef PG8_SA
#undef PG8_SB
#undef PG8_STAGE
#undef PG8_LDA
#undef PG8_LDB
#undef PG8_MMA
#undef PG8_WAIT_V
#undef PG8_WAIT_L
#undef PG8_BAR
#undef PG8_SCHED
}
}
#define GAS __attribute__((address_space(1)))
#define LAS __attribute__((address_space(3)))
typedef unsigned short bf16;
typedef unsigned u32x4 __attribute__((ext_vector_type(4)));
typedef unsigned u32x2 __attribute__((ext_vector_type(2)));
typedef float f32x4 __attribute__((ext_vector_type(4)));
typedef float f32x16 __attribute__((ext_vector_type(16)));
typedef short bf16x8 __attribute__((ext_vector_type(8)));
typedef short s16x4 __attribute__((ext_vector_type(4)));
typedef float f32x2_t __attribute__((ext_vector_type(2)));
constexpr int NW = 8, NT = 512;
constexpr int MTOK = 8704, MP = 8192, MS = 512, DM = 2048, NIN = 7176, NINP = 7424, DFF = 8192;
constexpr int NSEQ = 33;
constexpr int PAST = 1024;
constexpr int C_QA = 0, C_KA = 1024, C_VA = 2048, C_QM = 3072, C_KM = 4096, C_VM = 5120, C_OM = 6144, C_IG = 7168, C_FG = 7172;
constexpr int NCH = 160;
constexpr float EPS = 1e-6f;
constexpr float LAM_INIT = 0.2f;
constexpr float QSCALE = 0.125f * 1.4426950408889634f;
constexpr size_t O_YP = 0, O_YS = 16777216, O_KP = 17825792, O_VP = 26214400, O_CVP = 34603008, O_CP = 34609152, O_NP = 34871296, O_MPO = 34872320,
                 O_KS = 34872324, O_VS = 35396612, O_CVS = 35920900, O_CS = 36117508, O_NS = 44506116, O_MSO = 44538884;
constexpr size_t MiB = 1u << 20;
constexpr size_t WS_MOD = 1 * MiB;
constexpr size_t WS_ROPE = 3 * MiB;
constexpr size_t WS_SCAL = 4 * MiB;
constexpr size_t WS_DN = 5 * MiB;
constexpr size_t WS_NPREV = 6 * MiB;
constexpr size_t WS_WIN = 8 * MiB;
constexpr size_t WS_WOUT = 40 * MiB;
constexpr size_t WS_WUP = 48 * MiB;
constexpr size_t WS_WDN = 80 * MiB;
constexpr size_t WS_XN = 112 * MiB;
constexpr size_t WS_PROJ = 148 * MiB;
constexpr size_t WS_QA = 272 * MiB;
constexpr size_t WS_KA = 289 * MiB;
constexpr size_t WS_VT = 306 * MiB;
constexpr size_t WS_DC = 322 * MiB;
constexpr size_t WS_CPREV = 482 * MiB;
constexpr size_t WS_MIX = 562 * MiB;
constexpr size_t WS_END = 596 * MiB;
constexpr size_t WS_H = WS_PROJ;
constexpr size_t WS_X1 = WS_DC;
constexpr size_t WS_PART6 = 390 * MiB;
constexpr size_t WS_PART8 = 422 * MiB;
constexpr size_t WS_PART9 = 486 * MiB;
constexpr size_t WS_FLAG = 0;
static_assert(WS_H + (size_t)MTOK * DFF * 2 <= WS_VT + 16 * MiB && WS_X1 + (size_t)MTOK * DM * 4 <= WS_CPREV, "overlays");

constexpr int LDS_BYTES = 147456;

__device__ __forceinline__ f32x4 ld_bf4(const bf16* p) { const u32x2 w = *(const u32x2*)p; return (f32x4){__uint_as_float(w.x << 16), __uint_as_float(w.x & 0xffff0000u), __uint_as_float(w.y << 16), __uint_as_float(w.y & 0xffff0000u)}; }
__device__ __forceinline__ float bf2f(unsigned short u) { return __uint_as_float((unsigned)u << 16); }
__device__ __forceinline__ unsigned pk2(float lo, float hi) { return pg8::cvt_pk_bf16(lo, hi); }
__device__ __forceinline__ float lane_get(float v, int src_lane) { return __int_as_float(__builtin_amdgcn_ds_bpermute(src_lane << 2, __float_as_int(v))); }
__device__ __forceinline__ float xhalf_other(float v) { auto rr = __builtin_amdgcn_permlane32_swap(__float_as_uint(v), __float_as_uint(v), false, false); return __uint_as_float(rr[0]) + __uint_as_float(rr[1]) - v; }
__device__ __forceinline__ float xhalf_sum(float v) { auto rr = __builtin_amdgcn_permlane32_swap(__float_as_uint(v), __float_as_uint(v), false, false); return __uint_as_float(rr[0]) + __uint_as_float(rr[1]); }
__device__ __forceinline__ float wave_sum(float v, int lane) {
#pragma unroll
    for (int o = 1; o < 32; o <<= 1) v += lane_get(v, lane ^ o);
    return xhalf_sum(v);
}
__device__ __forceinline__ float wave_max(float v, int lane) {
#pragma unroll
    for (int o = 1; o < 64; o <<= 1) v = fmaxf(v, lane_get(v, lane ^ o));
    return v;
}
__device__ __forceinline__ float silu_f(float x) { return x / (1.f + __expf(-x)); }
__device__ __forceinline__ float sigmoid_f(float x) { return 1.f / (1.f + __expf(-x)); }
__device__ __forceinline__ int crow(int r, int hi) { return (r & 3) + 8 * (r >> 2) + 4 * hi; }
#define LDS_WAIT() asm volatile("s_waitcnt lgkmcnt(0)" ::: "memory")

struct Args {
    const float* in[29]; float* out; unsigned char* ws;
};
typedef const __attribute__((address_space(4))) Args* ArgsP;
#define FRESH_ARGS() ({ ArgsP p_ = (ArgsP)__builtin_amdgcn_kernarg_segment_ptr(); asm volatile("" : "+s"(p_)); p_; })

__device__ __forceinline__ void p0_transpose_item(const float* __restrict__ W, int K, int N, int Npad, bf16* WT, LAS float* T, int item, int tid, int wave, int lane) {
    const int nblk = Npad / 256, kb = item / nblk, nb = item % nblk, k0 = 64 * kb, n0 = 256 * nb;
    const int n = n0 + 4 * lane;
    f32x4 v[8];
#pragma unroll
    for (int i = 0; i < 8; ++i) v[i] = (n < N) ? *(const f32x4*)(W + (size_t)(k0 + 8 * wave + i) * N + n) : (f32x4){0.f, 0.f, 0.f, 0.f};
#pragma unroll
    for (int i = 0; i < 8; ++i) *(LAS f32x4*)(T + (8 * wave + i) * 260 + 4 * lane) = v[i];
    __syncthreads();
#pragma unroll
    for (int j = 0; j < 4; ++j) { const int q = tid + NT * j, nn = q >> 3, c = q & 7; const LAS float* s = T + (8 * c) * 260 + nn;
        u32x4 o; o.x = pk2(s[0], s[260]); o.y = pk2(s[2 * 260], s[3 * 260]); o.z = pk2(s[4 * 260], s[5 * 260]); o.w = pk2(s[6 * 260], s[7 * 260]);
        *(u32x4*)(WT + (size_t)(n0 + nn) * K + k0 + 8 * c) = o; }
    __syncthreads();
}

__device__ __forceinline__ void p0_ada_item(const float* __restrict__ cP, const float* __restrict__ cS, const float* __restrict__ Wada, const float* __restrict__ bada,
                                            float* mod, LAS float* red, int jb, int wave, int lane, int tid) {
    const int i32 = lane & 31, hi = lane >> 5;
    f32x16 acc[4]; f32x4 accp = {0.f, 0.f, 0.f, 0.f};
#pragma unroll
    for (int c = 0; c < 4; ++c) acc[c] = (f32x16){};
    const float* wp = Wada + (size_t)128 * jb + 4 * i32;
    for (int st = 0; st < 16; ++st) {
        const int k0 = 256 * wave + 16 * st + 8 * hi;
        f32x4 w[8];
#pragma unroll
        for (int i = 0; i < 8; ++i) w[i] = *(const f32x4*)(wp + (size_t)(k0 + i) * 12288);
        const f32x4 c0 = *(const f32x4*)(cS + (size_t)i32 * DM + k0), c1 = *(const f32x4*)(cS + (size_t)i32 * DM + k0 + 4);
        const f32x4 p0 = *(const f32x4*)(cP + k0), p1 = *(const f32x4*)(cP + k0 + 4);
        u32x4 a;
        a.x = pk2(silu_f(c0[0]), silu_f(c0[1])); a.y = pk2(silu_f(c0[2]), silu_f(c0[3])); a.z = pk2(silu_f(c1[0]), silu_f(c1[1])); a.w = pk2(silu_f(c1[2]), silu_f(c1[3]));
#pragma unroll
        for (int i = 0; i < 4; ++i) { accp += w[i] * silu_f(p0[i]); accp += w[4 + i] * silu_f(p1[i]); }
#pragma unroll
        for (int c = 0; c < 4; ++c) { u32x4 b; b.x = pk2(w[0][c], w[1][c]); b.y = pk2(w[2][c], w[3][c]); b.z = pk2(w[4][c], w[5][c]); b.w = pk2(w[6][c], w[7][c]);
            acc[c] = __builtin_amdgcn_mfma_f32_32x32x16_bf16(__builtin_bit_cast(bf16x8, a), __builtin_bit_cast(bf16x8, b), acc[c], 0, 0, 0); }
    }
    accp = (f32x4){xhalf_sum(accp[0]), xhalf_sum(accp[1]), xhalf_sum(accp[2]), xhalf_sum(accp[3])};
    LAS float* rp = red + 16384;
    if (hi == 0) *(LAS f32x4*)(rp + wave * 128 + 4 * i32) = accp;
#pragma unroll
    for (int half = 4; half >= 1; half >>= 1) {
        if (wave >= half && wave < 2 * half) { LAS float* dst = red + (wave - half) * 4096;
#pragma unroll
            for (int r = 0; r < 16; ++r) *(LAS f32x4*)(dst + crow(r, hi) * 128 + 4 * i32) = (f32x4){acc[0][r], acc[1][r], acc[2][r], acc[3][r]}; }
        __syncthreads();
        if (wave < half) { const LAS float* src = red + wave * 4096;
#pragma unroll
            for (int r = 0; r < 16; ++r) { const f32x4 t = *(const LAS f32x4*)(src + crow(r, hi) * 128 + 4 * i32); acc[0][r] += t[0]; acc[1][r] += t[1]; acc[2][r] += t[2]; acc[3][r] += t[3]; } }
        __syncthreads();
    }
    if (wave == 0) { const f32x4 bv = *(const f32x4*)(bada + 128 * jb + 4 * i32);
#pragma unroll
        for (int r = 0; r < 16; ++r) *(f32x4*)(mod + (size_t)(1 + crow(r, hi)) * 12288 + 128 * jb + 4 * i32) = (f32x4){acc[0][r], acc[1][r], acc[2][r], acc[3][r]} + bv; }
    if (wave == 1 && hi == 0) { f32x4 t = *(const f32x4*)(bada + 128 * jb + 4 * i32);
#pragma unroll
        for (int w = 0; w < 8; ++w) t += *(const LAS f32x4*)(rp + w * 128 + 4 * i32);
        *(f32x4*)(mod + 128 * jb + 4 * i32) = t; }
    __syncthreads();
}

__constant__ double INV_FREQ_TURNS[8] = {
    1.0 / 6.283185307179586, 0.19392274474868576 / 6.283185307179586, 0.03760603093086393 / 6.283185307179586, 0.007292664737217109 / 6.283185307179586,
    0.001414213562373095 / 6.283185307179586, 0.0002742481756762073 / 6.283185307179586, 5.318295896944988e-05 / 6.283185307179586, 1.031338537721246e-05 / 6.283185307179586 };

__device__ __forceinline__ void p0_prologue(ArgsP A, LAS unsigned char* lds, int tid, int wave, int lane) {
    unsigned char* ws = A->ws;
    const int G = gridDim.x, bid = blockIdx.x;
    for (int jb = bid; jb < 96; jb += G)
        p0_ada_item(A->in[8], A->in[9], A->in[10], A->in[11], (float*)(ws + WS_MOD), (LAS float*)lds, jb, wave, lane, tid);
    constexpr int I_IN = 32 * (NINP / 256), I_OUT = 32 * 8, I_UP = 32 * 32, I_DN = 128 * 8, I_ALL = I_IN + I_OUT + I_UP + I_DN;
    const bool split = (G > 128);
    const int nfree = split ? G - 96 : G, first = split ? 14 * nfree : 0;
    for (int pass = 0; pass < 2; ++pass) {
        int it, step, end;
        if (pass == 0) { if (!split || bid < 96) continue; it = bid - 96; step = nfree; end = (first < I_ALL) ? first : I_ALL; }
        else { it = first + bid; step = G; end = I_ALL; }
        for (; it < end; it += step) { int r = it;
            if (r < I_IN) { p0_transpose_item(A->in[13], DM, NIN, NINP, (bf16*)(ws + WS_WIN), (LAS float*)lds, r, tid, wave, lane); continue; } r -= I_IN;
            if (r < I_OUT) { p0_transpose_item(A->in[24], DM, DM, DM, (bf16*)(ws + WS_WOUT), (LAS float*)lds, r, tid, wave, lane); continue; } r -= I_OUT;
            if (r < I_UP) { p0_transpose_item(A->in[26], DM, DFF, DFF, (bf16*)(ws + WS_WUP), (LAS float*)lds, r, tid, wave, lane); continue; } r -= I_UP;
            p0_transpose_item(A->in[27], DFF, DM, DM, (bf16*)(ws + WS_WDN), (LAS float*)lds, r, tid, wave, lane); }
    }
    for (int idx = blockIdx.x * NT + tid; idx < 8192 * 8; idx += gridDim.x * NT) {
        const int pos = idx >> 3, i = idx & 7;
        const double t = (double)pos * INV_FREQ_TURNS[i]; const float fr = (float)(t - __builtin_rint(t));
        float* tab = (float*)(ws + WS_ROPE) + (size_t)pos * 16;
        tab[i] = __builtin_amdgcn_cosf(fr); tab[8 + i] = __builtin_amdgcn_sinf(fr);
    }
}

template <int NPART> __device__ __forceinline__ void norm_mod_rows(const float* xP, const float* xS, const float* __restrict__ g, const float* __restrict__ mod, int sh_off, int sc_off, bf16* out, int wave, int lane,
                                              const bf16* part = nullptr, int gate_off = 0, float* x1S = nullptr) {
    const int gw = blockIdx.x * NW + wave, NGW = gridDim.x * NW;
    for (int r = gw; r < MTOK; r += NGW) {
        const float* xr = (r < MP) ? xP + (size_t)r * DM : xS + (size_t)(r - MP) * DM;
        const float* mr = mod + (size_t)((r < MP) ? 0 : 1 + ((r - MP) >> 4)) * 12288;
        f32x4 v[8]; float s = 0.f;
#pragma unroll
        for (int j = 0; j < 8; ++j) v[j] = *(const f32x4*)(xr + 256 * j + 4 * lane);
        if (NPART > 0 && r >= MP) {
#pragma unroll
            for (int j = 0; j < 8; ++j) { const int c = 256 * j + 4 * lane; f32x4 a = {0.f, 0.f, 0.f, 0.f};
                f32x4 t[NPART > 0 ? NPART : 1];
#pragma unroll
                for (int p = 0; p < NPART; ++p) t[p] = ld_bf4(part + ((size_t)p * MS + (r - MP)) * DM + c);
#pragma unroll
                for (int p = 0; p < NPART; ++p) a += t[p];
                v[j] += *(const f32x4*)(mr + gate_off + c) * a; *(f32x4*)(x1S + (size_t)(r - MP) * DM + c) = v[j]; } }
#pragma unroll
        for (int j = 0; j < 8; ++j) s += (v[j].x * v[j].x + v[j].y * v[j].y) + (v[j].z * v[j].z + v[j].w * v[j].w);
        const float rstd = 1.f / sqrtf(wave_sum(s, lane) * (1.f / DM) + EPS);
#pragma unroll
        for (int j = 0; j < 8; ++j) { const int c = 256 * j + 4 * lane;
            const f32x4 gg = *(const f32x4*)(g + c), sc = *(const f32x4*)(mr + sc_off + c), sh = *(const f32x4*)(mr + sh_off + c);
            const f32x4 y = v[j] * rstd * gg * (sc + 1.f) + sh;
            u32x2 o; o.x = pk2(y.x, y.y); o.y = pk2(y.z, y.w);
            *(u32x2*)(out + (size_t)r * DM + c) = o; }
    }
}
#define XB_TMO      128
#define XB_XCNT(j)  (256  + 64 * (j))
#define XB_XSUB(j)  (1280 + 64 * (j))
#define XB_XGEN(j)  (2304 + 64 * (j))
#define XB_TOP      3328
#define XB_TOPGEN   3392
#define XCD_BAR_WORDS 3456
#define XB_SPIN_CAP (1u << 18)

__device__ __forceinline__ unsigned xb_ld(unsigned* p)              { return __hip_atomic_load(p, __ATOMIC_RELAXED, __HIP_MEMORY_SCOPE_AGENT); }
__device__ __forceinline__ unsigned xb_add(unsigned* p, unsigned v) { return __hip_atomic_fetch_add(p, v, __ATOMIC_RELAXED, __HIP_MEMORY_SCOPE_AGENT); }
__device__ __forceinline__ unsigned xb_xcc_id() { return (unsigned)__builtin_amdgcn_s_getreg((3 << 11) | 20) & 0xFu; }
#define XB_SPIN(cond, bar) do { unsigned _sp = 0; while (cond) { __builtin_amdgcn_s_sleep(1); \
    if ((++_sp & 255u) == 0u) { if (xb_ld(&(bar)[XB_TMO])) break; if (_sp > XB_SPIN_CAP) { atomicAdd(&(bar)[XB_TMO], 1u); break; } } } } while (0)

struct XcdBarrier {
    unsigned* bar; unsigned x;
    volatile LAS unsigned* st;
};

__device__ __forceinline__ XcdBarrier xcd_barrier_post(unsigned* bar, volatile LAS unsigned* st) {
    XcdBarrier b; b.bar = bar; b.x = xb_xcc_id(); b.st = st;
    if (threadIdx.x == 0) (void)xb_add(&bar[XB_XCNT(b.x)], 1u);
    return b;
}
__device__ __forceinline__ void xcd_barrier_complete(unsigned* bar, unsigned x, unsigned& nloc, unsigned& nx) {
    const unsigned G = gridDim.x * gridDim.y * gridDim.z;
    unsigned sum, cnt, mine, sp = 0u;
    for (;;) {
        sum = 0u; cnt = 0u; mine = 0u;
#pragma unroll
        for (unsigned j = 0; j < 16; ++j) { const unsigned c = xb_ld(&bar[XB_XCNT(j)]); sum += c; cnt += (c > 0u) ? 1u : 0u; mine = (j == x) ? c : mine; }
        if (sum == G) break;
        __builtin_amdgcn_s_sleep(1);
        if ((++sp & 255u) == 0u) { if (xb_ld(&bar[XB_TMO])) break; if (sp > XB_SPIN_CAP) { atomicAdd(&bar[XB_TMO], 1u); break; } }
    }
    nloc = mine > 0u ? mine : 1u; nx = cnt > 0u ? cnt : 1u;
}

__device__ __forceinline__ void xcd_barrier(const XcdBarrier& b) {
    asm volatile("s_waitcnt vmcnt(0)" ::: "memory");
    __syncthreads();
    if (threadIdx.x == 0) {
        unsigned* bar = b.bar;
        __builtin_amdgcn_s_waitcnt(0);
        unsigned nloc = b.st[0], nx = b.st[1];
        if (nloc == 0u) { xcd_barrier_complete(bar, b.x, nloc, nx); b.st[0] = nloc; b.st[1] = nx; }
        const unsigned old = xb_add(&bar[XB_XSUB(b.x)], 1u);
        const unsigned gen = old / nloc;
        if (old + 1u == (gen + 1u) * nloc) {
            __builtin_amdgcn_fence(__ATOMIC_RELEASE, "agent");
            asm volatile("s_waitcnt vmcnt(0)" ::: "memory");
            const unsigned og = xb_add(&bar[XB_TOP], 1u);
            const unsigned tg = og / nx;
            if (og + 1u == (tg + 1u) * nx) xb_add(&bar[XB_TOPGEN], 1u);
            else XB_SPIN(xb_ld(&bar[XB_TOPGEN]) == tg, bar);
            __builtin_amdgcn_fence(__ATOMIC_ACQUIRE, "agent");
            xb_add(&bar[XB_XGEN(b.x)], 1u);
            asm volatile("s_waitcnt vmcnt(0)" ::: "memory");
        } else {
            XB_SPIN(xb_ld(&bar[XB_XGEN(b.x)]) == gen, bar);
            __builtin_amdgcn_fence(__ATOMIC_ACQUIRE, "agent");
            asm volatile("s_waitcnt vmcnt(0)" ::: "memory");
        }
    }
    __syncthreads();
}
__device__ __forceinline__ void unpack16(const u32x4 a, const u32x4 b, float* v) {
#pragma unroll
    for (int i = 0; i < 4; ++i) { v[2 * i] = __uint_as_float(a[i] << 16); v[2 * i + 1] = __uint_as_float(a[i] & 0xffff0000u); v[8 + 2 * i] = __uint_as_float(b[i] << 16); v[8 + 2 * i + 1] = __uint_as_float(b[i] & 0xffff0000u); }
}
__device__ __forceinline__ void p3_post(ArgsP A, int tid) {
    unsigned char* ws = A->ws;
    const bf16* PROJ = (const bf16*)(ws + WS_PROJ); bf16* QA = (bf16*)(ws + WS_QA); bf16* KA = (bf16*)(ws + WS_KA);
    const float* rope = (const float*)(ws + WS_ROPE);
    for (int it = blockIdx.x * NT + tid; it < MTOK * 64; it += gridDim.x * NT) {
        const int r = it >> 6, cg16 = it & 63;
        const int pos = (r < MP) ? r : PAST + ((r - MP) & 15);
        const bf16* pr = PROJ + (size_t)r * NINP + 16 * cg16;
        float q[16], k[16], v[16];
        unpack16(*(const u32x4*)(pr + C_QA), *(const u32x4*)(pr + C_QA + 8), q);
        unpack16(*(const u32x4*)(pr + C_KA), *(const u32x4*)(pr + C_KA + 8), k);
        unpack16(*(const u32x4*)(pr + C_VA), *(const u32x4*)(pr + C_VA + 8), v);
        if ((cg16 & 3) == 0) {
            const float* tb = rope + (size_t)pos * 16;
#pragma unroll
            for (int i = 0; i < 8; ++i) { const float c = tb[i], s = tb[8 + i];
                const float q1 = q[i], q2 = q[8 + i]; q[i] = q1 * c - q2 * s; q[8 + i] = q2 * c + q1 * s;
                const float k1 = k[i], k2 = k[8 + i]; k[i] = k1 * c - k2 * s; k[8 + i] = k2 * c + k1 * s; }
        }
        u32x4 o0, o1;
#pragma unroll
        for (int i = 0; i < 4; ++i) { o0[i] = pk2(q[2 * i] * QSCALE, q[2 * i + 1] * QSCALE); o1[i] = pk2(q[8 + 2 * i] * QSCALE, q[8 + 2 * i + 1] * QSCALE); }
        *(u32x4*)(QA + (size_t)r * 1024 + 16 * cg16) = o0; *(u32x4*)(QA + (size_t)r * 1024 + 16 * cg16 + 8) = o1;
#pragma unroll
        for (int i = 0; i < 4; ++i) { o0[i] = pk2(k[2 * i], k[2 * i + 1]); o1[i] = pk2(k[8 + 2 * i], k[8 + 2 * i + 1]); }
        *(u32x4*)(KA + (size_t)r * 1024 + 16 * cg16) = o0; *(u32x4*)(KA + (size_t)r * 1024 + 16 * cg16 + 8) = o1;
        float* ko = A->out + ((r < MP) ? O_KP + (size_t)r * 1024 : O_KS + (size_t)(r - MP) * 1024) + 16 * cg16;
        float* vo = A->out + ((r < MP) ? O_VP + (size_t)r * 1024 : O_VS + (size_t)(r - MP) * 1024) + 16 * cg16;
#pragma unroll
        for (int i = 0; i < 4; ++i) { *(f32x4*)(ko + 4 * i) = (f32x4){k[4 * i], k[4 * i + 1], k[4 * i + 2], k[4 * i + 3]}; *(f32x4*)(vo + 4 * i) = (f32x4){v[4 * i], v[4 * i + 1], v[4 * i + 2], v[4 * i + 3]}; }
    }
    for (int it = blockIdx.x * NT + tid; it < 33 * 3 * 2048; it += gridDim.x * NT) {
        const int ch = it & 2047, j = (it >> 11) % 3, sq = it / (3 * 2048);
        const int r = (sq == 0) ? (MP - 3 + j) : (MP + 16 * (sq - 1) + 13 + j);
        const float val = bf2f(PROJ[(size_t)r * NINP + C_QM + ch]);
        if (sq == 0) A->out[O_CVP + (size_t)j * 2048 + ch] = val; else A->out[O_CVS + ((size_t)(sq - 1) * 3 + j) * 2048 + ch] = val;
    }
}
typedef short v4i16_t __attribute__((ext_vector_type(4)));
__device__ __forceinline__ s16x4 tr_rd(LAS const unsigned char* p) { return __builtin_bit_cast(s16x4, __builtin_amdgcn_ds_read_tr16_b64_v4i16((LAS v4i16_t*)p)); }
__device__ __forceinline__ bf16x8 mk8(s16x4 a, s16x4 b) { return (bf16x8){a[0], a[1], a[2], a[3], b[0], b[1], b[2], b[3]}; }
__device__ __forceinline__ int tr_off(int pitch, int krow, int colbase, int lane) { return (krow + ((lane & 15) >> 2)) * pitch + (colbase + 16 * ((lane >> 4) & 1) + 4 * (lane & 3)) * 2; }
__device__ __forceinline__ void unpack8(const u32x4 a, float* v) {
#pragma unroll
    for (int i = 0; i < 4; ++i) { v[2 * i] = __uint_as_float(a[i] << 16); v[2 * i + 1] = __uint_as_float(a[i] & 0xffff0000u); }
}
__device__ __forceinline__ int unit_row0(int u) { return (u < 128) ? 64 * u : MP + 16 * (u - 128); }
__device__ __forceinline__ void conv8(const bf16* PROJ, const float* __restrict__ stconv, const float* __restrict__ wconv, const float* __restrict__ bconv, int u, int s, int ch0, float* o) {
    const int r0 = unit_row0(u);
    f32x4 a0 = *(const f32x4*)(bconv + ch0), a1 = *(const f32x4*)(bconv + ch0 + 4);
#pragma unroll
    for (int j = 0; j < 4; ++j) { const int tau = s - 3 + j; float x[8];
        if (tau >= 0 || (u > 0 && u < 128)) unpack8(*(const u32x4*)(PROJ + (size_t)(r0 + tau) * NINP + C_QM + ch0), x);
        else if (u >= 128) { const float* p = stconv + ((size_t)(u - 128) * 3 + (3 + tau)) * 2048 + ch0; const f32x4 y0 = *(const f32x4*)p, y1 = *(const f32x4*)(p + 4);
            x[0] = y0[0]; x[1] = y0[1]; x[2] = y0[2]; x[3] = y0[3]; x[4] = y1[0]; x[5] = y1[1]; x[6] = y1[2]; x[7] = y1[3]; }
        else {
#pragma unroll
            for (int i = 0; i < 8; ++i) x[i] = 0.f; }
        const f32x4 w0 = *(const f32x4*)(wconv + j * 2048 + ch0), w1 = *(const f32x4*)(wconv + j * 2048 + ch0 + 4);
        a0 += (f32x4){x[0], x[1], x[2], x[3]} * w0; a1 += (f32x4){x[4], x[5], x[6], x[7]} * w1; }
#pragma unroll
    for (int i = 0; i < 4; ++i) { o[i] = silu_f(a0[i]); o[4 + i] = silu_f(a1[i]); }
}
__device__ __forceinline__ void conv_rows4(const bf16* PROJ, const float* __restrict__ stconv, const float* __restrict__ wconv, const float* __restrict__ bconv, int u, int L, int s0, int ch0, float sc, u32x4* o) {
    const int r0 = unit_row0(u);
    f32x4 w0[4], w1[4];
#pragma unroll
    for (int j = 0; j < 4; ++j) { w0[j] = *(const f32x4*)(wconv + j * 2048 + ch0); w1[j] = *(const f32x4*)(wconv + j * 2048 + ch0 + 4); }
    const f32x4 b0 = *(const f32x4*)(bconv + ch0), b1 = *(const f32x4*)(bconv + ch0 + 4);
    f32x4 x0[7], x1[7];
#pragma unroll
    for (int i = 0; i < 7; ++i) { const int tau = s0 - 3 + i; x0[i] = (f32x4){0.f, 0.f, 0.f, 0.f}; x1[i] = x0[i];
        if (tau >= 0 ? (tau < L) : (u > 0 && u < 128)) { float t[8]; unpack8(*(const u32x4*)(PROJ + (size_t)(r0 + tau) * NINP + C_QM + ch0), t); x0[i] = (f32x4){t[0], t[1], t[2], t[3]}; x1[i] = (f32x4){t[4], t[5], t[6], t[7]}; }
        else if (tau < 0 && u >= 128) { const float* p = stconv + ((size_t)(u - 128) * 3 + (3 + tau)) * 2048 + ch0; x0[i] = *(const f32x4*)p; x1[i] = *(const f32x4*)(p + 4); } }
#pragma unroll
    for (int r = 0; r < 4; ++r) { f32x4 a0 = b0, a1 = b1;
#pragma unroll
        for (int j = 0; j < 4; ++j) { a0 += x0[r + j] * w0[j]; a1 += x1[r + j] * w1[j]; }
        u32x4 q = {0u, 0u, 0u, 0u};
        if (s0 + r < L) { q.x = pk2(silu_f(a0[0]) * sc, silu_f(a0[1]) * sc); q.y = pk2(silu_f(a0[2]) * sc, silu_f(a0[3]) * sc); q.z = pk2(silu_f(a1[0]) * sc, silu_f(a1[1]) * sc); q.w = pk2(silu_f(a1[2]) * sc, silu_f(a1[3]) * sc); }
        o[r] = q; }
}
__device__ __forceinline__ u32x4 pack8(const float* v, float sc) { u32x4 o; o.x = pk2(v[0] * sc, v[1] * sc); o.y = pk2(v[2] * sc, v[3] * sc); o.z = pk2(v[4] * sc, v[5] * sc); o.w = pk2(v[6] * sc, v[7] * sc); return o; }
__device__ __forceinline__ float logsigmoid_f(float f) { return fminf(f, 0.f) - log1pf(__expf(-fabsf(f))); }
__device__ __forceinline__ void load_gates(const bf16* PROJ, const float* bi, const float* bfg, int u, int h, int t, float& ig, float& lf) {
    const int L = (u < 128) ? 64 : 16; const int r = unit_row0(u) + t;
    ig = -INFINITY; lf = 0.f;
    if (t < L) { ig = bf2f(PROJ[(size_t)r * NINP + C_IG + h]) + bi[h]; lf = logsigmoid_f(bf2f(PROJ[(size_t)r * NINP + C_FG + h]) + bfg[h]); }
}
__device__ __forceinline__ float scan_add(float v, int lane) {
#pragma unroll
    for (int o = 1; o < 64; o <<= 1) { const float x = lane_get(v, lane - o); if (lane >= o) v += x; }
    return v;
}
__device__ __forceinline__ float scan_max(float v, int lane) {
#pragma unroll
    for (int o = 1; o < 64; o <<= 1) { const float x = lane_get(v, lane - o); if (lane >= o) v = fmaxf(v, x); }
    return v;
}
constexpr int MA_K = 0, MA_V = 36864, MA_W = 73728;
constexpr int PK = 576;
__device__ __forceinline__ void mlstm_phaseA(ArgsP A, LAS unsigned char* lds, int u, int h, int tid, int wave, int lane) {
    unsigned char* ws = A->ws; const bf16* PROJ = (const bf16*)(ws + WS_PROJ);
    float* SC = (float*)(ws + WS_SCAL);
    LAS float* wl = (LAS float*)(lds + MA_W);
    const int L = (u < 128) ? 64 : 16, r0 = unit_row0(u);
    if (wave == 0) {
        float ig, lf; load_gates(PROJ, A->in[21], A->in[22], u, h, lane, ig, lf);
        const float b = scan_add(lf, lane); const float G = lane_get(b, 63);
        const float uu = (lane < L) ? G - b + ig : -INFINITY; const float mloc = wave_max(uu, lane);
        wl[lane] = (lane < L) ? __expf(uu - mloc) : 0.f;
        if (lane == 0) { SC[u * 4 + h] = G; SC[640 + u * 4 + h] = mloc; }
    }
    { const int c8 = 8 * (tid & 31), s0 = 4 * (tid >> 5);
      u32x4 ko[4]; conv_rows4(PROJ, A->in[4], A->in[19], A->in[20], u, L, s0, 1024 + h * 256 + c8, 0.0625f, ko);
      u32x4 vr[4];
#pragma unroll
      for (int r = 0; r < 4; ++r) { vr[r] = (u32x4){0u, 0u, 0u, 0u}; if (s0 + r < L) vr[r] = *(const u32x4*)(PROJ + (size_t)(r0 + s0 + r) * NINP + C_VM + h * 256 + c8); }
#pragma unroll
      for (int r = 0; r < 4; ++r) *(LAS u32x4*)(lds + MA_K + (s0 + r) * PK + c8 * 2) = ko[r];
      __syncthreads();
#pragma unroll
      for (int r = 0; r < 4; ++r) { float v[8]; unpack8(vr[r], v); *(LAS u32x4*)(lds + MA_V + (s0 + r) * PK + c8 * 2) = pack8(v, wl[s0 + r]); } }
    __syncthreads();
    { const int i32 = lane & 31, hi = lane >> 5, eb = wave;
      bf16x8 af[4];
#pragma unroll
      for (int ks = 0; ks < 4; ++ks) { const int o = tr_off(PK, 16 * ks + 8 * hi, 32 * eb, lane); af[ks] = mk8(tr_rd(lds + MA_V + o), tr_rd(lds + MA_V + o + 4 * PK)); }
      bf16* dC = (bf16*)(ws + WS_DC) + ((size_t)(u * 4 + h) * 256 + 32 * eb + i32) * 256 + 4 * hi;
      for (int db = 0; db < 8; ++db) { f32x16 acc = {};
#pragma unroll
          for (int ks = 0; ks < 4; ++ks) { const int o = tr_off(PK, 16 * ks + 8 * hi, 32 * db, lane); const bf16x8 bfr = mk8(tr_rd(lds + MA_K + o), tr_rd(lds + MA_K + o + 4 * PK));
              acc = __builtin_amdgcn_mfma_f32_32x32x16_bf16(bfr, af[ks], acc, 0, 0, 0); }
#pragma unroll
          for (int g4 = 0; g4 < 4; ++g4) { u32x2 o; o.x = pk2(acc[4 * g4], acc[4 * g4 + 1]); o.y = pk2(acc[4 * g4 + 2], acc[4 * g4 + 3]); *(u32x2*)(dC + 32 * db + 8 * g4) = o; } } }
    if (tid < 256) { float a = 0.f;
        for (int s = 0; s < 64; ++s) a += wl[s] * bf2f(*(LAS const unsigned short*)(lds + MA_K + s * PK + tid * 2));
        ((float*)(ws + WS_DN))[(size_t)(u * 4 + h) * 256 + tid] = a; }
    __syncthreads();
}
__device__ __forceinline__ void mlstm_phaseB(ArgsP A, LAS unsigned char* lds, int tid, int wave, int lane) {
    unsigned char* ws = A->ws; const float* SC = (const float*)(ws + WS_SCAL); float* MPREV = (float*)(ws + WS_SCAL) + 1280;
    const bf16* DC = (const bf16*)(ws + WS_DC); bf16* CP = (bf16*)(ws + WS_CPREV); const float* DN = (const float*)(ws + WS_DN); float* NP = (float*)(ws + WS_NPREV);
    const int gid = blockIdx.x * NT + tid, gsz = gridDim.x * NT;
    LAS float* AL = (LAS float*)lds; LAS float* BE = AL + 512;
    if (wave < 4) { const int h = wave; const float g0 = SC[lane * 4 + h], g1 = SC[(64 + lane) * 4 + h], l0 = SC[640 + lane * 4 + h], l1 = SC[640 + (64 + lane) * 4 + h];
        float m = 0.f;
        for (int c = 0; c < 128; ++c) { const float G = lane_get((c < 64) ? g0 : g1, c & 63), ml = lane_get((c < 64) ? l0 : l1, c & 63);
            const float mn = fmaxf(G + m, ml);
            if (lane == 0) { AL[h * 128 + c] = __expf(G + m - mn); BE[h * 128 + c] = __expf(ml - mn); if (blockIdx.x == 0) MPREV[c * 4 + h] = m; }
            m = mn; }
        if (blockIdx.x == 0 && lane == 0) A->out[O_MPO + h] = m; }
    __syncthreads();
    for (int idx = gid; idx < 4 * 32768; idx += gsz) { const int h = idx >> 15, el = (idx & 32767) * 2;
        float c0 = 0.f, c1 = 0.f;
        for (int cb = 0; cb < 128; cb += 32) { unsigned d[32];
#pragma unroll
            for (int j = 0; j < 32; ++j) d[j] = *(const unsigned*)(DC + ((size_t)((cb + j) * 4 + h) << 16) + el);
#pragma unroll
            for (int j = 0; j < 32; ++j) { const int c = cb + j; const float al = AL[h * 128 + c], be = BE[h * 128 + c];
                *(unsigned*)(CP + ((size_t)(c * 4 + h) << 16) + el) = pk2(c0, c1);
                c0 = al * c0 + be * __uint_as_float(d[j] << 16); c1 = al * c1 + be * __uint_as_float(d[j] & 0xffff0000u); } }
        *(f32x2_t*)(A->out + O_CP + ((size_t)h << 16) + el) = (f32x2_t){c0, c1}; }
    for (int idx = gid; idx < 4 * 256; idx += gsz) { const int h = idx >> 8, d = idx & 255; float n = 0.f;
        for (int cb = 0; cb < 128; cb += 32) { float dn[32];
#pragma unroll
            for (int j = 0; j < 32; ++j) dn[j] = DN[(size_t)((cb + j) * 4 + h) * 256 + d];
#pragma unroll
            for (int j = 0; j < 32; ++j) { const int c = cb + j; NP[(size_t)(c * 4 + h) * 256 + d] = n; n = AL[h * 128 + c] * n + BE[h * 128 + c] * dn[j]; } }
        A->out[O_NP + h * 256 + d] = n; }
    const float* C0 = A->in[5]; const float* N0 = A->in[6]; const float* M0 = A->in[7];
    for (int i0 = gid; i0 < 128 * 32768; i0 += 8 * gsz) {
        f32x2_t c[8]; unsigned d[8]; float m[8], G[8], ml[8];
#pragma unroll
        for (int k = 0; k < 8; ++k) { const int idx = i0 + k * gsz; if (idx < 128 * 32768) { const int bh = idx >> 15, el = (idx & 32767) * 2, ui = (128 + (bh >> 2)) * 4 + (bh & 3);
            m[k] = M0[bh]; G[k] = SC[ui]; ml[k] = SC[640 + ui]; c[k] = *(const f32x2_t*)(C0 + ((size_t)bh << 16) + el); d[k] = *(const unsigned*)(DC + ((size_t)ui << 16) + el); } }
#pragma unroll
        for (int k = 0; k < 8; ++k) { const int idx = i0 + k * gsz; if (idx < 128 * 32768) { const int bh = idx >> 15, el = (idx & 32767) * 2, ui = (128 + (bh >> 2)) * 4 + (bh & 3);
            const float mn = fmaxf(G[k] + m[k], ml[k]); const float al = __expf(G[k] + m[k] - mn), be = __expf(ml[k] - mn);
            *(unsigned*)(CP + ((size_t)ui << 16) + el) = pk2(c[k].x, c[k].y);
            *(f32x2_t*)(A->out + O_CS + ((size_t)bh << 16) + el) = (f32x2_t){al * c[k].x + be * __uint_as_float(d[k] << 16), al * c[k].y + be * __uint_as_float(d[k] & 0xffff0000u)};
            if (el == 0) { MPREV[ui] = m[k]; A->out[O_MSO + bh] = mn; } } } }
    for (int idx = gid; idx < 128 * 256; idx += gsz) { const int bh = idx >> 8, d = idx & 255, ui = (128 + (bh >> 2)) * 4 + (bh & 3);
        const float m = M0[bh], G = SC[ui], ml = SC[640 + ui]; const float mn = fmaxf(G + m, ml); const float al = __expf(G + m - mn), be = __expf(ml - mn);
        const float n = N0[idx]; NP[(size_t)ui * 256 + d] = n; A->out[O_NS + idx] = al * n + be * DN[(size_t)ui * 256 + d]; }
}
constexpr int MC_Q = 0, MC_K = 33792, MC_V = 67584, MC_S = 104448, MC_F = 113664;
constexpr int PQ = 528, PS = 144;
__device__ __forceinline__ void mlstm_phaseC(ArgsP A, LAS unsigned char* lds, int u, int h, int tid, int wave, int lane) {
    unsigned char* ws = A->ws; const bf16* PROJ = (const bf16*)(ws + WS_PROJ);
    const int L = (u < 128) ? 64 : 16, r0 = unit_row0(u), uh = u * 4 + h;
    LAS float* F = (LAS float*)(lds + MC_F);
    LAS float* rt = F, *gg = F + 64, *winter = F + 128, *eden = F + 192, *nq = F + 256, *denp = F + 320, *ssq = F + 448;
    const int i32 = lane & 31, hi = lane >> 5;
    LAS float* nl = F + 960;
    if (wave == 1) *(LAS f32x4*)(nl + 4 * lane) = *(const f32x4*)((const float*)(ws + WS_NPREV) + (size_t)uh * 256 + 4 * lane);
    if (wave == 0) {
        float ig, lf; load_gates(PROJ, A->in[21], A->in[22], u, h, lane, ig, lf);
        const float b = scan_add(lf, lane); const float g = (lane < L) ? ig - b : -INFINITY; const float cm = scan_max(g, lane);
        const float mprev = ((const float*)(ws + WS_SCAL))[1280 + uh]; const float mx = fmaxf(mprev, cm);
        rt[lane] = -mx; gg[lane] = g; winter[lane] = __expf(mprev - mx); eden[lane] = __expf(-(b + mx));
    }
    { const int c8 = 8 * (tid & 31), s0 = 4 * (tid >> 5);
      u32x4 qo[4], ko[4], vo[4];
      conv_rows4(PROJ, A->in[4], A->in[19], A->in[20], u, L, s0, h * 256 + c8, 1.f, qo);
      conv_rows4(PROJ, A->in[4], A->in[19], A->in[20], u, L, s0, 1024 + h * 256 + c8, 0.0625f, ko);
#pragma unroll
      for (int r = 0; r < 4; ++r) { vo[r] = (u32x4){0u, 0u, 0u, 0u}; if (s0 + r < L) vo[r] = *(const u32x4*)(PROJ + (size_t)(r0 + s0 + r) * NINP + C_VM + h * 256 + c8); }
#pragma unroll
      for (int r = 0; r < 4; ++r) { *(LAS u32x4*)(lds + MC_Q + (s0 + r) * PQ + c8 * 2) = qo[r]; *(LAS u32x4*)(lds + MC_K + (s0 + r) * PQ + c8 * 2) = ko[r]; *(LAS u32x4*)(lds + MC_V + (s0 + r) * PK + c8 * 2) = vo[r]; } }
    bf16x8 ca[16];
    { const bf16* Cp = (const bf16*)(ws + WS_CPREV) + ((size_t)uh * 256 + 32 * wave + i32) * 256 + 8 * hi;
#pragma unroll
      for (int kk = 0; kk < 16; ++kk) ca[kk] = *(const bf16x8*)(Cp + 16 * kk); }
    __syncthreads();
    if (wave < 3) {
        const int tt = (wave > 0) ? 1 : 0, st = (wave == 2) ? 1 : 0;
        f32x16 acc = {};
#pragma unroll 4
        for (int kk = 0; kk < 16; ++kk) { const bf16x8 a = *(LAS const bf16x8*)(lds + MC_K + (32 * st + i32) * PQ + (16 * kk + 8 * hi) * 2), b = *(LAS const bf16x8*)(lds + MC_Q + (32 * tt + i32) * PQ + (16 * kk + 8 * hi) * 2);
            acc = __builtin_amdgcn_mfma_f32_32x32x16_bf16(a, b, acc, 0, 0, 0); }
        const int t = 32 * tt + i32; const float rtt = rt[t]; float rs = 0.f;
#pragma unroll
        for (int g4 = 0; g4 < 4; ++g4) { const int s0 = 32 * st + 8 * g4 + 4 * hi; float v[4];
#pragma unroll
            for (int j = 0; j < 4; ++j) { const int s = s0 + j; const float e = __expf(rtt + gg[s]) * acc[4 * g4 + j]; v[j] = (s <= t) ? e : 0.f; rs += v[j]; }
            u32x2 o; o.x = pk2(v[0], v[1]); o.y = pk2(v[2], v[3]); *(LAS u32x2*)(lds + MC_S + t * PS + s0 * 2) = o; }
        rs = xhalf_sum(rs);
        if (hi == 0) { denp[st * 64 + t] = rs; if (wave == 0) denp[64 + t] = 0.f; }
    } else if (wave == 3) {
        const LAS float* np = nl + 8 * hi;
#pragma unroll
        for (int tt = 0; tt < 2; ++tt) { f32x16 acc = {};
#pragma unroll 4
            for (int kk = 0; kk < 16; ++kk) { u32x4 aw = {0u, 0u, 0u, 0u};
                if (i32 == 0) { const f32x4 n0 = *(const LAS f32x4*)(np + 16 * kk), n1 = *(const LAS f32x4*)(np + 16 * kk + 4); aw.x = pk2(n0[0], n0[1]); aw.y = pk2(n0[2], n0[3]); aw.z = pk2(n1[0], n1[1]); aw.w = pk2(n1[2], n1[3]); }
                const bf16x8 b = *(LAS const bf16x8*)(lds + MC_Q + (32 * tt + i32) * PQ + (16 * kk + 8 * hi) * 2);
                acc = __builtin_amdgcn_mfma_f32_32x32x16_bf16(__builtin_bit_cast(bf16x8, aw), b, acc, 0, 0, 0); }
            if (hi == 0) nq[32 * tt + i32] = acc[0]; }
    }
    __syncthreads();
    const int eb = wave, ntt = (L > 32) ? 2 : 1;
    u32x2 ovp[2][4]; f32x4 gmp[4];
#pragma unroll
    for (int g4 = 0; g4 < 4; ++g4) { const int e = 32 * eb + 8 * g4 + 4 * hi; gmp[g4] = *(const f32x4*)(A->in[23] + h * 256 + e);
#pragma unroll
        for (int tt = 0; tt < 2; ++tt) { const int t = 32 * tt + i32; ovp[tt][g4] = (u32x2){0u, 0u};
            if (t < L) ovp[tt][g4] = *(const u32x2*)(PROJ + (size_t)(r0 + t) * NINP + C_OM + h * 256 + e); } }
    bf16x8 va[4];
#pragma unroll
    for (int ks = 0; ks < 4; ++ks) { const int o = tr_off(PK, 16 * ks + 8 * hi, 32 * eb, lane); va[ks] = mk8(tr_rd(lds + MC_V + o), tr_rd(lds + MC_V + o + 4 * PK)); }
    f32x16 hv[2];
#pragma unroll
    for (int tt = 0; tt < 2; ++tt) { f32x16 acc = {};
        if (tt < ntt) { const int t = 32 * tt + i32;
#pragma unroll
            for (int kk = 0; kk < 16; ++kk) { const bf16x8 b = *(LAS const bf16x8*)(lds + MC_Q + t * PQ + (16 * kk + 8 * hi) * 2);
                acc = __builtin_amdgcn_mfma_f32_32x32x16_bf16(ca[kk], b, acc, 0, 0, 0); }
            const float wi = winter[t];
#pragma unroll
            for (int r = 0; r < 16; ++r) acc[r] *= wi;
#pragma unroll
            for (int ks = 0; ks < 4; ++ks) if (ks < 2 * (tt + 1)) { const bf16x8 b = *(LAS const bf16x8*)(lds + MC_S + t * PS + (16 * ks + 8 * hi) * 2);
                acc = __builtin_amdgcn_mfma_f32_32x32x16_bf16(va[ks], b, acc, 0, 0, 0); }
            const float den = wi * nq[t] + denp[t] + denp[64 + t]; const float inv = 1.f / fmaxf(fabsf(den), eden[t]); float sq = 0.f;
#pragma unroll
            for (int r = 0; r < 16; ++r) { acc[r] *= inv; sq += acc[r] * acc[r]; }
            sq = xhalf_sum(sq); if (hi == 0) ssq[wave * 64 + t] = sq; }
        hv[tt] = acc; }
    __syncthreads();
    bf16* MIX = (bf16*)(ws + WS_MIX);
#pragma unroll
    for (int tt = 0; tt < 2; ++tt) if (tt < ntt) { const int t = 32 * tt + i32;
        if (t < L) { float tot = 0.f;
#pragma unroll
            for (int w = 0; w < 8; ++w) tot += ssq[w * 64 + t];
            const float rstd = 1.f / sqrtf(tot * (1.f / 256.f) + EPS); const size_t row = (size_t)(r0 + t);
#pragma unroll
            for (int g4 = 0; g4 < 4; ++g4) { const int e = 32 * eb + 8 * g4 + 4 * hi; const f32x4 g = gmp[g4];
                const u32x2 ov = ovp[tt][g4];
                const float o0 = sigmoid_f(__uint_as_float(ov.x << 16)), o1 = sigmoid_f(__uint_as_float(ov.x & 0xffff0000u)), o2 = sigmoid_f(__uint_as_float(ov.y << 16)), o3 = sigmoid_f(__uint_as_float(ov.y & 0xffff0000u));
                u32x2 w; w.x = pk2(hv[tt][4 * g4] * rstd * g[0] * o0, hv[tt][4 * g4 + 1] * rstd * g[1] * o1); w.y = pk2(hv[tt][4 * g4 + 2] * rstd * g[2] * o2, hv[tt][4 * g4 + 3] * rstd * g[3] * o3);
                *(u32x2*)(MIX + row * DM + 1024 + h * 256 + e) = w; } } }
    __syncthreads();
}
constexpr int AT_PKT = 272, AT_PVT = 320, AT_V = 17408, AT_BUF = 37888;
struct AttnState { f32x16 o[4]; bf16x8 pf[4]; float m, l; };
__device__ __forceinline__ float xhalf_max(float v) { auto rr = __builtin_amdgcn_permlane32_swap(__float_as_uint(v), __float_as_uint(v), false, false); return fmaxf(__uint_as_float(rr[0]), __uint_as_float(rr[1])); }
constexpr float ATT_THR = 6.0f;
__device__ __forceinline__ void attn_qk(LAS const unsigned char* kt, int map, const bf16x8 (&qf)[4], const AttnState& S, f32x16 (&p)[2], int lane) {
    const int i32 = lane & 31, hi = lane >> 5;
#pragma unroll
    for (int kb = 0; kb < 2; ++kb) { f32x16 acc = {};
#pragma unroll
        for (int d0 = 0; d0 < 4; ++d0) { const bf16x8 a = *(LAS const bf16x8*)(kt + (32 * kb + i32) * AT_PKT + (64 * map + 16 * d0 + 8 * hi) * 2);
            acc = __builtin_amdgcn_mfma_f32_32x32x16_bf16(a, qf[d0], acc, 0, 0, 0); }
        p[kb] = acc; }
}
__device__ __forceinline__ void attn_pv(LAS const unsigned char* vt, AttnState& S, int lane) {
    const int hi = lane >> 5;
    LAS const unsigned char* base = vt + tr_off(AT_PVT, 4 * hi, 0, lane);
#pragma unroll
    for (int st = 0; st < 4; ++st) { s16x4 lo[4], hh[4];
#pragma unroll
        for (int eb = 0; eb < 4; ++eb) { lo[eb] = tr_rd(base + st * 16 * AT_PVT + eb * 64); hh[eb] = tr_rd(base + st * 16 * AT_PVT + eb * 64 + 8 * AT_PVT); }
#pragma unroll
        for (int eb = 0; eb < 4; ++eb) S.o[eb] = __builtin_amdgcn_mfma_f32_32x32x16_bf16(mk8(lo[eb], hh[eb]), S.pf[st], S.o[eb], 0, 0, 0);
    }
}
__device__ __forceinline__ void attn_softmax(f32x16 (&p)[2], AttnState& S, int nvalid, int lane) {
    const int hi = lane >> 5;
    if (nvalid < 64) {
#pragma unroll
        for (int kb = 0; kb < 2; ++kb)
#pragma unroll
            for (int r = 0; r < 16; ++r) if (32 * kb + crow(r, hi) >= nvalid) p[kb][r] = -INFINITY; }
    float ma = fmaxf(fmaxf(p[0][0], p[0][1]), p[1][0]), mb = fmaxf(fmaxf(p[0][2], p[0][3]), p[1][1]);
    ma = fmaxf(fmaxf(ma, p[1][2]), p[1][3]);
#pragma unroll
    for (int r = 4; r < 16; r += 4) { ma = fmaxf(fmaxf(ma, p[0][r]), p[0][r + 1]); mb = fmaxf(fmaxf(mb, p[0][r + 2]), p[0][r + 3]); ma = fmaxf(fmaxf(ma, p[1][r]), p[1][r + 1]); mb = fmaxf(fmaxf(mb, p[1][r + 2]), p[1][r + 3]); }
    const float mref = S.m; const float mx = xhalf_max(fmaxf(ma, mb)) - mref;
#pragma unroll
    for (int kb = 0; kb < 2; ++kb)
#pragma unroll
        for (int r = 0; r < 16; ++r) p[kb][r] = __builtin_amdgcn_exp2f(p[kb][r] - mref);
    if (__any(mx > ATT_THR)) {
        const float dl = fmaxf(mx, 0.f); S.m += dl;
        const float f = __builtin_amdgcn_exp2f(-dl); S.l *= f;
#pragma unroll
        for (int kb = 0; kb < 2; ++kb)
#pragma unroll
            for (int r = 0; r < 16; ++r) p[kb][r] *= f;
#pragma unroll
        for (int eb = 0; eb < 4; ++eb)
#pragma unroll
            for (int r = 0; r < 16; ++r) S.o[eb][r] *= f;
    }
    float sa = 0.f, sb = 0.f;
#pragma unroll
    for (int kb = 0; kb < 2; ++kb)
#pragma unroll
        for (int r = 0; r < 16; r += 2) { sa += p[kb][r]; sb += p[kb][r + 1]; }
    S.l += sa + sb;
#pragma unroll
    for (int kb = 0; kb < 2; ++kb)
#pragma unroll
        for (int ks = 0; ks < 2; ++ks) { u32x4 pw; pw.x = pk2(p[kb][8 * ks], p[kb][8 * ks + 1]); pw.y = pk2(p[kb][8 * ks + 2], p[kb][8 * ks + 3]); pw.z = pk2(p[kb][8 * ks + 4], p[kb][8 * ks + 5]); pw.w = pk2(p[kb][8 * ks + 6], p[kb][8 * ks + 7]);
            S.pf[2 * kb + ks] = __builtin_bit_cast(bf16x8, pw); }
}
__device__ __forceinline__ void attn_step(LAS const unsigned char* ktn, LAS const unsigned char* vtc, int map, const bf16x8 (&qf)[4], AttnState& S, int lane) {
    const int i32 = lane & 31, hi = lane >> 5;
    f32x16 p[2];
    LAS const unsigned char* base = vtc + tr_off(AT_PVT, 4 * hi, 0, lane);
    s16x4 lo[2][4], hh[2][4];
#pragma unroll
    for (int eb = 0; eb < 4; ++eb) { lo[0][eb] = tr_rd(base + eb * 64); hh[0][eb] = tr_rd(base + eb * 64 + 8 * AT_PVT); }
#pragma unroll
    for (int kb = 0; kb < 2; ++kb) { f32x16 acc = {};
#pragma unroll
        for (int d0 = 0; d0 < 4; ++d0) { const bf16x8 a = *(LAS const bf16x8*)(ktn + (32 * kb + i32) * AT_PKT + (64 * map + 16 * d0 + 8 * hi) * 2);
            acc = __builtin_amdgcn_mfma_f32_32x32x16_bf16(a, qf[d0], acc, 0, 0, 0); }
        p[kb] = acc; }
    const float mref = S.m;
    __builtin_amdgcn_sched_barrier(0);
#pragma unroll
    for (int st = 0; st < 4; ++st) {
        if (st < 3) {
#pragma unroll
            for (int eb = 0; eb < 4; ++eb) { lo[(st + 1) & 1][eb] = tr_rd(base + (st + 1) * 16 * AT_PVT + eb * 64); hh[(st + 1) & 1][eb] = tr_rd(base + (st + 1) * 16 * AT_PVT + eb * 64 + 8 * AT_PVT); } }
        __builtin_amdgcn_sched_barrier(0);
#pragma unroll
        for (int eb = 0; eb < 4; ++eb) {
            S.o[eb] = __builtin_amdgcn_mfma_f32_32x32x16_bf16(mk8(lo[st & 1][eb], hh[st & 1][eb]), S.pf[st], S.o[eb], 0, 0, 0);
            const int e0 = 2 * (4 * st + eb);
            p[e0 >> 4][e0 & 15] = __builtin_amdgcn_exp2f(p[e0 >> 4][e0 & 15] - mref); p[e0 >> 4][(e0 & 15) + 1] = __builtin_amdgcn_exp2f(p[e0 >> 4][(e0 & 15) + 1] - mref);
            __builtin_amdgcn_sched_barrier(0);
        }
    }
    float ma = fmaxf(fmaxf(p[0][0], p[0][1]), p[1][0]), mb = fmaxf(fmaxf(p[0][2], p[0][3]), p[1][1]);
    ma = fmaxf(fmaxf(ma, p[1][2]), p[1][3]);
#pragma unroll
    for (int r = 4; r < 16; r += 4) { ma = fmaxf(fmaxf(ma, p[0][r]), p[0][r + 1]); mb = fmaxf(fmaxf(mb, p[0][r + 2]), p[0][r + 3]); ma = fmaxf(fmaxf(ma, p[1][r]), p[1][r + 1]); mb = fmaxf(fmaxf(mb, p[1][r + 2]), p[1][r + 3]); }
    const float emx = xhalf_max(fmaxf(ma, mb));
    if (__any(emx > 64.0f)) {
        const float dl = fmaxf(__builtin_amdgcn_logf(emx), 0.f);
        S.m += dl;
        const float f = __builtin_amdgcn_exp2f(-dl); S.l *= f;
#pragma unroll
        for (int kb = 0; kb < 2; ++kb)
#pragma unroll
            for (int r = 0; r < 16; ++r) p[kb][r] *= f;
#pragma unroll
        for (int eb = 0; eb < 4; ++eb)
#pragma unroll
            for (int r = 0; r < 16; ++r) S.o[eb][r] *= f;
    }
    float sa = 0.f, sb = 0.f;
#pragma unroll
    for (int kb = 0; kb < 2; ++kb)
#pragma unroll
        for (int r = 0; r < 16; r += 2) { sa += p[kb][r]; sb += p[kb][r + 1]; }
    S.l += sa + sb;
#pragma unroll
    for (int kb = 0; kb < 2; ++kb)
#pragma unroll
        for (int ks = 0; ks < 2; ++ks) { u32x4 pw; pw.x = pk2(p[kb][8 * ks], p[kb][8 * ks + 1]); pw.y = pk2(p[kb][8 * ks + 2], p[kb][8 * ks + 3]); pw.z = pk2(p[kb][8 * ks + 4], p[kb][8 * ks + 5]); pw.w = pk2(p[kb][8 * ks + 6], p[kb][8 * ks + 7]);
            S.pf[2 * kb + ks] = __builtin_bit_cast(bf16x8, pw); }
}
__device__ __forceinline__ void attn_tile(LAS const unsigned char* kt, LAS const unsigned char* vt, int map, const bf16x8 (&qf)[4], AttnState& S, int nvalid, int lane) {
    f32x16 p[2]; attn_qk(kt, map, qf, S, p, lane); attn_softmax(p, S, nvalid, lane); attn_pv(vt, S, lane);
}
__device__ __forceinline__ void attn_finish(ArgsP A, LAS unsigned char* lds, AttnState& S, int map, int g, int h, size_t row_base, int nrows, float lam, int lane) {
    const int i32 = lane & 31, hi = lane >> 5;
    const float lt = xhalf_sum(S.l); const float inv = 1.f / lt;
    LAS float* X = (LAS float*)lds + g * 4096;
    __syncthreads();
    if (map == 1) {
#pragma unroll
        for (int eb = 0; eb < 4; ++eb)
#pragma unroll
            for (int r = 0; r < 16; ++r) X[(32 * eb + crow(r, hi)) * 32 + i32] = S.o[eb][r] * inv; }
    __syncthreads();
    if (map == 0) { float sq = 0.f;
#pragma unroll
        for (int eb = 0; eb < 4; ++eb)
#pragma unroll
            for (int r = 0; r < 16; ++r) { const float v = S.o[eb][r] * inv - lam * X[(32 * eb + crow(r, hi)) * 32 + i32]; S.o[eb][r] = v; sq += v * v; }
        sq = xhalf_sum(sq);
        const float rstd = (1.f - LAM_INIT) / sqrtf(sq * (1.f / 128.f) + EPS);
        if (i32 < nrows) { bf16* mp = (bf16*)(A->ws + WS_MIX) + (row_base + i32) * DM + h * 128; const float* gs = A->in[18] + h * 128;
#pragma unroll
            for (int eb = 0; eb < 4; ++eb)
#pragma unroll
                for (int g4 = 0; g4 < 4; ++g4) { const int e = 32 * eb + 8 * g4 + 4 * hi; const f32x4 gv = *(const f32x4*)(gs + e);
                    u32x2 w; w.x = pk2(S.o[eb][4 * g4] * rstd * gv[0], S.o[eb][4 * g4 + 1] * rstd * gv[1]); w.y = pk2(S.o[eb][4 * g4 + 2] * rstd * gv[2], S.o[eb][4 * g4 + 3] * rstd * gv[3]);
                    *(u32x2*)(mp + e) = w; } } }
    __syncthreads();
}
__device__ __forceinline__ void attn_prompt_unit(ArgsP A, LAS unsigned char* lds, int h, int qb, float lam, int tid, int wave, int lane) {
    unsigned char* ws = A->ws; const bf16* QA = (const bf16*)(ws + WS_QA); const bf16* KA = (const bf16*)(ws + WS_KA); const bf16* PROJ = (const bf16*)(ws + WS_PROJ);
    const int map = wave & 1, g = wave >> 1, i32 = lane & 31, hi = lane >> 5;
    const int ntiles = 2 * qb + 2, mytiles = 2 * qb + (g >> 1) + 1;
    bf16x8 qf[4];
    { const bf16* qp = QA + (size_t)(128 * qb + 32 * g + i32) * 1024 + h * 128 + 64 * map + 8 * hi;
#pragma unroll
      for (int d0 = 0; d0 < 4; ++d0) qf[d0] = *(const bf16x8*)(qp + 16 * d0); }
    AttnState S; S.m = 0.f; S.l = 0.f;
#pragma unroll
    for (int i = 0; i < 4; ++i) S.pf[i] = (bf16x8){0, 0, 0, 0, 0, 0, 0, 0};
#pragma unroll
    for (int eb = 0; eb < 4; ++eb) S.o[eb] = (f32x16){};
    const int key = tid >> 3, seg = tid & 7;
    const bf16* kp = KA + (size_t)key * 1024 + h * 128 + 16 * seg; const bf16* vp = PROJ + (size_t)key * NINP + C_VA + h * 128 + 16 * seg;
    const int ko = key * AT_PKT + seg * 32, vo = AT_V + key * AT_PVT + seg * 32;
    { u32x4 k0 = *(const u32x4*)kp, k1 = *(const u32x4*)(kp + 8), v0 = *(const u32x4*)vp, v1 = *(const u32x4*)(vp + 8);
      const bf16* kq = kp + (size_t)64 * 1024; const bf16* vq = vp + (size_t)64 * NINP;
      u32x4 k2 = *(const u32x4*)kq, k3 = *(const u32x4*)(kq + 8), v2 = *(const u32x4*)vq, v3 = *(const u32x4*)(vq + 8);
      *(LAS u32x4*)(lds + ko) = k0; *(LAS u32x4*)(lds + ko + 16) = k1; *(LAS u32x4*)(lds + vo) = v0; *(LAS u32x4*)(lds + vo + 16) = v1;
      *(LAS u32x4*)(lds + AT_BUF + ko) = k2; *(LAS u32x4*)(lds + AT_BUF + ko + 16) = k3; *(LAS u32x4*)(lds + AT_BUF + vo) = v2; *(LAS u32x4*)(lds + AT_BUF + vo + 16) = v3; }
    __syncthreads();
    { f32x16 p[2]; attn_qk(lds, map, qf, S, p, lane); attn_softmax(p, S, 64, lane); }
    int bc = 0, bn = AT_BUF, bw = 2 * AT_BUF;
    for (int j = 0; j < ntiles; ++j) {
        const bool more = (j + 2 < ntiles);
        u32x4 k0, k1, v0, v1;
        if (more) { const bf16* kq = kp + (size_t)(j + 2) * 64 * 1024; const bf16* vq = vp + (size_t)(j + 2) * 64 * NINP;
            k0 = *(const u32x4*)kq; k1 = *(const u32x4*)(kq + 8); v0 = *(const u32x4*)vq; v1 = *(const u32x4*)(vq + 8); }
        if (j + 1 < mytiles) attn_step(lds + bn, lds + bc + AT_V, map, qf, S, lane);
        else if (j < mytiles) attn_pv(lds + bc + AT_V, S, lane);
        if (more) { LAS unsigned char* w = lds + bw; *(LAS u32x4*)(w + ko) = k0; *(LAS u32x4*)(w + ko + 16) = k1; *(LAS u32x4*)(w + vo) = v0; *(LAS u32x4*)(w + vo + 16) = v1; }
        __syncthreads();
        const int t = bc; bc = bn; bn = bw; bw = t;
    }
    attn_finish(A, lds, S, map, g, h, (size_t)(128 * qb + 32 * g), 32, lam, lane);
}
__device__ __forceinline__ void attn_sample_unit(ArgsP A, LAS unsigned char* lds, int b, int h, float lam, int tid, int wave, int lane) {
    unsigned char* ws = A->ws; const bf16* QA = (const bf16*)(ws + WS_QA); const bf16* KA = (const bf16*)(ws + WS_KA); const bf16* PROJ = (const bf16*)(ws + WS_PROJ);
    const int map = wave & 1, i32 = lane & 31, hi = lane >> 5; const bool comp = wave < 2;
    bf16x8 qf[4];
#pragma unroll
    for (int d0 = 0; d0 < 4; ++d0) qf[d0] = (bf16x8){0, 0, 0, 0, 0, 0, 0, 0};
    if (i32 < 16) { const bf16* qp = QA + (size_t)(MP + 16 * b + i32) * 1024 + h * 128 + 64 * map + 8 * hi;
#pragma unroll
      for (int d0 = 0; d0 < 4; ++d0) qf[d0] = *(const bf16x8*)(qp + 16 * d0); }
    AttnState S; S.m = 0.f; S.l = 0.f;
#pragma unroll
    for (int i = 0; i < 4; ++i) S.pf[i] = (bf16x8){0, 0, 0, 0, 0, 0, 0, 0};
#pragma unroll
    for (int eb = 0; eb < 4; ++eb) S.o[eb] = (f32x16){};
    const int key = tid >> 3, seg = tid & 7;
    const float* kc = A->in[2] + (((size_t)b * PAST + key) * 8 + h) * 128 + 16 * seg; const float* vc = A->in[3] + (((size_t)b * PAST + key) * 8 + h) * 128 + 16 * seg;
    const int ko = key * AT_PKT + seg * 32, vo = AT_V + key * AT_PVT + seg * 32;
    f32x4 kr[4], vr[4];
#pragma unroll
    for (int i = 0; i < 4; ++i) { kr[i] = *(const f32x4*)(kc + 4 * i); vr[i] = *(const f32x4*)(vc + 4 * i); }
    for (int j = 0; j < 17; ++j) {
        LAS unsigned char* nb = lds + (j & 1) * AT_BUF;
        if (j < 16) { u32x4 a, c;
            a.x = pk2(kr[0][0], kr[0][1]); a.y = pk2(kr[0][2], kr[0][3]); a.z = pk2(kr[1][0], kr[1][1]); a.w = pk2(kr[1][2], kr[1][3]);
            c.x = pk2(kr[2][0], kr[2][1]); c.y = pk2(kr[2][2], kr[2][3]); c.z = pk2(kr[3][0], kr[3][1]); c.w = pk2(kr[3][2], kr[3][3]);
            *(LAS u32x4*)(nb + ko) = a; *(LAS u32x4*)(nb + ko + 16) = c;
            a.x = pk2(vr[0][0], vr[0][1]); a.y = pk2(vr[0][2], vr[0][3]); a.z = pk2(vr[1][0], vr[1][1]); a.w = pk2(vr[1][2], vr[1][3]);
            c.x = pk2(vr[2][0], vr[2][1]); c.y = pk2(vr[2][2], vr[2][3]); c.z = pk2(vr[3][0], vr[3][1]); c.w = pk2(vr[3][2], vr[3][3]);
            *(LAS u32x4*)(nb + vo) = a; *(LAS u32x4*)(nb + vo + 16) = c;
        } else { u32x4 a = {0u, 0u, 0u, 0u}, c = a, d = a, e = a;
            if (key < 16) { const bf16* kq = KA + (size_t)(MP + 16 * b + key) * 1024 + h * 128 + 16 * seg; const bf16* vq = PROJ + (size_t)(MP + 16 * b + key) * NINP + C_VA + h * 128 + 16 * seg;
                a = *(const u32x4*)kq; c = *(const u32x4*)(kq + 8); d = *(const u32x4*)vq; e = *(const u32x4*)(vq + 8); }
            *(LAS u32x4*)(nb + ko) = a; *(LAS u32x4*)(nb + ko + 16) = c; *(LAS u32x4*)(nb + vo) = d; *(LAS u32x4*)(nb + vo + 16) = e; }
        if (j + 1 < 16) {
#pragma unroll
            for (int i = 0; i < 4; ++i) { kr[i] = *(const f32x4*)(kc + (size_t)(j + 1) * 64 * 1024 + 4 * i); vr[i] = *(const f32x4*)(vc + (size_t)(j + 1) * 64 * 1024 + 4 * i); } }
        __syncthreads();
        if (comp) attn_tile(nb, nb + AT_V, map, qf, S, (j < 16) ? 64 : 16, lane);
    }
    attn_finish(A, lds, S, comp ? map : 2, 0, h, (size_t)(MP + 16 * b), 16, lam, lane);
}
template <int NPART> __device__ __forceinline__ void final_norm_rows(float* y, const float* __restrict__ g, int wave, int lane, const float* x1S, const bf16* part, const float* gate) {
    const int gw = blockIdx.x * NW + wave, NGW = gridDim.x * NW;
    for (int r = gw; r < MTOK; r += NGW) { float* yr = y + (size_t)r * DM; f32x4 v[8]; float s = 0.f;
        if (r < MP) {
#pragma unroll
            for (int j = 0; j < 8; ++j) v[j] = *(const f32x4*)(yr + 256 * j + 4 * lane);
        } else {
            const float* gr = gate + (size_t)(1 + ((r - MP) >> 4)) * 12288;
#pragma unroll
            for (int j = 0; j < 8; ++j) { const int c = 256 * j + 4 * lane; f32x4 a = {0.f, 0.f, 0.f, 0.f};
                f32x4 t[NPART];
#pragma unroll
                for (int p = 0; p < NPART; ++p) t[p] = ld_bf4(part + ((size_t)p * MS + (r - MP)) * DM + c);
#pragma unroll
                for (int p = 0; p < NPART; ++p) a += t[p];
                v[j] = *(const f32x4*)(x1S + (size_t)(r - MP) * DM + c) + *(const f32x4*)(gr + c) * a; } }
#pragma unroll
        for (int j = 0; j < 8; ++j) s += (v[j].x * v[j].x + v[j].y * v[j].y) + (v[j].z * v[j].z + v[j].w * v[j].w);
        const float rstd = 1.f / sqrtf(wave_sum(s, lane) * (1.f / DM) + EPS);
#pragma unroll
        for (int j = 0; j < 8; ++j) { const f32x4 gg = *(const f32x4*)(g + 256 * j + 4 * lane); *(f32x4*)(yr + 256 * j + 4 * lane) = v[j] * rstd * gg; } }
}
__global__ void __launch_bounds__(NT, 2) fwd_megakernel(Args A_) {
    extern __shared__ __attribute__((aligned(16))) unsigned char lds_raw[];
    LAS unsigned char* lds = (LAS unsigned char*)lds_raw;
    cg::grid_group grid = cg::this_grid();
    int tid, lane, wave;
#define FRESH_TID() do { tid = threadIdx.x; asm volatile("" : "+v"(tid)); lane = tid & 63; wave = __builtin_amdgcn_readfirstlane(tid >> 6); } while (0)
    FRESH_TID();
    ArgsP A = FRESH_ARGS();
    unsigned char* ws = A->ws;
    float* mod = (float*)(ws + WS_MOD);
    const int G = gridDim.x, bid = blockIdx.x;
    A = FRESH_ARGS(); ws = A->ws; mod = (float*)(ws + WS_MOD); FRESH_TID();
    if (tid < 2) ((volatile LAS unsigned*)(lds + LDS_BYTES - 16))[tid] = 0u;
    __syncthreads();
    XcdBarrier xb = xcd_barrier_post((unsigned*)(ws + WS_FLAG) + 1024, (volatile LAS unsigned*)(lds + LDS_BYTES - 16));
    if (ws == nullptr) grid.sync();
#ifndef NO_P0
    p0_prologue(A, lds, tid, wave, lane);
#endif
    xcd_barrier(xb);
    A = FRESH_ARGS(); ws = A->ws; mod = (float*)(ws + WS_MOD); FRESH_TID();
    norm_mod_rows<0>(A->in[0], A->in[1], A->in[12], mod, 0, 2048, (bf16*)(ws + WS_XN), wave, lane);
    xcd_barrier(xb);
    A = FRESH_ARGS(); ws = A->ws; mod = (float*)(ws + WS_MOD); FRESH_TID();
    { pg8::Gemm g{(const pg8::bf16_t*)(ws + WS_XN), (const pg8::bf16_t*)(ws + WS_WIN), MTOK, NINP, DM, DM}; pg8::StaticOrder S; S.init(MTOK, NINP, G, bid);
      pg8::EpiStore<0> E{(pg8::bf16_t*)(ws + WS_PROJ), NINP};
      pg8::gemm_phase<pg8::EpiStore<0>, pg8::StaticOrder, true, true>(lds, g, S, E); }
    xcd_barrier(xb);
    A = FRESH_ARGS(); ws = A->ws; mod = (float*)(ws + WS_MOD); FRESH_TID();
#ifndef NO_P3
    p3_post(A, tid);
#endif
#ifndef NO_PA
    for (int i = bid; i < NCH * 4; i += G) mlstm_phaseA(A, lds, i >> 2, i & 3, tid, wave, lane);
#endif
    xcd_barrier(xb);
    A = FRESH_ARGS(); ws = A->ws; mod = (float*)(ws + WS_MOD); FRESH_TID();
#ifndef NO_PB
    mlstm_phaseB(A, lds, tid, wave, lane);
#endif
    xcd_barrier(xb);
    A = FRESH_ARGS(); ws = A->ws; mod = (float*)(ws + WS_MOD); FRESH_TID();
    { const float s1 = wave_sum(A->in[14][lane] * A->in[15][lane], lane), s2 = wave_sum(A->in[16][lane] * A->in[17][lane], lane);
      const float lam = __expf(s1) - __expf(s2) + LAM_INIT;
      for (int i = bid; i < 256; i += G) { const int h = i & 7, p = i >> 3; const int rot = (p & 1) ? 0 : 3;
          for (int sl = 0; sl < 6; ++sl) { int kk = sl + rot; if (kk >= 6) kk -= 6;
              FRESH_TID();
              if (kk < 2) attn_prompt_unit(A, lds, h, kk == 0 ? 63 - p : p, lam, tid, wave, lane);
              else if (kk == 2) attn_sample_unit(A, lds, i >> 3, i & 7, lam, tid, wave, lane);
              else { const int cu = i + 256 * (kk - 3); if (cu < NCH * 4) mlstm_phaseC(A, lds, cu >> 2, cu & 3, tid, wave, lane); } } }
    }
    xcd_barrier(xb);
    A = FRESH_ARGS(); ws = A->ws; mod = (float*)(ws + WS_MOD); FRESH_TID();
    { pg8::Gemm g{(const pg8::bf16_t*)(ws + WS_MIX), (const pg8::bf16_t*)(ws + WS_WOUT), MP, DM, DM, DM}; pg8::StaticOrder S; S.init(MP, DM, G, bid);
      pg8::EpiResid E{A->in[0], A->in[1], mod + 4096, (float*)(ws + WS_X1)};
      pg8::gemm_phase<pg8::EpiResid, pg8::StaticOrder, true, true>(lds, g, S, E); }
    for (int un = bid; un < 128; un += G) { const int tile = un >> 3, kc = un & 7;
      pg8::Gemm g{(const pg8::bf16_t*)(ws + WS_MIX) + 256 * kc, (const pg8::bf16_t*)(ws + WS_WOUT) + 256 * kc, MTOK, DM, 256, DM}; pg8::OneUnit S{{32 + (tile >> 3), tile & 7}};
      pg8::EpiPart E{(pg8::bf16_t*)(ws + WS_PART6) + (size_t)kc * MS * DM, DM};
      pg8::gemm_phase<pg8::EpiPart, pg8::OneUnit, false, true>(lds, g, S, E); }
    xcd_barrier(xb);
    A = FRESH_ARGS(); ws = A->ws; mod = (float*)(ws + WS_MOD); FRESH_TID();
    norm_mod_rows<8>((const float*)(ws + WS_X1), A->in[1], A->in[25], mod, 6144, 8192, (bf16*)(ws + WS_XN), wave, lane, (const bf16*)(ws + WS_PART6), 4096, (float*)(ws + WS_X1) + (size_t)MP * DM);
    xcd_barrier(xb);
    A = FRESH_ARGS(); ws = A->ws; mod = (float*)(ws + WS_MOD); FRESH_TID();
    { pg8::Gemm g{(const pg8::bf16_t*)(ws + WS_XN), (const pg8::bf16_t*)(ws + WS_WUP), MP, DFF, DM, DM}; pg8::StaticOrder S; S.init(MP, DFF, G, bid);
      pg8::EpiStore<2> E{(pg8::bf16_t*)(ws + WS_H), DFF};
      pg8::gemm_phase<pg8::EpiStore<2>, pg8::StaticOrder, true, true>(lds, g, S, E); }
    for (int un = bid; un < 256; un += G) { const int tile = un >> 2, kq = un & 3;
      pg8::Gemm g{(const pg8::bf16_t*)(ws + WS_XN) + 512 * kq, (const pg8::bf16_t*)(ws + WS_WUP) + 512 * kq, MTOK, DFF, 512, DM}; pg8::OneUnit S{{32 + (tile >> 5), tile & 31}};
      pg8::EpiPart E{(pg8::bf16_t*)(ws + WS_PART8) + (size_t)kq * MS * DFF, DFF};
      pg8::gemm_phase<pg8::EpiPart, pg8::OneUnit, false, true>(lds, g, S, E); }
    xcd_barrier(xb);
    A = FRESH_ARGS(); ws = A->ws; mod = (float*)(ws + WS_MOD); FRESH_TID();
    { const bf16* P8 = (const bf16*)(ws + WS_PART8); bf16* H = (bf16*)(ws + WS_H);
      for (int r = bid; r < MS; r += G)
          for (int c = 4 * tid; c < DFF; c += 4 * NT) { f32x4 a = ld_bf4(P8 + (size_t)r * DFF + c);
#pragma unroll
              for (int p = 1; p < 4; ++p) a += ld_bf4(P8 + ((size_t)p * MS + r) * DFF + c);
              a.x = fmaxf(a.x, 0.f); a.y = fmaxf(a.y, 0.f); a.z = fmaxf(a.z, 0.f); a.w = fmaxf(a.w, 0.f);
              u32x2 o; o.x = pk2(a.x * a.x, a.y * a.y); o.y = pk2(a.z * a.z, a.w * a.w); *(u32x2*)(H + (size_t)(MP + r) * DFF + c) = o; }
      __threadfence(); __syncthreads();
      if (tid == 0) __hip_atomic_fetch_add((unsigned*)(ws + WS_FLAG), 1u, __ATOMIC_RELEASE, __HIP_MEMORY_SCOPE_AGENT); }
    { pg8::Gemm g{(const pg8::bf16_t*)(ws + WS_H), (const pg8::bf16_t*)(ws + WS_WDN), MP, DM, DFF, DFF}; pg8::StaticOrder S; S.init(MP, DM, G, bid);
      pg8::EpiResid E{(const float*)(ws + WS_X1), (const float*)(ws + WS_X1) + (size_t)MP * DM, mod + 10240, A->out};
      pg8::gemm_phase<pg8::EpiResid, pg8::StaticOrder, true, true>(lds, g, S, E); }
    { if (tid == 0) { while (__hip_atomic_load((unsigned*)(ws + WS_FLAG), __ATOMIC_ACQUIRE, __HIP_MEMORY_SCOPE_AGENT) < (unsigned)G) __builtin_amdgcn_s_sleep(8); }
      __syncthreads(); __builtin_amdgcn_fence(__ATOMIC_ACQUIRE, "agent"); }
    for (int un = bid; un < 256; un += G) { const int tile = un >> 4, kc = un & 15;
      pg8::Gemm g{(const pg8::bf16_t*)(ws + WS_H) + 512 * kc, (const pg8::bf16_t*)(ws + WS_WDN) + 512 * kc, MTOK, DM, 512, DFF}; pg8::OneUnit S{{32 + (tile >> 3), tile & 7}};
      pg8::EpiPart E{(pg8::bf16_t*)(ws + WS_PART9) + (size_t)kc * MS * DM, DM};
      pg8::gemm_phase<pg8::EpiPart, pg8::OneUnit, false, true>(lds, g, S, E); }
    xcd_barrier(xb);
    A = FRESH_ARGS(); ws = A->ws; mod = (float*)(ws + WS_MOD); FRESH_TID();
    final_norm_rows<16>(A->out, A->in[28], wave, lane, (const float*)(ws + WS_X1) + (size_t)MP * DM, (const bf16*)(ws + WS_PART9), mod + 10240);
}

extern "C" void kernel_launch(void* const* d_in, const int* in_sizes, int n_in, void* d_out, int out_size, void* d_ws, size_t ws_size, hipStream_t stream) {
    static int grid = 0;
    if (grid == 0) {
        if (n_in != 29 || ws_size < WS_END) { fprintf(stderr, "kernel_launch: unexpected n_in %d / ws %zu\n", n_in, ws_size); grid = -1; return; }
        int dev = 0, cus = 0, per_cu = 0;
        (void)hipGetDevice(&dev); (void)hipDeviceGetAttribute(&cus, hipDeviceAttributeMultiprocessorCount, dev);
        (void)hipFuncSetAttribute((const void*)fwd_megakernel, hipFuncAttributeMaxDynamicSharedMemorySize, LDS_BYTES);
        (void)hipOccupancyMaxActiveBlocksPerMultiprocessor(&per_cu, (const void*)fwd_megakernel, NT, LDS_BYTES);
        (void)hipGetLastError();
        grid = cus;
    }
    if (grid < 0) return;
    (void)hipMemsetAsync((char*)d_ws + WS_FLAG, 0, 32768, stream);
    Args a{};
    for (int i = 0; i < 29; ++i) a.in[i] = (const float*)d_in[i];
    a.out = (float*)d_out; a.ws = (unsigned char*)d_ws;
    void* args[] = {&a};
    hipError_t e = hipLaunchCooperativeKernel((void*)fwd_megakernel, dim3(grid), dim3(NT), args, LDS_BYTES, stream);
    if (e != hipSuccess) fprintf(stderr, "cooperative launch failed: %s (grid %d)\n", hipGetErrorString(e), grid);
}
```

```cpp
#include <hip/hip_runtime.h>
#include <hip/hip_cooperative_groups.h>
#include <cstdio>
#include <cstdint>
namespace cg = cooperative_groups;
namespace pg8 {
#define PG8_LAS __attribute__((address_space(3)))
typedef unsigned short bf16_t;
typedef short bf16x8 __attribute__((ext_vector_type(8)));
typedef float f32x4 __attribute__((ext_vector_type(4)));
typedef unsigned u32x4 __attribute__((ext_vector_type(4)));
constexpr int BM = 256, BK = 64, HALF = 128, HTB = HALF * BK * 2  , STAGE_BYTES = 8 * HTB, NXCD = 8, WGM = 8;

__host__ __device__ __forceinline__ int lds_byte(int r, int c) { const int st = (r >> 4) * 2 + (c >> 5), rr = r & 15, cc = c & 31, ob = rr * 64 + cc * 2; return st * 1024 + (ob ^ (((ob >> 9) & 1) << 5)); }
__host__ __device__ __forceinline__ void stage_rc(int b, int& R, int& C) { const int st = b / 1024, sb = b % 1024, swz = sb ^ (((sb >> 9) & 1) << 5); R = (st >> 1) * 16 + swz / 64; C = (st & 1) * 32 + (swz % 64) / 2; }
__host__ __device__ __forceinline__ int perm32(int rho) { const int n = rho >> 4, i = rho & 15; return 8 * (i >> 2) + 4 * n + (i & 3); }

struct Unit { int pm, pn; };
struct Gemm { const bf16_t* A; const bf16_t* Bt; int M, N, K, ld; };

struct StaticOrder {
    int nM, nN, nwg, G, c;
    __host__ __device__ void init(int M, int N, int G_, int c_) { nM = M / BM; nN = N / BM; nwg = nM * nN; G = G_; c = c_; }
    __host__ __device__ bool next(int i, Unit& u) const {
        const long L = (long)i * G + c; if (L >= nwg) return false;
        int wgid = (int)L; { const int q = nwg / NXCD, r = nwg % NXCD, xcd = wgid % NXCD, off = wgid / NXCD; wgid = (xcd < r ? xcd * (q + 1) : r * (q + 1) + (xcd - r) * q) + off; }
        const int nig = WGM * nN, gid = wgid / nig, fm = gid * WGM, gsz = (nM - fm) < WGM ? (nM - fm) : WGM;
        u.pm = fm + ((wgid % nig) % gsz); u.pn = (wgid % nig) / gsz; return true;
    }
    __device__ __forceinline__ void a_ready(const Unit&) const {}
    __device__ __forceinline__ void done(const Unit&) const {}
};

typedef float f32x2_t __attribute__((ext_vector_type(2)));
typedef __bf16 bf16x2_t __attribute__((ext_vector_type(2)));
__device__ __forceinline__ unsigned cvt_pk_bf16(float lo, float hi) { f32x2_t v = {lo, hi}; bf16x2_t b = __builtin_convertvector(v, bf16x2_t); return __builtin_bit_cast(unsigned, b); }
template <int ACT  > struct EpiStore {
    static constexpr bool PERM = true, AFTER_DRAIN = false;
    bf16_t* O; int ldc;
    __device__ __forceinline__ void operator()(const f32x4 (&acc)[2][2][4][2], const Unit& u, int wr, int wc, int fr, int fq) const {
        const int row0 = u.pm * BM + wr * 64 + fr; const int col0 = u.pn * BM + wc * 32 + 8 * fq;
#pragma unroll
        for (int ai = 0; ai < 2; ++ai)
#pragma unroll
            for (int m = 0; m < 4; ++m) { bf16_t* rowp = O + (size_t)(row0 + ai * HALF + m * 16) * ldc + col0;
#pragma unroll
                for (int bj = 0; bj < 2; ++bj) { f32x4 v0 = acc[ai][bj][m][0], v1 = acc[ai][bj][m][1];
                    if (ACT == 2) {
#pragma unroll
                        for (int j = 0; j < 4; ++j) { float a = fmaxf(v0[j], 0.f), b = fmaxf(v1[j], 0.f); v0[j] = a * a; v1[j] = b * b; } }
                    u32x4 w; w.x = cvt_pk_bf16(v0[0], v0[1]); w.y = cvt_pk_bf16(v0[2], v0[3]); w.z = cvt_pk_bf16(v1[0], v1[1]); w.w = cvt_pk_bf16(v1[2], v1[3]);
                    *(u32x4*)(rowp + bj * HALF) = w; } }
    }
};
struct EpiProj {
    static constexpr bool PERM = true, AFTER_DRAIN = false;
    bf16_t* O; int ldc; float* vP; float* vS;
    __device__ __forceinline__ void operator()(const f32x4 (&acc)[2][2][4][2], const Unit& u, int wr, int wc, int fr, int fq) const {
        const int row0 = u.pm * BM + wr * 64 + fr; const int col0 = u.pn * BM + wc * 32 + 8 * fq;
        const bool isv = (u.pn >= 8 && u.pn < 12);
#pragma unroll
        for (int ai = 0; ai < 2; ++ai)
#pragma unroll
            for (int m = 0; m < 4; ++m) { const int r = row0 + ai * HALF + m * 16; bf16_t* rowp = O + (size_t)r * ldc + col0;
                float* vrow = (r < 8192) ? vP + (size_t)r * 1024 + (col0 - 2048) : vS + (size_t)(r - 8192) * 1024 + (col0 - 2048);
#pragma unroll
                for (int bj = 0; bj < 2; ++bj) { const f32x4 v0 = acc[ai][bj][m][0], v1 = acc[ai][bj][m][1];
                    u32x4 w; w.x = cvt_pk_bf16(v0[0], v0[1]); w.y = cvt_pk_bf16(v0[2], v0[3]); w.z = cvt_pk_bf16(v1[0], v1[1]); w.w = cvt_pk_bf16(v1[2], v1[3]);
                    *(u32x4*)(rowp + bj * HALF) = w;
                    if (isv) { *(f32x4*)(vrow + bj * HALF) = v0; *(f32x4*)(vrow + bj * HALF + 4) = v1; } } }
    }
};
struct EpiResid {
    static constexpr bool PERM = true, AFTER_DRAIN = false;
    const float* baseP; const float* baseS; const float* gate; float* out;
    __device__ __forceinline__ void operator()(const f32x4 (&acc)[2][2][4][2], const Unit& u, int wr, int wc, int fr, int fq) const {
        const int row0 = u.pm * BM + wr * 64 + fr; const int col0 = u.pn * BM + wc * 32 + 8 * fq;
#pragma unroll
        for (int ai = 0; ai < 2; ++ai)
#pragma unroll
            for (int m = 0; m < 4; ++m) { const int r = row0 + ai * HALF + m * 16;
                const float* bp = (r < 8192) ? baseP + (size_t)r * 2048 : baseS + (size_t)(r - 8192) * 2048;
                const float* gp = gate + (size_t)((r < 8192) ? 0 : 1 + ((r - 8192) >> 4)) * 12288;
                float* op = out + (size_t)r * 2048;
#pragma unroll
                for (int bj = 0; bj < 2; ++bj) { const int c = col0 + bj * HALF;
#pragma unroll
                    for (int n = 0; n < 2; ++n) { const f32x4 b = *(const f32x4*)(bp + c + 4 * n), g = *(const f32x4*)(gp + c + 4 * n);
                        *(f32x4*)(op + c + 4 * n) = b + g * acc[ai][bj][m][n]; } }
                asm volatile("" ::: "memory"); }
    }
};

struct EpiPart {
    static constexpr bool PERM = true, AFTER_DRAIN = false;
    bf16_t* out; int ldc;
    __device__ __forceinline__ void operator()(const f32x4 (&acc)[2][2][4][2], const Unit& u, int wr, int wc, int fr, int fq) const {
        const int row0 = u.pm * BM + wr * 64 + fr - 8192; const int col0 = u.pn * BM + wc * 32 + 8 * fq;
#pragma unroll
        for (int ai = 0; ai < 2; ++ai)
#pragma unroll
            for (int m = 0; m < 4; ++m) { bf16_t* op = out + (size_t)(row0 + ai * HALF + m * 16) * ldc + col0;
#pragma unroll
                for (int bj = 0; bj < 2; ++bj) { const f32x4 v0 = acc[ai][bj][m][0], v1 = acc[ai][bj][m][1];
                    u32x4 w; w.x = cvt_pk_bf16(v0[0], v0[1]); w.y = cvt_pk_bf16(v0[2], v0[3]); w.z = cvt_pk_bf16(v1[0], v1[1]); w.w = cvt_pk_bf16(v1[2], v1[3]);
                    *(u32x4*)(op + bj * HALF) = w; } }
    }
};
struct OneUnit { Unit u;
    __device__ __forceinline__ bool next(int i, Unit& o) const { if (i != 0) return false; o = u; return true; }
    __device__ __forceinline__ void a_ready(const Unit&) const {}
    __device__ __forceinline__ void done(const Unit&) const {}
};
template <class Epi, class Sched, bool ALIGN_EPI = false, bool SP2 = false>
__device__ __forceinline__ void gemm_phase(PG8_LAS unsigned char* lds, const Gemm g, const Sched& S, const Epi& E) {
    int tid_ = threadIdx.x; asm volatile("" : "+v"(tid_));
    const int tid = tid_, wid = __builtin_amdgcn_readfirstlane(tid >> 6), lane = tid & 63, wr = wid >> 2, wc = wid & 3, fr = lane & 15, fq = lane >> 4;
    const int K = g.ld, nt = g.K / BK;
    unsigned voffA[2], voffB[2];
#pragma unroll
    for (int i = 0; i < 2; ++i) { int R, C; stage_rc(tid * 16 + i * 8192, R, C); const int Rb = Epi::PERM ? ((R & ~31) + perm32(R & 31)) : R;
        voffA[i] = (unsigned)(R * K + C) * 2u; voffB[i] = (unsigned)(Rb * K + C) * 2u; }
    const size_t kstep = (size_t)(BK * 2);
    const size_t hstep = (size_t)HALF * K * 2;
    const size_t tstep = 2 * hstep;
    const unsigned ldsw = (unsigned)wid * 1024u;
    const int aoff = lds_byte(wr * 64 + fr, fq * 8), boff = lds_byte(wc * 32 + fr, fq * 8);
#define PG8_SA(b, h) (((b) * 2 + (h)) * HTB)
#define PG8_SB(b, h) ((4 + (b) * 2 + (h)) * HTB)
#define PG8_STAGE(bufoff, gbase, voff) do { _Pragma("unroll") for (int _i = 0; _i < 2; ++_i) \
        __builtin_amdgcn_global_load_lds((const unsigned*)((const char*)(gbase) + (voff)[_i]), (PG8_LAS unsigned*)(lds + (bufoff) + ldsw + _i * 8192), 16, 0, 0); } while (0)
#define PG8_LDA(dst, b, h) do { _Pragma("unroll") for (int m = 0; m < 4; ++m) _Pragma("unroll") for (int k = 0; k < 2; ++k) dst[m][k] = *(const PG8_LAS bf16x8*)(lds + PG8_SA(b, h) + aoff + m * 2048 + k * 1024); } while (0)
#define PG8_LDB(dst, b, h) do { _Pragma("unroll") for (int n = 0; n < 2; ++n) _Pragma("unroll") for (int k = 0; k < 2; ++k) dst[n][k] = *(const PG8_LAS bf16x8*)(lds + PG8_SB(b, h) + boff + n * 2048 + k * 1024); } while (0)
#define PG8_MMA(ai, bj, At, Bt) do { __builtin_amdgcn_s_setprio(1); _Pragma("unroll") for (int m = 0; m < 4; ++m) _Pragma("unroll") for (int n = 0; n < 2; ++n) _Pragma("unroll") for (int k = 0; k < 2; ++k) \
        acc[ai][bj][m][n] = __builtin_amdgcn_mfma_f32_16x16x32_bf16(Bt[n][k], At[m][k], acc[ai][bj][m][n], 0, 0, 0); __builtin_amdgcn_s_setprio(0); } while (0)
#define PG8_WAIT_V(n) asm volatile("s_waitcnt vmcnt(" #n ")" ::: "memory")
#define PG8_WAIT_L(n) asm volatile("s_waitcnt lgkmcnt(" #n ")" ::: "memory")
#define PG8_BAR __builtin_amdgcn_s_barrier()
#define PG8_SCHED __builtin_amdgcn_sched_barrier(0)
    Unit cur, nxt; int ui = 0;
    if (!S.next(0, cur)) return;
    f32x4 acc[2][2][4][2];
#pragma unroll
    for (int a = 0; a < 2; ++a)
#pragma unroll
        for (int b = 0; b < 2; ++b)
#pragma unroll
            for (int m = 0; m < 4; ++m)
#pragma unroll
                for (int n = 0; n < 2; ++n) acc[a][b][m][n] = (f32x4){0.f, 0.f, 0.f, 0.f};
    bf16x8 At[4][2], B0[2][2], B1[2][2];
    const char* cA = (const char*)g.A + (size_t)cur.pm * tstep; const char* cB = (const char*)g.Bt + (size_t)cur.pn * tstep;
    S.a_ready(cur);
    if constexpr (SP2) {
        PG8_STAGE(PG8_SB(0, 0), cB, voffB); PG8_STAGE(PG8_SB(0, 1), cB + hstep, voffB); PG8_STAGE(PG8_SA(0, 0), cA, voffA); PG8_STAGE(PG8_SA(0, 1), cA + hstep, voffA);
        if (wr == 1) PG8_BAR;
        PG8_WAIT_V(2); PG8_BAR;
        PG8_STAGE(PG8_SB(1, 0), cB + kstep, voffB); PG8_STAGE(PG8_SA(1, 0), cA + kstep, voffA); PG8_STAGE(PG8_SB(1, 1), cB + hstep + kstep, voffB);
        PG8_WAIT_V(6); PG8_BAR;
    } else {
        PG8_STAGE(PG8_SB(0, 0), cB, voffB); PG8_STAGE(PG8_SA(0, 0), cA, voffA); PG8_STAGE(PG8_SB(0, 1), cB + hstep, voffB); PG8_STAGE(PG8_SA(0, 1), cA + hstep, voffA);
        if (wr == 1) PG8_BAR;
        PG8_WAIT_V(4); PG8_BAR;
        PG8_STAGE(PG8_SB(1, 0), cB + kstep, voffB); PG8_STAGE(PG8_SA(1, 0), cA + kstep, voffA); PG8_STAGE(PG8_SB(1, 1), cB + hstep + kstep, voffB);
        PG8_WAIT_V(6); PG8_BAR;
    }
    for (;;) {
        const bool has_next = S.next(ui + 1, nxt);
        const char* nA = has_next ? (const char*)g.A + (size_t)nxt.pm * tstep : cA; const char* nB = has_next ? (const char*)g.Bt + (size_t)nxt.pn * tstep : cB;
        for (int t = 0; t < nt; t += 2) {
            const bool last = (t == nt - 2);
            const char* a1 = cA + (size_t)(t + 1) * kstep;
            const char* a2 = last ? nA : cA + (size_t)(t + 2) * kstep; const char* b2 = last ? nB : cB + (size_t)(t + 2) * kstep;
            const char* a3 = a2 + kstep; const char* b3 = b2 + kstep;
            if (last && has_next) S.a_ready(nxt);
            if constexpr (SP2) {
            PG8_LDB(B0, 0, 0); PG8_LDB(B1, 0, 1); PG8_SCHED; PG8_LDA(At, 0, 0); PG8_STAGE(PG8_SA(1, 1), a1 + hstep, voffA);
            PG8_WAIT_V(8); PG8_WAIT_L(0); PG8_BAR; PG8_MMA(0, 0, At, B0); PG8_MMA(0, 1, At, B1); PG8_BAR; PG8_SCHED;
            PG8_LDA(At, 0, 1); PG8_STAGE(PG8_SB(0, 0), b2, voffB); PG8_STAGE(PG8_SB(0, 1), b2 + hstep, voffB); PG8_STAGE(PG8_SA(0, 0), a2, voffA);
            PG8_WAIT_V(8); PG8_WAIT_L(0); PG8_BAR; PG8_MMA(1, 0, At, B0); PG8_MMA(1, 1, At, B1); PG8_BAR; PG8_SCHED;
            PG8_LDB(B0, 1, 0); PG8_LDB(B1, 1, 1); PG8_SCHED; PG8_LDA(At, 1, 0); PG8_STAGE(PG8_SA(0, 1), a2 + hstep, voffA);
            PG8_WAIT_V(8); PG8_WAIT_L(0); PG8_BAR; PG8_MMA(0, 0, At, B0); PG8_MMA(0, 1, At, B1); PG8_BAR; PG8_SCHED;
            PG8_LDA(At, 1, 1); PG8_STAGE(PG8_SB(1, 0), b3, voffB); PG8_STAGE(PG8_SB(1, 1), b3 + hstep, voffB); PG8_STAGE(PG8_SA(1, 0), a3, voffA);
            PG8_WAIT_V(8); PG8_WAIT_L(0); PG8_BAR; PG8_MMA(1, 0, At, B0); PG8_MMA(1, 1, At, B1); PG8_BAR; PG8_SCHED;
            } else {
            PG8_LDB(B0, 0, 0); PG8_SCHED; PG8_LDA(At, 0, 0); PG8_STAGE(PG8_SA(1, 1), a1 + hstep, voffA);
            PG8_WAIT_L(8); PG8_BAR; PG8_WAIT_L(0); PG8_MMA(0, 0, At, B0); PG8_BAR; PG8_SCHED;
            PG8_LDB(B1, 0, 1); PG8_STAGE(PG8_SB(0, 0), b2, voffB);
            PG8_BAR; PG8_WAIT_L(0); PG8_MMA(0, 1, At, B1); PG8_BAR;
            PG8_LDA(At, 0, 1); PG8_STAGE(PG8_SA(0, 0), a2, voffA);
            PG8_BAR; PG8_WAIT_L(0); PG8_MMA(1, 0, At, B0); PG8_BAR; PG8_SCHED;
            PG8_STAGE(PG8_SB(0, 1), b2 + hstep, voffB);
            PG8_WAIT_V(6); PG8_BAR; PG8_MMA(1, 1, At, B1); PG8_BAR;
            PG8_LDB(B0, 1, 0); PG8_SCHED; PG8_LDA(At, 1, 0); PG8_STAGE(PG8_SA(0, 1), a2 + hstep, voffA);
            PG8_WAIT_L(8); PG8_BAR; PG8_WAIT_L(0); PG8_MMA(0, 0, At, B0); PG8_BAR; PG8_SCHED;
            PG8_LDB(B1, 1, 1); PG8_STAGE(PG8_SB(1, 0), b3, voffB);
            PG8_BAR; PG8_WAIT_L(0); PG8_MMA(0, 1, At, B1); PG8_BAR;
            PG8_LDA(At, 1, 1); PG8_STAGE(PG8_SA(1, 0), a3, voffA);
            PG8_BAR; PG8_WAIT_L(0); PG8_MMA(1, 0, At, B0); PG8_BAR; PG8_SCHED;
            PG8_STAGE(PG8_SB(1, 1), b3 + hstep, voffB);
            PG8_WAIT_V(6); PG8_BAR; PG8_MMA(1, 1, At, B1); PG8_BAR;
            }
        }
        if constexpr (ALIGN_EPI) { if (wr == 0) PG8_BAR; }
        if constexpr (!Epi::AFTER_DRAIN) { E(acc, cur, wr, wc, fr, fq); S.done(cur); }
        if (!has_next) break;
#pragma unroll
        for (int a = 0; a < 2; ++a)
#pragma unroll
            for (int b = 0; b < 2; ++b)
#pragma unroll
                for (int m = 0; m < 4; ++m)
#pragma unroll
                    for (int n = 0; n < 2; ++n) acc[a][b][m][n] = (f32x4){0.f, 0.f, 0.f, 0.f};
        cur = nxt; cA = nA; cB = nB; ++ui;
        if constexpr (ALIGN_EPI) { if (wr == 1) PG8_BAR; }
    }
    PG8_WAIT_V(0);
    if constexpr (!ALIGN_EPI) { if (wr == 0) PG8_BAR; }
    PG8_BAR;
    if constexpr (Epi::AFTER_DRAIN) { E.fused(acc, cur, wr, wc, fr, fq, lds, wid, lane); S.done(cur); }
#undef PG8_SA
#undef PG8_SB
#undef PG8_STAGE
#undef PG8_LDA
#undef PG8_LDB
#undef PG8_MMA
#undef PG8_WAIT_V
#undef PG8_WAIT_L
#undef PG8_BAR
#undef PG8_SCHED
}
}
#define GAS __attribute__((address_space(1)))
#define LAS __attribute__((address_space(3)))
typedef unsigned short bf16;
typedef unsigned u32x4 __attribute__((ext_vector_type(4)));
typedef unsigned u32x2 __attribute__((ext_vector_type(2)));
typedef float f32x4 __attribute__((ext_vector_type(4)));
typedef float f32x16 __attribute__((ext_vector_type(16)));
typedef short bf16x8 __attribute__((ext_vector_type(8)));
typedef short s16x4 __attribute__((ext_vector_type(4)));
typedef float f32x2_t __attribute__((ext_vector_type(2)));
constexpr int NW = 8, NT = 512;
constexpr int MTOK = 8704, MP = 8192, MS = 512, DM = 2048, NIN = 7176, NINP = 7424, DFF = 8192;
constexpr int NSEQ = 33;
constexpr int PAST = 1024;
constexpr int C_QA = 0, C_KA = 1024, C_VA = 2048, C_QM = 3072, C_KM = 4096, C_VM = 5120, C_OM = 6144, C_IG = 7168, C_FG = 7172;
constexpr int NCH = 160;
constexpr float EPS = 1e-6f;
constexpr float LAM_INIT = 0.2f;
constexpr float QSCALE = 0.125f * 1.4426950408889634f;
constexpr size_t O_YP = 0, O_YS = 16777216, O_KP = 17825792, O_VP = 26214400, O_CVP = 34603008, O_CP = 34609152, O_NP = 34871296, O_MPO = 34872320,
                 O_KS = 34872324, O_VS = 35396612, O_CVS = 35920900, O_CS = 36117508, O_NS = 44506116, O_MSO = 44538884;
constexpr size_t MiB = 1u << 20;
constexpr size_t WS_MOD = 1 * MiB;
constexpr size_t WS_ROPE = 3 * MiB;
constexpr size_t WS_SCAL = 4 * MiB;
constexpr size_t WS_DN = 5 * MiB;
constexpr size_t WS_NPREV = 6 * MiB;
constexpr size_t WS_WIN = 8 * MiB;
constexpr size_t WS_WOUT = 40 * MiB;
constexpr size_t WS_WUP = 48 * MiB;
constexpr size_t WS_WDN = 80 * MiB;
constexpr size_t WS_XN = 112 * MiB;
constexpr size_t WS_PROJ = 148 * MiB;
constexpr size_t WS_QA = 272 * MiB;
constexpr size_t WS_KA = 289 * MiB;
constexpr size_t WS_VT = 306 * MiB;
constexpr size_t WS_DC = 322 * MiB;
constexpr size_t WS_CPREV = 482 * MiB;
constexpr size_t WS_MIX = 562 * MiB;
constexpr size_t WS_END = 596 * MiB;
constexpr size_t WS_H = WS_PROJ;
constexpr size_t WS_X1 = WS_DC;
constexpr size_t WS_PART6 = 390 * MiB;
constexpr size_t WS_PART8 = 422 * MiB;
constexpr size_t WS_PART9 = 486 * MiB;
constexpr size_t WS_FLAG = 0;
static_assert(WS_H + (size_t)MTOK * DFF * 2 <= WS_VT + 16 * MiB && WS_X1 + (size_t)MTOK * DM * 4 <= WS_CPREV, "overlays");

constexpr int LDS_BYTES = 147456;

__device__ __forceinline__ f32x4 ld_bf4(const bf16* p) { const u32x2 w = *(const u32x2*)p; return (f32x4){__uint_as_float(w.x << 16), __uint_as_float(w.x & 0xffff0000u), __uint_as_float(w.y << 16), __uint_as_float(w.y & 0xffff0000u)}; }
__device__ __forceinline__ float bf2f(unsigned short u) { return __uint_as_float((unsigned)u << 16); }
__device__ __forceinline__ unsigned pk2(float lo, float hi) { return pg8::cvt_pk_bf16(lo, hi); }
__device__ __forceinline__ float lane_get(float v, int src_lane) { return __int_as_float(__builtin_amdgcn_ds_bpermute(src_lane << 2, __float_as_int(v))); }
__device__ __forceinline__ float xhalf_other(float v) { auto rr = __builtin_amdgcn_permlane32_swap(__float_as_uint(v), __float_as_uint(v), false, false); return __uint_as_float(rr[0]) + __uint_as_float(rr[1]) - v; }
__device__ __forceinline__ float xhalf_sum(float v) { auto rr = __builtin_amdgcn_permlane32_swap(__float_as_uint(v), __float_as_uint(v), false, false); return __uint_as_float(rr[0]) + __uint_as_float(rr[1]); }
__device__ __forceinline__ float wave_sum(float v, int lane) {
#pragma unroll
    for (int o = 1; o < 32; o <<= 1) v += lane_get(v, lane ^ o);
    return xhalf_sum(v);
}
__device__ __forceinline__ float wave_max(float v, int lane) {
#pragma unroll
    for (int o = 1; o < 64; o <<= 1) v = fmaxf(v, lane_get(v, lane ^ o));
    return v;
}
__device__ __forceinline__ float silu_f(float x) { return x / (1.f + __expf(-x)); }
__device__ __forceinline__ float sigmoid_f(float x) { return 1.f / (1.f + __expf(-x)); }
__device__ __forceinline__ int crow(int r, int hi) { return (r & 3) + 8 * (r >> 2) + 4 * hi; }
#define LDS_WAIT() asm volatile("s_waitcnt lgkmcnt(0)" ::: "memory")

struct Args {
    const float* in[29]; float* out; unsigned char* ws;
};
typedef const __attribute__((address_space(4))) Args* ArgsP;
#define FRESH_ARGS() ({ ArgsP p_ = (ArgsP)__builtin_amdgcn_kernarg_segment_ptr(); asm volatile("" : "+s"(p_)); p_; })

__device__ __forceinline__ void p0_transpose_item(const float* __restrict__ W, int K, int N, int Npad, bf16* WT, LAS float* T, int item, int tid, int wave, int lane) {
    const int nblk = Npad / 256, kb = item / nblk, nb = item % nblk, k0 = 64 * kb, n0 = 256 * nb;
    const int n = n0 + 4 * lane;
    f32x4 v[8];
#pragma unroll
    for (int i = 0; i < 8; ++i) v[i] = (n < N) ? *(const f32x4*)(W + (size_t)(k0 + 8 * wave + i) * N + n) : (f32x4){0.f, 0.f, 0.f, 0.f};
#pragma unroll
    for (int i = 0; i < 8; ++i) *(LAS f32x4*)(T + (8 * wave + i) * 260 + 4 * lane) = v[i];
    __syncthreads();
#pragma unroll
    for (int j = 0; j < 4; ++j) { const int q = tid + NT * j, nn = q >> 3, c = q & 7; const LAS float* s = T + (8 * c) * 260 + nn;
        u32x4 o; o.x = pk2(s[0], s[260]); o.y = pk2(s[2 * 260], s[3 * 260]); o.z = pk2(s[4 * 260], s[5 * 260]); o.w = pk2(s[6 * 260], s[7 * 260]);
        *(u32x4*)(WT + (size_t)(n0 + nn) * K + k0 + 8 * c) = o; }
    __syncthreads();
}

__device__ __forceinline__ void p0_ada_item(const float* __restrict__ cP, const float* __restrict__ cS, const float* __restrict__ Wada, const float* __restrict__ bada,
                                            float* mod, LAS float* red, int jb, int wave, int lane, int tid) {
    const int i32 = lane & 31, hi = lane >> 5;
    f32x16 acc[4]; f32x4 accp = {0.f, 0.f, 0.f, 0.f};
#pragma unroll
    for (int c = 0; c < 4; ++c) acc[c] = (f32x16){};
    const float* wp = Wada + (size_t)128 * jb + 4 * i32;
    for (int st = 0; st < 16; ++st) {
        const int k0 = 256 * wave + 16 * st + 8 * hi;
        f32x4 w[8];
#pragma unroll
        for (int i = 0; i < 8; ++i) w[i] = *(const f32x4*)(wp + (size_t)(k0 + i) * 12288);
        const f32x4 c0 = *(const f32x4*)(cS + (size_t)i32 * DM + k0), c1 = *(const f32x4*)(cS + (size_t)i32 * DM + k0 + 4);
        const f32x4 p0 = *(const f32x4*)(cP + k0), p1 = *(const f32x4*)(cP + k0 + 4);
        u32x4 a;
        a.x = pk2(silu_f(c0[0]), silu_f(c0[1])); a.y = pk2(silu_f(c0[2]), silu_f(c0[3])); a.z = pk2(silu_f(c1[0]), silu_f(c1[1])); a.w = pk2(silu_f(c1[2]), silu_f(c1[3]));
#pragma unroll
        for (int i = 0; i < 4; ++i) { accp += w[i] * silu_f(p0[i]); accp += w[4 + i] * silu_f(p1[i]); }
#pragma unroll
        for (int c = 0; c < 4; ++c) { u32x4 b; b.x = pk2(w[0][c], w[1][c]); b.y = pk2(w[2][c], w[3][c]); b.z = pk2(w[4][c], w[5][c]); b.w = pk2(w[6][c], w[7][c]);
            acc[c] = __builtin_amdgcn_mfma_f32_32x32x16_bf16(__builtin_bit_cast(bf16x8, a), __builtin_bit_cast(bf16x8, b), acc[c], 0, 0, 0); }
    }
    accp = (f32x4){xhalf_sum(accp[0]), xhalf_sum(accp[1]), xhalf_sum(accp[2]), xhalf_sum(accp[3])};
    LAS float* rp = red + 16384;
    if (hi == 0) *(LAS f32x4*)(rp + wave * 128 + 4 * i32) = accp;
#pragma unroll
    for (int half = 4; half >= 1; half >>= 1) {
        if (wave >= half && wave < 2 * half) { LAS float* dst = red + (wave - half) * 4096;
#pragma unroll
            for (int r = 0; r < 16; ++r) *(LAS f32x4*)(dst + crow(r, hi) * 128 + 4 * i32) = (f32x4){acc[0][r], acc[1][r], acc[2][r], acc[3][r]}; }
        __syncthreads();
        if (wave < half) { const LAS float* src = red + wave * 4096;
#pragma unroll
            for (int r = 0; r < 16; ++r) { const f32x4 t = *(const LAS f32x4*)(src + crow(r, hi) * 128 + 4 * i32); acc[0][r] += t[0]; acc[1][r] += t[1]; acc[2][r] += t[2]; acc[3][r] += t[3]; } }
        __syncthreads();
    }
    if (wave == 0) { const f32x4 bv = *(const f32x4*)(bada + 128 * jb + 4 * i32);
#pragma unroll
        for (int r = 0; r < 16; ++r) *(f32x4*)(mod + (size_t)(1 + crow(r, hi)) * 12288 + 128 * jb + 4 * i32) = (f32x4){acc[0][r], acc[1][r], acc[2][r], acc[3][r]} + bv; }
    if (wave == 1 && hi == 0) { f32x4 t = *(const f32x4*)(bada + 128 * jb + 4 * i32);
#pragma unroll
        for (int w = 0; w < 8; ++w) t += *(const LAS f32x4*)(rp + w * 128 + 4 * i32);
        *(f32x4*)(mod + 128 * jb + 4 * i32) = t; }
    __syncthreads();
}

__constant__ double INV_FREQ_TURNS[8] = {
    1.0 / 6.283185307179586, 0.19392274474868576 / 6.283185307179586, 0.03760603093086393 / 6.283185307179586, 0.007292664737217109 / 6.283185307179586,
    0.001414213562373095 / 6.283185307179586, 0.0002742481756762073 / 6.283185307179586, 5.318295896944988e-05 / 6.283185307179586, 1.031338537721246e-05 / 6.283185307179586 };

__device__ __forceinline__ void p0_prologue(ArgsP A, LAS unsigned char* lds, int tid, int wave, int lane) {
    unsigned char* ws = A->ws;
    const int G = gridDim.x, bid = blockIdx.x;
    for (int jb = bid; jb < 96; jb += G)
        p0_ada_item(A->in[8], A->in[9], A->in[10], A->in[11], (float*)(ws + WS_MOD), (LAS float*)lds, jb, wave, lane, tid);
    constexpr int I_IN = 32 * (NINP / 256), I_OUT = 32 * 8, I_UP = 32 * 32, I_DN = 128 * 8, I_ALL = I_IN + I_OUT + I_UP + I_DN;
    const bool split = (G > 128);
    const int nfree = split ? G - 96 : G, first = split ? 14 * nfree : 0;
    for (int pass = 0; pass < 2; ++pass) {
        int it, step, end;
        if (pass == 0) { if (!split || bid < 96) continue; it = bid - 96; step = nfree; end = (first < I_ALL) ? first : I_ALL; }
        else { it = first + bid; step = G; end = I_ALL; }
        for (; it < end; it += step) { int r = it;
            if (r < I_IN) { p0_transpose_item(A->in[13], DM, NIN, NINP, (bf16*)(ws + WS_WIN), (LAS float*)lds, r, tid, wave, lane); continue; } r -= I_IN;
            if (r < I_OUT) { p0_transpose_item(A->in[24], DM, DM, DM, (bf16*)(ws + WS_WOUT), (LAS float*)lds, r, tid, wave, lane); continue; } r -= I_OUT;
            if (r < I_UP) { p0_transpose_item(A->in[26], DM, DFF, DFF, (bf16*)(ws + WS_WUP), (LAS float*)lds, r, tid, wave, lane); continue; } r -= I_UP;
            p0_transpose_item(A->in[27], DFF, DM, DM, (bf16*)(ws + WS_WDN), (LAS float*)lds, r, tid, wave, lane); }
    }
    for (int idx = blockIdx.x * NT + tid; idx < 8192 * 8; idx += gridDim.x * NT) {
        const int pos = idx >> 3, i = idx & 7;
        const double t = (double)pos * INV_FREQ_TURNS[i]; const float fr = (float)(t - __builtin_rint(t));
        float* tab = (float*)(ws + WS_ROPE) + (size_t)pos * 16;
        tab[i] = __builtin_amdgcn_cosf(fr); tab[8 + i] = __builtin_amdgcn_sinf(fr);
    }
}

template <int NPART> __device__ __forceinline__ void norm_mod_rows(const float* xP, const float* xS, const float* __restrict__ g, const float* __restrict__ mod, int sh_off, int sc_off, bf16* out, int wave, int lane,
                                              const bf16* part = nullptr, int gate_off = 0, float* x1S = nullptr) {
    const int gw = blockIdx.x * NW + wave, NGW = gridDim.x * NW;
    for (int r = gw; r < MTOK; r += NGW) {
        const float* xr = (r < MP) ? xP + (size_t)r * DM : xS + (size_t)(r - MP) * DM;
        const float* mr = mod + (size_t)((r < MP) ? 0 : 1 + ((r - MP) >> 4)) * 12288;
        f32x4 v[8]; float s = 0.f;
#pragma unroll
        for (int j = 0; j < 8; ++j) v[j] = *(const f32x4*)(xr + 256 * j + 4 * lane);
        if (NPART > 0 && r >= MP) {
#pragma unroll
            for (int j = 0; j < 8; ++j) { const int c = 256 * j + 4 * lane; f32x4 a = {0.f, 0.f, 0.f, 0.f};
                f32x4 t[NPART > 0 ? NPART : 1];
#pragma unroll
                for (int p = 0; p < NPART; ++p) t[p] = ld_bf4(part + ((size_t)p * MS + (r - MP)) * DM + c);
#pragma unroll
                for (int p = 0; p < NPART; ++p) a += t[p];
                v[j] += *(const f32x4*)(mr + gate_off + c) * a; *(f32x4*)(x1S + (size_t)(r - MP) * DM + c) = v[j]; } }
#pragma unroll
        for (int j = 0; j < 8; ++j) s += (v[j].x * v[j].x + v[j].y * v[j].y) + (v[j].z * v[j].z + v[j].w * v[j].w);
        const float rstd = 1.f / sqrtf(wave_sum(s, lane) * (1.f / DM) + EPS);
#pragma unroll
        for (int j = 0; j < 8; ++j) { const int c = 256 * j + 4 * lane;
            const f32x4 gg = *(const f32x4*)(g + c), sc = *(const f32x4*)(mr + sc_off + c), sh = *(const f32x4*)(mr + sh_off + c);
            const f32x4 y = v[j] * rstd * gg * (sc + 1.f) + sh;
            u32x2 o; o.x = pk2(y.x, y.y); o.y = pk2(y.z, y.w);
            *(u32x2*)(out + (size_t)r * DM + c) = o; }
    }
}
#define XB_TMO      128
#define XB_XCNT(j)  (256  + 64 * (j))
#define XB_XSUB(j)  (1280 + 64 * (j))
#define XB_XGEN(j)  (2304 + 64 * (j))
#define XB_TOP      3328
#define XB_TOPGEN   3392
#define XCD_BAR_WORDS 3456
#define XB_SPIN_CAP (1u << 18)

__device__ __forceinline__ unsigned xb_ld(unsigned* p)              { return __hip_atomic_load(p, __ATOMIC_RELAXED, __HIP_MEMORY_SCOPE_AGENT); }
__device__ __forceinline__ unsigned xb_add(unsigned* p, unsigned v) { return __hip_atomic_fetch_add(p, v, __ATOMIC_RELAXED, __HIP_MEMORY_SCOPE_AGENT); }
__device__ __forceinline__ unsigned xb_xcc_id() { return (unsigned)__builtin_amdgcn_s_getreg((3 << 11) | 20) & 0xFu; }
#define XB_SPIN(cond, bar) do { unsigned _sp = 0; while (cond) { __builtin_amdgcn_s_sleep(1); \
    if ((++_sp & 255u) == 0u) { if (xb_ld(&(bar)[XB_TMO])) break; if (_sp > XB_SPIN_CAP) { atomicAdd(&(bar)[XB_TMO], 1u); break; } } } } while (0)

struct XcdBarrier {
    unsigned* bar; unsigned x;
    volatile LAS unsigned* st;
};

__device__ __forceinline__ XcdBarrier xcd_barrier_post(unsigned* bar, volatile LAS unsigned* st) {
    XcdBarrier b; b.bar = bar; b.x = xb_xcc_id(); b.st = st;
    if (threadIdx.x == 0) (void)xb_add(&bar[XB_XCNT(b.x)], 1u);
    return b;
}
__device__ __forceinline__ void xcd_barrier_complete(unsigned* bar, unsigned x, unsigned& nloc, unsigned& nx) {
    const unsigned G = gridDim.x * gridDim.y * gridDim.z;
    unsigned sum, cnt, mine, sp = 0u;
    for (;;) {
        sum = 0u; cnt = 0u; mine = 0u;
#pragma unroll
        for (unsigned j = 0; j < 16; ++j) { const unsigned c = xb_ld(&bar[XB_XCNT(j)]); sum += c; cnt += (c > 0u) ? 1u : 0u; mine = (j == x) ? c : mine; }
        if (sum == G) break;
        __builtin_amdgcn_s_sleep(1);
        if ((++sp & 255u) == 0u) { if (xb_ld(&bar[XB_TMO])) break; if (sp > XB_SPIN_CAP) { atomicAdd(&bar[XB_TMO], 1u); break; } }
    }
    nloc = mine > 0u ? mine : 1u; nx = cnt > 0u ? cnt : 1u;
}

__device__ __forceinline__ void xcd_barrier(const XcdBarrier& b) {
    asm volatile("s_waitcnt vmcnt(0)" ::: "memory");
    __syncthreads();
    if (threadIdx.x == 0) {
        unsigned* bar = b.bar;
        __builtin_amdgcn_s_waitcnt(0);
        unsigned nloc = b.st[0], nx = b.st[1];
        if (nloc == 0u) { xcd_barrier_complete(bar, b.x, nloc, nx); b.st[0] = nloc; b.st[1] = nx; }
        const unsigned old = xb_add(&bar[XB_XSUB(b.x)], 1u);
        const unsigned gen = old / nloc;
        if (old + 1u == (gen + 1u) * nloc) {
            __builtin_amdgcn_fence(__ATOMIC_RELEASE, "agent");
            asm volatile("s_waitcnt vmcnt(0)" ::: "memory");
            const unsigned og = xb_add(&bar[XB_TOP], 1u);
            const unsigned tg = og / nx;
            if (og + 1u == (tg + 1u) * nx) xb_add(&bar[XB_TOPGEN], 1u);
            else XB_SPIN(xb_ld(&bar[XB_TOPGEN]) == tg, bar);
            __builtin_amdgcn_fence(__ATOMIC_ACQUIRE, "agent");
            xb_add(&bar[XB_XGEN(b.x)], 1u);
            asm volatile("s_waitcnt vmcnt(0)" ::: "memory");
        } else {
            XB_SPIN(xb_ld(&bar[XB_XGEN(b.x)]) == gen, bar);
            __builtin_amdgcn_fence(__ATOMIC_ACQUIRE, "agent");
            asm volatile("s_waitcnt vmcnt(0)" ::: "memory");
        }
    }
    __syncthreads();
}
__device__ __forceinline__ void unpack16(const u32x4 a, const u32x4 b, float* v) {
#pragma unroll
    for (int i = 0; i < 4; ++i) { v[2 * i] = __uint_as_float(a[i] << 16); v[2 * i + 1] = __uint_as_float(a[i] & 0xffff0000u); v[8 + 2 * i] = __uint_as_float(b[i] << 16); v[8 + 2 * i + 1] = __uint_as_float(b[i] & 0xffff0000u); }
}
__device__ __forceinline__ void p3_post(ArgsP A, int tid) {
    unsigned char* ws = A->ws;
    const bf16* PROJ = (const bf16*)(ws + WS_PROJ); bf16* QA = (bf16*)(ws + WS_QA); bf16* KA = (bf16*)(ws + WS_KA);
    const float* rope = (const float*)(ws + WS_ROPE);
    for (int it = blockIdx.x * NT + tid; it < MTOK * 64; it += gridDim.x * NT) {
        const int r = it >> 6, cg16 = it & 63;
        const int pos = (r < MP) ? r : PAST + ((r - MP) & 15);
        const bf16* pr = PROJ + (size_t)r * NINP + 16 * cg16;
        float q[16], k[16];
        unpack16(*(const u32x4*)(pr + C_QA), *(const u32x4*)(pr + C_QA + 8), q);
        unpack16(*(const u32x4*)(pr + C_KA), *(const u32x4*)(pr + C_KA + 8), k);
        if ((cg16 & 3) == 0) {
            const float* tb = rope + (size_t)pos * 16;
#pragma unroll
            for (int i = 0; i < 8; ++i) { const float c = tb[i], s = tb[8 + i];
                const float q1 = q[i], q2 = q[8 + i]; q[i] = q1 * c - q2 * s; q[8 + i] = q2 * c + q1 * s;
                const float k1 = k[i], k2 = k[8 + i]; k[i] = k1 * c - k2 * s; k[8 + i] = k2 * c + k1 * s; }
        }
        u32x4 o0, o1;
#pragma unroll
        for (int i = 0; i < 4; ++i) { o0[i] = pk2(q[2 * i] * QSCALE, q[2 * i + 1] * QSCALE); o1[i] = pk2(q[8 + 2 * i] * QSCALE, q[8 + 2 * i + 1] * QSCALE); }
        *(u32x4*)(QA + (size_t)r * 1024 + 16 * cg16) = o0; *(u32x4*)(QA + (size_t)r * 1024 + 16 * cg16 + 8) = o1;
#pragma unroll
        for (int i = 0; i < 4; ++i) { o0[i] = pk2(k[2 * i], k[2 * i + 1]); o1[i] = pk2(k[8 + 2 * i], k[8 + 2 * i + 1]); }
        *(u32x4*)(KA + (size_t)r * 1024 + 16 * cg16) = o0; *(u32x4*)(KA + (size_t)r * 1024 + 16 * cg16 + 8) = o1;
        float* ko = A->out + ((r < MP) ? O_KP + (size_t)r * 1024 : O_KS + (size_t)(r - MP) * 1024) + 16 * cg16;
#pragma unroll
        for (int i = 0; i < 4; ++i) *(f32x4*)(ko + 4 * i) = (f32x4){k[4 * i], k[4 * i + 1], k[4 * i + 2], k[4 * i + 3]};
    }
    for (int it = blockIdx.x * NT + tid; it < 33 * 3 * 2048; it += gridDim.x * NT) {
        const int ch = it & 2047, j = (it >> 11) % 3, sq = it / (3 * 2048);
        const int r = (sq == 0) ? (MP - 3 + j) : (MP + 16 * (sq - 1) + 13 + j);
        const float val = bf2f(PROJ[(size_t)r * NINP + C_QM + ch]);
        if (sq == 0) A->out[O_CVP + (size_t)j * 2048 + ch] = val; else A->out[O_CVS + ((size_t)(sq - 1) * 3 + j) * 2048 + ch] = val;
    }
}
typedef short v4i16_t __attribute__((ext_vector_type(4)));
__device__ __forceinline__ s16x4 tr_rd(LAS const unsigned char* p) { return __builtin_bit_cast(s16x4, __builtin_amdgcn_ds_read_tr16_b64_v4i16((LAS v4i16_t*)p)); }
__device__ __forceinline__ bf16x8 mk8(s16x4 a, s16x4 b) { return (bf16x8){a[0], a[1], a[2], a[3], b[0], b[1], b[2], b[3]}; }
__device__ __forceinline__ int tr_off(int pitch, int krow, int colbase, int lane) { return (krow + ((lane & 15) >> 2)) * pitch + (colbase + 16 * ((lane >> 4) & 1) + 4 * (lane & 3)) * 2; }
__device__ __forceinline__ void unpack8(const u32x4 a, float* v) {
#pragma unroll
    for (int i = 0; i < 4; ++i) { v[2 * i] = __uint_as_float(a[i] << 16); v[2 * i + 1] = __uint_as_float(a[i] & 0xffff0000u); }
}
__device__ __forceinline__ int unit_row0(int u) { return (u < 128) ? 64 * u : MP + 16 * (u - 128); }
__device__ __forceinline__ void conv8(const bf16* PROJ, const float* __restrict__ stconv, const float* __restrict__ wconv, const float* __restrict__ bconv, int u, int s, int ch0, float* o) {
    const int r0 = unit_row0(u);
    f32x4 a0 = *(const f32x4*)(bconv + ch0), a1 = *(const f32x4*)(bconv + ch0 + 4);
#pragma unroll
    for (int j = 0; j < 4; ++j) { const int tau = s - 3 + j; float x[8];
        if (tau >= 0 || (u > 0 && u < 128)) unpack8(*(const u32x4*)(PROJ + (size_t)(r0 + tau) * NINP + C_QM + ch0), x);
        else if (u >= 128) { const float* p = stconv + ((size_t)(u - 128) * 3 + (3 + tau)) * 2048 + ch0; const f32x4 y0 = *(const f32x4*)p, y1 = *(const f32x4*)(p + 4);
            x[0] = y0[0]; x[1] = y0[1]; x[2] = y0[2]; x[3] = y0[3]; x[4] = y1[0]; x[5] = y1[1]; x[6] = y1[2]; x[7] = y1[3]; }
        else {
#pragma unroll
            for (int i = 0; i < 8; ++i) x[i] = 0.f; }
        const f32x4 w0 = *(const f32x4*)(wconv + j * 2048 + ch0), w1 = *(const f32x4*)(wconv + j * 2048 + ch0 + 4);
        a0 += (f32x4){x[0], x[1], x[2], x[3]} * w0; a1 += (f32x4){x[4], x[5], x[6], x[7]} * w1; }
#pragma unroll
    for (int i = 0; i < 4; ++i) { o[i] = silu_f(a0[i]); o[4 + i] = silu_f(a1[i]); }
}
__device__ __forceinline__ void conv_rows4(const bf16* PROJ, const float* __restrict__ stconv, const float* __restrict__ wconv, const float* __restrict__ bconv, int u, int L, int s0, int ch0, float sc, u32x4* o) {
    const int r0 = unit_row0(u);
    f32x4 w0[4], w1[4];
#pragma unroll
    for (int j = 0; j < 4; ++j) { w0[j] = *(const f32x4*)(wconv + j * 2048 + ch0); w1[j] = *(const f32x4*)(wconv + j * 2048 + ch0 + 4); }
    const f32x4 b0 = *(const f32x4*)(bconv + ch0), b1 = *(const f32x4*)(bconv + ch0 + 4);
    f32x4 x0[7], x1[7];
#pragma unroll
    for (int i = 0; i < 7; ++i) { const int tau = s0 - 3 + i; x0[i] = (f32x4){0.f, 0.f, 0.f, 0.f}; x1[i] = x0[i];
        if (tau >= 0 ? (tau < L) : (u > 0 && u < 128)) { float t[8]; unpack8(*(const u32x4*)(PROJ + (size_t)(r0 + tau) * NINP + C_QM + ch0), t); x0[i] = (f32x4){t[0], t[1], t[2], t[3]}; x1[i] = (f32x4){t[4], t[5], t[6], t[7]}; }
        else if (tau < 0 && u >= 128) { const float* p = stconv + ((size_t)(u - 128) * 3 + (3 + tau)) * 2048 + ch0; x0[i] = *(const f32x4*)p; x1[i] = *(const f32x4*)(p + 4); } }
#pragma unroll
    for (int r = 0; r < 4; ++r) { f32x4 a0 = b0, a1 = b1;
#pragma unroll
        for (int j = 0; j < 4; ++j) { a0 += x0[r + j] * w0[j]; a1 += x1[r + j] * w1[j]; }
        u32x4 q = {0u, 0u, 0u, 0u};
        if (s0 + r < L) { q.x = pk2(silu_f(a0[0]) * sc, silu_f(a0[1]) * sc); q.y = pk2(silu_f(a0[2]) * sc, silu_f(a0[3]) * sc); q.z = pk2(silu_f(a1[0]) * sc, silu_f(a1[1]) * sc); q.w = pk2(silu_f(a1[2]) * sc, silu_f(a1[3]) * sc); }
        o[r] = q; }
}
__device__ __forceinline__ u32x4 pack8(const float* v, float sc) { u32x4 o; o.x = pk2(v[0] * sc, v[1] * sc); o.y = pk2(v[2] * sc, v[3] * sc); o.z = pk2(v[4] * sc, v[5] * sc); o.w = pk2(v[6] * sc, v[7] * sc); return o; }
__device__ __forceinline__ float logsigmoid_f(float f) { return fminf(f, 0.f) - log1pf(__expf(-fabsf(f))); }
__device__ __forceinline__ void load_gates(const bf16* PROJ, const float* bi, const float* bfg, int u, int h, int t, float& ig, float& lf) {
    const int L = (u < 128) ? 64 : 16; const int r = unit_row0(u) + t;
    ig = -INFINITY; lf = 0.f;
    if (t < L) { ig = bf2f(PROJ[(size_t)r * NINP + C_IG + h]) + bi[h]; lf = logsigmoid_f(bf2f(PROJ[(size_t)r * NINP + C_FG + h]) + bfg[h]); }
}
__device__ __forceinline__ float scan_add(float v, int lane) {
#pragma unroll
    for (int o = 1; o < 64; o <<= 1) { const float x = lane_get(v, lane - o); if (lane >= o) v += x; }
    return v;
}
__device__ __forceinline__ float scan_max(float v, int lane) {
#pragma unroll
    for (int o = 1; o < 64; o <<= 1) { const float x = lane_get(v, lane - o); if (lane >= o) v = fmaxf(v, x); }
    return v;
}
constexpr int MA_K = 0, MA_V = 36864, MA_W = 73728;
constexpr int PK = 576;
__device__ __forceinline__ void mlstm_phaseA(ArgsP A, LAS unsigned char* lds, int u, int h, int tid, int wave, int lane) {
    unsigned char* ws = A->ws; const bf16* PROJ = (const bf16*)(ws + WS_PROJ);
    float* SC = (float*)(ws + WS_SCAL);
    LAS float* wl = (LAS float*)(lds + MA_W);
    const int L = (u < 128) ? 64 : 16, r0 = unit_row0(u);
    if (wave == 0) {
        float ig, lf; load_gates(PROJ, A->in[21], A->in[22], u, h, lane, ig, lf);
        const float b = scan_add(lf, lane); const float G = lane_get(b, 63);
        const float uu = (lane < L) ? G - b + ig : -INFINITY; const float mloc = wave_max(uu, lane);
        wl[lane] = (lane < L) ? __expf(uu - mloc) : 0.f;
        if (lane == 0) { SC[u * 4 + h] = G; SC[640 + u * 4 + h] = mloc; }
    }
    { const int c8 = 8 * (tid & 31), s0 = 4 * (tid >> 5);
      u32x4 ko[4]; conv_rows4(PROJ, A->in[4], A->in[19], A->in[20], u, L, s0, 1024 + h * 256 + c8, 0.0625f, ko);
      u32x4 vr[4];
#pragma unroll
      for (int r = 0; r < 4; ++r) { vr[r] = (u32x4){0u, 0u, 0u, 0u}; if (s0 + r < L) vr[r] = *(const u32x4*)(PROJ + (size_t)(r0 + s0 + r) * NINP + C_VM + h * 256 + c8); }
#pragma unroll
      for (int r = 0; r < 4; ++r) *(LAS u32x4*)(lds + MA_K + (s0 + r) * PK + c8 * 2) = ko[r];
      __syncthreads();
#pragma unroll
      for (int r = 0; r < 4; ++r) { float v[8]; unpack8(vr[r], v); *(LAS u32x4*)(lds + MA_V + (s0 + r) * PK + c8 * 2) = pack8(v, wl[s0 + r]); } }
    __syncthreads();
    { const int i32 = lane & 31, hi = lane >> 5, eb = wave;
      bf16x8 af[4];
#pragma unroll
      for (int ks = 0; ks < 4; ++ks) { const int o = tr_off(PK, 16 * ks + 8 * hi, 32 * eb, lane); af[ks] = mk8(tr_rd(lds + MA_V + o), tr_rd(lds + MA_V + o + 4 * PK)); }
      bf16* dC = (bf16*)(ws + WS_DC) + ((size_t)(u * 4 + h) * 256 + 32 * eb + i32) * 256 + 4 * hi;
      for (int db = 0; db < 8; ++db) { f32x16 acc = {};
#pragma unroll
          for (int ks = 0; ks < 4; ++ks) { const int o = tr_off(PK, 16 * ks + 8 * hi, 32 * db, lane); const bf16x8 bfr = mk8(tr_rd(lds + MA_K + o), tr_rd(lds + MA_K + o + 4 * PK));
              acc = __builtin_amdgcn_mfma_f32_32x32x16_bf16(bfr, af[ks], acc, 0, 0, 0); }
#pragma unroll
          for (int g4 = 0; g4 < 4; ++g4) { u32x2 o; o.x = pk2(acc[4 * g4], acc[4 * g4 + 1]); o.y = pk2(acc[4 * g4 + 2], acc[4 * g4 + 3]); *(u32x2*)(dC + 32 * db + 8 * g4) = o; } } }
    if (tid < 256) { float a = 0.f;
        for (int s = 0; s < 64; ++s) a += wl[s] * bf2f(*(LAS const unsigned short*)(lds + MA_K + s * PK + tid * 2));
        ((float*)(ws + WS_DN))[(size_t)(u * 4 + h) * 256 + tid] = a; }
    __syncthreads();
}
__device__ __forceinline__ void mlstm_phaseB(ArgsP A, LAS unsigned char* lds, int tid, int wave, int lane) {
    unsigned char* ws = A->ws; const float* SC = (const float*)(ws + WS_SCAL); float* MPREV = (float*)(ws + WS_SCAL) + 1280;
    const bf16* DC = (const bf16*)(ws + WS_DC); bf16* CP = (bf16*)(ws + WS_CPREV); const float* DN = (const float*)(ws + WS_DN); float* NP = (float*)(ws + WS_NPREV);
    const int gid = blockIdx.x * NT + tid, gsz = gridDim.x * NT;
    LAS float* AL = (LAS float*)lds; LAS float* BE = AL + 512;
    if (wave < 4) { const int h = wave; const float g0 = SC[lane * 4 + h], g1 = SC[(64 + lane) * 4 + h], l0 = SC[640 + lane * 4 + h], l1 = SC[640 + (64 + lane) * 4 + h];
        float m = 0.f;
        for (int c = 0; c < 128; ++c) { const float G = lane_get((c < 64) ? g0 : g1, c & 63), ml = lane_get((c < 64) ? l0 : l1, c & 63);
            const float mn = fmaxf(G + m, ml);
            if (lane == 0) { AL[h * 128 + c] = __expf(G + m - mn); BE[h * 128 + c] = __expf(ml - mn); if (blockIdx.x == 0) MPREV[c * 4 + h] = m; }
            m = mn; }
        if (blockIdx.x == 0 && lane == 0) A->out[O_MPO + h] = m; }
    __syncthreads();
    for (int idx = gid; idx < 4 * 32768; idx += gsz) { const int h = idx >> 15, el = (idx & 32767) * 2;
        float c0 = 0.f, c1 = 0.f;
        for (int cb = 0; cb < 128; cb += 32) { unsigned d[32];
#pragma unroll
            for (int j = 0; j < 32; ++j) d[j] = *(const unsigned*)(DC + ((size_t)((cb + j) * 4 + h) << 16) + el);
#pragma unroll
            for (int j = 0; j < 32; ++j) { const int c = cb + j; const float al = AL[h * 128 + c], be = BE[h * 128 + c];
                *(unsigned*)(CP + ((size_t)(c * 4 + h) << 16) + el) = pk2(c0, c1);
                c0 = al * c0 + be * __uint_as_float(d[j] << 16); c1 = al * c1 + be * __uint_as_float(d[j] & 0xffff0000u); } }
        *(f32x2_t*)(A->out + O_CP + ((size_t)h << 16) + el) = (f32x2_t){c0, c1}; }
    for (int idx = gid; idx < 4 * 256; idx += gsz) { const int h = idx >> 8, d = idx & 255; float n = 0.f;
        for (int cb = 0; cb < 128; cb += 32) { float dn[32];
#pragma unroll
            for (int j = 0; j < 32; ++j) dn[j] = DN[(size_t)((cb + j) * 4 + h) * 256 + d];
#pragma unroll
            for (int j = 0; j < 32; ++j) { const int c = cb + j; NP[(size_t)(c * 4 + h) * 256 + d] = n; n = AL[h * 128 + c] * n + BE[h * 128 + c] * dn[j]; } }
        A->out[O_NP + h * 256 + d] = n; }
    const float* C0 = A->in[5]; const float* N0 = A->in[6]; const float* M0 = A->in[7];
    for (int i0 = gid; i0 < 128 * 32768; i0 += 8 * gsz) {
        f32x2_t c[8]; unsigned d[8]; float m[8], G[8], ml[8];
#pragma unroll
        for (int k = 0; k < 8; ++k) { const int idx = i0 + k * gsz; if (idx < 128 * 32768) { const int bh = idx >> 15, el = (idx & 32767) * 2, ui = (128 + (bh >> 2)) * 4 + (bh & 3);
            m[k] = M0[bh]; G[k] = SC[ui]; ml[k] = SC[640 + ui]; c[k] = *(const f32x2_t*)(C0 + ((size_t)bh << 16) + el); d[k] = *(const unsigned*)(DC + ((size_t)ui << 16) + el); } }
#pragma unroll
        for (int k = 0; k < 8; ++k) { const int idx = i0 + k * gsz; if (idx < 128 * 32768) { const int bh = idx >> 15, el = (idx & 32767) * 2, ui = (128 + (bh >> 2)) * 4 + (bh & 3);
            const float mn = fmaxf(G[k] + m[k], ml[k]); const float al = __expf(G[k] + m[k] - mn), be = __expf(ml[k] - mn);
            *(unsigned*)(CP + ((size_t)ui << 16) + el) = pk2(c[k].x, c[k].y);
            *(f32x2_t*)(A->out + O_CS + ((size_t)bh << 16) + el) = (f32x2_t){al * c[k].x + be * __uint_as_float(d[k] << 16), al * c[k].y + be * __uint_as_float(d[k] & 0xffff0000u)};
            if (el == 0) { MPREV[ui] = m[k]; A->out[O_MSO + bh] = mn; } } } }
    for (int idx = gid; idx < 128 * 256; idx += gsz) { const int bh = idx >> 8, d = idx & 255, ui = (128 + (bh >> 2)) * 4 + (bh & 3);
        const float m = M0[bh], G = SC[ui], ml = SC[640 + ui]; const float mn = fmaxf(G + m, ml); const float al = __expf(G + m - mn), be = __expf(ml - mn);
        const float n = N0[idx]; NP[(size_t)ui * 256 + d] = n; A->out[O_NS + idx] = al * n + be * DN[(size_t)ui * 256 + d]; }
}
constexpr int MC_Q = 0, MC_K = 33792, MC_V = 67584, MC_S = 104448, MC_F = 113664;
constexpr int PQ = 528, PS = 144;
__device__ __forceinline__ void mlstm_phaseC(ArgsP A, LAS unsigned char* lds, int u, int h, int tid, int wave, int lane) {
    unsigned char* ws = A->ws; const bf16* PROJ = (const bf16*)(ws + WS_PROJ);
    const int L = (u < 128) ? 64 : 16, r0 = unit_row0(u), uh = u * 4 + h;
    LAS float* F = (LAS float*)(lds + MC_F);
    LAS float* rt = F, *gg = F + 64, *winter = F + 128, *eden = F + 192, *nq = F + 256, *denp = F + 320, *ssq = F + 448;
    const int i32 = lane & 31, hi = lane >> 5;
    LAS float* nl = F + 960;
    if (wave == 1) *(LAS f32x4*)(nl + 4 * lane) = *(const f32x4*)((const float*)(ws + WS_NPREV) + (size_t)uh * 256 + 4 * lane);
    if (wave == 0) {
        float ig, lf; load_gates(PROJ, A->in[21], A->in[22], u, h, lane, ig, lf);
        const float b = scan_add(lf, lane); const float g = (lane < L) ? ig - b : -INFINITY; const float cm = scan_max(g, lane);
        const float mprev = ((const float*)(ws + WS_SCAL))[1280 + uh]; const float mx = fmaxf(mprev, cm);
        rt[lane] = -mx; gg[lane] = g; winter[lane] = __expf(mprev - mx); eden[lane] = __expf(-(b + mx));
    }
    { const int c8 = 8 * (tid & 31), s0 = 4 * (tid >> 5);
      u32x4 qo[4], ko[4], vo[4];
      conv_rows4(PROJ, A->in[4], A->in[19], A->in[20], u, L, s0, h * 256 + c8, 1.f, qo);
      conv_rows4(PROJ, A->in[4], A->in[19], A->in[20], u, L, s0, 1024 + h * 256 + c8, 0.0625f, ko);
#pragma unroll
      for (int r = 0; r < 4; ++r) { vo[r] = (u32x4){0u, 0u, 0u, 0u}; if (s0 + r < L) vo[r] = *(const u32x4*)(PROJ + (size_t)(r0 + s0 + r) * NINP + C_VM + h * 256 + c8); }
#pragma unroll
      for (int r = 0; r < 4; ++r) { *(LAS u32x4*)(lds + MC_Q + (s0 + r) * PQ + c8 * 2) = qo[r]; *(LAS u32x4*)(lds + MC_K + (s0 + r) * PQ + c8 * 2) = ko[r]; *(LAS u32x4*)(lds + MC_V + (s0 + r) * PK + c8 * 2) = vo[r]; } }
    bf16x8 ca[16];
    { const bf16* Cp = (const bf16*)(ws + WS_CPREV) + ((size_t)uh * 256 + 32 * wave + i32) * 256 + 8 * hi;
#pragma unroll
      for (int kk = 0; kk < 16; ++kk) ca[kk] = *(const bf16x8*)(Cp + 16 * kk); }
    __syncthreads();
    if (wave < 3) {
        const int tt = (wave > 0) ? 1 : 0, st = (wave == 2) ? 1 : 0;
        f32x16 acc = {};
#pragma unroll 4
        for (int kk = 0; kk < 16; ++kk) { const bf16x8 a = *(LAS const bf16x8*)(lds + MC_K + (32 * st + i32) * PQ + (16 * kk + 8 * hi) * 2), b = *(LAS const bf16x8*)(lds + MC_Q + (32 * tt + i32) * PQ + (16 * kk + 8 * hi) * 2);
            acc = __builtin_amdgcn_mfma_f32_32x32x16_bf16(a, b, acc, 0, 0, 0); }
        const int t = 32 * tt + i32; const float rtt = rt[t]; float rs = 0.f;
#pragma unroll
        for (int g4 = 0; g4 < 4; ++g4) { const int s0 = 32 * st + 8 * g4 + 4 * hi; float v[4];
#pragma unroll
            for (int j = 0; j < 4; ++j) { const int s = s0 + j; const float e = __expf(rtt + gg[s]) * acc[4 * g4 + j]; v[j] = (s <= t) ? e : 0.f; rs += v[j]; }
            u32x2 o; o.x = pk2(v[0], v[1]); o.y = pk2(v[2], v[3]); *(LAS u32x2*)(lds + MC_S + t * PS + s0 * 2) = o; }
        rs = xhalf_sum(rs);
        if (hi == 0) { denp[st * 64 + t] = rs; if (wave == 0) denp[64 + t] = 0.f; }
    } else if (wave == 3) {
        const LAS float* np = nl + 8 * hi;
#pragma unroll
        for (int tt = 0; tt < 2; ++tt) { f32x16 acc = {};
#pragma unroll 4
            for (int kk = 0; kk < 16; ++kk) { u32x4 aw = {0u, 0u, 0u, 0u};
                if (i32 == 0) { const f32x4 n0 = *(const LAS f32x4*)(np + 16 * kk), n1 = *(const LAS f32x4*)(np + 16 * kk + 4); aw.x = pk2(n0[0], n0[1]); aw.y = pk2(n0[2], n0[3]); aw.z = pk2(n1[0], n1[1]); aw.w = pk2(n1[2], n1[3]); }
                const bf16x8 b = *(LAS const bf16x8*)(lds + MC_Q + (32 * tt + i32) * PQ + (16 * kk + 8 * hi) * 2);
                acc = __builtin_amdgcn_mfma_f32_32x32x16_bf16(__builtin_bit_cast(bf16x8, aw), b, acc, 0, 0, 0); }
            if (hi == 0) nq[32 * tt + i32] = acc[0]; }
    }
    __syncthreads();
    const int eb = wave, ntt = (L > 32) ? 2 : 1;
    u32x2 ovp[2][4]; f32x4 gmp[4];
#pragma unroll
    for (int g4 = 0; g4 < 4; ++g4) { const int e = 32 * eb + 8 * g4 + 4 * hi; gmp[g4] = *(const f32x4*)(A->in[23] + h * 256 + e);
#pragma unroll
        for (int tt = 0; tt < 2; ++tt) { const int t = 32 * tt + i32; ovp[tt][g4] = (u32x2){0u, 0u};
            if (t < L) ovp[tt][g4] = *(const u32x2*)(PROJ + (size_t)(r0 + t) * NINP + C_OM + h * 256 + e); } }
    bf16x8 va[4];
#pragma unroll
    for (int ks = 0; ks < 4; ++ks) { const int o = tr_off(PK, 16 * ks + 8 * hi, 32 * eb, lane); va[ks] = mk8(tr_rd(lds + MC_V + o), tr_rd(lds + MC_V + o + 4 * PK)); }
    f32x16 hv[2];
#pragma unroll
    for (int tt = 0; tt < 2; ++tt) { f32x16 acc = {};
        if (tt < ntt) { const int t = 32 * tt + i32;
#pragma unroll
            for (int kk = 0; kk < 16; ++kk) { const bf16x8 b = *(LAS const bf16x8*)(lds + MC_Q + t * PQ + (16 * kk + 8 * hi) * 2);
                acc = __builtin_amdgcn_mfma_f32_32x32x16_bf16(ca[kk], b, acc, 0, 0, 0); }
            const float wi = winter[t];
#pragma unroll
            for (int r = 0; r < 16; ++r) acc[r] *= wi;
#pragma unroll
            for (int ks = 0; ks < 4; ++ks) if (ks < 2 * (tt + 1)) { const bf16x8 b = *(LAS const bf16x8*)(lds + MC_S + t * PS + (16 * ks + 8 * hi) * 2);
                acc = __builtin_amdgcn_mfma_f32_32x32x16_bf16(va[ks], b, acc, 0, 0, 0); }
            const float den = wi * nq[t] + denp[t] + denp[64 + t]; const float inv = 1.f / fmaxf(fabsf(den), eden[t]); float sq = 0.f;
#pragma unroll
            for (int r = 0; r < 16; ++r) { acc[r] *= inv; sq += acc[r] * acc[r]; }
            sq = xhalf_sum(sq); if (hi == 0) ssq[wave * 64 + t] = sq; }
        hv[tt] = acc; }
    __syncthreads();
    bf16* MIX = (bf16*)(ws + WS_MIX);
#pragma unroll
    for (int tt = 0; tt < 2; ++tt) if (tt < ntt) { const int t = 32 * tt + i32;
        if (t < L) { float tot = 0.f;
#pragma unroll
            for (int w = 0; w < 8; ++w) tot += ssq[w * 64 + t];
            const float rstd = 1.f / sqrtf(tot * (1.f / 256.f) + EPS); const size_t row = (size_t)(r0 + t);
#pragma unroll
            for (int g4 = 0; g4 < 4; ++g4) { const int e = 32 * eb + 8 * g4 + 4 * hi; const f32x4 g = gmp[g4];
                const u32x2 ov = ovp[tt][g4];
                const float o0 = sigmoid_f(__uint_as_float(ov.x << 16)), o1 = sigmoid_f(__uint_as_float(ov.x & 0xffff0000u)), o2 = sigmoid_f(__uint_as_float(ov.y << 16)), o3 = sigmoid_f(__uint_as_float(ov.y & 0xffff0000u));
                u32x2 w; w.x = pk2(hv[tt][4 * g4] * rstd * g[0] * o0, hv[tt][4 * g4 + 1] * rstd * g[1] * o1); w.y = pk2(hv[tt][4 * g4 + 2] * rstd * g[2] * o2, hv[tt][4 * g4 + 3] * rstd * g[3] * o3);
                *(u32x2*)(MIX + row * DM + 1024 + h * 256 + e) = w; } } }
    __syncthreads();
}
constexpr int AT_PKT = 272, AT_PVT = 320, AT_V = 17408, AT_BUF = 37888;
struct AttnState { f32x16 o[4]; bf16x8 pf[4]; float m, l; };
__device__ __forceinline__ float xhalf_max(float v) { auto rr = __builtin_amdgcn_permlane32_swap(__float_as_uint(v), __float_as_uint(v), false, false); return fmaxf(__uint_as_float(rr[0]), __uint_as_float(rr[1])); }
constexpr float ATT_THR = 6.0f;
__device__ __forceinline__ void attn_qk(LAS const unsigned char* kt, int map, const bf16x8 (&qf)[4], const AttnState& S, f32x16 (&p)[2], int lane) {
    const int i32 = lane & 31, hi = lane >> 5;
#pragma unroll
    for (int kb = 0; kb < 2; ++kb) { f32x16 acc = {};
#pragma unroll
        for (int d0 = 0; d0 < 4; ++d0) { const bf16x8 a = *(LAS const bf16x8*)(kt + (32 * kb + i32) * AT_PKT + (64 * map + 16 * d0 + 8 * hi) * 2);
            acc = __builtin_amdgcn_mfma_f32_32x32x16_bf16(a, qf[d0], acc, 0, 0, 0); }
        p[kb] = acc; }
}
__device__ __forceinline__ void attn_pv(LAS const unsigned char* vt, AttnState& S, int lane) {
    const int hi = lane >> 5;
    LAS const unsigned char* base = vt + tr_off(AT_PVT, 4 * hi, 0, lane);
#pragma unroll
    for (int st = 0; st < 4; ++st) { s16x4 lo[4], hh[4];
#pragma unroll
        for (int eb = 0; eb < 4; ++eb) { lo[eb] = tr_rd(base + st * 16 * AT_PVT + eb * 64); hh[eb] = tr_rd(base + st * 16 * AT_PVT + eb * 64 + 8 * AT_PVT); }
#pragma unroll
        for (int eb = 0; eb < 4; ++eb) S.o[eb] = __builtin_amdgcn_mfma_f32_32x32x16_bf16(mk8(lo[eb], hh[eb]), S.pf[st], S.o[eb], 0, 0, 0);
    }
}
__device__ __forceinline__ void attn_softmax(f32x16 (&p)[2], AttnState& S, int nvalid, int lane) {
    const int hi = lane >> 5;
    if (nvalid < 64) {
#pragma unroll
        for (int kb = 0; kb < 2; ++kb)
#pragma unroll
            for (int r = 0; r < 16; ++r) if (32 * kb + crow(r, hi) >= nvalid) p[kb][r] = -INFINITY; }
    float ma = fmaxf(fmaxf(p[0][0], p[0][1]), p[1][0]), mb = fmaxf(fmaxf(p[0][2], p[0][3]), p[1][1]);
    ma = fmaxf(fmaxf(ma, p[1][2]), p[1][3]);
#pragma unroll
    for (int r = 4; r < 16; r += 4) { ma = fmaxf(fmaxf(ma, p[0][r]), p[0][r + 1]); mb = fmaxf(fmaxf(mb, p[0][r + 2]), p[0][r + 3]); ma = fmaxf(fmaxf(ma, p[1][r]), p[1][r + 1]); mb = fmaxf(fmaxf(mb, p[1][r + 2]), p[1][r + 3]); }
    const float mref = S.m; const float mx = xhalf_max(fmaxf(ma, mb)) - mref;
#pragma unroll
    for (int kb = 0; kb < 2; ++kb)
#pragma unroll
        for (int r = 0; r < 16; ++r) p[kb][r] = __builtin_amdgcn_exp2f(p[kb][r] - mref);
    if (__any(mx > ATT_THR)) {
        const float dl = fmaxf(mx, 0.f); S.m += dl;
        const float f = __builtin_amdgcn_exp2f(-dl); S.l *= f;
#pragma unroll
        for (int kb = 0; kb < 2; ++kb)
#pragma unroll
            for (int r = 0; r < 16; ++r) p[kb][r] *= f;
#pragma unroll
        for (int eb = 0; eb < 4; ++eb)
#pragma unroll
            for (int r = 0; r < 16; ++r) S.o[eb][r] *= f;
    }
    float sa = 0.f, sb = 0.f;
#pragma unroll
    for (int kb = 0; kb < 2; ++kb)
#pragma unroll
        for (int r = 0; r < 16; r += 2) { sa += p[kb][r]; sb += p[kb][r + 1]; }
    S.l += sa + sb;
#pragma unroll
    for (int kb = 0; kb < 2; ++kb)
#pragma unroll
        for (int ks = 0; ks < 2; ++ks) { u32x4 pw; pw.x = pk2(p[kb][8 * ks], p[kb][8 * ks + 1]); pw.y = pk2(p[kb][8 * ks + 2], p[kb][8 * ks + 3]); pw.z = pk2(p[kb][8 * ks + 4], p[kb][8 * ks + 5]); pw.w = pk2(p[kb][8 * ks + 6], p[kb][8 * ks + 7]);
            S.pf[2 * kb + ks] = __builtin_bit_cast(bf16x8, pw); }
}
__device__ __forceinline__ void attn_step(LAS const unsigned char* ktn, LAS const unsigned char* vtc, int map, const bf16x8 (&qf)[4], AttnState& S, int lane) {
    const int i32 = lane & 31, hi = lane >> 5;
    f32x16 p[2];
    LAS const unsigned char* base = vtc + tr_off(AT_PVT, 4 * hi, 0, lane);
    s16x4 lo[2][4], hh[2][4];
#pragma unroll
    for (int eb = 0; eb < 4; ++eb) { lo[0][eb] = tr_rd(base + eb * 64); hh[0][eb] = tr_rd(base + eb * 64 + 8 * AT_PVT); }
#pragma unroll
    for (int kb = 0; kb < 2; ++kb) { f32x16 acc = {};
#pragma unroll
        for (int d0 = 0; d0 < 4; ++d0) { const bf16x8 a = *(LAS const bf16x8*)(ktn + (32 * kb + i32) * AT_PKT + (64 * map + 16 * d0 + 8 * hi) * 2);
            acc = __builtin_amdgcn_mfma_f32_32x32x16_bf16(a, qf[d0], acc, 0, 0, 0); }
        p[kb] = acc; }
    const float mref = S.m;
    __builtin_amdgcn_sched_barrier(0);
#pragma unroll
    for (int st = 0; st < 4; ++st) {
        if (st < 3) {
#pragma unroll
            for (int eb = 0; eb < 4; ++eb) { lo[(st + 1) & 1][eb] = tr_rd(base + (st + 1) * 16 * AT_PVT + eb * 64); hh[(st + 1) & 1][eb] = tr_rd(base + (st + 1) * 16 * AT_PVT + eb * 64 + 8 * AT_PVT); } }
        __builtin_amdgcn_sched_barrier(0);
#pragma unroll
        for (int eb = 0; eb < 4; ++eb) {
            S.o[eb] = __builtin_amdgcn_mfma_f32_32x32x16_bf16(mk8(lo[st & 1][eb], hh[st & 1][eb]), S.pf[st], S.o[eb], 0, 0, 0);
            const int e0 = 2 * (4 * st + eb);
            p[e0 >> 4][e0 & 15] = __builtin_amdgcn_exp2f(p[e0 >> 4][e0 & 15] - mref); p[e0 >> 4][(e0 & 15) + 1] = __builtin_amdgcn_exp2f(p[e0 >> 4][(e0 & 15) + 1] - mref);
            __builtin_amdgcn_sched_barrier(0);
        }
    }
    float ma = fmaxf(fmaxf(p[0][0], p[0][1]), p[1][0]), mb = fmaxf(fmaxf(p[0][2], p[0][3]), p[1][1]);
    ma = fmaxf(fmaxf(ma, p[1][2]), p[1][3]);
#pragma unroll
    for (int r = 4; r < 16; r += 4) { ma = fmaxf(fmaxf(ma, p[0][r]), p[0][r + 1]); mb = fmaxf(fmaxf(mb, p[0][r + 2]), p[0][r + 3]); ma = fmaxf(fmaxf(ma, p[1][r]), p[1][r + 1]); mb = fmaxf(fmaxf(mb, p[1][r + 2]), p[1][r + 3]); }
    const float emx = xhalf_max(fmaxf(ma, mb));
    if (__any(emx > 64.0f)) {
        const float dl = fmaxf(__builtin_amdgcn_logf(emx), 0.f);
        S.m += dl;
        const float f = __builtin_amdgcn_exp2f(-dl); S.l *= f;
#pragma unroll
        for (int kb = 0; kb < 2; ++kb)
#pragma unroll
            for (int r = 0; r < 16; ++r) p[kb][r] *= f;
#pragma unroll
        for (int eb = 0; eb < 4; ++eb)
#pragma unroll
            for (int r = 0; r < 16; ++r) S.o[eb][r] *= f;
    }
    float sa = 0.f, sb = 0.f;
#pragma unroll
    for (int kb = 0; kb < 2; ++kb)
#pragma unroll
        for (int r = 0; r < 16; r += 2) { sa += p[kb][r]; sb += p[kb][r + 1]; }
    S.l += sa + sb;
#pragma unroll
    for (int kb = 0; kb < 2; ++kb)
#pragma unroll
        for (int ks = 0; ks < 2; ++ks) { u32x4 pw; pw.x = pk2(p[kb][8 * ks], p[kb][8 * ks + 1]); pw.y = pk2(p[kb][8 * ks + 2], p[kb][8 * ks + 3]); pw.z = pk2(p[kb][8 * ks + 4], p[kb][8 * ks + 5]); pw.w = pk2(p[kb][8 * ks + 6], p[kb][8 * ks + 7]);
            S.pf[2 * kb + ks] = __builtin_bit_cast(bf16x8, pw); }
}
__device__ __forceinline__ void attn_tile(LAS const unsigned char* kt, LAS const unsigned char* vt, int map, const bf16x8 (&qf)[4], AttnState& S, int nvalid, int lane) {
    f32x16 p[2]; attn_qk(kt, map, qf, S, p, lane); attn_softmax(p, S, nvalid, lane); attn_pv(vt, S, lane);
}
__device__ __forceinline__ void attn_finish(ArgsP A, LAS unsigned char* lds, AttnState& S, int map, int g, int h, size_t row_base, int nrows, float lam, int lane) {
    const int i32 = lane & 31, hi = lane >> 5;
    const float lt = xhalf_sum(S.l); const float inv = 1.f / lt;
    LAS float* X = (LAS float*)lds + g * 4096;
    __syncthreads();
    if (map == 1) {
#pragma unroll
        for (int eb = 0; eb < 4; ++eb)
#pragma unroll
            for (int r = 0; r < 16; ++r) X[(32 * eb + crow(r, hi)) * 32 + i32] = S.o[eb][r] * inv; }
    __syncthreads();
    if (map == 0) { float sq = 0.f;
#pragma unroll
        for (int eb = 0; eb < 4; ++eb)
#pragma unroll
            for (int r = 0; r < 16; ++r) { const float v = S.o[eb][r] * inv - lam * X[(32 * eb + crow(r, hi)) * 32 + i32]; S.o[eb][r] = v; sq += v * v; }
        sq = xhalf_sum(sq);
        const float rstd = (1.f - LAM_INIT) / sqrtf(sq * (1.f / 128.f) + EPS);
        if (i32 < nrows) { bf16* mp = (bf16*)(A->ws + WS_MIX) + (row_base + i32) * DM + h * 128; const float* gs = A->in[18] + h * 128;
#pragma unroll
            for (int eb = 0; eb < 4; ++eb)
#pragma unroll
                for (int g4 = 0; g4 < 4; ++g4) { const int e = 32 * eb + 8 * g4 + 4 * hi; const f32x4 gv = *(const f32x4*)(gs + e);
                    u32x2 w; w.x = pk2(S.o[eb][4 * g4] * rstd * gv[0], S.o[eb][4 * g4 + 1] * rstd * gv[1]); w.y = pk2(S.o[eb][4 * g4 + 2] * rstd * gv[2], S.o[eb][4 * g4 + 3] * rstd * gv[3]);
                    *(u32x2*)(mp + e) = w; } } }
    __syncthreads();
}
__device__ __forceinline__ void attn_prompt_unit(ArgsP A, LAS unsigned char* lds, int h, int qb, float lam, int tid, int wave, int lane) {
    unsigned char* ws = A->ws; const bf16* QA = (const bf16*)(ws + WS_QA); const bf16* KA = (const bf16*)(ws + WS_KA); const bf16* PROJ = (const bf16*)(ws + WS_PROJ);
    const int map = wave & 1, g = wave >> 1, i32 = lane & 31, hi = lane >> 5;
    const int ntiles = 2 * qb + 2, mytiles = 2 * qb + (g >> 1) + 1;
    bf16x8 qf[4];
    { const bf16* qp = QA + (size_t)(128 * qb + 32 * g + i32) * 1024 + h * 128 + 64 * map + 8 * hi;
#pragma unroll
      for (int d0 = 0; d0 < 4; ++d0) qf[d0] = *(const bf16x8*)(qp + 16 * d0); }
    AttnState S; S.m = 0.f; S.l = 0.f;
#pragma unroll
    for (int i = 0; i < 4; ++i) S.pf[i] = (bf16x8){0, 0, 0, 0, 0, 0, 0, 0};
#pragma unroll
    for (int eb = 0; eb < 4; ++eb) S.o[eb] = (f32x16){};
    const int key = tid >> 3, seg = tid & 7;
    const bf16* kp = KA + (size_t)key * 1024 + h * 128 + 16 * seg; const bf16* vp = PROJ + (size_t)key * NINP + C_VA + h * 128 + 16 * seg;
    const int ko = key * AT_PKT + seg * 32, vo = AT_V + key * AT_PVT + seg * 32;
    { u32x4 k0 = *(const u32x4*)kp, k1 = *(const u32x4*)(kp + 8), v0 = *(const u32x4*)vp, v1 = *(const u32x4*)(vp + 8);
      const bf16* kq = kp + (size_t)64 * 1024; const bf16* vq = vp + (size_t)64 * NINP;
      u32x4 k2 = *(const u32x4*)kq, k3 = *(const u32x4*)(kq + 8), v2 = *(const u32x4*)vq, v3 = *(const u32x4*)(vq + 8);
      *(LAS u32x4*)(lds + ko) = k0; *(LAS u32x4*)(lds + ko + 16) = k1; *(LAS u32x4*)(lds + vo) = v0; *(LAS u32x4*)(lds + vo + 16) = v1;
      *(LAS u32x4*)(lds + AT_BUF + ko) = k2; *(LAS u32x4*)(lds + AT_BUF + ko + 16) = k3; *(LAS u32x4*)(lds + AT_BUF + vo) = v2; *(LAS u32x4*)(lds + AT_BUF + vo + 16) = v3; }
    __syncthreads();
    { f32x16 p[2]; attn_qk(lds, map, qf, S, p, lane); attn_softmax(p, S, 64, lane); }
    int bc = 0, bn = AT_BUF, bw = 2 * AT_BUF;
    for (int j = 0; j < ntiles; ++j) {
        const bool more = (j + 2 < ntiles);
        u32x4 k0, k1, v0, v1;
        if (more) { const bf16* kq = kp + (size_t)(j + 2) * 64 * 1024; const bf16* vq = vp + (size_t)(j + 2) * 64 * NINP;
            k0 = *(const u32x4*)kq; k1 = *(const u32x4*)(kq + 8); v0 = *(const u32x4*)vq; v1 = *(const u32x4*)(vq + 8); }
        if (j + 1 < mytiles) attn_step(lds + bn, lds + bc + AT_V, map, qf, S, lane);
        else if (j < mytiles) attn_pv(lds + bc + AT_V, S, lane);
        if (more) { LAS unsigned char* w = lds + bw; *(LAS u32x4*)(w + ko) = k0; *(LAS u32x4*)(w + ko + 16) = k1; *(LAS u32x4*)(w + vo) = v0; *(LAS u32x4*)(w + vo + 16) = v1; }
        __syncthreads();
        const int t = bc; bc = bn; bn = bw; bw = t;
    }
    attn_finish(A, lds, S, map, g, h, (size_t)(128 * qb + 32 * g), 32, lam, lane);
}
__device__ __forceinline__ void attn_sample_unit(ArgsP A, LAS unsigned char* lds, int b, int h, float lam, int tid, int wave, int lane) {
    unsigned char* ws = A->ws; const bf16* QA = (const bf16*)(ws + WS_QA); const bf16* KA = (const bf16*)(ws + WS_KA); const bf16* PROJ = (const bf16*)(ws + WS_PROJ);
    const int map = wave & 1, i32 = lane & 31, hi = lane >> 5; const bool comp = wave < 2;
    bf16x8 qf[4];
#pragma unroll
    for (int d0 = 0; d0 < 4; ++d0) qf[d0] = (bf16x8){0, 0, 0, 0, 0, 0, 0, 0};
    if (i32 < 16) { const bf16* qp = QA + (size_t)(MP + 16 * b + i32) * 1024 + h * 128 + 64 * map + 8 * hi;
#pragma unroll
      for (int d0 = 0; d0 < 4; ++d0) qf[d0] = *(const bf16x8*)(qp + 16 * d0); }
    AttnState S; S.m = 0.f; S.l = 0.f;
#pragma unroll
    for (int i = 0; i < 4; ++i) S.pf[i] = (bf16x8){0, 0, 0, 0, 0, 0, 0, 0};
#pragma unroll
    for (int eb = 0; eb < 4; ++eb) S.o[eb] = (f32x16){};
    const int key = tid >> 3, seg = tid & 7;
    const float* kc = A->in[2] + (((size_t)b * PAST + key) * 8 + h) * 128 + 16 * seg; const float* vc = A->in[3] + (((size_t)b * PAST + key) * 8 + h) * 128 + 16 * seg;
    const int ko = key * AT_PKT + seg * 32, vo = AT_V + key * AT_PVT + seg * 32;
    f32x4 kr[4], vr[4];
#pragma unroll
    for (int i = 0; i < 4; ++i) { kr[i] = *(const f32x4*)(kc + 4 * i); vr[i] = *(const f32x4*)(vc + 4 * i); }
    for (int j = 0; j < 17; ++j) {
        LAS unsigned char* nb = lds + (j & 1) * AT_BUF;
        if (j < 16) { u32x4 a, c;
            a.x = pk2(kr[0][0], kr[0][1]); a.y = pk2(kr[0][2], kr[0][3]); a.z = pk2(kr[1][0], kr[1][1]); a.w = pk2(kr[1][2], kr[1][3]);
            c.x = pk2(kr[2][0], kr[2][1]); c.y = pk2(kr[2][2], kr[2][3]); c.z = pk2(kr[3][0], kr[3][1]); c.w = pk2(kr[3][2], kr[3][3]);
            *(LAS u32x4*)(nb + ko) = a; *(LAS u32x4*)(nb + ko + 16) = c;
            a.x = pk2(vr[0][0], vr[0][1]); a.y = pk2(vr[0][2], vr[0][3]); a.z = pk2(vr[1][0], vr[1][1]); a.w = pk2(vr[1][2], vr[1][3]);
            c.x = pk2(vr[2][0], vr[2][1]); c.y = pk2(vr[2][2], vr[2][3]); c.z = pk2(vr[3][0], vr[3][1]); c.w = pk2(vr[3][2], vr[3][3]);
            *(LAS u32x4*)(nb + vo) = a; *(LAS u32x4*)(nb + vo + 16) = c;
        } else { u32x4 a = {0u, 0u, 0u, 0u}, c = a, d = a, e = a;
            if (key < 16) { const bf16* kq = KA + (size_t)(MP + 16 * b + key) * 1024 + h * 128 + 16 * seg; const bf16* vq = PROJ + (size_t)(MP + 16 * b + key) * NINP + C_VA + h * 128 + 16 * seg;
                a = *(const u32x4*)kq; c = *(const u32x4*)(kq + 8); d = *(const u32x4*)vq; e = *(const u32x4*)(vq + 8); }
            *(LAS u32x4*)(nb + ko) = a; *(LAS u32x4*)(nb + ko + 16) = c; *(LAS u32x4*)(nb + vo) = d; *(LAS u32x4*)(nb + vo + 16) = e; }
        if (j + 1 < 16) {
#pragma unroll
            for (int i = 0; i < 4; ++i) { kr[i] = *(const f32x4*)(kc + (size_t)(j + 1) * 64 * 1024 + 4 * i); vr[i] = *(const f32x4*)(vc + (size_t)(j + 1) * 64 * 1024 + 4 * i); } }
        __syncthreads();
        if (comp) attn_tile(nb, nb + AT_V, map, qf, S, (j < 16) ? 64 : 16, lane);
    }
    attn_finish(A, lds, S, comp ? map : 2, 0, h, (size_t)(MP + 16 * b), 16, lam, lane);
}
template <int NPART> __device__ __forceinline__ void final_norm_rows(float* y, const float* __restrict__ g, int wave, int lane, const float* x1S, const bf16* part, const float* gate) {
    const int gw = blockIdx.x * NW + wave, NGW = gridDim.x * NW;
    for (int r = gw; r < MTOK; r += NGW) { float* yr = y + (size_t)r * DM; f32x4 v[8]; float s = 0.f;
        if (r < MP) {
#pragma unroll
            for (int j = 0; j < 8; ++j) v[j] = *(const f32x4*)(yr + 256 * j + 4 * lane);
        } else {
            const float* gr = gate + (size_t)(1 + ((r - MP) >> 4)) * 12288;
#pragma unroll
            for (int j = 0; j < 8; ++j) { const int c = 256 * j + 4 * lane; f32x4 a = {0.f, 0.f, 0.f, 0.f};
                f32x4 t[NPART];
#pragma unroll
                for (int p = 0; p < NPART; ++p) t[p] = ld_bf4(part + ((size_t)p * MS + (r - MP)) * DM + c);
#pragma unroll
                for (int p = 0; p < NPART; ++p) a += t[p];
                v[j] = *(const f32x4*)(x1S + (size_t)(r - MP) * DM + c) + *(const f32x4*)(gr + c) * a; } }
#pragma unroll
        for (int j = 0; j < 8; ++j) s += (v[j].x * v[j].x + v[j].y * v[j].y) + (v[j].z * v[j].z + v[j].w * v[j].w);
        const float rstd = 1.f / sqrtf(wave_sum(s, lane) * (1.f / DM) + EPS);
#pragma unroll
        for (int j = 0; j < 8; ++j) { const f32x4 gg = *(const f32x4*)(g + 256 * j + 4 * lane); *(f32x4*)(yr + 256 * j + 4 * lane) = v[j] * rstd * gg; } }
}
__global__ void __launch_bounds__(NT, 2) fwd_megakernel(Args A_) {
    extern __shared__ __attribute__((aligned(16))) unsigned char lds_raw[];
    LAS unsigned char* lds = (LAS unsigned char*)lds_raw;
    cg::grid_group grid = cg::this_grid();
    int tid, lane, wave;
#define FRESH_TID() do { tid = threadIdx.x; asm volatile("" : "+v"(tid)); lane = tid & 63; wave = __builtin_amdgcn_readfirstlane(tid >> 6); } while (0)
    FRESH_TID();
    ArgsP A = FRESH_ARGS();
    unsigned char* ws = A->ws;
    float* mod = (float*)(ws + WS_MOD);
    const int G = gridDim.x, bid = blockIdx.x;
    A = FRESH_ARGS(); ws = A->ws; mod = (float*)(ws + WS_MOD); FRESH_TID();
    if (tid < 2) ((volatile LAS unsigned*)(lds + LDS_BYTES - 16))[tid] = 0u;
    __syncthreads();
    XcdBarrier xb = xcd_barrier_post((unsigned*)(ws + WS_FLAG) + 1024, (volatile LAS unsigned*)(lds + LDS_BYTES - 16));
    if (ws == nullptr) grid.sync();
#ifndef NO_P0
    p0_prologue(A, lds, tid, wave, lane);
#endif
    xcd_barrier(xb);
    A = FRESH_ARGS(); ws = A->ws; mod = (float*)(ws + WS_MOD); FRESH_TID();
    norm_mod_rows<0>(A->in[0], A->in[1], A->in[12], mod, 0, 2048, (bf16*)(ws + WS_XN), wave, lane);
    xcd_barrier(xb);
    A = FRESH_ARGS(); ws = A->ws; mod = (float*)(ws + WS_MOD); FRESH_TID();
    { pg8::Gemm g{(const pg8::bf16_t*)(ws + WS_XN), (const pg8::bf16_t*)(ws + WS_WIN), MTOK, NINP, DM, DM}; pg8::StaticOrder S; S.init(MTOK, NINP, G, bid);
      pg8::EpiProj E{(pg8::bf16_t*)(ws + WS_PROJ), NINP, A->out + O_VP, A->out + O_VS};
      pg8::gemm_phase<pg8::EpiProj, pg8::StaticOrder, true, true>(lds, g, S, E); }
    xcd_barrier(xb);
    A = FRESH_ARGS(); ws = A->ws; mod = (float*)(ws + WS_MOD); FRESH_TID();
#ifndef NO_P3
    p3_post(A, tid);
#endif
#ifndef NO_PA
    for (int i = bid; i < NCH * 4; i += G) mlstm_phaseA(A, lds, i >> 2, i & 3, tid, wave, lane);
#endif
    xcd_barrier(xb);
    A = FRESH_ARGS(); ws = A->ws; mod = (float*)(ws + WS_MOD); FRESH_TID();
#ifndef NO_PB
    mlstm_phaseB(A, lds, tid, wave, lane);
#endif
    xcd_barrier(xb);
    A = FRESH_ARGS(); ws = A->ws; mod = (float*)(ws + WS_MOD); FRESH_TID();
    { const float s1 = wave_sum(A->in[14][lane] * A->in[15][lane], lane), s2 = wave_sum(A->in[16][lane] * A->in[17][lane], lane);
      const float lam = __expf(s1) - __expf(s2) + LAM_INIT;
      for (int i = bid; i < 256; i += G) { const int h = i & 7, p = i >> 3; const int rot = (p & 1) ? 0 : 3;
          for (int sl = 0; sl < 6; ++sl) { int kk = sl + rot; if (kk >= 6) kk -= 6;
              FRESH_TID();
              if (kk < 2) attn_prompt_unit(A, lds, h, kk == 0 ? 63 - p : p, lam, tid, wave, lane);
              else if (kk == 2) attn_sample_unit(A, lds, i >> 3, i & 7, lam, tid, wave, lane);
              else { const int cu = i + 256 * (kk - 3); if (cu < NCH * 4) mlstm_phaseC(A, lds, cu >> 2, cu & 3, tid, wave, lane); } } }
    }
    xcd_barrier(xb);
    A = FRESH_ARGS(); ws = A->ws; mod = (float*)(ws + WS_MOD); FRESH_TID();
    { pg8::Gemm g{(const pg8::bf16_t*)(ws + WS_MIX), (const pg8::bf16_t*)(ws + WS_WOUT), MP, DM, DM, DM}; pg8::StaticOrder S; S.init(MP, DM, G, bid);
      pg8::EpiResid E{A->in[0], A->in[1], mod + 4096, (float*)(ws + WS_X1)};
      pg8::gemm_phase<pg8::EpiResid, pg8::StaticOrder, true, true>(lds, g, S, E); }
    for (int un = bid; un < 128; un += G) { const int tile = un >> 3, kc = un & 7;
      pg8::Gemm g{(const pg8::bf16_t*)(ws + WS_MIX) + 256 * kc, (const pg8::bf16_t*)(ws + WS_WOUT) + 256 * kc, MTOK, DM, 256, DM}; pg8::OneUnit S{{32 + (tile >> 3), tile & 7}};
      pg8::EpiPart E{(pg8::bf16_t*)(ws + WS_PART6) + (size_t)kc * MS * DM, DM};
      pg8::gemm_phase<pg8::EpiPart, pg8::OneUnit, false, true>(lds, g, S, E); }
    xcd_barrier(xb);
    A = FRESH_ARGS(); ws = A->ws; mod = (float*)(ws + WS_MOD); FRESH_TID();
    norm_mod_rows<8>((const float*)(ws + WS_X1), A->in[1], A->in[25], mod, 6144, 8192, (bf16*)(ws + WS_XN), wave, lane, (const bf16*)(ws + WS_PART6), 4096, (float*)(ws + WS_X1) + (size_t)MP * DM);
    xcd_barrier(xb);
    A = FRESH_ARGS(); ws = A->ws; mod = (float*)(ws + WS_MOD); FRESH_TID();
    { pg8::Gemm g{(const pg8::bf16_t*)(ws + WS_XN), (const pg8::bf16_t*)(ws + WS_WUP), MP, DFF, DM, DM}; pg8::StaticOrder S; S.init(MP, DFF, G, bid);
      pg8::EpiStore<2> E{(pg8::bf16_t*)(ws + WS_H), DFF};
      pg8::gemm_phase<pg8::EpiStore<2>, pg8::StaticOrder, true, true>(lds, g, S, E); }
    for (int un = bid; un < 256; un += G) { const int tile = un >> 2, kq = un & 3;
      pg8::Gemm g{(const pg8::bf16_t*)(ws + WS_XN) + 512 * kq, (const pg8::bf16_t*)(ws + WS_WUP) + 512 * kq, MTOK, DFF, 512, DM}; pg8::OneUnit S{{32 + (tile >> 5), tile & 31}};
      pg8::EpiPart E{(pg8::bf16_t*)(ws + WS_PART8) + (size_t)kq * MS * DFF, DFF};
      pg8::gemm_phase<pg8::EpiPart, pg8::OneUnit, false, true>(lds, g, S, E); }
    xcd_barrier(xb);
    A = FRESH_ARGS(); ws = A->ws; mod = (float*)(ws + WS_MOD); FRESH_TID();
    { const bf16* P8 = (const bf16*)(ws + WS_PART8); bf16* H = (bf16*)(ws + WS_H);
      for (int r = bid; r < MS; r += G)
          for (int c = 4 * tid; c < DFF; c += 4 * NT) { f32x4 a = ld_bf4(P8 + (size_t)r * DFF + c);
#pragma unroll
              for (int p = 1; p < 4; ++p) a += ld_bf4(P8 + ((size_t)p * MS + r) * DFF + c);
              a.x = fmaxf(a.x, 0.f); a.y = fmaxf(a.y, 0.f); a.z = fmaxf(a.z, 0.f); a.w = fmaxf(a.w, 0.f);
              u32x2 o; o.x = pk2(a.x * a.x, a.y * a.y); o.y = pk2(a.z * a.z, a.w * a.w); *(u32x2*)(H + (size_t)(MP + r) * DFF + c) = o; }
      __threadfence(); __syncthreads();
      if (tid == 0) __hip_atomic_fetch_add((unsigned*)(ws + WS_FLAG), 1u, __ATOMIC_RELEASE, __HIP_MEMORY_SCOPE_AGENT); }
    { pg8::Gemm g{(const pg8::bf16_t*)(ws + WS_H), (const pg8::bf16_t*)(ws + WS_WDN), MP, DM, DFF, DFF}; pg8::StaticOrder S; S.init(MP, DM, G, bid);
      pg8::EpiResid E{(const float*)(ws + WS_X1), (const float*)(ws + WS_X1) + (size_t)MP * DM, mod + 10240, A->out};
      pg8::gemm_phase<pg8::EpiResid, pg8::StaticOrder, true, true>(lds, g, S, E); }
    { if (tid == 0) { while (__hip_atomic_load((unsigned*)(ws + WS_FLAG), __ATOMIC_ACQUIRE, __HIP_MEMORY_SCOPE_AGENT) < (unsigned)G) __builtin_amdgcn_s_sleep(8); }
      __syncthreads(); __builtin_amdgcn_fence(__ATOMIC_ACQUIRE, "agent"); }
    for (int un = bid; un < 256; un += G) { const int tile = un >> 4, kc = un & 15;
      pg8::Gemm g{(const pg8::bf16_t*)(ws + WS_H) + 512 * kc, (const pg8::bf16_t*)(ws + WS_WDN) + 512 * kc, MTOK, DM, 512, DFF}; pg8::OneUnit S{{32 + (tile >> 3), tile & 7}};
      pg8::EpiPart E{(pg8::bf16_t*)(ws + WS_PART9) + (size_t)kc * MS * DM, DM};
      pg8::gemm_phase<pg8::EpiPart, pg8::OneUnit, false, true>(lds, g, S, E); }
    xcd_barrier(xb);
    A = FRESH_ARGS(); ws = A->ws; mod = (float*)(ws + WS_MOD); FRESH_TID();
    final_norm_rows<16>(A->out, A->in[28], wave, lane, (const float*)(ws + WS_X1) + (size_t)MP * DM, (const bf16*)(ws + WS_PART9), mod + 10240);
}

extern "C" void kernel_launch(void* const* d_in, const int* in_sizes, int n_in, void* d_out, int out_size, void* d_ws, size_t ws_size, hipStream_t stream) {
    static int grid = 0;
    if (grid == 0) {
        if (n_in != 29 || ws_size < WS_END) { fprintf(stderr, "kernel_launch: unexpected n_in %d / ws %zu\n", n_in, ws_size); grid = -1; return; }
        int dev = 0, cus = 0, per_cu = 0;
        (void)hipGetDevice(&dev); (void)hipDeviceGetAttribute(&cus, hipDeviceAttributeMultiprocessorCount, dev);
        (void)hipFuncSetAttribute((const void*)fwd_megakernel, hipFuncAttributeMaxDynamicSharedMemorySize, LDS_BYTES);
        (void)hipOccupancyMaxActiveBlocksPerMultiprocessor(&per_cu, (const void*)fwd_megakernel, NT, LDS_BYTES);
        (void)hipGetLastError();
        grid = cus;
    }
    if (grid < 0) return;
    (void)hipMemsetAsync((char*)d_ws + WS_FLAG, 0, 32768, stream);
    Args a{};
    for (int i = 0; i < 29; ++i) a.in[i] = (const float*)d_in[i];
    a.out = (float*)d_out; a.ws = (unsigned char*)d_ws;
    void* args[] = {&a};
    hipError_t e = hipLaunchCooperativeKernel((void*)fwd_megakernel, dim3(grid), dim3(NT), args, LDS_BYTES, stream);
    if (e != hipSuccess) fprintf(stderr, "cooperative launch failed: %s (grid %d)\n", hipGetErrorString(e), grid);
}
```

```cpp
#include <hip/hip_runtime.h>
#include <hip/hip_cooperative_groups.h>
#include <cstdio>
#include <cstdint>
namespace cg = cooperative_groups;
namespace pg8 {
#define PG8_LAS __attribute__((address_space(3)))
typedef unsigned short bf16_t;
typedef short bf16x8 __attribute__((ext_vector_type(8)));
typedef float f32x4 __attribute__((ext_vector_type(4)));
typedef unsigned u32x4 __attribute__((ext_vector_type(4)));
constexpr int BM = 256, BK = 64, HALF = 128, HTB = HALF * BK * 2  , STAGE_BYTES = 8 * HTB, NXCD = 8, WGM = 8;

__host__ __device__ __forceinline__ int lds_byte(int r, int c) { const int st = (r >> 4) * 2 + (c >> 5), rr = r & 15, cc = c & 31, ob = rr * 64 + cc * 2; return st * 1024 + (ob ^ (((ob >> 9) & 1) << 5)); }
__host__ __device__ __forceinline__ void stage_rc(int b, int& R, int& C) { const int st = b / 1024, sb = b % 1024, swz = sb ^ (((sb >> 9) & 1) << 5); R = (st >> 1) * 16 + swz / 64; C = (st & 1) * 32 + (swz % 64) / 2; }
__host__ __device__ __forceinline__ int perm32(int rho) { const int n = rho >> 4, i = rho & 15; return 8 * (i >> 2) + 4 * n + (i & 3); }

struct Unit { int pm, pn; };
struct Gemm { const bf16_t* A; const bf16_t* Bt; int M, N, K, ld; };

struct StaticOrder {
    int nM, nN, nwg, G, c;
    __host__ __device__ void init(int M, int N, int G_, int c_) { nM = M / BM; nN = N / BM; nwg = nM * nN; G = G_; c = c_; }
    __host__ __device__ bool next(int i, Unit& u) const {
        const long L = (long)i * G + c; if (L >= nwg) return false;
        int wgid = (int)L; { const int q = nwg / NXCD, r = nwg % NXCD, xcd = wgid % NXCD, off = wgid / NXCD; wgid = (xcd < r ? xcd * (q + 1) : r * (q + 1) + (xcd - r) * q) + off; }
        const int nig = WGM * nN, gid = wgid / nig, fm = gid * WGM, gsz = (nM - fm) < WGM ? (nM - fm) : WGM;
        u.pm = fm + ((wgid % nig) % gsz); u.pn = (wgid % nig) / gsz; return true;
    }
    __device__ __forceinline__ void a_ready(const Unit&) const {}
    __device__ __forceinline__ void done(const Unit&) const {}
};

typedef float f32x2_t __attribute__((ext_vector_type(2)));
typedef __bf16 bf16x2_t __attribute__((ext_vector_type(2)));
__device__ __forceinline__ unsigned cvt_pk_bf16(float lo, float hi) { f32x2_t v = {lo, hi}; bf16x2_t b = __builtin_convertvector(v, bf16x2_t); return __builtin_bit_cast(unsigned, b); }
template <int ACT  > struct EpiStore {
    static constexpr bool PERM = true, AFTER_DRAIN = false;
    bf16_t* O; int ldc;
    __device__ __forceinline__ void operator()(const f32x4 (&acc)[2][2][4][2], const Unit& u, int wr, int wc, int fr, int fq) const {
        const int row0 = u.pm * BM + wr * 64 + fr; const int col0 = u.pn * BM + wc * 32 + 8 * fq;
#pragma unroll
        for (int ai = 0; ai < 2; ++ai)
#pragma unroll
            for (int m = 0; m < 4; ++m) { bf16_t* rowp = O + (size_t)(row0 + ai * HALF + m * 16) * ldc + col0;
#pragma unroll
                for (int bj = 0; bj < 2; ++bj) { f32x4 v0 = acc[ai][bj][m][0], v1 = acc[ai][bj][m][1];
                    if (ACT == 2) {
#pragma unroll
                        for (int j = 0; j < 4; ++j) { float a = fmaxf(v0[j], 0.f), b = fmaxf(v1[j], 0.f); v0[j] = a * a; v1[j] = b * b; } }
                    u32x4 w; w.x = cvt_pk_bf16(v0[0], v0[1]); w.y = cvt_pk_bf16(v0[2], v0[3]); w.z = cvt_pk_bf16(v1[0], v1[1]); w.w = cvt_pk_bf16(v1[2], v1[3]);
                    *(u32x4*)(rowp + bj * HALF) = w; } }
    }
};
struct EpiProj {
    static constexpr bool PERM = true, AFTER_DRAIN = false;
    bf16_t* O; int ldc; bf16_t* QA; bf16_t* KA; float* kP; float* kS; float* vP; float* vS; const float* rope; float qscale;
    __device__ __forceinline__ void operator()(const f32x4 (&acc)[2][2][4][2], const Unit& u, int wr, int wc, int fr, int fq) const {
        const int row0 = u.pm * BM + wr * 64 + fr; const int col0 = u.pn * BM + wc * 32 + 8 * fq;
        const int kind = (u.pn < 4) ? 0 : (u.pn < 8) ? 1 : (u.pn < 12) ? 2 : 3;
        const bool ropew = (kind < 2) && ((wc & 1) == 0);
        const int plane = ((int)(threadIdx.x & 63) ^ 16) << 2;
#pragma unroll
        for (int ai = 0; ai < 2; ++ai)
#pragma unroll
            for (int m = 0; m < 4; ++m) { const int r = row0 + ai * HALF + m * 16; const int rs = r - 8192;
                f32x4 cs0 = {1.f, 1.f, 1.f, 1.f}, cs1 = cs0, sn0 = {0.f, 0.f, 0.f, 0.f}, sn1 = sn0;
                if (ropew && fq < 2) { const float* tb = rope + (size_t)((r < 8192) ? r : 1024 + (rs & 15)) * 16;
                    cs0 = *(const f32x4*)tb; cs1 = *(const f32x4*)(tb + 4); sn0 = *(const f32x4*)(tb + 8); sn1 = *(const f32x4*)(tb + 12);
                    if (fq == 0) { sn0 = -sn0; sn1 = -sn1; } }
#pragma unroll
                for (int bj = 0; bj < 2; ++bj) { f32x4 v0 = acc[ai][bj][m][0], v1 = acc[ai][bj][m][1];
                    if (ropew) { f32x4 p0, p1;
#pragma unroll
                        for (int j = 0; j < 4; ++j) { p0[j] = __int_as_float(__builtin_amdgcn_ds_bpermute(plane, __float_as_int(v0[j]))); p1[j] = __int_as_float(__builtin_amdgcn_ds_bpermute(plane, __float_as_int(v1[j]))); }
                        v0 = v0 * cs0 + p0 * sn0; v1 = v1 * cs1 + p1 * sn1; }
                    const int c = col0 + bj * HALF;
                    if (kind == 0) { v0 = v0 * qscale; v1 = v1 * qscale; }
                    u32x4 w; w.x = cvt_pk_bf16(v0[0], v0[1]); w.y = cvt_pk_bf16(v0[2], v0[3]); w.z = cvt_pk_bf16(v1[0], v1[1]); w.w = cvt_pk_bf16(v1[2], v1[3]);
                    if (kind == 0) *(u32x4*)(QA + (size_t)r * 1024 + c) = w;
                    else if (kind == 1) { *(u32x4*)(KA + (size_t)r * 1024 + (c - 1024)) = w;
                        float* ko = (r < 8192) ? kP + (size_t)r * 1024 + (c - 1024) : kS + (size_t)rs * 1024 + (c - 1024);
                        *(f32x4*)ko = v0; *(f32x4*)(ko + 4) = v1; }
                    else { *(u32x4*)(O + (size_t)r * ldc + c) = w;
                        if (kind == 2) { float* vo = (r < 8192) ? vP + (size_t)r * 1024 + (c - 2048) : vS + (size_t)rs * 1024 + (c - 2048);
                            *(f32x4*)vo = v0; *(f32x4*)(vo + 4) = v1; } } } }
    }
};
struct EpiResid {
    static constexpr bool PERM = true, AFTER_DRAIN = false;
    const float* baseP; const float* baseS; const float* gate; float* out;
    __device__ __forceinline__ void operator()(const f32x4 (&acc)[2][2][4][2], const Unit& u, int wr, int wc, int fr, int fq) const {
        const int row0 = u.pm * BM + wr * 64 + fr; const int col0 = u.pn * BM + wc * 32 + 8 * fq;
#pragma unroll
        for (int ai = 0; ai < 2; ++ai)
#pragma unroll
            for (int m = 0; m < 4; ++m) { const int r = row0 + ai * HALF + m * 16;
                const float* bp = (r < 8192) ? baseP + (size_t)r * 2048 : baseS + (size_t)(r - 8192) * 2048;
                const float* gp = gate + (size_t)((r < 8192) ? 0 : 1 + ((r - 8192) >> 4)) * 12288;
                float* op = out + (size_t)r * 2048;
#pragma unroll
                for (int bj = 0; bj < 2; ++bj) { const int c = col0 + bj * HALF;
#pragma unroll
                    for (int n = 0; n < 2; ++n) { const f32x4 b = *(const f32x4*)(bp + c + 4 * n), g = *(const f32x4*)(gp + c + 4 * n);
                        *(f32x4*)(op + c + 4 * n) = b + g * acc[ai][bj][m][n]; } }
                asm volatile("" ::: "memory"); }
    }
};

struct EpiPart {
    static constexpr bool PERM = true, AFTER_DRAIN = false;
    bf16_t* out; int ldc;
    __device__ __forceinline__ void operator()(const f32x4 (&acc)[2][2][4][2], const Unit& u, int wr, int wc, int fr, int fq) const {
        const int row0 = u.pm * BM + wr * 64 + fr - 8192; const int col0 = u.pn * BM + wc * 32 + 8 * fq;
#pragma unroll
        for (int ai = 0; ai < 2; ++ai)
#pragma unroll
            for (int m = 0; m < 4; ++m) { bf16_t* op = out + (size_t)(row0 + ai * HALF + m * 16) * ldc + col0;
#pragma unroll
                for (int bj = 0; bj < 2; ++bj) { const f32x4 v0 = acc[ai][bj][m][0], v1 = acc[ai][bj][m][1];
                    u32x4 w; w.x = cvt_pk_bf16(v0[0], v0[1]); w.y = cvt_pk_bf16(v0[2], v0[3]); w.z = cvt_pk_bf16(v1[0], v1[1]); w.w = cvt_pk_bf16(v1[2], v1[3]);
                    *(u32x4*)(op + bj * HALF) = w; } }
    }
};
struct OneUnit { Unit u;
    __device__ __forceinline__ bool next(int i, Unit& o) const { if (i != 0) return false; o = u; return true; }
    __device__ __forceinline__ void a_ready(const Unit&) const {}
    __device__ __forceinline__ void done(const Unit&) const {}
};
template <class Epi, class Sched, bool ALIGN_EPI = false, bool SP2 = false>
__device__ __forceinline__ void gemm_phase(PG8_LAS unsigned char* lds, const Gemm g, const Sched& S, const Epi& E) {
    int tid_ = threadIdx.x; asm volatile("" : "+v"(tid_));
    const int tid = tid_, wid = __builtin_amdgcn_readfirstlane(tid >> 6), lane = tid & 63, wr = wid >> 2, wc = wid & 3, fr = lane & 15, fq = lane >> 4;
    const int K = g.ld, nt = g.K / BK;
    unsigned voffA[2], voffB[2];
#pragma unroll
    for (int i = 0; i < 2; ++i) { int R, C; stage_rc(tid * 16 + i * 8192, R, C); const int Rb = Epi::PERM ? ((R & ~31) + perm32(R & 31)) : R;
        voffA[i] = (unsigned)(R * K + C) * 2u; voffB[i] = (unsigned)(Rb * K + C) * 2u; }
    const size_t kstep = (size_t)(BK * 2);
    const size_t hstep = (size_t)HALF * K * 2;
    const size_t tstep = 2 * hstep;
    const unsigned ldsw = (unsigned)wid * 1024u;
    const int aoff = lds_byte(wr * 64 + fr, fq * 8), boff = lds_byte(wc * 32 + fr, fq * 8);
#define PG8_SA(b, h) (((b) * 2 + (h)) * HTB)
#define PG8_SB(b, h) ((4 + (b) * 2 + (h)) * HTB)
#define PG8_STAGE(bufoff, gbase, voff) do { _Pragma("unroll") for (int _i = 0; _i < 2; ++_i) \
        __builtin_amdgcn_global_load_lds((const unsigned*)((const char*)(gbase) + (voff)[_i]), (PG8_LAS unsigned*)(lds + (bufoff) + ldsw + _i * 8192), 16, 0, 0); } while (0)
#define PG8_LDA(dst, b, h) do { _Pragma("unroll") for (int m = 0; m < 4; ++m) _Pragma("unroll") for (int k = 0; k < 2; ++k) dst[m][k] = *(const PG8_LAS bf16x8*)(lds + PG8_SA(b, h) + aoff + m * 2048 + k * 1024); } while (0)
#define PG8_LDB(dst, b, h) do { _Pragma("unroll") for (int n = 0; n < 2; ++n) _Pragma("unroll") for (int k = 0; k < 2; ++k) dst[n][k] = *(const PG8_LAS bf16x8*)(lds + PG8_SB(b, h) + boff + n * 2048 + k * 1024); } while (0)
#define PG8_MMA(ai, bj, At, Bt) do { __builtin_amdgcn_s_setprio(1); _Pragma("unroll") for (int m = 0; m < 4; ++m) _Pragma("unroll") for (int n = 0; n < 2; ++n) _Pragma("unroll") for (int k = 0; k < 2; ++k) \
        acc[ai][bj][m][n] = __builtin_amdgcn_mfma_f32_16x16x32_bf16(Bt[n][k], At[m][k], acc[ai][bj][m][n], 0, 0, 0); __builtin_amdgcn_s_setprio(0); } while (0)
#define PG8_WAIT_V(n) asm volatile("s_waitcnt vmcnt(" #n ")" ::: "memory")
#define PG8_WAIT_L(n) asm volatile("s_waitcnt lgkmcnt(" #n ")" ::: "memory")
#define PG8_BAR __builtin_amdgcn_s_barrier()
#define PG8_SCHED __builtin_amdgcn_sched_barrier(0)
    Unit cur, nxt; int ui = 0;
    if (!S.next(0, cur)) return;
    f32x4 acc[2][2][4][2];
#pragma unroll
    for (int a = 0; a < 2; ++a)
#pragma unroll
        for (int b = 0; b < 2; ++b)
#pragma unroll
            for (int m = 0; m < 4; ++m)
#pragma unroll
                for (int n = 0; n < 2; ++n) acc[a][b][m][n] = (f32x4){0.f, 0.f, 0.f, 0.f};
    bf16x8 At[4][2], B0[2][2], B1[2][2];
    const char* cA = (const char*)g.A + (size_t)cur.pm * tstep; const char* cB = (const char*)g.Bt + (size_t)cur.pn * tstep;
    S.a_ready(cur);
    if constexpr (SP2) {
        PG8_STAGE(PG8_SB(0, 0), cB, voffB); PG8_STAGE(PG8_SB(0, 1), cB + hstep, voffB); PG8_STAGE(PG8_SA(0, 0), cA, voffA); PG8_STAGE(PG8_SA(0, 1), cA + hstep, voffA);
        if (wr == 1) PG8_BAR;
        PG8_WAIT_V(2); PG8_BAR;
        PG8_STAGE(PG8_SB(1, 0), cB + kstep, voffB); PG8_STAGE(PG8_SA(1, 0), cA + kstep, voffA); PG8_STAGE(PG8_SB(1, 1), cB + hstep + kstep, voffB);
        PG8_WAIT_V(6); PG8_BAR;
    } else {
        PG8_STAGE(PG8_SB(0, 0), cB, voffB); PG8_STAGE(PG8_SA(0, 0), cA, voffA); PG8_STAGE(PG8_SB(0, 1), cB + hstep, voffB); PG8_STAGE(PG8_SA(0, 1), cA + hstep, voffA);
        if (wr == 1) PG8_BAR;
        PG8_WAIT_V(4); PG8_BAR;
        PG8_STAGE(PG8_SB(1, 0), cB + kstep, voffB); PG8_STAGE(PG8_SA(1, 0), cA + kstep, voffA); PG8_STAGE(PG8_SB(1, 1), cB + hstep + kstep, voffB);
        PG8_WAIT_V(6); PG8_BAR;
    }
    for (;;) {
        const bool has_next = S.next(ui + 1, nxt);
        const char* nA = has_next ? (const char*)g.A + (size_t)nxt.pm * tstep : cA; const char* nB = has_next ? (const char*)g.Bt + (size_t)nxt.pn * tstep : cB;
        for (int t = 0; t < nt; t += 2) {
            const bool last = (t == nt - 2);
            const char* a1 = cA + (size_t)(t + 1) * kstep;
            const char* a2 = last ? nA : cA + (size_t)(t + 2) * kstep; const char* b2 = last ? nB : cB + (size_t)(t + 2) * kstep;
            const char* a3 = a2 + kstep; const char* b3 = b2 + kstep;
            if (last && has_next) S.a_ready(nxt);
            if constexpr (SP2) {
            PG8_LDB(B0, 0, 0); PG8_LDB(B1, 0, 1); PG8_SCHED; PG8_LDA(At, 0, 0); PG8_STAGE(PG8_SA(1, 1), a1 + hstep, voffA);
            PG8_WAIT_V(8); PG8_WAIT_L(0); PG8_BAR; PG8_MMA(0, 0, At, B0); PG8_MMA(0, 1, At, B1); PG8_BAR; PG8_SCHED;
            PG8_LDA(At, 0, 1); PG8_STAGE(PG8_SB(0, 0), b2, voffB); PG8_STAGE(PG8_SB(0, 1), b2 + hstep, voffB); PG8_STAGE(PG8_SA(0, 0), a2, voffA);
            PG8_WAIT_V(8); PG8_WAIT_L(0); PG8_BAR; PG8_MMA(1, 0, At, B0); PG8_MMA(1, 1, At, B1); PG8_BAR; PG8_SCHED;
            PG8_LDB(B0, 1, 0); PG8_LDB(B1, 1, 1); PG8_SCHED; PG8_LDA(At, 1, 0); PG8_STAGE(PG8_SA(0, 1), a2 + hstep, voffA);
            PG8_WAIT_V(8); PG8_WAIT_L(0); PG8_BAR; PG8_MMA(0, 0, At, B0); PG8_MMA(0, 1, At, B1); PG8_BAR; PG8_SCHED;
            PG8_LDA(At, 1, 1); PG8_STAGE(PG8_SB(1, 0), b3, voffB); PG8_STAGE(PG8_SB(1, 1), b3 + hstep, voffB); PG8_STAGE(PG8_SA(1, 0), a3, voffA);
            PG8_WAIT_V(8); PG8_WAIT_L(0); PG8_BAR; PG8_MMA(1, 0, At, B0); PG8_MMA(1, 1, At, B1); PG8_BAR; PG8_SCHED;
            } else {
            PG8_LDB(B0, 0, 0); PG8_SCHED; PG8_LDA(At, 0, 0); PG8_STAGE(PG8_SA(1, 1), a1 + hstep, voffA);
            PG8_WAIT_L(8); PG8_BAR; PG8_WAIT_L(0); PG8_MMA(0, 0, At, B0); PG8_BAR; PG8_SCHED;
            PG8_LDB(B1, 0, 1); PG8_STAGE(PG8_SB(0, 0), b2, voffB);
            PG8_BAR; PG8_WAIT_L(0); PG8_MMA(0, 1, At, B1); PG8_BAR;
            PG8_LDA(At, 0, 1); PG8_STAGE(PG8_SA(0, 0), a2, voffA);
            PG8_BAR; PG8_WAIT_L(0); PG8_MMA(1, 0, At, B0); PG8_BAR; PG8_SCHED;
            PG8_STAGE(PG8_SB(0, 1), b2 + hstep, voffB);
            PG8_WAIT_V(6); PG8_BAR; PG8_MMA(1, 1, At, B1); PG8_BAR;
            PG8_LDB(B0, 1, 0); PG8_SCHED; PG8_LDA(At, 1, 0); PG8_STAGE(PG8_SA(0, 1), a2 + hstep, voffA);
            PG8_WAIT_L(8); PG8_BAR; PG8_WAIT_L(0); PG8_MMA(0, 0, At, B0); PG8_BAR; PG8_SCHED;
            PG8_LDB(B1, 1, 1); PG8_STAGE(PG8_SB(1, 0), b3, voffB);
            PG8_BAR; PG8_WAIT_L(0); PG8_MMA(0, 1, At, B1); PG8_BAR;
            PG8_LDA(At, 1, 1); PG8_STAGE(PG8_SA(1, 0), a3, voffA);
            PG8_BAR; PG8_WAIT_L(0); PG8_MMA(1, 0, At, B0); PG8_BAR; PG8_SCHED;
            PG8_STAGE(PG8_SB(1, 1), b3 + hstep, voffB);
            PG8_WAIT_V(6); PG8_BAR; PG8_MMA(1, 1, At, B1); PG8_BAR;
            }
        }
        if constexpr (ALIGN_EPI) { if (wr == 0) PG8_BAR; }
        if constexpr (!Epi::AFTER_DRAIN) { E(acc, cur, wr, wc, fr, fq); S.done(cur); }
        if (!has_next) break;
#pragma unroll
        for (int a = 0; a < 2; ++a)
#pragma unroll
            for (int b = 0; b < 2; ++b)
#pragma unroll
                for (int m = 0; m < 4; ++m)
#pragma unroll
                    for (int n = 0; n < 2; ++n) acc[a][b][m][n] = (f32x4){0.f, 0.f, 0.f, 0.f};
        cur = nxt; cA = nA; cB = nB; ++ui;
        if constexpr (ALIGN_EPI) { if (wr == 1) PG8_BAR; }
    }
    PG8_WAIT_V(0);
    if constexpr (!ALIGN_EPI) { if (wr == 0) PG8_BAR; }
    PG8_BAR;
    if constexpr (Epi::AFTER_DRAIN) { E.fused(acc, cur, wr, wc, fr, fq, lds, wid, lane); S.done(cur); }
#undef PG8_SA
#undef PG8_SB
#undef PG8_STAGE
#undef PG8_LDA
#undef PG8_LDB
#undef PG8_MMA
#undef PG8_WAIT_V
#undef PG8_WAIT_L
#undef PG8_BAR
#undef PG8_SCHED
}
}
#define GAS __attribute__((address_space(1)))
#define LAS __attribute__((address_space(3)))
typedef unsigned short bf16;
typedef unsigned u32x4 __attribute__((ext_vector_type(4)));
typedef unsigned u32x2 __attribute__((ext_vector_type(2)));
typedef float f32x4 __attribute__((ext_vector_type(4)));
typedef float f32x16 __attribute__((ext_vector_type(16)));
typedef short bf16x8 __attribute__((ext_vector_type(8)));
typedef short s16x4 __attribute__((ext_vector_type(4)));
typedef float f32x2_t __attribute__((ext_vector_type(2)));
constexpr int NW = 8, NT = 512;
constexpr int MTOK = 8704, MP = 8192, MS = 512, DM = 2048, NIN = 7176, NINP = 7424, DFF = 8192;
constexpr int NSEQ = 33;
constexpr int PAST = 1024;
constexpr int C_QA = 0, C_KA = 1024, C_VA = 2048, C_QM = 3072, C_KM = 4096, C_VM = 5120, C_OM = 6144, C_IG = 7168, C_FG = 7172;
constexpr int NCH = 160;
constexpr float EPS = 1e-6f;
constexpr float LAM_INIT = 0.2f;
constexpr float QSCALE = 0.125f * 1.4426950408889634f;
constexpr size_t O_YP = 0, O_YS = 16777216, O_KP = 17825792, O_VP = 26214400, O_CVP = 34603008, O_CP = 34609152, O_NP = 34871296, O_MPO = 34872320,
                 O_KS = 34872324, O_VS = 35396612, O_CVS = 35920900, O_CS = 36117508, O_NS = 44506116, O_MSO = 44538884;
constexpr size_t MiB = 1u << 20;
constexpr size_t WS_MOD = 1 * MiB;
constexpr size_t WS_ROPE = 3 * MiB;
constexpr size_t WS_SCAL = 4 * MiB;
constexpr size_t WS_DN = 5 * MiB;
constexpr size_t WS_NPREV = 6 * MiB;
constexpr size_t WS_WIN = 8 * MiB;
constexpr size_t WS_WOUT = 40 * MiB;
constexpr size_t WS_WUP = 48 * MiB;
constexpr size_t WS_WDN = 80 * MiB;
constexpr size_t WS_XN = 112 * MiB;
constexpr size_t WS_PROJ = 148 * MiB;
constexpr size_t WS_QA = 272 * MiB;
constexpr size_t WS_KA = 289 * MiB;
constexpr size_t WS_VT = 306 * MiB;
constexpr size_t WS_DC = 322 * MiB;
constexpr size_t WS_CPREV = 482 * MiB;
constexpr size_t WS_MIX = 562 * MiB;
constexpr size_t WS_END = 596 * MiB;
constexpr size_t WS_H = WS_PROJ;
constexpr size_t WS_X1 = WS_DC;
constexpr size_t WS_PART6 = 390 * MiB;
constexpr size_t WS_PART8 = 422 * MiB;
constexpr size_t WS_PART9 = 486 * MiB;
constexpr size_t WS_FLAG = 0;
static_assert(WS_H + (size_t)MTOK * DFF * 2 <= WS_VT + 16 * MiB && WS_X1 + (size_t)MTOK * DM * 4 <= WS_CPREV, "overlays");

constexpr int LDS_BYTES = 147456;

__device__ __forceinline__ f32x4 ld_bf4(const bf16* p) { const u32x2 w = *(const u32x2*)p; return (f32x4){__uint_as_float(w.x << 16), __uint_as_float(w.x & 0xffff0000u), __uint_as_float(w.y << 16), __uint_as_float(w.y & 0xffff0000u)}; }
__device__ __forceinline__ float bf2f(unsigned short u) { return __uint_as_float((unsigned)u << 16); }
__device__ __forceinline__ unsigned pk2(float lo, float hi) { return pg8::cvt_pk_bf16(lo, hi); }
__device__ __forceinline__ float lane_get(float v, int src_lane) { return __int_as_float(__builtin_amdgcn_ds_bpermute(src_lane << 2, __float_as_int(v))); }
__device__ __forceinline__ float xhalf_other(float v) { auto rr = __builtin_amdgcn_permlane32_swap(__float_as_uint(v), __float_as_uint(v), false, false); return __uint_as_float(rr[0]) + __uint_as_float(rr[1]) - v; }
__device__ __forceinline__ float xhalf_sum(float v) { auto rr = __builtin_amdgcn_permlane32_swap(__float_as_uint(v), __float_as_uint(v), false, false); return __uint_as_float(rr[0]) + __uint_as_float(rr[1]); }
__device__ __forceinline__ float wave_sum(float v, int lane) {
#pragma unroll
    for (int o = 1; o < 32; o <<= 1) v += lane_get(v, lane ^ o);
    return xhalf_sum(v);
}
__device__ __forceinline__ float wave_max(float v, int lane) {
#pragma unroll
    for (int o = 1; o < 64; o <<= 1) v = fmaxf(v, lane_get(v, lane ^ o));
    return v;
}
__device__ __forceinline__ float silu_f(float x) { return x / (1.f + __expf(-x)); }
__device__ __forceinline__ float sigmoid_f(float x) { return 1.f / (1.f + __expf(-x)); }
__device__ __forceinline__ int crow(int r, int hi) { return (r & 3) + 8 * (r >> 2) + 4 * hi; }
#define LDS_WAIT() asm volatile("s_waitcnt lgkmcnt(0)" ::: "memory")

struct Args {
    const float* in[29]; float* out; unsigned char* ws;
};
typedef const __attribute__((address_space(4))) Args* ArgsP;
#define FRESH_ARGS() ({ ArgsP p_ = (ArgsP)__builtin_amdgcn_kernarg_segment_ptr(); asm volatile("" : "+s"(p_)); p_; })

__device__ __forceinline__ void p0_transpose_item(const float* __restrict__ W, int K, int N, int Npad, bf16* WT, LAS float* T, int item, int tid, int wave, int lane) {
    const int nblk = Npad / 256, kb = item / nblk, nb = item % nblk, k0 = 64 * kb, n0 = 256 * nb;
    const int n = n0 + 4 * lane;
    f32x4 v[8];
#pragma unroll
    for (int i = 0; i < 8; ++i) v[i] = (n < N) ? *(const f32x4*)(W + (size_t)(k0 + 8 * wave + i) * N + n) : (f32x4){0.f, 0.f, 0.f, 0.f};
#pragma unroll
    for (int i = 0; i < 8; ++i) *(LAS f32x4*)(T + (8 * wave + i) * 260 + 4 * lane) = v[i];
    __syncthreads();
#pragma unroll
    for (int j = 0; j < 4; ++j) { const int q = tid + NT * j, nn = q >> 3, c = q & 7; const LAS float* s = T + (8 * c) * 260 + nn;
        u32x4 o; o.x = pk2(s[0], s[260]); o.y = pk2(s[2 * 260], s[3 * 260]); o.z = pk2(s[4 * 260], s[5 * 260]); o.w = pk2(s[6 * 260], s[7 * 260]);
        *(u32x4*)(WT + (size_t)(n0 + nn) * K + k0 + 8 * c) = o; }
    __syncthreads();
}

__device__ __forceinline__ void p0_ada_item(const float* __restrict__ cP, const float* __restrict__ cS, const float* __restrict__ Wada, const float* __restrict__ bada,
                                            float* mod, LAS float* red, int jb, int wave, int lane, int tid) {
    const int i32 = lane & 31, hi = lane >> 5;
    f32x16 acc[4]; f32x4 accp = {0.f, 0.f, 0.f, 0.f};
#pragma unroll
    for (int c = 0; c < 4; ++c) acc[c] = (f32x16){};
    const float* wp = Wada + (size_t)128 * jb + 4 * i32;
    for (int st = 0; st < 16; ++st) {
        const int k0 = 256 * wave + 16 * st + 8 * hi;
        f32x4 w[8];
#pragma unroll
        for (int i = 0; i < 8; ++i) w[i] = *(const f32x4*)(wp + (size_t)(k0 + i) * 12288);
        const f32x4 c0 = *(const f32x4*)(cS + (size_t)i32 * DM + k0), c1 = *(const f32x4*)(cS + (size_t)i32 * DM + k0 + 4);
        const f32x4 p0 = *(const f32x4*)(cP + k0), p1 = *(const f32x4*)(cP + k0 + 4);
        u32x4 a;
        a.x = pk2(silu_f(c0[0]), silu_f(c0[1])); a.y = pk2(silu_f(c0[2]), silu_f(c0[3])); a.z = pk2(silu_f(c1[0]), silu_f(c1[1])); a.w = pk2(silu_f(c1[2]), silu_f(c1[3]));
#pragma unroll
        for (int i = 0; i < 4; ++i) { accp += w[i] * silu_f(p0[i]); accp += w[4 + i] * silu_f(p1[i]); }
#pragma unroll
        for (int c = 0; c < 4; ++c) { u32x4 b; b.x = pk2(w[0][c], w[1][c]); b.y = pk2(w[2][c], w[3][c]); b.z = pk2(w[4][c], w[5][c]); b.w = pk2(w[6][c], w[7][c]);
            acc[c] = __builtin_amdgcn_mfma_f32_32x32x16_bf16(__builtin_bit_cast(bf16x8, a), __builtin_bit_cast(bf16x8, b), acc[c], 0, 0, 0); }
    }
    accp = (f32x4){xhalf_sum(accp[0]), xhalf_sum(accp[1]), xhalf_sum(accp[2]), xhalf_sum(accp[3])};
    LAS float* rp = red + 16384;
    if (hi == 0) *(LAS f32x4*)(rp + wave * 128 + 4 * i32) = accp;
#pragma unroll
    for (int half = 4; half >= 1; half >>= 1) {
        if (wave >= half && wave < 2 * half) { LAS float* dst = red + (wave - half) * 4096;
#pragma unroll
            for (int r = 0; r < 16; ++r) *(LAS f32x4*)(dst + crow(r, hi) * 128 + 4 * i32) = (f32x4){acc[0][r], acc[1][r], acc[2][r], acc[3][r]}; }
        __syncthreads();
        if (wave < half) { const LAS float* src = red + wave * 4096;
#pragma unroll
            for (int r = 0; r < 16; ++r) { const f32x4 t = *(const LAS f32x4*)(src + crow(r, hi) * 128 + 4 * i32); acc[0][r] += t[0]; acc[1][r] += t[1]; acc[2][r] += t[2]; acc[3][r] += t[3]; } }
        __syncthreads();
    }
    if (wave == 0) { const f32x4 bv = *(const f32x4*)(bada + 128 * jb + 4 * i32);
#pragma unroll
        for (int r = 0; r < 16; ++r) *(f32x4*)(mod + (size_t)(1 + crow(r, hi)) * 12288 + 128 * jb + 4 * i32) = (f32x4){acc[0][r], acc[1][r], acc[2][r], acc[3][r]} + bv; }
    if (wave == 1 && hi == 0) { f32x4 t = *(const f32x4*)(bada + 128 * jb + 4 * i32);
#pragma unroll
        for (int w = 0; w < 8; ++w) t += *(const LAS f32x4*)(rp + w * 128 + 4 * i32);
        *(f32x4*)(mod + 128 * jb + 4 * i32) = t; }
    __syncthreads();
}

__constant__ double INV_FREQ_TURNS[8] = {
    1.0 / 6.283185307179586, 0.19392274474868576 / 6.283185307179586, 0.03760603093086393 / 6.283185307179586, 0.007292664737217109 / 6.283185307179586,
    0.001414213562373095 / 6.283185307179586, 0.0002742481756762073 / 6.283185307179586, 5.318295896944988e-05 / 6.283185307179586, 1.031338537721246e-05 / 6.283185307179586 };

__device__ __forceinline__ void p0_prologue(ArgsP A, LAS unsigned char* lds, int tid, int wave, int lane) {
    unsigned char* ws = A->ws;
    const int G = gridDim.x, bid = blockIdx.x;
    for (int jb = bid; jb < 96; jb += G)
        p0_ada_item(A->in[8], A->in[9], A->in[10], A->in[11], (float*)(ws + WS_MOD), (LAS float*)lds, jb, wave, lane, tid);
    constexpr int I_IN = 32 * (NINP / 256), I_OUT = 32 * 8, I_UP = 32 * 32, I_DN = 128 * 8, I_ALL = I_IN + I_OUT + I_UP + I_DN;
    const bool split = (G > 128);
    const int nfree = split ? G - 96 : G, first = split ? 14 * nfree : 0;
    for (int pass = 0; pass < 2; ++pass) {
        int it, step, end;
        if (pass == 0) { if (!split || bid < 96) continue; it = bid - 96; step = nfree; end = (first < I_ALL) ? first : I_ALL; }
        else { it = first + bid; step = G; end = I_ALL; }
        for (; it < end; it += step) { int r = it;
            if (r < I_IN) { p0_transpose_item(A->in[13], DM, NIN, NINP, (bf16*)(ws + WS_WIN), (LAS float*)lds, r, tid, wave, lane); continue; } r -= I_IN;
            if (r < I_OUT) { p0_transpose_item(A->in[24], DM, DM, DM, (bf16*)(ws + WS_WOUT), (LAS float*)lds, r, tid, wave, lane); continue; } r -= I_OUT;
            if (r < I_UP) { p0_transpose_item(A->in[26], DM, DFF, DFF, (bf16*)(ws + WS_WUP), (LAS float*)lds, r, tid, wave, lane); continue; } r -= I_UP;
            p0_transpose_item(A->in[27], DFF, DM, DM, (bf16*)(ws + WS_WDN), (LAS float*)lds, r, tid, wave, lane); }
    }
    for (int idx = blockIdx.x * NT + tid; idx < 8192 * 8; idx += gridDim.x * NT) {
        const int pos = idx >> 3, i = idx & 7;
        const double t = (double)pos * INV_FREQ_TURNS[i]; const float fr = (float)(t - __builtin_rint(t));
        float* tab = (float*)(ws + WS_ROPE) + (size_t)pos * 16;
        tab[i] = __builtin_amdgcn_cosf(fr); tab[8 + i] = __builtin_amdgcn_sinf(fr);
    }
}

template <int NPART> __device__ __forceinline__ void norm_mod_rows(const float* xP, const float* xS, const float* __restrict__ g, const float* __restrict__ mod, int sh_off, int sc_off, bf16* out, int wave, int lane,
                                              const bf16* part = nullptr, int gate_off = 0, float* x1S = nullptr) {
    const int gw = blockIdx.x * NW + wave, NGW = gridDim.x * NW;
    for (int r = gw; r < MTOK; r += NGW) {
        const float* xr = (r < MP) ? xP + (size_t)r * DM : xS + (size_t)(r - MP) * DM;
        const float* mr = mod + (size_t)((r < MP) ? 0 : 1 + ((r - MP) >> 4)) * 12288;
        f32x4 v[8]; float s = 0.f;
#pragma unroll
        for (int j = 0; j < 8; ++j) v[j] = *(const f32x4*)(xr + 256 * j + 4 * lane);
        if (NPART > 0 && r >= MP) {
#pragma unroll
            for (int j = 0; j < 8; ++j) { const int c = 256 * j + 4 * lane; f32x4 a = {0.f, 0.f, 0.f, 0.f};
                f32x4 t[NPART > 0 ? NPART : 1];
#pragma unroll
                for (int p = 0; p < NPART; ++p) t[p] = ld_bf4(part + ((size_t)p * MS + (r - MP)) * DM + c);
#pragma unroll
                for (int p = 0; p < NPART; ++p) a += t[p];
                v[j] += *(const f32x4*)(mr + gate_off + c) * a; *(f32x4*)(x1S + (size_t)(r - MP) * DM + c) = v[j]; } }
#pragma unroll
        for (int j = 0; j < 8; ++j) s += (v[j].x * v[j].x + v[j].y * v[j].y) + (v[j].z * v[j].z + v[j].w * v[j].w);
        const float rstd = 1.f / sqrtf(wave_sum(s, lane) * (1.f / DM) + EPS);
#pragma unroll
        for (int j = 0; j < 8; ++j) { const int c = 256 * j + 4 * lane;
            const f32x4 gg = *(const f32x4*)(g + c), sc = *(const f32x4*)(mr + sc_off + c), sh = *(const f32x4*)(mr + sh_off + c);
            const f32x4 y = v[j] * rstd * gg * (sc + 1.f) + sh;
            u32x2 o; o.x = pk2(y.x, y.y); o.y = pk2(y.z, y.w);
            *(u32x2*)(out + (size_t)r * DM + c) = o; }
    }
}
#define XB_TMO      128
#define XB_XCNT(j)  (256  + 64 * (j))
#define XB_XSUB(j)  (1280 + 64 * (j))
#define XB_XGEN(j)  (2304 + 64 * (j))
#define XB_TOP      3328
#define XB_TOPGEN   3392
#define XCD_BAR_WORDS 3456
#define XB_SPIN_CAP (1u << 18)

__device__ __forceinline__ unsigned xb_ld(unsigned* p)              { return __hip_atomic_load(p, __ATOMIC_RELAXED, __HIP_MEMORY_SCOPE_AGENT); }
__device__ __forceinline__ unsigned xb_add(unsigned* p, unsigned v) { return __hip_atomic_fetch_add(p, v, __ATOMIC_RELAXED, __HIP_MEMORY_SCOPE_AGENT); }
__device__ __forceinline__ unsigned xb_xcc_id() { return (unsigned)__builtin_amdgcn_s_getreg((3 << 11) | 20) & 0xFu; }
#define XB_SPIN(cond, bar) do { unsigned _sp = 0; while (cond) { __builtin_amdgcn_s_sleep(1); \
    if ((++_sp & 255u) == 0u) { if (xb_ld(&(bar)[XB_TMO])) break; if (_sp > XB_SPIN_CAP) { atomicAdd(&(bar)[XB_TMO], 1u); break; } } } } while (0)

struct XcdBarrier {
    unsigned* bar; unsigned x;
    volatile LAS unsigned* st;
};

__device__ __forceinline__ XcdBarrier xcd_barrier_post(unsigned* bar, volatile LAS unsigned* st) {
    XcdBarrier b; b.bar = bar; b.x = xb_xcc_id(); b.st = st;
    if (threadIdx.x == 0) (void)xb_add(&bar[XB_XCNT(b.x)], 1u);
    return b;
}
__device__ __forceinline__ void xcd_barrier_complete(unsigned* bar, unsigned x, unsigned& nloc, unsigned& nx) {
    const unsigned G = gridDim.x * gridDim.y * gridDim.z;
    unsigned sum, cnt, mine, sp = 0u;
    for (;;) {
        sum = 0u; cnt = 0u; mine = 0u;
#pragma unroll
        for (unsigned j = 0; j < 16; ++j) { const unsigned c = xb_ld(&bar[XB_XCNT(j)]); sum += c; cnt += (c > 0u) ? 1u : 0u; mine = (j == x) ? c : mine; }
        if (sum == G) break;
        __builtin_amdgcn_s_sleep(1);
        if ((++sp & 255u) == 0u) { if (xb_ld(&bar[XB_TMO])) break; if (sp > XB_SPIN_CAP) { atomicAdd(&bar[XB_TMO], 1u); break; } }
    }
    nloc = mine > 0u ? mine : 1u; nx = cnt > 0u ? cnt : 1u;
}

__device__ __forceinline__ void xcd_barrier(const XcdBarrier& b) {
    asm volatile("s_waitcnt vmcnt(0)" ::: "memory");
    __syncthreads();
    if (threadIdx.x == 0) {
        unsigned* bar = b.bar;
        __builtin_amdgcn_s_waitcnt(0);
        unsigned nloc = b.st[0], nx = b.st[1];
        if (nloc == 0u) { xcd_barrier_complete(bar, b.x, nloc, nx); b.st[0] = nloc; b.st[1] = nx; }
        const unsigned old = xb_add(&bar[XB_XSUB(b.x)], 1u);
        const unsigned gen = old / nloc;
        if (old + 1u == (gen + 1u) * nloc) {
            __builtin_amdgcn_fence(__ATOMIC_RELEASE, "agent");
            asm volatile("s_waitcnt vmcnt(0)" ::: "memory");
            const unsigned og = xb_add(&bar[XB_TOP], 1u);
            const unsigned tg = og / nx;
            if (og + 1u == (tg + 1u) * nx) xb_add(&bar[XB_TOPGEN], 1u);
            else XB_SPIN(xb_ld(&bar[XB_TOPGEN]) == tg, bar);
            __builtin_amdgcn_fence(__ATOMIC_ACQUIRE, "agent");
            xb_add(&bar[XB_XGEN(b.x)], 1u);
            asm volatile("s_waitcnt vmcnt(0)" ::: "memory");
        } else {
            XB_SPIN(xb_ld(&bar[XB_XGEN(b.x)]) == gen, bar);
            __builtin_amdgcn_fence(__ATOMIC_ACQUIRE, "agent");
            asm volatile("s_waitcnt vmcnt(0)" ::: "memory");
        }
    }
    __syncthreads();
}
__device__ __forceinline__ void unpack16(const u32x4 a, const u32x4 b, float* v) {
#pragma unroll
    for (int i = 0; i < 4; ++i) { v[2 * i] = __uint_as_float(a[i] << 16); v[2 * i + 1] = __uint_as_float(a[i] & 0xffff0000u); v[8 + 2 * i] = __uint_as_float(b[i] << 16); v[8 + 2 * i + 1] = __uint_as_float(b[i] & 0xffff0000u); }
}
__device__ __forceinline__ void p3_post(ArgsP A, int tid) {
    unsigned char* ws = A->ws;
    const bf16* PROJ = (const bf16*)(ws + WS_PROJ);
    for (int it = blockIdx.x * NT + tid; it < 33 * 3 * 2048; it += gridDim.x * NT) {
        const int ch = it & 2047, j = (it >> 11) % 3, sq = it / (3 * 2048);
        const int r = (sq == 0) ? (MP - 3 + j) : (MP + 16 * (sq - 1) + 13 + j);
        const float val = bf2f(PROJ[(size_t)r * NINP + C_QM + ch]);
        if (sq == 0) A->out[O_CVP + (size_t)j * 2048 + ch] = val; else A->out[O_CVS + ((size_t)(sq - 1) * 3 + j) * 2048 + ch] = val;
    }
}
typedef short v4i16_t __attribute__((ext_vector_type(4)));
__device__ __forceinline__ s16x4 tr_rd(LAS const unsigned char* p) { return __builtin_bit_cast(s16x4, __builtin_amdgcn_ds_read_tr16_b64_v4i16((LAS v4i16_t*)p)); }
__device__ __forceinline__ bf16x8 mk8(s16x4 a, s16x4 b) { return (bf16x8){a[0], a[1], a[2], a[3], b[0], b[1], b[2], b[3]}; }
__device__ __forceinline__ int tr_off(int pitch, int krow, int colbase, int lane) { return (krow + ((lane & 15) >> 2)) * pitch + (colbase + 16 * ((lane >> 4) & 1) + 4 * (lane & 3)) * 2; }
__device__ __forceinline__ void unpack8(const u32x4 a, float* v) {
#pragma unroll
    for (int i = 0; i < 4; ++i) { v[2 * i] = __uint_as_float(a[i] << 16); v[2 * i + 1] = __uint_as_float(a[i] & 0xffff0000u); }
}
__device__ __forceinline__ int unit_row0(int u) { return (u < 128) ? 64 * u : MP + 16 * (u - 128); }
__device__ __forceinline__ void conv8(const bf16* PROJ, const float* __restrict__ stconv, const float* __restrict__ wconv, const float* __restrict__ bconv, int u, int s, int ch0, float* o) {
    const int r0 = unit_row0(u);
    f32x4 a0 = *(const f32x4*)(bconv + ch0), a1 = *(const f32x4*)(bconv + ch0 + 4);
#pragma unroll
    for (int j = 0; j < 4; ++j) { const int tau = s - 3 + j; float x[8];
        if (tau >= 0 || (u > 0 && u < 128)) unpack8(*(const u32x4*)(PROJ + (size_t)(r0 + tau) * NINP + C_QM + ch0), x);
        else if (u >= 128) { const float* p = stconv + ((size_t)(u - 128) * 3 + (3 + tau)) * 2048 + ch0; const f32x4 y0 = *(const f32x4*)p, y1 = *(const f32x4*)(p + 4);
            x[0] = y0[0]; x[1] = y0[1]; x[2] = y0[2]; x[3] = y0[3]; x[4] = y1[0]; x[5] = y1[1]; x[6] = y1[2]; x[7] = y1[3]; }
        else {
#pragma unroll
            for (int i = 0; i < 8; ++i) x[i] = 0.f; }
        const f32x4 w0 = *(const f32x4*)(wconv + j * 2048 + ch0), w1 = *(const f32x4*)(wconv + j * 2048 + ch0 + 4);
        a0 += (f32x4){x[0], x[1], x[2], x[3]} * w0; a1 += (f32x4){x[4], x[5], x[6], x[7]} * w1; }
#pragma unroll
    for (int i = 0; i < 4; ++i) { o[i] = silu_f(a0[i]); o[4 + i] = silu_f(a1[i]); }
}
__device__ __forceinline__ void conv_rows4(const bf16* PROJ, const float* __restrict__ stconv, const float* __restrict__ wconv, const float* __restrict__ bconv, int u, int L, int s0, int ch0, float sc, u32x4* o) {
    const int r0 = unit_row0(u);
    f32x4 w0[4], w1[4];
#pragma unroll
    for (int j = 0; j < 4; ++j) { w0[j] = *(const f32x4*)(wconv + j * 2048 + ch0); w1[j] = *(const f32x4*)(wconv + j * 2048 + ch0 + 4); }
    const f32x4 b0 = *(const f32x4*)(bconv + ch0), b1 = *(const f32x4*)(bconv + ch0 + 4);
    f32x4 x0[7], x1[7];
#pragma unroll
    for (int i = 0; i < 7; ++i) { const int tau = s0 - 3 + i; x0[i] = (f32x4){0.f, 0.f, 0.f, 0.f}; x1[i] = x0[i];
        if (tau >= 0 ? (tau < L) : (u > 0 && u < 128)) { float t[8]; unpack8(*(const u32x4*)(PROJ + (size_t)(r0 + tau) * NINP + C_QM + ch0), t); x0[i] = (f32x4){t[0], t[1], t[2], t[3]}; x1[i] = (f32x4){t[4], t[5], t[6], t[7]}; }
        else if (tau < 0 && u >= 128) { const float* p = stconv + ((size_t)(u - 128) * 3 + (3 + tau)) * 2048 + ch0; x0[i] = *(const f32x4*)p; x1[i] = *(const f32x4*)(p + 4); } }
#pragma unroll
    for (int r = 0; r < 4; ++r) { f32x4 a0 = b0, a1 = b1;
#pragma unroll
        for (int j = 0; j < 4; ++j) { a0 += x0[r + j] * w0[j]; a1 += x1[r + j] * w1[j]; }
        u32x4 q = {0u, 0u, 0u, 0u};
        if (s0 + r < L) { q.x = pk2(silu_f(a0[0]) * sc, silu_f(a0[1]) * sc); q.y = pk2(silu_f(a0[2]) * sc, silu_f(a0[3]) * sc); q.z = pk2(silu_f(a1[0]) * sc, silu_f(a1[1]) * sc); q.w = pk2(silu_f(a1[2]) * sc, silu_f(a1[3]) * sc); }
        o[r] = q; }
}
__device__ __forceinline__ u32x4 pack8(const float* v, float sc) { u32x4 o; o.x = pk2(v[0] * sc, v[1] * sc); o.y = pk2(v[2] * sc, v[3] * sc); o.z = pk2(v[4] * sc, v[5] * sc); o.w = pk2(v[6] * sc, v[7] * sc); return o; }
__device__ __forceinline__ float logsigmoid_f(float f) { return fminf(f, 0.f) - log1pf(__expf(-fabsf(f))); }
__device__ __forceinline__ void load_gates(const bf16* PROJ, const float* bi, const float* bfg, int u, int h, int t, float& ig, float& lf) {
    const int L = (u < 128) ? 64 : 16; const int r = unit_row0(u) + t;
    ig = -INFINITY; lf = 0.f;
    if (t < L) { ig = bf2f(PROJ[(size_t)r * NINP + C_IG + h]) + bi[h]; lf = logsigmoid_f(bf2f(PROJ[(size_t)r * NINP + C_FG + h]) + bfg[h]); }
}
__device__ __forceinline__ float scan_add(float v, int lane) {
#pragma unroll
    for (int o = 1; o < 64; o <<= 1) { const float x = lane_get(v, lane - o); if (lane >= o) v += x; }
    return v;
}
__device__ __forceinline__ float scan_max(float v, int lane) {
#pragma unroll
    for (int o = 1; o < 64; o <<= 1) { const float x = lane_get(v, lane - o); if (lane >= o) v = fmaxf(v, x); }
    return v;
}
constexpr int MA_K = 0, MA_V = 36864, MA_W = 73728;
constexpr int PK = 576;
__device__ __forceinline__ void mlstm_phaseA(ArgsP A, LAS unsigned char* lds, int u, int h, int tid, int wave, int lane) {
    unsigned char* ws = A->ws; const bf16* PROJ = (const bf16*)(ws + WS_PROJ);
    float* SC = (float*)(ws + WS_SCAL);
    LAS float* wl = (LAS float*)(lds + MA_W);
    const int L = (u < 128) ? 64 : 16, r0 = unit_row0(u);
    if (wave == 0) {
        float ig, lf; load_gates(PROJ, A->in[21], A->in[22], u, h, lane, ig, lf);
        const float b = scan_add(lf, lane); const float G = lane_get(b, 63);
        const float uu = (lane < L) ? G - b + ig : -INFINITY; const float mloc = wave_max(uu, lane);
        wl[lane] = (lane < L) ? __expf(uu - mloc) : 0.f;
        if (lane == 0) { SC[u * 4 + h] = G; SC[640 + u * 4 + h] = mloc; }
    }
    { const int c8 = 8 * (tid & 31), s0 = 4 * (tid >> 5);
      u32x4 ko[4]; conv_rows4(PROJ, A->in[4], A->in[19], A->in[20], u, L, s0, 1024 + h * 256 + c8, 0.0625f, ko);
      u32x4 vr[4];
#pragma unroll
      for (int r = 0; r < 4; ++r) { vr[r] = (u32x4){0u, 0u, 0u, 0u}; if (s0 + r < L) vr[r] = *(const u32x4*)(PROJ + (size_t)(r0 + s0 + r) * NINP + C_VM + h * 256 + c8); }
#pragma unroll
      for (int r = 0; r < 4; ++r) *(LAS u32x4*)(lds + MA_K + (s0 + r) * PK + c8 * 2) = ko[r];
      __syncthreads();
#pragma unroll
      for (int r = 0; r < 4; ++r) { float v[8]; unpack8(vr[r], v); *(LAS u32x4*)(lds + MA_V + (s0 + r) * PK + c8 * 2) = pack8(v, wl[s0 + r]); } }
    __syncthreads();
    { const int i32 = lane & 31, hi = lane >> 5, eb = wave;
      bf16x8 af[4];
#pragma unroll
      for (int ks = 0; ks < 4; ++ks) { const int o = tr_off(PK, 16 * ks + 8 * hi, 32 * eb, lane); af[ks] = mk8(tr_rd(lds + MA_V + o), tr_rd(lds + MA_V + o + 4 * PK)); }
      bf16* dC = (bf16*)(ws + WS_DC) + ((size_t)(u * 4 + h) * 256 + 32 * eb + i32) * 256 + 4 * hi;
      for (int db = 0; db < 8; ++db) { f32x16 acc = {};
#pragma unroll
          for (int ks = 0; ks < 4; ++ks) { const int o = tr_off(PK, 16 * ks + 8 * hi, 32 * db, lane); const bf16x8 bfr = mk8(tr_rd(lds + MA_K + o), tr_rd(lds + MA_K + o + 4 * PK));
              acc = __builtin_amdgcn_mfma_f32_32x32x16_bf16(bfr, af[ks], acc, 0, 0, 0); }
#pragma unroll
          for (int g4 = 0; g4 < 4; ++g4) { u32x2 o; o.x = pk2(acc[4 * g4], acc[4 * g4 + 1]); o.y = pk2(acc[4 * g4 + 2], acc[4 * g4 + 3]); *(u32x2*)(dC + 32 * db + 8 * g4) = o; } } }
    if (tid < 256) { float a = 0.f;
        for (int s = 0; s < 64; ++s) a += wl[s] * bf2f(*(LAS const unsigned short*)(lds + MA_K + s * PK + tid * 2));
        ((float*)(ws + WS_DN))[(size_t)(u * 4 + h) * 256 + tid] = a; }
    __syncthreads();
}
__device__ __forceinline__ void mlstm_phaseB(ArgsP A, LAS unsigned char* lds, int tid, int wave, int lane) {
    unsigned char* ws = A->ws; const float* SC = (const float*)(ws + WS_SCAL); float* MPREV = (float*)(ws + WS_SCAL) + 1280;
    const bf16* DC = (const bf16*)(ws + WS_DC); bf16* CP = (bf16*)(ws + WS_CPREV); const float* DN = (const float*)(ws + WS_DN); float* NP = (float*)(ws + WS_NPREV);
    const int gid = blockIdx.x * NT + tid, gsz = gridDim.x * NT;
    LAS float* AL = (LAS float*)lds; LAS float* BE = AL + 512;
    if (wave < 4) { const int h = wave; const float g0 = SC[lane * 4 + h], g1 = SC[(64 + lane) * 4 + h], l0 = SC[640 + lane * 4 + h], l1 = SC[640 + (64 + lane) * 4 + h];
        float m = 0.f;
        for (int c = 0; c < 128; ++c) { const float G = lane_get((c < 64) ? g0 : g1, c & 63), ml = lane_get((c < 64) ? l0 : l1, c & 63);
            const float mn = fmaxf(G + m, ml);
            if (lane == 0) { AL[h * 128 + c] = __expf(G + m - mn); BE[h * 128 + c] = __expf(ml - mn); if (blockIdx.x == 0) MPREV[c * 4 + h] = m; }
            m = mn; }
        if (blockIdx.x == 0 && lane == 0) A->out[O_MPO + h] = m; }
    __syncthreads();
    for (int idx = gid; idx < 4 * 32768; idx += gsz) { const int h = idx >> 15, el = (idx & 32767) * 2;
        float c0 = 0.f, c1 = 0.f;
        for (int cb = 0; cb < 128; cb += 32) { unsigned d[32];
#pragma unroll
            for (int j = 0; j < 32; ++j) d[j] = *(const unsigned*)(DC + ((size_t)((cb + j) * 4 + h) << 16) + el);
#pragma unroll
            for (int j = 0; j < 32; ++j) { const int c = cb + j; const float al = AL[h * 128 + c], be = BE[h * 128 + c];
                *(unsigned*)(CP + ((size_t)(c * 4 + h) << 16) + el) = pk2(c0, c1);
                c0 = al * c0 + be * __uint_as_float(d[j] << 16); c1 = al * c1 + be * __uint_as_float(d[j] & 0xffff0000u); } }
        *(f32x2_t*)(A->out + O_CP + ((size_t)h << 16) + el) = (f32x2_t){c0, c1}; }
    for (int idx = gid; idx < 4 * 256; idx += gsz) { const int h = idx >> 8, d = idx & 255; float n = 0.f;
        for (int cb = 0; cb < 128; cb += 32) { float dn[32];
#pragma unroll
            for (int j = 0; j < 32; ++j) dn[j] = DN[(size_t)((cb + j) * 4 + h) * 256 + d];
#pragma unroll
            for (int j = 0; j < 32; ++j) { const int c = cb + j; NP[(size_t)(c * 4 + h) * 256 + d] = n; n = AL[h * 128 + c] * n + BE[h * 128 + c] * dn[j]; } }
        A->out[O_NP + h * 256 + d] = n; }
    const float* C0 = A->in[5]; const float* N0 = A->in[6]; const float* M0 = A->in[7];
    for (int i0 = gid; i0 < 128 * 32768; i0 += 8 * gsz) {
        f32x2_t c[8]; unsigned d[8]; float m[8], G[8], ml[8];
#pragma unroll
        for (int k = 0; k < 8; ++k) { const int idx = i0 + k * gsz; if (idx < 128 * 32768) { const int bh = idx >> 15, el = (idx & 32767) * 2, ui = (128 + (bh >> 2)) * 4 + (bh & 3);
            m[k] = M0[bh]; G[k] = SC[ui]; ml[k] = SC[640 + ui]; c[k] = *(const f32x2_t*)(C0 + ((size_t)bh << 16) + el); d[k] = *(const unsigned*)(DC + ((size_t)ui << 16) + el); } }
#pragma unroll
        for (int k = 0; k < 8; ++k) { const int idx = i0 + k * gsz; if (idx < 128 * 32768) { const int bh = idx >> 15, el = (idx & 32767) * 2, ui = (128 + (bh >> 2)) * 4 + (bh & 3);
            const float mn = fmaxf(G[k] + m[k], ml[k]); const float al = __expf(G[k] + m[k] - mn), be = __expf(ml[k] - mn);
            *(unsigned*)(CP + ((size_t)ui << 16) + el) = pk2(c[k].x, c[k].y);
            *(f32x2_t*)(A->out + O_CS + ((size_t)bh << 16) + el) = (f32x2_t){al * c[k].x + be * __uint_as_float(d[k] << 16), al * c[k].y + be * __uint_as_float(d[k] & 0xffff0000u)};
            if (el == 0) { MPREV[ui] = m[k]; A->out[O_MSO + bh] = mn; } } } }
    for (int idx = gid; idx < 128 * 256; idx += gsz) { const int bh = idx >> 8, d = idx & 255, ui = (128 + (bh >> 2)) * 4 + (bh & 3);
        const float m = M0[bh], G = SC[ui], ml = SC[640 + ui]; const float mn = fmaxf(G + m, ml); const float al = __expf(G + m - mn), be = __expf(ml - mn);
        const float n = N0[idx]; NP[(size_t)ui * 256 + d] = n; A->out[O_NS + idx] = al * n + be * DN[(size_t)ui * 256 + d]; }
}
constexpr int MC_Q = 0, MC_K = 33792, MC_V = 67584, MC_S = 104448, MC_F = 113664;
constexpr int PQ = 528, PS = 144;
__device__ __forceinline__ void mlstm_phaseC(ArgsP A, LAS unsigned char* lds, int u, int h, int tid, int wave, int lane) {
    unsigned char* ws = A->ws; const bf16* PROJ = (const bf16*)(ws + WS_PROJ);
    const int L = (u < 128) ? 64 : 16, r0 = unit_row0(u), uh = u * 4 + h;
    LAS float* F = (LAS float*)(lds + MC_F);
    LAS float* rt = F, *gg = F + 64, *winter = F + 128, *eden = F + 192, *nq = F + 256, *denp = F + 320, *ssq = F + 448;
    const int i32 = lane & 31, hi = lane >> 5;
    LAS float* nl = F + 960;
    if (wave == 1) *(LAS f32x4*)(nl + 4 * lane) = *(const f32x4*)((const float*)(ws + WS_NPREV) + (size_t)uh * 256 + 4 * lane);
    if (wave == 0) {
        float ig, lf; load_gates(PROJ, A->in[21], A->in[22], u, h, lane, ig, lf);
        const float b = scan_add(lf, lane); const float g = (lane < L) ? ig - b : -INFINITY; const float cm = scan_max(g, lane);
        const float mprev = ((const float*)(ws + WS_SCAL))[1280 + uh]; const float mx = fmaxf(mprev, cm);
        rt[lane] = -mx; gg[lane] = g; winter[lane] = __expf(mprev - mx); eden[lane] = __expf(-(b + mx));
    }
    { const int c8 = 8 * (tid & 31), s0 = 4 * (tid >> 5);
      u32x4 qo[4], ko[4], vo[4];
      conv_rows4(PROJ, A->in[4], A->in[19], A->in[20], u, L, s0, h * 256 + c8, 1.f, qo);
      conv_rows4(PROJ, A->in[4], A->in[19], A->in[20], u, L, s0, 1024 + h * 256 + c8, 0.0625f, ko);
#pragma unroll
      for (int r = 0; r < 4; ++r) { vo[r] = (u32x4){0u, 0u, 0u, 0u}; if (s0 + r < L) vo[r] = *(const u32x4*)(PROJ + (size_t)(r0 + s0 + r) * NINP + C_VM + h * 256 + c8); }
#pragma unroll
      for (int r = 0; r < 4; ++r) { *(LAS u32x4*)(lds + MC_Q + (s0 + r) * PQ + c8 * 2) = qo[r]; *(LAS u32x4*)(lds + MC_K + (s0 + r) * PQ + c8 * 2) = ko[r]; *(LAS u32x4*)(lds + MC_V + (s0 + r) * PK + c8 * 2) = vo[r]; } }
    bf16x8 ca[16];
    { const bf16* Cp = (const bf16*)(ws + WS_CPREV) + ((size_t)uh * 256 + 32 * wave + i32) * 256 + 8 * hi;
#pragma unroll
      for (int kk = 0; kk < 16; ++kk) ca[kk] = *(const bf16x8*)(Cp + 16 * kk); }
    __syncthreads();
    if (wave < 3) {
        const int tt = (wave > 0) ? 1 : 0, st = (wave == 2) ? 1 : 0;
        f32x16 acc = {};
#pragma unroll 4
        for (int kk = 0; kk < 16; ++kk) { const bf16x8 a = *(LAS const bf16x8*)(lds + MC_K + (32 * st + i32) * PQ + (16 * kk + 8 * hi) * 2), b = *(LAS const bf16x8*)(lds + MC_Q + (32 * tt + i32) * PQ + (16 * kk + 8 * hi) * 2);
            acc = __builtin_amdgcn_mfma_f32_32x32x16_bf16(a, b, acc, 0, 0, 0); }
        const int t = 32 * tt + i32; const float rtt = rt[t]; float rs = 0.f;
#pragma unroll
        for (int g4 = 0; g4 < 4; ++g4) { const int s0 = 32 * st + 8 * g4 + 4 * hi; float v[4];
#pragma unroll
            for (int j = 0; j < 4; ++j) { const int s = s0 + j; const float e = __expf(rtt + gg[s]) * acc[4 * g4 + j]; v[j] = (s <= t) ? e : 0.f; rs += v[j]; }
            u32x2 o; o.x = pk2(v[0], v[1]); o.y = pk2(v[2], v[3]); *(LAS u32x2*)(lds + MC_S + t * PS + s0 * 2) = o; }
        rs = xhalf_sum(rs);
        if (hi == 0) { denp[st * 64 + t] = rs; if (wave == 0) denp[64 + t] = 0.f; }
    } else if (wave == 3) {
        const LAS float* np = nl + 8 * hi;
#pragma unroll
        for (int tt = 0; tt < 2; ++tt) { f32x16 acc = {};
#pragma unroll 4
            for (int kk = 0; kk < 16; ++kk) { u32x4 aw = {0u, 0u, 0u, 0u};
                if (i32 == 0) { const f32x4 n0 = *(const LAS f32x4*)(np + 16 * kk), n1 = *(const LAS f32x4*)(np + 16 * kk + 4); aw.x = pk2(n0[0], n0[1]); aw.y = pk2(n0[2], n0[3]); aw.z = pk2(n1[0], n1[1]); aw.w = pk2(n1[2], n1[3]); }
                const bf16x8 b = *(LAS const bf16x8*)(lds + MC_Q + (32 * tt + i32) * PQ + (16 * kk + 8 * hi) * 2);
                acc = __builtin_amdgcn_mfma_f32_32x32x16_bf16(__builtin_bit_cast(bf16x8, aw), b, acc, 0, 0, 0); }
            if (hi == 0) nq[32 * tt + i32] = acc[0]; }
    }
    __syncthreads();
    const int eb = wave, ntt = (L > 32) ? 2 : 1;
    u32x2 ovp[2][4]; f32x4 gmp[4];
#pragma unroll
    for (int g4 = 0; g4 < 4; ++g4) { const int e = 32 * eb + 8 * g4 + 4 * hi; gmp[g4] = *(const f32x4*)(A->in[23] + h * 256 + e);
#pragma unroll
        for (int tt = 0; tt < 2; ++tt) { const int t = 32 * tt + i32; ovp[tt][g4] = (u32x2){0u, 0u};
            if (t < L) ovp[tt][g4] = *(const u32x2*)(PROJ + (size_t)(r0 + t) * NINP + C_OM + h * 256 + e); } }
    bf16x8 va[4];
#pragma unroll
    for (int ks = 0; ks < 4; ++ks) { const int o = tr_off(PK, 16 * ks + 8 * hi, 32 * eb, lane); va[ks] = mk8(tr_rd(lds + MC_V + o), tr_rd(lds + MC_V + o + 4 * PK)); }
    f32x16 hv[2];
#pragma unroll
    for (int tt = 0; tt < 2; ++tt) { f32x16 acc = {};
        if (tt < ntt) { const int t = 32 * tt + i32;
#pragma unroll
            for (int kk = 0; kk < 16; ++kk) { const bf16x8 b = *(LAS const bf16x8*)(lds + MC_Q + t * PQ + (16 * kk + 8 * hi) * 2);
                acc = __builtin_amdgcn_mfma_f32_32x32x16_bf16(ca[kk], b, acc, 0, 0, 0); }
            const float wi = winter[t];
#pragma unroll
            for (int r = 0; r < 16; ++r) acc[r] *= wi;
#pragma unroll
            for (int ks = 0; ks < 4; ++ks) if (ks < 2 * (tt + 1)) { const bf16x8 b = *(LAS const bf16x8*)(lds + MC_S + t * PS + (16 * ks + 8 * hi) * 2);
                acc = __builtin_amdgcn_mfma_f32_32x32x16_bf16(va[ks], b, acc, 0, 0, 0); }
            const float den = wi * nq[t] + denp[t] + denp[64 + t]; const float inv = 1.f / fmaxf(fabsf(den), eden[t]); float sq = 0.f;
#pragma unroll
            for (int r = 0; r < 16; ++r) { acc[r] *= inv; sq += acc[r] * acc[r]; }
            sq = xhalf_sum(sq); if (hi == 0) ssq[wave * 64 + t] = sq; }
        hv[tt] = acc; }
    __syncthreads();
    bf16* MIX = (bf16*)(ws + WS_MIX);
#pragma unroll
    for (int tt = 0; tt < 2; ++tt) if (tt < ntt) { const int t = 32 * tt + i32;
        if (t < L) { float tot = 0.f;
#pragma unroll
            for (int w = 0; w < 8; ++w) tot += ssq[w * 64 + t];
            const float rstd = 1.f / sqrtf(tot * (1.f / 256.f) + EPS); const size_t row = (size_t)(r0 + t);
#pragma unroll
            for (int g4 = 0; g4 < 4; ++g4) { const int e = 32 * eb + 8 * g4 + 4 * hi; const f32x4 g = gmp[g4];
                const u32x2 ov = ovp[tt][g4];
                const float o0 = sigmoid_f(__uint_as_float(ov.x << 16)), o1 = sigmoid_f(__uint_as_float(ov.x & 0xffff0000u)), o2 = sigmoid_f(__uint_as_float(ov.y << 16)), o3 = sigmoid_f(__uint_as_float(ov.y & 0xffff0000u));
                u32x2 w; w.x = pk2(hv[tt][4 * g4] * rstd * g[0] * o0, hv[tt][4 * g4 + 1] * rstd * g[1] * o1); w.y = pk2(hv[tt][4 * g4 + 2] * rstd * g[2] * o2, hv[tt][4 * g4 + 3] * rstd * g[3] * o3);
                *(u32x2*)(MIX + row * DM + 1024 + h * 256 + e) = w; } } }
    __syncthreads();
}
constexpr int AT_PKT = 272, AT_PVT = 320, AT_V = 17408, AT_BUF = 37888;
struct AttnState { f32x16 o[4]; bf16x8 pf[4]; float m, l; };
__device__ __forceinline__ float xhalf_max(float v) { auto rr = __builtin_amdgcn_permlane32_swap(__float_as_uint(v), __float_as_uint(v), false, false); return fmaxf(__uint_as_float(rr[0]), __uint_as_float(rr[1])); }
constexpr float ATT_THR = 6.0f;
__device__ __forceinline__ void attn_qk(LAS const unsigned char* kt, int map, const bf16x8 (&qf)[4], const AttnState& S, f32x16 (&p)[2], int lane) {
    const int i32 = lane & 31, hi = lane >> 5;
#pragma unroll
    for (int kb = 0; kb < 2; ++kb) { f32x16 acc = {};
#pragma unroll
        for (int d0 = 0; d0 < 4; ++d0) { const bf16x8 a = *(LAS const bf16x8*)(kt + (32 * kb + i32) * AT_PKT + (64 * map + 16 * d0 + 8 * hi) * 2);
            acc = __builtin_amdgcn_mfma_f32_32x32x16_bf16(a, qf[d0], acc, 0, 0, 0); }
        p[kb] = acc; }
}
__device__ __forceinline__ void attn_pv(LAS const unsigned char* vt, AttnState& S, int lane) {
    const int hi = lane >> 5;
    LAS const unsigned char* base = vt + tr_off(AT_PVT, 4 * hi, 0, lane);
#pragma unroll
    for (int st = 0; st < 4; ++st) { s16x4 lo[4], hh[4];
#pragma unroll
        for (int eb = 0; eb < 4; ++eb) { lo[eb] = tr_rd(base + st * 16 * AT_PVT + eb * 64); hh[eb] = tr_rd(base + st * 16 * AT_PVT + eb * 64 + 8 * AT_PVT); }
#pragma unroll
        for (int eb = 0; eb < 4; ++eb) S.o[eb] = __builtin_amdgcn_mfma_f32_32x32x16_bf16(mk8(lo[eb], hh[eb]), S.pf[st], S.o[eb], 0, 0, 0);
    }
}
__device__ __forceinline__ void attn_softmax(f32x16 (&p)[2], AttnState& S, int nvalid, int lane) {
    const int hi = lane >> 5;
    if (nvalid < 64) {
#pragma unroll
        for (int kb = 0; kb < 2; ++kb)
#pragma unroll
            for (int r = 0; r < 16; ++r) if (32 * kb + crow(r, hi) >= nvalid) p[kb][r] = -INFINITY; }
    float ma = fmaxf(fmaxf(p[0][0], p[0][1]), p[1][0]), mb = fmaxf(fmaxf(p[0][2], p[0][3]), p[1][1]);
    ma = fmaxf(fmaxf(ma, p[1][2]), p[1][3]);
#pragma unroll
    for (int r = 4; r < 16; r += 4) { ma = fmaxf(fmaxf(ma, p[0][r]), p[0][r + 1]); mb = fmaxf(fmaxf(mb, p[0][r + 2]), p[0][r + 3]); ma = fmaxf(fmaxf(ma, p[1][r]), p[1][r + 1]); mb = fmaxf(fmaxf(mb, p[1][r + 2]), p[1][r + 3]); }
    const float mref = S.m; const float mx = xhalf_max(fmaxf(ma, mb)) - mref;
#pragma unroll
    for (int kb = 0; kb < 2; ++kb)
#pragma unroll
        for (int r = 0; r < 16; ++r) p[kb][r] = __builtin_amdgcn_exp2f(p[kb][r] - mref);
    if (__any(mx > ATT_THR)) {
        const float dl = fmaxf(mx, 0.f); S.m += dl;
        const float f = __builtin_amdgcn_exp2f(-dl); S.l *= f;
#pragma unroll
        for (int kb = 0; kb < 2; ++kb)
#pragma unroll
            for (int r = 0; r < 16; ++r) p[kb][r] *= f;
#pragma unroll
        for (int eb = 0; eb < 4; ++eb)
#pragma unroll
            for (int r = 0; r < 16; ++r) S.o[eb][r] *= f;
    }
    float sa = 0.f, sb = 0.f;
#pragma unroll
    for (int kb = 0; kb < 2; ++kb)
#pragma unroll
        for (int r = 0; r < 16; r += 2) { sa += p[kb][r]; sb += p[kb][r + 1]; }
    S.l += sa + sb;
#pragma unroll
    for (int kb = 0; kb < 2; ++kb)
#pragma unroll
        for (int ks = 0; ks < 2; ++ks) { u32x4 pw; pw.x = pk2(p[kb][8 * ks], p[kb][8 * ks + 1]); pw.y = pk2(p[kb][8 * ks + 2], p[kb][8 * ks + 3]); pw.z = pk2(p[kb][8 * ks + 4], p[kb][8 * ks + 5]); pw.w = pk2(p[kb][8 * ks + 6], p[kb][8 * ks + 7]);
            S.pf[2 * kb + ks] = __builtin_bit_cast(bf16x8, pw); }
}
__device__ __forceinline__ void attn_step(LAS const unsigned char* ktn, LAS const unsigned char* vtc, int map, const bf16x8 (&qf)[4], AttnState& S, int lane) {
    const int i32 = lane & 31, hi = lane >> 5;
    f32x16 p[2];
    LAS const unsigned char* base = vtc + tr_off(AT_PVT, 4 * hi, 0, lane);
    s16x4 lo[2][4], hh[2][4];
#pragma unroll
    for (int eb = 0; eb < 4; ++eb) { lo[0][eb] = tr_rd(base + eb * 64); hh[0][eb] = tr_rd(base + eb * 64 + 8 * AT_PVT); }
#pragma unroll
    for (int kb = 0; kb < 2; ++kb) { f32x16 acc = {};
#pragma unroll
        for (int d0 = 0; d0 < 4; ++d0) { const bf16x8 a = *(LAS const bf16x8*)(ktn + (32 * kb + i32) * AT_PKT + (64 * map + 16 * d0 + 8 * hi) * 2);
            acc = __builtin_amdgcn_mfma_f32_32x32x16_bf16(a, qf[d0], acc, 0, 0, 0); }
        p[kb] = acc; }
    const float mref = S.m;
    __builtin_amdgcn_sched_barrier(0);
#pragma unroll
    for (int st = 0; st < 4; ++st) {
        if (st < 3) {
#pragma unroll
            for (int eb = 0; eb < 4; ++eb) { lo[(st + 1) & 1][eb] = tr_rd(base + (st + 1) * 16 * AT_PVT + eb * 64); hh[(st + 1) & 1][eb] = tr_rd(base + (st + 1) * 16 * AT_PVT + eb * 64 + 8 * AT_PVT); } }
        __builtin_amdgcn_sched_barrier(0);
#pragma unroll
        for (int eb = 0; eb < 4; ++eb) {
            S.o[eb] = __builtin_amdgcn_mfma_f32_32x32x16_bf16(mk8(lo[st & 1][eb], hh[st & 1][eb]), S.pf[st], S.o[eb], 0, 0, 0);
            const int e0 = 2 * (4 * st + eb);
            p[e0 >> 4][e0 & 15] = __builtin_amdgcn_exp2f(p[e0 >> 4][e0 & 15] - mref); p[e0 >> 4][(e0 & 15) + 1] = __builtin_amdgcn_exp2f(p[e0 >> 4][(e0 & 15) + 1] - mref);
            __builtin_amdgcn_sched_barrier(0);
        }
    }
    float ma = fmaxf(fmaxf(p[0][0], p[0][1]), p[1][0]), mb = fmaxf(fmaxf(p[0][2], p[0][3]), p[1][1]);
    ma = fmaxf(fmaxf(ma, p[1][2]), p[1][3]);
#pragma unroll
    for (int r = 4; r < 16; r += 4) { ma = fmaxf(fmaxf(ma, p[0][r]), p[0][r + 1]); mb = fmaxf(fmaxf(mb, p[0][r + 2]), p[0][r + 3]); ma = fmaxf(fmaxf(ma, p[1][r]), p[1][r + 1]); mb = fmaxf(fmaxf(mb, p[1][r + 2]), p[1][r + 3]); }
    const float emx = xhalf_max(fmaxf(ma, mb));
    if (__any(emx > 64.0f)) {
        const float dl = fmaxf(__builtin_amdgcn_logf(emx), 0.f);
        S.m += dl;
        const float f = __builtin_amdgcn_exp2f(-dl); S.l *= f;
#pragma unroll
        for (int kb = 0; kb < 2; ++kb)
#pragma unroll
            for (int r = 0; r < 16; ++r) p[kb][r] *= f;
#pragma unroll
        for (int eb = 0; eb < 4; ++eb)
#pragma unroll
            for (int r = 0; r < 16; ++r) S.o[eb][r] *= f;
    }
    float sa = 0.f, sb = 0.f;
#pragma unroll
    for (int kb = 0; kb < 2; ++kb)
#pragma unroll
        for (int r = 0; r < 16; r += 2) { sa += p[kb][r]; sb += p[kb][r + 1]; }
    S.l += sa + sb;
#pragma unroll
    for (int kb = 0; kb < 2; ++kb)
#pragma unroll
        for (int ks = 0; ks < 2; ++ks) { u32x4 pw; pw.x = pk2(p[kb][8 * ks], p[kb][8 * ks + 1]); pw.y = pk2(p[kb][8 * ks + 2], p[kb][8 * ks + 3]); pw.z = pk2(p[kb][8 * ks + 4], p[kb][8 * ks + 5]); pw.w = pk2(p[kb][8 * ks + 6], p[kb][8 * ks + 7]);
            S.pf[2 * kb + ks] = __builtin_bit_cast(bf16x8, pw); }
}
__device__ __forceinline__ void attn_tile(LAS const unsigned char* kt, LAS const unsigned char* vt, int map, const bf16x8 (&qf)[4], AttnState& S, int nvalid, int lane) {
    f32x16 p[2]; attn_qk(kt, map, qf, S, p, lane); attn_softmax(p, S, nvalid, lane); attn_pv(vt, S, lane);
}
__device__ __forceinline__ void attn_finish(ArgsP A, LAS unsigned char* lds, AttnState& S, int map, int g, int h, size_t row_base, int nrows, float lam, int lane) {
    const int i32 = lane & 31, hi = lane >> 5;
    const float lt = xhalf_sum(S.l); const float inv = 1.f / lt;
    LAS float* X = (LAS float*)lds + g * 4096;
    __syncthreads();
    if (map == 1) {
#pragma unroll
        for (int eb = 0; eb < 4; ++eb)
#pragma unroll
            for (int r = 0; r < 16; ++r) X[(32 * eb + crow(r, hi)) * 32 + i32] = S.o[eb][r] * inv; }
    __syncthreads();
    if (map == 0) { float sq = 0.f;
#pragma unroll
        for (int eb = 0; eb < 4; ++eb)
#pragma unroll
            for (int r = 0; r < 16; ++r) { const float v = S.o[eb][r] * inv - lam * X[(32 * eb + crow(r, hi)) * 32 + i32]; S.o[eb][r] = v; sq += v * v; }
        sq = xhalf_sum(sq);
        const float rstd = (1.f - LAM_INIT) / sqrtf(sq * (1.f / 128.f) + EPS);
        if (i32 < nrows) { bf16* mp = (bf16*)(A->ws + WS_MIX) + (row_base + i32) * DM + h * 128; const float* gs = A->in[18] + h * 128;
#pragma unroll
            for (int eb = 0; eb < 4; ++eb)
#pragma unroll
                for (int g4 = 0; g4 < 4; ++g4) { const int e = 32 * eb + 8 * g4 + 4 * hi; const f32x4 gv = *(const f32x4*)(gs + e);
                    u32x2 w; w.x = pk2(S.o[eb][4 * g4] * rstd * gv[0], S.o[eb][4 * g4 + 1] * rstd * gv[1]); w.y = pk2(S.o[eb][4 * g4 + 2] * rstd * gv[2], S.o[eb][4 * g4 + 3] * rstd * gv[3]);
                    *(u32x2*)(mp + e) = w; } } }
    __syncthreads();
}
__device__ __forceinline__ void attn_prompt_unit(ArgsP A, LAS unsigned char* lds, int h, int qb, float lam, int tid, int wave, int lane) {
    unsigned char* ws = A->ws; const bf16* QA = (const bf16*)(ws + WS_QA); const bf16* KA = (const bf16*)(ws + WS_KA); const bf16* PROJ = (const bf16*)(ws + WS_PROJ);
    const int map = wave & 1, g = wave >> 1, i32 = lane & 31, hi = lane >> 5;
    const int ntiles = 2 * qb + 2, mytiles = 2 * qb + (g >> 1) + 1;
    bf16x8 qf[4];
    { const bf16* qp = QA + (size_t)(128 * qb + 32 * g + i32) * 1024 + h * 128 + 64 * map + 8 * hi;
#pragma unroll
      for (int d0 = 0; d0 < 4; ++d0) qf[d0] = *(const bf16x8*)(qp + 16 * d0); }
    AttnState S; S.m = 0.f; S.l = 0.f;
#pragma unroll
    for (int i = 0; i < 4; ++i) S.pf[i] = (bf16x8){0, 0, 0, 0, 0, 0, 0, 0};
#pragma unroll
    for (int eb = 0; eb < 4; ++eb) S.o[eb] = (f32x16){};
    const int key = tid >> 3, seg = tid & 7;
    const bf16* kp = KA + (size_t)key * 1024 + h * 128 + 16 * seg; const bf16* vp = PROJ + (size_t)key * NINP + C_VA + h * 128 + 16 * seg;
    const int ko = key * AT_PKT + seg * 32, vo = AT_V + key * AT_PVT + seg * 32;
    { u32x4 k0 = *(const u32x4*)kp, k1 = *(const u32x4*)(kp + 8), v0 = *(const u32x4*)vp, v1 = *(const u32x4*)(vp + 8);
      const bf16* kq = kp + (size_t)64 * 1024; const bf16* vq = vp + (size_t)64 * NINP;
      u32x4 k2 = *(const u32x4*)kq, k3 = *(const u32x4*)(kq + 8), v2 = *(const u32x4*)vq, v3 = *(const u32x4*)(vq + 8);
      *(LAS u32x4*)(lds + ko) = k0; *(LAS u32x4*)(lds + ko + 16) = k1; *(LAS u32x4*)(lds + vo) = v0; *(LAS u32x4*)(lds + vo + 16) = v1;
      *(LAS u32x4*)(lds + AT_BUF + ko) = k2; *(LAS u32x4*)(lds + AT_BUF + ko + 16) = k3; *(LAS u32x4*)(lds + AT_BUF + vo) = v2; *(LAS u32x4*)(lds + AT_BUF + vo + 16) = v3; }
    __syncthreads();
    { f32x16 p[2]; attn_qk(lds, map, qf, S, p, lane); attn_softmax(p, S, 64, lane); }
    int bc = 0, bn = AT_BUF, bw = 2 * AT_BUF;
    for (int j = 0; j < ntiles; ++j) {
        const bool more = (j + 2 < ntiles);
        u32x4 k0, k1, v0, v1;
        if (more) { const bf16* kq = kp + (size_t)(j + 2) * 64 * 1024; const bf16* vq = vp + (size_t)(j + 2) * 64 * NINP;
            k0 = *(const u32x4*)kq; k1 = *(const u32x4*)(kq + 8); v0 = *(const u32x4*)vq; v1 = *(const u32x4*)(vq + 8); }
        if (j + 1 < mytiles) attn_step(lds + bn, lds + bc + AT_V, map, qf, S, lane);
        else if (j < mytiles) attn_pv(lds + bc + AT_V, S, lane);
        if (more) { LAS unsigned char* w = lds + bw; *(LAS u32x4*)(w + ko) = k0; *(LAS u32x4*)(w + ko + 16) = k1; *(LAS u32x4*)(w + vo) = v0; *(LAS u32x4*)(w + vo + 16) = v1; }
        __syncthreads();
        const int t = bc; bc = bn; bn = bw; bw = t;
    }
    attn_finish(A, lds, S, map, g, h, (size_t)(128 * qb + 32 * g), 32, lam, lane);
}
__device__ __forceinline__ void attn_sample_unit(ArgsP A, LAS unsigned char* lds, int b, int h, float lam, int tid, int wave, int lane) {
    unsigned char* ws = A->ws; const bf16* QA = (const bf16*)(ws + WS_QA); const bf16* KA = (const bf16*)(ws + WS_KA); const bf16* PROJ = (const bf16*)(ws + WS_PROJ);
    const int map = wave & 1, i32 = lane & 31, hi = lane >> 5; const bool comp = wave < 2;
    bf16x8 qf[4];
#pragma unroll
    for (int d0 = 0; d0 < 4; ++d0) qf[d0] = (bf16x8){0, 0, 0, 0, 0, 0, 0, 0};
    if (i32 < 16) { const bf16* qp = QA + (size_t)(MP + 16 * b + i32) * 1024 + h * 128 + 64 * map + 8 * hi;
#pragma unroll
      for (int d0 = 0; d0 < 4; ++d0) qf[d0] = *(const bf16x8*)(qp + 16 * d0); }
    AttnState S; S.m = 0.f; S.l = 0.f;
#pragma unroll
    for (int i = 0; i < 4; ++i) S.pf[i] = (bf16x8){0, 0, 0, 0, 0, 0, 0, 0};
#pragma unroll
    for (int eb = 0; eb < 4; ++eb) S.o[eb] = (f32x16){};
    const int key = tid >> 3, seg = tid & 7;
    const float* kc = A->in[2] + (((size_t)b * PAST + key) * 8 + h) * 128 + 16 * seg; const float* vc = A->in[3] + (((size_t)b * PAST + key) * 8 + h) * 128 + 16 * seg;
    const int ko = key * AT_PKT + seg * 32, vo = AT_V + key * AT_PVT + seg * 32;
    f32x4 kr[4], vr[4];
#pragma unroll
    for (int i = 0; i < 4; ++i) { kr[i] = *(const f32x4*)(kc + 4 * i); vr[i] = *(const f32x4*)(vc + 4 * i); }
    for (int j = 0; j < 17; ++j) {
        LAS unsigned char* nb = lds + (j & 1) * AT_BUF;
        if (j < 16) { u32x4 a, c;
            a.x = pk2(kr[0][0], kr[0][1]); a.y = pk2(kr[0][2], kr[0][3]); a.z = pk2(kr[1][0], kr[1][1]); a.w = pk2(kr[1][2], kr[1][3]);
            c.x = pk2(kr[2][0], kr[2][1]); c.y = pk2(kr[2][2], kr[2][3]); c.z = pk2(kr[3][0], kr[3][1]); c.w = pk2(kr[3][2], kr[3][3]);
            *(LAS u32x4*)(nb + ko) = a; *(LAS u32x4*)(nb + ko + 16) = c;
            a.x = pk2(vr[0][0], vr[0][1]); a.y = pk2(vr[0][2], vr[0][3]); a.z = pk2(vr[1][0], vr[1][1]); a.w = pk2(vr[1][2], vr[1][3]);
            c.x = pk2(vr[2][0], vr[2][1]); c.y = pk2(vr[2][2], vr[2][3]); c.z = pk2(vr[3][0], vr[3][1]); c.w = pk2(vr[3][2], vr[3][3]);
            *(LAS u32x4*)(nb + vo) = a; *(LAS u32x4*)(nb + vo + 16) = c;
        } else { u32x4 a = {0u, 0u, 0u, 0u}, c = a, d = a, e = a;
            if (key < 16) { const bf16* kq = KA + (size_t)(MP + 16 * b + key) * 1024 + h * 128 + 16 * seg; const bf16* vq = PROJ + (size_t)(MP + 16 * b + key) * NINP + C_VA + h * 128 + 16 * seg;
                a = *(const u32x4*)kq; c = *(const u32x4*)(kq + 8); d = *(const u32x4*)vq; e = *(const u32x4*)(vq + 8); }
            *(LAS u32x4*)(nb + ko) = a; *(LAS u32x4*)(nb + ko + 16) = c; *(LAS u32x4*)(nb + vo) = d; *(LAS u32x4*)(nb + vo + 16) = e; }
        if (j + 1 < 16) {
#pragma unroll
            for (int i = 0; i < 4; ++i) { kr[i] = *(const f32x4*)(kc + (size_t)(j + 1) * 64 * 1024 + 4 * i); vr[i] = *(const f32x4*)(vc + (size_t)(j + 1) * 64 * 1024 + 4 * i); } }
        __syncthreads();
        if (comp) attn_tile(nb, nb + AT_V, map, qf, S, (j < 16) ? 64 : 16, lane);
    }
    attn_finish(A, lds, S, comp ? map : 2, 0, h, (size_t)(MP + 16 * b), 16, lam, lane);
}
template <int NPART> __device__ __forceinline__ void final_norm_rows(float* y, const float* __restrict__ g, int wave, int lane, const float* x1S, const bf16* part, const float* gate) {
    const int gw = blockIdx.x * NW + wave, NGW = gridDim.x * NW;
    for (int r = gw; r < MTOK; r += NGW) { float* yr = y + (size_t)r * DM; f32x4 v[8]; float s = 0.f;
        if (r < MP) {
#pragma unroll
            for (int j = 0; j < 8; ++j) v[j] = *(const f32x4*)(yr + 256 * j + 4 * lane);
        } else {
            const float* gr = gate + (size_t)(1 + ((r - MP) >> 4)) * 12288;
#pragma unroll
            for (int j = 0; j < 8; ++j) { const int c = 256 * j + 4 * lane; f32x4 a = {0.f, 0.f, 0.f, 0.f};
                f32x4 t[NPART];
#pragma unroll
                for (int p = 0; p < NPART; ++p) t[p] = ld_bf4(part + ((size_t)p * MS + (r - MP)) * DM + c);
#pragma unroll
                for (int p = 0; p < NPART; ++p) a += t[p];
                v[j] = *(const f32x4*)(x1S + (size_t)(r - MP) * DM + c) + *(const f32x4*)(gr + c) * a; } }
#pragma unroll
        for (int j = 0; j < 8; ++j) s += (v[j].x * v[j].x + v[j].y * v[j].y) + (v[j].z * v[j].z + v[j].w * v[j].w);
        const float rstd = 1.f / sqrtf(wave_sum(s, lane) * (1.f / DM) + EPS);
#pragma unroll
        for (int j = 0; j < 8; ++j) { const f32x4 gg = *(const f32x4*)(g + 256 * j + 4 * lane); *(f32x4*)(yr + 256 * j + 4 * lane) = v[j] * rstd * gg; } }
}
__global__ void __launch_bounds__(NT, 2) fwd_megakernel(Args A_) {
    extern __shared__ __attribute__((aligned(16))) unsigned char lds_raw[];
    LAS unsigned char* lds = (LAS unsigned char*)lds_raw;
    cg::grid_group grid = cg::this_grid();
    int tid, lane, wave;
#define FRESH_TID() do { tid = threadIdx.x; asm volatile("" : "+v"(tid)); lane = tid & 63; wave = __builtin_amdgcn_readfirstlane(tid >> 6); } while (0)
    FRESH_TID();
    ArgsP A = FRESH_ARGS();
    unsigned char* ws = A->ws;
    float* mod = (float*)(ws + WS_MOD);
    const int G = gridDim.x, bid = blockIdx.x;
    A = FRESH_ARGS(); ws = A->ws; mod = (float*)(ws + WS_MOD); FRESH_TID();
    if (tid < 2) ((volatile LAS unsigned*)(lds + LDS_BYTES - 16))[tid] = 0u;
    __syncthreads();
    XcdBarrier xb = xcd_barrier_post((unsigned*)(ws + WS_FLAG) + 1024, (volatile LAS unsigned*)(lds + LDS_BYTES - 16));
    if (ws == nullptr) grid.sync();
#ifndef NO_P0
    p0_prologue(A, lds, tid, wave, lane);
#endif
    xcd_barrier(xb);
    A = FRESH_ARGS(); ws = A->ws; mod = (float*)(ws + WS_MOD); FRESH_TID();
    norm_mod_rows<0>(A->in[0], A->in[1], A->in[12], mod, 0, 2048, (bf16*)(ws + WS_XN), wave, lane);
    xcd_barrier(xb);
    A = FRESH_ARGS(); ws = A->ws; mod = (float*)(ws + WS_MOD); FRESH_TID();
    { pg8::Gemm g{(const pg8::bf16_t*)(ws + WS_XN), (const pg8::bf16_t*)(ws + WS_WIN), MTOK, NINP, DM, DM}; pg8::StaticOrder S; S.init(MTOK, NINP, G, bid);
      pg8::EpiProj E{(pg8::bf16_t*)(ws + WS_PROJ), NINP, (pg8::bf16_t*)(ws + WS_QA), (pg8::bf16_t*)(ws + WS_KA), A->out + O_KP, A->out + O_KS, A->out + O_VP, A->out + O_VS, (const float*)(ws + WS_ROPE), QSCALE};
      pg8::gemm_phase<pg8::EpiProj, pg8::StaticOrder, true, true>(lds, g, S, E); }
    xcd_barrier(xb);
    A = FRESH_ARGS(); ws = A->ws; mod = (float*)(ws + WS_MOD); FRESH_TID();
#ifndef NO_P3
    p3_post(A, tid);
#endif
#ifndef NO_PA
    for (int i = bid; i < NCH * 4; i += G) mlstm_phaseA(A, lds, i >> 2, i & 3, tid, wave, lane);
#endif
    xcd_barrier(xb);
    A = FRESH_ARGS(); ws = A->ws; mod = (float*)(ws + WS_MOD); FRESH_TID();
#ifndef NO_PB
    mlstm_phaseB(A, lds, tid, wave, lane);
#endif
    xcd_barrier(xb);
    A = FRESH_ARGS(); ws = A->ws; mod = (float*)(ws + WS_MOD); FRESH_TID();
    { const float s1 = wave_sum(A->in[14][lane] * A->in[15][lane], lane), s2 = wave_sum(A->in[16][lane] * A->in[17][lane], lane);
      const float lam = __expf(s1) - __expf(s2) + LAM_INIT;
      for (int i = bid; i < 256; i += G) { const int h = i & 7, p = i >> 3; const int rot = (p & 1) ? 0 : 3;
          for (int sl = 0; sl < 6; ++sl) { int kk = sl + rot; if (kk >= 6) kk -= 6;
              FRESH_TID();
              if (kk < 2) attn_prompt_unit(A, lds, h, kk == 0 ? 63 - p : p, lam, tid, wave, lane);
              else if (kk == 2) attn_sample_unit(A, lds, i >> 3, i & 7, lam, tid, wave, lane);
              else { const int cu = i + 256 * (kk - 3); if (cu < NCH * 4) mlstm_phaseC(A, lds, cu >> 2, cu & 3, tid, wave, lane); } } }
    }
    xcd_barrier(xb);
    A = FRESH_ARGS(); ws = A->ws; mod = (float*)(ws + WS_MOD); FRESH_TID();
    { pg8::Gemm g{(const pg8::bf16_t*)(ws + WS_MIX), (const pg8::bf16_t*)(ws + WS_WOUT), MP, DM, DM, DM}; pg8::StaticOrder S; S.init(MP, DM, G, bid);
      pg8::EpiResid E{A->in[0], A->in[1], mod + 4096, (float*)(ws + WS_X1)};
      pg8::gemm_phase<pg8::EpiResid, pg8::StaticOrder, true, true>(lds, g, S, E); }
    for (int un = bid; un < 128; un += G) { const int tile = un >> 3, kc = un & 7;
      pg8::Gemm g{(const pg8::bf16_t*)(ws + WS_MIX) + 256 * kc, (const pg8::bf16_t*)(ws + WS_WOUT) + 256 * kc, MTOK, DM, 256, DM}; pg8::OneUnit S{{32 + (tile >> 3), tile & 7}};
      pg8::EpiPart E{(pg8::bf16_t*)(ws + WS_PART6) + (size_t)kc * MS * DM, DM};
      pg8::gemm_phase<pg8::EpiPart, pg8::OneUnit, false, true>(lds, g, S, E); }
    xcd_barrier(xb);
    A = FRESH_ARGS(); ws = A->ws; mod = (float*)(ws + WS_MOD); FRESH_TID();
    norm_mod_rows<8>((const float*)(ws + WS_X1), A->in[1], A->in[25], mod, 6144, 8192, (bf16*)(ws + WS_XN), wave, lane, (const bf16*)(ws + WS_PART6), 4096, (float*)(ws + WS_X1) + (size_t)MP * DM);
    xcd_barrier(xb);
    A = FRESH_ARGS(); ws = A->ws; mod = (float*)(ws + WS_MOD); FRESH_TID();
    { pg8::Gemm g{(const pg8::bf16_t*)(ws + WS_XN), (const pg8::bf16_t*)(ws + WS_WUP), MP, DFF, DM, DM}; pg8::StaticOrder S; S.init(MP, DFF, G, bid);
      pg8::EpiStore<2> E{(pg8::bf16_t*)(ws + WS_H), DFF};
      pg8::gemm_phase<pg8::EpiStore<2>, pg8::StaticOrder, true, true>(lds, g, S, E); }
    for (int un = bid; un < 256; un += G) { const int tile = un >> 2, kq = un & 3;
      pg8::Gemm g{(const pg8::bf16_t*)(ws + WS_XN) + 512 * kq, (const pg8::bf16_t*)(ws + WS_WUP) + 512 * kq, MTOK, DFF, 512, DM}; pg8::OneUnit S{{32 + (tile >> 5), tile & 31}};
      pg8::EpiPart E{(pg8::bf16_t*)(ws + WS_PART8) + (size_t)kq * MS * DFF, DFF};
      pg8::gemm_phase<pg8::EpiPart, pg8::OneUnit, false, true>(lds, g, S, E); }
    xcd_barrier(xb);
    A = FRESH_ARGS(); ws = A->ws; mod = (float*)(ws + WS_MOD); FRESH_TID();
    { const bf16* P8 = (const bf16*)(ws + WS_PART8); bf16* H = (bf16*)(ws + WS_H);
      for (int r = bid; r < MS; r += G)
          for (int c = 4 * tid; c < DFF; c += 4 * NT) { f32x4 a = ld_bf4(P8 + (size_t)r * DFF + c);
#pragma unroll
              for (int p = 1; p < 4; ++p) a += ld_bf4(P8 + ((size_t)p * MS + r) * DFF + c);
              a.x = fmaxf(a.x, 0.f); a.y = fmaxf(a.y, 0.f); a.z = fmaxf(a.z, 0.f); a.w = fmaxf(a.w, 0.f);
              u32x2 o; o.x = pk2(a.x * a.x, a.y * a.y); o.y = pk2(a.z * a.z, a.w * a.w); *(u32x2*)(H + (size_t)(MP + r) * DFF + c) = o; }
      __threadfence(); __syncthreads();
      if (tid == 0) __hip_atomic_fetch_add((unsigned*)(ws + WS_FLAG), 1u, __ATOMIC_RELEASE, __HIP_MEMORY_SCOPE_AGENT); }
    { pg8::Gemm g{(const pg8::bf16_t*)(ws + WS_H), (const pg8::bf16_t*)(ws + WS_WDN), MP, DM, DFF, DFF}; pg8::StaticOrder S; S.init(MP, DM, G, bid);
      pg8::EpiResid E{(const float*)(ws + WS_X1), (const float*)(ws + WS_X1) + (size_t)MP * DM, mod + 10240, A->out};
      pg8::gemm_phase<pg8::EpiResid, pg8::StaticOrder, true, true>(lds, g, S, E); }
    { if (tid == 0) { while (__hip_atomic_load((unsigned*)(ws + WS_FLAG), __ATOMIC_ACQUIRE, __HIP_MEMORY_SCOPE_AGENT) < (unsigned)G) __builtin_amdgcn_s_sleep(8); }
      __syncthreads(); __builtin_amdgcn_fence(__ATOMIC_ACQUIRE, "agent"); }
    for (int un = bid; un < 256; un += G) { const int tile = un >> 4, kc = un & 15;
      pg8::Gemm g{(const pg8::bf16_t*)(ws + WS_H) + 512 * kc, (const pg8::bf16_t*)(ws + WS_WDN) + 512 * kc, MTOK, DM, 512, DFF}; pg8::OneUnit S{{32 + (tile >> 3), tile & 7}};
      pg8::EpiPart E{(pg8::bf16_t*)(ws + WS_PART9) + (size_t)kc * MS * DM, DM};
      pg8::gemm_phase<pg8::EpiPart, pg8::OneUnit, false, true>(lds, g, S, E); }
    xcd_barrier(xb);
    A = FRESH_ARGS(); ws = A->ws; mod = (float*)(ws + WS_MOD); FRESH_TID();
    final_norm_rows<16>(A->out, A->in[28], wave, lane, (const float*)(ws + WS_X1) + (size_t)MP * DM, (const bf16*)(ws + WS_PART9), mod + 10240);
}

extern "C" void kernel_launch(void* const* d_in, const int* in_sizes, int n_in, void* d_out, int out_size, void* d_ws, size_t ws_size, hipStream_t stream) {
    static int grid = 0;
    if (grid == 0) {
        if (n_in != 29 || ws_size < WS_END) { fprintf(stderr, "kernel_launch: unexpected n_in %d / ws %zu\n", n_in, ws_size); grid = -1; return; }
        int dev = 0, cus = 0, per_cu = 0;
        (void)hipGetDevice(&dev); (void)hipDeviceGetAttribute(&cus, hipDeviceAttributeMultiprocessorCount, dev);
        (void)hipFuncSetAttribute((const void*)fwd_megakernel, hipFuncAttributeMaxDynamicSharedMemorySize, LDS_BYTES);
        (void)hipOccupancyMaxActiveBlocksPerMultiprocessor(&per_cu, (const void*)fwd_megakernel, NT, LDS_BYTES);
        (void)hipGetLastError();
        grid = cus;
    }
    if (grid < 0) return;
    (void)hipMemsetAsync((char*)d_ws + WS_FLAG, 0, 32768, stream);
    Args a{};
    for (int i = 0; i < 29; ++i) a.in[i] = (const float*)d_in[i];
    a.out = (float*)d_out; a.ws = (unsigned char*)d_ws;
    void* args[] = {&a};
    hipError_t e = hipLaunchCooperativeKernel((void*)fwd_megakernel, dim3(grid), dim3(NT), args, LDS_BYTES, stream);
    if (e != hipSuccess) fprintf(stderr, "cooperative launch failed: %s (grid %d)\n", hipGetErrorString(e), grid);
}
```

```cpp
#include <hip/hip_runtime.h>
#include <hip/hip_cooperative_groups.h>
#include <cstdio>
#include <cstdint>
namespace cg = cooperative_groups;
namespace pg8 {
#define PG8_LAS __attribute__((address_space(3)))
typedef unsigned short bf16_t;
typedef short bf16x8 __attribute__((ext_vector_type(8)));
typedef float f32x4 __attribute__((ext_vector_type(4)));
typedef unsigned u32x4 __attribute__((ext_vector_type(4)));
constexpr int BM = 256, BK = 64, HALF = 128, HTB = HALF * BK * 2  , STAGE_BYTES = 8 * HTB, NXCD = 8, WGM = 8;

__host__ __device__ __forceinline__ int lds_byte(int r, int c) { const int st = (r >> 4) * 2 + (c >> 5), rr = r & 15, cc = c & 31, ob = rr * 64 + cc * 2; return st * 1024 + (ob ^ (((ob >> 9) & 1) << 5)); }
__host__ __device__ __forceinline__ void stage_rc(int b, int& R, int& C) { const int st = b / 1024, sb = b % 1024, swz = sb ^ (((sb >> 9) & 1) << 5); R = (st >> 1) * 16 + swz / 64; C = (st & 1) * 32 + (swz % 64) / 2; }
__host__ __device__ __forceinline__ int perm32(int rho) { const int n = rho >> 4, i = rho & 15; return 8 * (i >> 2) + 4 * n + (i & 3); }

struct Unit { int pm, pn; };
struct Gemm { const bf16_t* A; const bf16_t* Bt; int M, N, K, ld; };

struct StaticOrder {
    int nM, nN, nwg, G, c;
    __host__ __device__ void init(int M, int N, int G_, int c_) { nM = M / BM; nN = N / BM; nwg = nM * nN; G = G_; c = c_; }
    __host__ __device__ bool next(int i, Unit& u) const {
        const long L = (long)i * G + c; if (L >= nwg) return false;
        int wgid = (int)L; { const int q = nwg / NXCD, r = nwg % NXCD, xcd = wgid % NXCD, off = wgid / NXCD; wgid = (xcd < r ? xcd * (q + 1) : r * (q + 1) + (xcd - r) * q) + off; }
        const int nig = WGM * nN, gid = wgid / nig, fm = gid * WGM, gsz = (nM - fm) < WGM ? (nM - fm) : WGM;
        u.pm = fm + ((wgid % nig) % gsz); u.pn = (wgid % nig) / gsz; return true;
    }
    __device__ __forceinline__ void a_ready(const Unit&) const {}
    __device__ __forceinline__ void done(const Unit&) const {}
};

typedef float f32x2_t __attribute__((ext_vector_type(2)));
typedef __bf16 bf16x2_t __attribute__((ext_vector_type(2)));
__device__ __forceinline__ unsigned cvt_pk_bf16(float lo, float hi) { f32x2_t v = {lo, hi}; bf16x2_t b = __builtin_convertvector(v, bf16x2_t); return __builtin_bit_cast(unsigned, b); }
template <int ACT  > struct EpiStore {
    static constexpr bool PERM = true, AFTER_DRAIN = false;
    bf16_t* O; int ldc;
    __device__ __forceinline__ void operator()(const f32x4 (&acc)[2][2][4][2], const Unit& u, int wr, int wc, int fr, int fq) const {
        const int row0 = u.pm * BM + wr * 64 + fr; const int col0 = u.pn * BM + wc * 32 + 8 * fq;
#pragma unroll
        for (int ai = 0; ai < 2; ++ai)
#pragma unroll
            for (int m = 0; m < 4; ++m) { bf16_t* rowp = O + (size_t)(row0 + ai * HALF + m * 16) * ldc + col0;
#pragma unroll
                for (int bj = 0; bj < 2; ++bj) { f32x4 v0 = acc[ai][bj][m][0], v1 = acc[ai][bj][m][1];
                    if (ACT == 2) {
#pragma unroll
                        for (int j = 0; j < 4; ++j) { float a = fmaxf(v0[j], 0.f), b = fmaxf(v1[j], 0.f); v0[j] = a * a; v1[j] = b * b; } }
                    u32x4 w; w.x = cvt_pk_bf16(v0[0], v0[1]); w.y = cvt_pk_bf16(v0[2], v0[3]); w.z = cvt_pk_bf16(v1[0], v1[1]); w.w = cvt_pk_bf16(v1[2], v1[3]);
                    *(u32x4*)(rowp + bj * HALF) = w; } }
    }
};
struct EpiProj {
    static constexpr bool PERM = true, AFTER_DRAIN = false;
    bf16_t* O; int ldc; bf16_t* QA; bf16_t* KA; float* kP; float* kS; float* vP; float* vS; const float* rope; float qscale;
    __device__ __forceinline__ void operator()(const f32x4 (&acc)[2][2][4][2], const Unit& u, int wr, int wc, int fr, int fq) const {
        const int row0 = u.pm * BM + wr * 64 + fr; const int col0 = u.pn * BM + wc * 32 + 8 * fq;
        const int kind = (u.pn < 4) ? 0 : (u.pn < 8) ? 1 : (u.pn < 12) ? 2 : 3;
        const bool ropew = (kind < 2) && ((wc & 1) == 0);
        const int plane = ((int)(threadIdx.x & 63) ^ 16) << 2;
#pragma unroll
        for (int ai = 0; ai < 2; ++ai)
#pragma unroll
            for (int m = 0; m < 4; ++m) { const int r = row0 + ai * HALF + m * 16; const int rs = r - 8192;
                f32x4 cs0 = {1.f, 1.f, 1.f, 1.f}, cs1 = cs0, sn0 = {0.f, 0.f, 0.f, 0.f}, sn1 = sn0;
                if (ropew && fq < 2) { const float* tb = rope + (size_t)((r < 8192) ? r : 1024 + (rs & 15)) * 16;
                    cs0 = *(const f32x4*)tb; cs1 = *(const f32x4*)(tb + 4); sn0 = *(const f32x4*)(tb + 8); sn1 = *(const f32x4*)(tb + 12);
                    if (fq == 0) { sn0 = -sn0; sn1 = -sn1; } }
#pragma unroll
                for (int bj = 0; bj < 2; ++bj) { f32x4 v0 = acc[ai][bj][m][0], v1 = acc[ai][bj][m][1];
                    if (ropew) { f32x4 p0, p1;
#pragma unroll
                        for (int j = 0; j < 4; ++j) { p0[j] = __int_as_float(__builtin_amdgcn_ds_bpermute(plane, __float_as_int(v0[j]))); p1[j] = __int_as_float(__builtin_amdgcn_ds_bpermute(plane, __float_as_int(v1[j]))); }
                        v0 = v0 * cs0 + p0 * sn0; v1 = v1 * cs1 + p1 * sn1; }
                    const int c = col0 + bj * HALF;
                    if (kind == 0) { v0 = v0 * qscale; v1 = v1 * qscale; }
                    u32x4 w; w.x = cvt_pk_bf16(v0[0], v0[1]); w.y = cvt_pk_bf16(v0[2], v0[3]); w.z = cvt_pk_bf16(v1[0], v1[1]); w.w = cvt_pk_bf16(v1[2], v1[3]);
                    if (kind == 0) *(u32x4*)(QA + (size_t)r * 1024 + c) = w;
                    else if (kind == 1) { *(u32x4*)(KA + (size_t)r * 1024 + (c - 1024)) = w;
                        float* ko = (r < 8192) ? kP + (size_t)r * 1024 + (c - 1024) : kS + (size_t)rs * 1024 + (c - 1024);
                        *(f32x4*)ko = v0; *(f32x4*)(ko + 4) = v1; }
                    else { *(u32x4*)(O + (size_t)r * ldc + c) = w;
                        if (kind == 2) { float* vo = (r < 8192) ? vP + (size_t)r * 1024 + (c - 2048) : vS + (size_t)rs * 1024 + (c - 2048);
                            *(f32x4*)vo = v0; *(f32x4*)(vo + 4) = v1; } } } }
    }
};
struct EpiResid {
    static constexpr bool PERM = true, AFTER_DRAIN = false;
    const float* baseP; const float* baseS; const float* gate; float* out;
    __device__ __forceinline__ void operator()(const f32x4 (&acc)[2][2][4][2], const Unit& u, int wr, int wc, int fr, int fq) const {
        const int row0 = u.pm * BM + wr * 64 + fr; const int col0 = u.pn * BM + wc * 32 + 8 * fq;
#pragma unroll
        for (int ai = 0; ai < 2; ++ai)
#pragma unroll
            for (int m = 0; m < 4; ++m) { const int r = row0 + ai * HALF + m * 16;
                const float* bp = (r < 8192) ? baseP + (size_t)r * 2048 : baseS + (size_t)(r - 8192) * 2048;
                const float* gp = gate + (size_t)((r < 8192) ? 0 : 1 + ((r - 8192) >> 4)) * 12288;
                float* op = out + (size_t)r * 2048;
#pragma unroll
                for (int bj = 0; bj < 2; ++bj) { const int c = col0 + bj * HALF;
#pragma unroll
                    for (int n = 0; n < 2; ++n) { const f32x4 b = *(const f32x4*)(bp + c + 4 * n), g = *(const f32x4*)(gp + c + 4 * n);
                        *(f32x4*)(op + c + 4 * n) = b + g * acc[ai][bj][m][n]; } }
                asm volatile("" ::: "memory"); }
    }
};

struct EpiPart {
    static constexpr bool PERM = true, AFTER_DRAIN = false;
    bf16_t* out; int ldc;
    __device__ __forceinline__ void operator()(const f32x4 (&acc)[2][2][4][2], const Unit& u, int wr, int wc, int fr, int fq) const {
        const int row0 = u.pm * BM + wr * 64 + fr - 8192; const int col0 = u.pn * BM + wc * 32 + 8 * fq;
#pragma unroll
        for (int ai = 0; ai < 2; ++ai)
#pragma unroll
            for (int m = 0; m < 4; ++m) { bf16_t* op = out + (size_t)(row0 + ai * HALF + m * 16) * ldc + col0;
#pragma unroll
                for (int bj = 0; bj < 2; ++bj) { const f32x4 v0 = acc[ai][bj][m][0], v1 = acc[ai][bj][m][1];
                    u32x4 w; w.x = cvt_pk_bf16(v0[0], v0[1]); w.y = cvt_pk_bf16(v0[2], v0[3]); w.z = cvt_pk_bf16(v1[0], v1[1]); w.w = cvt_pk_bf16(v1[2], v1[3]);
                    *(u32x4*)(op + bj * HALF) = w; } }
    }
};
struct OneUnit { Unit u;
    __device__ __forceinline__ bool next(int i, Unit& o) const { if (i != 0) return false; o = u; return true; }
    __device__ __forceinline__ void a_ready(const Unit&) const {}
    __device__ __forceinline__ void done(const Unit&) const {}
};
template <class Epi, class Sched, bool ALIGN_EPI = false, bool SP2 = false>
__device__ __forceinline__ void gemm_phase(PG8_LAS unsigned char* lds, const Gemm g, const Sched& S, const Epi& E) {
    int tid_ = threadIdx.x; asm volatile("" : "+v"(tid_));
    const int tid = tid_, wid = __builtin_amdgcn_readfirstlane(tid >> 6), lane = tid & 63, wr = wid >> 2, wc = wid & 3, fr = lane & 15, fq = lane >> 4;
    const int K = g.ld, nt = g.K / BK;
    unsigned voffA[2], voffB[2];
#pragma unroll
    for (int i = 0; i < 2; ++i) { int R, C; stage_rc(tid * 16 + i * 8192, R, C); const int Rb = Epi::PERM ? ((R & ~31) + perm32(R & 31)) : R;
        voffA[i] = (unsigned)(R * K + C) * 2u; voffB[i] = (unsigned)(Rb * K + C) * 2u; }
    const size_t kstep = (size_t)(BK * 2);
    const size_t hstep = (size_t)HALF * K * 2;
    const size_t tstep = 2 * hstep;
    const unsigned ldsw = (unsigned)wid * 1024u;
    const int aoff = lds_byte(wr * 64 + fr, fq * 8), boff = lds_byte(wc * 32 + fr, fq * 8);
#define PG8_SA(b, h) (((b) * 2 + (h)) * HTB)
#define PG8_SB(b, h) ((4 + (b) * 2 + (h)) * HTB)
#define PG8_STAGE(bufoff, gbase, voff) do { _Pragma("unroll") for (int _i = 0; _i < 2; ++_i) \
        __builtin_amdgcn_global_load_lds((const unsigned*)((const char*)(gbase) + (voff)[_i]), (PG8_LAS unsigned*)(lds + (bufoff) + ldsw + _i * 8192), 16, 0, 0); } while (0)
#define PG8_LDA(dst, b, h) do { _Pragma("unroll") for (int m = 0; m < 4; ++m) _Pragma("unroll") for (int k = 0; k < 2; ++k) dst[m][k] = *(const PG8_LAS bf16x8*)(lds + PG8_SA(b, h) + aoff + m * 2048 + k * 1024); } while (0)
#define PG8_LDB(dst, b, h) do { _Pragma("unroll") for (int n = 0; n < 2; ++n) _Pragma("unroll") for (int k = 0; k < 2; ++k) dst[n][k] = *(const PG8_LAS bf16x8*)(lds + PG8_SB(b, h) + boff + n * 2048 + k * 1024); } while (0)
#define PG8_MMA(ai, bj, At, Bt) do { __builtin_amdgcn_s_setprio(1); _Pragma("unroll") for (int m = 0; m < 4; ++m) _Pragma("unroll") for (int n = 0; n < 2; ++n) _Pragma("unroll") for (int k = 0; k < 2; ++k) \
        acc[ai][bj][m][n] = __builtin_amdgcn_mfma_f32_16x16x32_bf16(Bt[n][k], At[m][k], acc[ai][bj][m][n], 0, 0, 0); __builtin_amdgcn_s_setprio(0); } while (0)
#define PG8_WAIT_V(n) asm volatile("s_waitcnt vmcnt(" #n ")" ::: "memory")
#define PG8_WAIT_L(n) asm volatile("s_waitcnt lgkmcnt(" #n ")" ::: "memory")
#define PG8_BAR __builtin_amdgcn_s_barrier()
#define PG8_SCHED __builtin_amdgcn_sched_barrier(0)
    Unit cur, nxt; int ui = 0;
    if (!S.next(0, cur)) return;
    f32x4 acc[2][2][4][2];
#pragma unroll
    for (int a = 0; a < 2; ++a)
#pragma unroll
        for (int b = 0; b < 2; ++b)
#pragma unroll
            for (int m = 0; m < 4; ++m)
#pragma unroll
                for (int n = 0; n < 2; ++n) acc[a][b][m][n] = (f32x4){0.f, 0.f, 0.f, 0.f};
    bf16x8 At[4][2], B0[2][2], B1[2][2];
    const char* cA = (const char*)g.A + (size_t)cur.pm * tstep; const char* cB = (const char*)g.Bt + (size_t)cur.pn * tstep;
    S.a_ready(cur);
    if constexpr (SP2) {
        PG8_STAGE(PG8_SB(0, 0), cB, voffB); PG8_STAGE(PG8_SB(0, 1), cB + hstep, voffB); PG8_STAGE(PG8_SA(0, 0), cA, voffA); PG8_STAGE(PG8_SA(0, 1), cA + hstep, voffA);
        if (wr == 1) PG8_BAR;
        PG8_WAIT_V(2); PG8_BAR;
        PG8_STAGE(PG8_SB(1, 0), cB + kstep, voffB); PG8_STAGE(PG8_SA(1, 0), cA + kstep, voffA); PG8_STAGE(PG8_SB(1, 1), cB + hstep + kstep, voffB);
        PG8_WAIT_V(6); PG8_BAR;
    } else {
        PG8_STAGE(PG8_SB(0, 0), cB, voffB); PG8_STAGE(PG8_SA(0, 0), cA, voffA); PG8_STAGE(PG8_SB(0, 1), cB + hstep, voffB); PG8_STAGE(PG8_SA(0, 1), cA + hstep, voffA);
        if (wr == 1) PG8_BAR;
        PG8_WAIT_V(4); PG8_BAR;
        PG8_STAGE(PG8_SB(1, 0), cB + kstep, voffB); PG8_STAGE(PG8_SA(1, 0), cA + kstep, voffA); PG8_STAGE(PG8_SB(1, 1), cB + hstep + kstep, voffB);
        PG8_WAIT_V(6); PG8_BAR;
    }
    for (;;) {
        const bool has_next = S.next(ui + 1, nxt);
        const char* nA = has_next ? (const char*)g.A + (size_t)nxt.pm * tstep : cA; const char* nB = has_next ? (const char*)g.Bt + (size_t)nxt.pn * tstep : cB;
        for (int t = 0; t < nt; t += 2) {
            const bool last = (t == nt - 2);
            const char* a1 = cA + (size_t)(t + 1) * kstep;
            const char* a2 = last ? nA : cA + (size_t)(t + 2) * kstep; const char* b2 = last ? nB : cB + (size_t)(t + 2) * kstep;
            const char* a3 = a2 + kstep; const char* b3 = b2 + kstep;
            if (last && has_next) S.a_ready(nxt);
            if constexpr (SP2) {
            PG8_LDB(B0, 0, 0); PG8_LDB(B1, 0, 1); PG8_SCHED; PG8_LDA(At, 0, 0); PG8_STAGE(PG8_SA(1, 1), a1 + hstep, voffA);
            PG8_WAIT_V(8); PG8_WAIT_L(0); PG8_BAR; PG8_MMA(0, 0, At, B0); PG8_MMA(0, 1, At, B1); PG8_BAR; PG8_SCHED;
            PG8_LDA(At, 0, 1); PG8_STAGE(PG8_SB(0, 0), b2, voffB); PG8_STAGE(PG8_SB(0, 1), b2 + hstep, voffB); PG8_STAGE(PG8_SA(0, 0), a2, voffA);
            PG8_WAIT_V(8); PG8_WAIT_L(0); PG8_BAR; PG8_MMA(1, 0, At, B0); PG8_MMA(1, 1, At, B1); PG8_BAR; PG8_SCHED;
            PG8_LDB(B0, 1, 0); PG8_LDB(B1, 1, 1); PG8_SCHED; PG8_LDA(At, 1, 0); PG8_STAGE(PG8_SA(0, 1), a2 + hstep, voffA);
            PG8_WAIT_V(8); PG8_WAIT_L(0); PG8_BAR; PG8_MMA(0, 0, At, B0); PG8_MMA(0, 1, At, B1); PG8_BAR; PG8_SCHED;
            PG8_LDA(At, 1, 1); PG8_STAGE(PG8_SB(1, 0), b3, voffB); PG8_STAGE(PG8_SB(1, 1), b3 + hstep, voffB); PG8_STAGE(PG8_SA(1, 0), a3, voffA);
            PG8_WAIT_V(8); PG8_WAIT_L(0); PG8_BAR; PG8_MMA(1, 0, At, B0); PG8_MMA(1, 1, At, B1); PG8_BAR; PG8_SCHED;
            } else {
            PG8_LDB(B0, 0, 0); PG8_SCHED; PG8_LDA(At, 0, 0); PG8_STAGE(PG8_SA(1, 1), a1 + hstep, voffA);
            PG8_WAIT_L(8); PG8_BAR; PG8_WAIT_L(0); PG8_MMA(0, 0, At, B0); PG8_BAR; PG8_SCHED;
            PG8_LDB(B1, 0, 1); PG8_STAGE(PG8_SB(0, 0), b2, voffB);
            PG8_BAR; PG8_WAIT_L(0); PG8_MMA(0, 1, At, B1); PG8_BAR;
            PG8_LDA(At, 0, 1); PG8_STAGE(PG8_SA(0, 0), a2, voffA);
            PG8_BAR; PG8_WAIT_L(0); PG8_MMA(1, 0, At, B0); PG8_BAR; PG8_SCHED;
            PG8_STAGE(PG8_SB(0, 1), b2 + hstep, voffB);
            PG8_WAIT_V(6); PG8_BAR; PG8_MMA(1, 1, At, B1); PG8_BAR;
            PG8_LDB(B0, 1, 0); PG8_SCHED; PG8_LDA(At, 1, 0); PG8_STAGE(PG8_SA(0, 1), a2 + hstep, voffA);
            PG8_WAIT_L(8); PG8_BAR; PG8_WAIT_L(0); PG8_MMA(0, 0, At, B0); PG8_BAR; PG8_SCHED;
            PG8_LDB(B1, 1, 1); PG8_STAGE(PG8_SB(1, 0), b3, voffB);
            PG8_BAR; PG8_WAIT_L(0); PG8_MMA(0, 1, At, B1); PG8_BAR;
            PG8_LDA(At, 1, 1); PG8_STAGE(PG8_SA(1, 0), a3, voffA);
            PG8_BAR; PG8_WAIT_L(0); PG8_MMA(1, 0, At, B0); PG8_BAR; PG8_SCHED;
            PG8_STAGE(PG8_SB(1, 1), b3 + hstep, voffB);
            PG8_WAIT_V(6); PG8_BAR; PG8_MMA(1, 1, At, B1); PG8_BAR;
            }
        }
        if constexpr (ALIGN_EPI) { if (wr == 0) PG8_BAR; }
        if constexpr (!Epi::AFTER_DRAIN) { E(acc, cur, wr, wc, fr, fq); S.done(cur); }
        if (!has_next) break;
#pragma unroll
        for (int a = 0; a < 2; ++a)
#pragma unroll
            for (int b = 0; b < 2; ++b)
#pragma unroll
                for (int m = 0; m < 4; ++m)
#pragma unroll
                    for (int n = 0; n < 2; ++n) acc[a][b][m][n] = (f32x4){0.f, 0.f, 0.f, 0.f};
        cur = nxt; cA = nA; cB = nB; ++ui;
        if constexpr (ALIGN_EPI) { if (wr == 1) PG8_BAR; }
    }
    PG8_WAIT_V(0);
    if constexpr (!ALIGN_EPI) { if (wr == 0) PG8_BAR; }
    PG8_BAR;
    if constexpr (Epi::AFTER_DRAIN) { E.fused(acc, cur, wr, wc, fr, fq, lds, wid, lane); S.done(cur); }
#undef PG8_SA
#undef PG8_SB
#undef PG8_STAGE
#undef PG8_LDA
#undef PG8_LDB
#undef PG8_MMA
#undef PG8_WAIT_V
#undef PG8_WAIT_L
#undef PG8_BAR
#undef PG8_SCHED
}
}
#define GAS __attribute__((address_space(1)))
#define LAS __attribute__((address_space(3)))
typedef unsigned short bf16;
typedef unsigned u32x4 __attribute__((ext_vector_type(4)));
typedef unsigned u32x2 __attribute__((ext_vector_type(2)));
typedef float f32x4 __attribute__((ext_vector_type(4)));
typedef float f32x16 __attribute__((ext_vector_type(16)));
typedef short bf16x8 __attribute__((ext_vector_type(8)));
typedef short s16x4 __attribute__((ext_vector_type(4)));
typedef float f32x2_t __attribute__((ext_vector_type(2)));
constexpr int NW = 8, NT = 512;
constexpr int MTOK = 8704, MP = 8192, MS = 512, DM = 2048, NIN = 7176, NINP = 7424, DFF = 8192;
constexpr int NSEQ = 33;
constexpr int PAST = 1024;
constexpr int C_QA = 0, C_KA = 1024, C_VA = 2048, C_QM = 3072, C_KM = 4096, C_VM = 5120, C_OM = 6144, C_IG = 7168, C_FG = 7172;
constexpr int NCH = 160;
constexpr float EPS = 1e-6f;
constexpr float LAM_INIT = 0.2f;
constexpr float QSCALE = 0.125f * 1.4426950408889634f;
constexpr size_t O_YP = 0, O_YS = 16777216, O_KP = 17825792, O_VP = 26214400, O_CVP = 34603008, O_CP = 34609152, O_NP = 34871296, O_MPO = 34872320,
                 O_KS = 34872324, O_VS = 35396612, O_CVS = 35920900, O_CS = 36117508, O_NS = 44506116, O_MSO = 44538884;
constexpr size_t MiB = 1u << 20;
constexpr size_t WS_MOD = 1 * MiB;
constexpr size_t WS_ROPE = 3 * MiB;
constexpr size_t WS_SCAL = 4 * MiB;
constexpr size_t WS_DN = 5 * MiB;
constexpr size_t WS_NPREV = 6 * MiB;
constexpr size_t WS_WIN = 8 * MiB;
constexpr size_t WS_WOUT = 40 * MiB;
constexpr size_t WS_WUP = 48 * MiB;
constexpr size_t WS_WDN = 80 * MiB;
constexpr size_t WS_XN = 112 * MiB;
constexpr size_t WS_PROJ = 148 * MiB;
constexpr size_t WS_QA = 272 * MiB;
constexpr size_t WS_KA = 289 * MiB;
constexpr size_t WS_VT = 306 * MiB;
constexpr size_t WS_DC = 322 * MiB;
constexpr size_t WS_CPREV = 482 * MiB;
constexpr size_t WS_MIX = 562 * MiB;
constexpr size_t WS_END = 596 * MiB;
constexpr size_t WS_H = WS_PROJ;
constexpr size_t WS_X1 = WS_DC;
constexpr size_t WS_PART6 = 390 * MiB;
constexpr size_t WS_PART8 = 422 * MiB;
constexpr size_t WS_PART9 = 486 * MiB;
constexpr size_t WS_FLAG = 0;
static_assert(WS_H + (size_t)MTOK * DFF * 2 <= WS_VT + 16 * MiB && WS_X1 + (size_t)MTOK * DM * 4 <= WS_CPREV, "overlays");

constexpr int LDS_BYTES = 147456;

__device__ __forceinline__ f32x4 ld_bf4(const bf16* p) { const u32x2 w = *(const u32x2*)p; return (f32x4){__uint_as_float(w.x << 16), __uint_as_float(w.x & 0xffff0000u), __uint_as_float(w.y << 16), __uint_as_float(w.y & 0xffff0000u)}; }
__device__ __forceinline__ float bf2f(unsigned short u) { return __uint_as_float((unsigned)u << 16); }
__device__ __forceinline__ unsigned pk2(float lo, float hi) { return pg8::cvt_pk_bf16(lo, hi); }
__device__ __forceinline__ float lane_get(float v, int src_lane) { return __int_as_float(__builtin_amdgcn_ds_bpermute(src_lane << 2, __float_as_int(v))); }
__device__ __forceinline__ float xhalf_other(float v) { auto rr = __builtin_amdgcn_permlane32_swap(__float_as_uint(v), __float_as_uint(v), false, false); return __uint_as_float(rr[0]) + __uint_as_float(rr[1]) - v; }
__device__ __forceinline__ float xhalf_sum(float v) { auto rr = __builtin_amdgcn_permlane32_swap(__float_as_uint(v), __float_as_uint(v), false, false); return __uint_as_float(rr[0]) + __uint_as_float(rr[1]); }
__device__ __forceinline__ float wave_sum(float v, int lane) {
#pragma unroll
    for (int o = 1; o < 32; o <<= 1) v += lane_get(v, lane ^ o);
    return xhalf_sum(v);
}
__device__ __forceinline__ float wave_max(float v, int lane) {
#pragma unroll
    for (int o = 1; o < 64; o <<= 1) v = fmaxf(v, lane_get(v, lane ^ o));
    return v;
}
__device__ __forceinline__ float silu_f(float x) { return x / (1.f + __expf(-x)); }
__device__ __forceinline__ float sigmoid_f(float x) { return 1.f / (1.f + __expf(-x)); }
__device__ __forceinline__ int crow(int r, int hi) { return (r & 3) + 8 * (r >> 2) + 4 * hi; }
#define LDS_WAIT() asm volatile("s_waitcnt lgkmcnt(0)" ::: "memory")

struct Args {
    const float* in[29]; float* out; unsigned char* ws;
};
typedef const __attribute__((address_space(4))) Args* ArgsP;
#define FRESH_ARGS() ({ ArgsP p_ = (ArgsP)__builtin_amdgcn_kernarg_segment_ptr(); asm volatile("" : "+s"(p_)); p_; })

__device__ __forceinline__ void p0_transpose_item(const float* __restrict__ W, int K, int N, int Npad, bf16* WT, LAS float* T, int item, int tid, int wave, int lane) {
    const int nblk = Npad / 256, kb = item / nblk, nb = item % nblk, k0 = 64 * kb, n0 = 256 * nb;
    const int n = n0 + 4 * lane;
    f32x4 v[8];
#pragma unroll
    for (int i = 0; i < 8; ++i) v[i] = (n < N) ? *(const f32x4*)(W + (size_t)(k0 + 8 * wave + i) * N + n) : (f32x4){0.f, 0.f, 0.f, 0.f};
#pragma unroll
    for (int i = 0; i < 8; ++i) *(LAS f32x4*)(T + (8 * wave + i) * 260 + 4 * lane) = v[i];
    __syncthreads();
#pragma unroll
    for (int j = 0; j < 4; ++j) { const int q = tid + NT * j, nn = q >> 3, c = q & 7; const LAS float* s = T + (8 * c) * 260 + nn;
        u32x4 o; o.x = pk2(s[0], s[260]); o.y = pk2(s[2 * 260], s[3 * 260]); o.z = pk2(s[4 * 260], s[5 * 260]); o.w = pk2(s[6 * 260], s[7 * 260]);
        *(u32x4*)(WT + (size_t)(n0 + nn) * K + k0 + 8 * c) = o; }
    __syncthreads();
}

__device__ __forceinline__ void p0_ada_item(const float* __restrict__ cP, const float* __restrict__ cS, const float* __restrict__ Wada, const float* __restrict__ bada,
                                            float* mod, LAS float* red, int jb, int wave, int lane, int tid) {
    const int i32 = lane & 31, hi = lane >> 5;
    f32x16 acc[4]; f32x4 accp = {0.f, 0.f, 0.f, 0.f};
#pragma unroll
    for (int c = 0; c < 4; ++c) acc[c] = (f32x16){};
    const float* wp = Wada + (size_t)128 * jb + 4 * i32;
    for (int st = 0; st < 16; ++st) {
        const int k0 = 256 * wave + 16 * st + 8 * hi;
        f32x4 w[8];
#pragma unroll
        for (int i = 0; i < 8; ++i) w[i] = *(const f32x4*)(wp + (size_t)(k0 + i) * 12288);
        const f32x4 c0 = *(const f32x4*)(cS + (size_t)i32 * DM + k0), c1 = *(const f32x4*)(cS + (size_t)i32 * DM + k0 + 4);
        const f32x4 p0 = *(const f32x4*)(cP + k0), p1 = *(const f32x4*)(cP + k0 + 4);
        u32x4 a;
        a.x = pk2(silu_f(c0[0]), silu_f(c0[1])); a.y = pk2(silu_f(c0[2]), silu_f(c0[3])); a.z = pk2(silu_f(c1[0]), silu_f(c1[1])); a.w = pk2(silu_f(c1[2]), silu_f(c1[3]));
#pragma unroll
        for (int i = 0; i < 4; ++i) { accp += w[i] * silu_f(p0[i]); accp += w[4 + i] * silu_f(p1[i]); }
#pragma unroll
        for (int c = 0; c < 4; ++c) { u32x4 b; b.x = pk2(w[0][c], w[1][c]); b.y = pk2(w[2][c], w[3][c]); b.z = pk2(w[4][c], w[5][c]); b.w = pk2(w[6][c], w[7][c]);
            acc[c] = __builtin_amdgcn_mfma_f32_32x32x16_bf16(__builtin_bit_cast(bf16x8, a), __builtin_bit_cast(bf16x8, b), acc[c], 0, 0, 0); }
    }
    accp = (f32x4){xhalf_sum(accp[0]), xhalf_sum(accp[1]), xhalf_sum(accp[2]), xhalf_sum(accp[3])};
    LAS float* rp = red + 16384;
    if (hi == 0) *(LAS f32x4*)(rp + wave * 128 + 4 * i32) = accp;
#pragma unroll
    for (int half = 4; half >= 1; half >>= 1) {
        if (wave >= half && wave < 2 * half) { LAS float* dst = red + (wave - half) * 4096;
#pragma unroll
            for (int r = 0; r < 16; ++r) *(LAS f32x4*)(dst + crow(r, hi) * 128 + 4 * i32) = (f32x4){acc[0][r], acc[1][r], acc[2][r], acc[3][r]}; }
        __syncthreads();
        if (wave < half) { const LAS float* src = red + wave * 4096;
#pragma unroll
            for (int r = 0; r < 16; ++r) { const f32x4 t = *(const LAS f32x4*)(src + crow(r, hi) * 128 + 4 * i32); acc[0][r] += t[0]; acc[1][r] += t[1]; acc[2][r] += t[2]; acc[3][r] += t[3]; } }
        __syncthreads();
    }
    if (wave == 0) { const f32x4 bv = *(const f32x4*)(bada + 128 * jb + 4 * i32);
#pragma unroll
        for (int r = 0; r < 16; ++r) *(f32x4*)(mod + (size_t)(1 + crow(r, hi)) * 12288 + 128 * jb + 4 * i32) = (f32x4){acc[0][r], acc[1][r], acc[2][r], acc[3][r]} + bv; }
    if (wave == 1 && hi == 0) { f32x4 t = *(const f32x4*)(bada + 128 * jb + 4 * i32);
#pragma unroll
        for (int w = 0; w < 8; ++w) t += *(const LAS f32x4*)(rp + w * 128 + 4 * i32);
        *(f32x4*)(mod + 128 * jb + 4 * i32) = t; }
    __syncthreads();
}

__constant__ double INV_FREQ_TURNS[8] = {
    1.0 / 6.283185307179586, 0.19392274474868576 / 6.283185307179586, 0.03760603093086393 / 6.283185307179586, 0.007292664737217109 / 6.283185307179586,
    0.001414213562373095 / 6.283185307179586, 0.0002742481756762073 / 6.283185307179586, 5.318295896944988e-05 / 6.283185307179586, 1.031338537721246e-05 / 6.283185307179586 };

__device__ __forceinline__ void p0_prologue(ArgsP A, LAS unsigned char* lds, int tid, int wave, int lane) {
    unsigned char* ws = A->ws;
    const int G = gridDim.x, bid = blockIdx.x;
    for (int jb = bid; jb < 96; jb += G)
        p0_ada_item(A->in[8], A->in[9], A->in[10], A->in[11], (float*)(ws + WS_MOD), (LAS float*)lds, jb, wave, lane, tid);
    constexpr int I_IN = 32 * (NINP / 256), I_OUT = 32 * 8, I_UP = 32 * 32, I_DN = 128 * 8, I_ALL = I_IN + I_OUT + I_UP + I_DN;
    const bool split = (G > 128);
    const int nfree = split ? G - 96 : G, first = split ? 14 * nfree : 0;
    for (int pass = 0; pass < 2; ++pass) {
        int it, step, end;
        if (pass == 0) { if (!split || bid < 96) continue; it = bid - 96; step = nfree; end = (first < I_ALL) ? first : I_ALL; }
        else { it = first + bid; step = G; end = I_ALL; }
        for (; it < end; it += step) { int r = it;
            if (r < I_IN) { p0_transpose_item(A->in[13], DM, NIN, NINP, (bf16*)(ws + WS_WIN), (LAS float*)lds, r, tid, wave, lane); continue; } r -= I_IN;
            if (r < I_OUT) { p0_transpose_item(A->in[24], DM, DM, DM, (bf16*)(ws + WS_WOUT), (LAS float*)lds, r, tid, wave, lane); continue; } r -= I_OUT;
            if (r < I_UP) { p0_transpose_item(A->in[26], DM, DFF, DFF, (bf16*)(ws + WS_WUP), (LAS float*)lds, r, tid, wave, lane); continue; } r -= I_UP;
            p0_transpose_item(A->in[27], DFF, DM, DM, (bf16*)(ws + WS_WDN), (LAS float*)lds, r, tid, wave, lane); }
    }
    for (int idx = blockIdx.x * NT + tid; idx < 8192 * 8; idx += gridDim.x * NT) {
        const int pos = idx >> 3, i = idx & 7;
        const double t = (double)pos * INV_FREQ_TURNS[i]; const float fr = (float)(t - __builtin_rint(t));
        float* tab = (float*)(ws + WS_ROPE) + (size_t)pos * 16;
        tab[i] = __builtin_amdgcn_cosf(fr); tab[8 + i] = __builtin_amdgcn_sinf(fr);
    }
}

template <int NPART> __device__ __forceinline__ void norm_mod_rows(const float* xP, const float* xS, const float* __restrict__ g, const float* __restrict__ mod, int sh_off, int sc_off, bf16* out, int wave, int lane,
                                              const bf16* part = nullptr, int gate_off = 0, float* x1S = nullptr) {
    const int gw = blockIdx.x * NW + wave, NGW = gridDim.x * NW;
    for (int r = gw; r < MTOK; r += NGW) {
        const float* xr = (r < MP) ? xP + (size_t)r * DM : xS + (size_t)(r - MP) * DM;
        const float* mr = mod + (size_t)((r < MP) ? 0 : 1 + ((r - MP) >> 4)) * 12288;
        f32x4 v[8]; float s = 0.f;
#pragma unroll
        for (int j = 0; j < 8; ++j) v[j] = *(const f32x4*)(xr + 256 * j + 4 * lane);
        if (NPART > 0 && r >= MP) {
#pragma unroll
            for (int j = 0; j < 8; ++j) { const int c = 256 * j + 4 * lane; f32x4 a = {0.f, 0.f, 0.f, 0.f};
                f32x4 t[NPART > 0 ? NPART : 1];
#pragma unroll
                for (int p = 0; p < NPART; ++p) t[p] = ld_bf4(part + ((size_t)p * MS + (r - MP)) * DM + c);
#pragma unroll
                for (int p = 0; p < NPART; ++p) a += t[p];
                v[j] += *(const f32x4*)(mr + gate_off + c) * a; *(f32x4*)(x1S + (size_t)(r - MP) * DM + c) = v[j]; } }
#pragma unroll
        for (int j = 0; j < 8; ++j) s += (v[j].x * v[j].x + v[j].y * v[j].y) + (v[j].z * v[j].z + v[j].w * v[j].w);
        const float rstd = 1.f / sqrtf(wave_sum(s, lane) * (1.f / DM) + EPS);
#pragma unroll
        for (int j = 0; j < 8; ++j) { const int c = 256 * j + 4 * lane;
            const f32x4 gg = *(const f32x4*)(g + c), sc = *(const f32x4*)(mr + sc_off + c), sh = *(const f32x4*)(mr + sh_off + c);
            const f32x4 y = v[j] * rstd * gg * (sc + 1.f) + sh;
            u32x2 o; o.x = pk2(y.x, y.y); o.y = pk2(y.z, y.w);
            *(u32x2*)(out + (size_t)r * DM + c) = o; }
    }
}
#define XB_TMO      128
#define XB_XCNT(j)  (256  + 64 * (j))
#define XB_XSUB(j)  (1280 + 64 * (j))
#define XB_XGEN(j)  (2304 + 64 * (j))
#define XB_TOP      3328
#define XB_TOPGEN   3392
#define XCD_BAR_WORDS 3456
#define XB_SPIN_CAP (1u << 18)

__device__ __forceinline__ unsigned xb_ld(unsigned* p)              { return __hip_atomic_load(p, __ATOMIC_RELAXED, __HIP_MEMORY_SCOPE_AGENT); }
__device__ __forceinline__ unsigned xb_add(unsigned* p, unsigned v) { return __hip_atomic_fetch_add(p, v, __ATOMIC_RELAXED, __HIP_MEMORY_SCOPE_AGENT); }
__device__ __forceinline__ unsigned xb_xcc_id() { return (unsigned)__builtin_amdgcn_s_getreg((3 << 11) | 20) & 0xFu; }
#define XB_SPIN(cond, bar) do { unsigned _sp = 0; while (cond) { __builtin_amdgcn_s_sleep(1); \
    if ((++_sp & 255u) == 0u) { if (xb_ld(&(bar)[XB_TMO])) break; if (_sp > XB_SPIN_CAP) { atomicAdd(&(bar)[XB_TMO], 1u); break; } } } } while (0)

struct XcdBarrier {
    unsigned* bar; unsigned x;
    volatile LAS unsigned* st;
};

__device__ __forceinline__ XcdBarrier xcd_barrier_post(unsigned* bar, volatile LAS unsigned* st) {
    XcdBarrier b; b.bar = bar; b.x = xb_xcc_id(); b.st = st;
    if (threadIdx.x == 0) (void)xb_add(&bar[XB_XCNT(b.x)], 1u);
    return b;
}
__device__ __forceinline__ void xcd_barrier_complete(unsigned* bar, unsigned x, unsigned& nloc, unsigned& nx) {
    const unsigned G = gridDim.x * gridDim.y * gridDim.z;
    unsigned sum, cnt, mine, sp = 0u;
    for (;;) {
        sum = 0u; cnt = 0u; mine = 0u;
#pragma unroll
        for (unsigned j = 0; j < 16; ++j) { const unsigned c = xb_ld(&bar[XB_XCNT(j)]); sum += c; cnt += (c > 0u) ? 1u : 0u; mine = (j == x) ? c : mine; }
        if (sum == G) break;
        __builtin_amdgcn_s_sleep(1);
        if ((++sp & 255u) == 0u) { if (xb_ld(&bar[XB_TMO])) break; if (sp > XB_SPIN_CAP) { atomicAdd(&bar[XB_TMO], 1u); break; } }
    }
    nloc = mine > 0u ? mine : 1u; nx = cnt > 0u ? cnt : 1u;
}

__device__ __forceinline__ void xcd_barrier(const XcdBarrier& b) {
    asm volatile("s_waitcnt vmcnt(0)" ::: "memory");
    __syncthreads();
    if (threadIdx.x == 0) {
        unsigned* bar = b.bar;
        __builtin_amdgcn_s_waitcnt(0);
        unsigned nloc = b.st[0], nx = b.st[1];
        if (nloc == 0u) { xcd_barrier_complete(bar, b.x, nloc, nx); b.st[0] = nloc; b.st[1] = nx; }
        const unsigned old = xb_add(&bar[XB_XSUB(b.x)], 1u);
        const unsigned gen = old / nloc;
        if (old + 1u == (gen + 1u) * nloc) {
            __builtin_amdgcn_fence(__ATOMIC_RELEASE, "agent");
            asm volatile("s_waitcnt vmcnt(0)" ::: "memory");
            const unsigned og = xb_add(&bar[XB_TOP], 1u);
            const unsigned tg = og / nx;
            if (og + 1u == (tg + 1u) * nx) xb_add(&bar[XB_TOPGEN], 1u);
            else XB_SPIN(xb_ld(&bar[XB_TOPGEN]) == tg, bar);
            __builtin_amdgcn_fence(__ATOMIC_ACQUIRE, "agent");
            xb_add(&bar[XB_XGEN(b.x)], 1u);
            asm volatile("s_waitcnt vmcnt(0)" ::: "memory");
        } else {
            XB_SPIN(xb_ld(&bar[XB_XGEN(b.x)]) == gen, bar);
            __builtin_amdgcn_fence(__ATOMIC_ACQUIRE, "agent");
            asm volatile("s_waitcnt vmcnt(0)" ::: "memory");
        }
    }
    __syncthreads();
}

struct EpiResidNorm {
    static constexpr bool PERM = true, AFTER_DRAIN = true;
    const float* base; const float* gate; const float* gfin; float* out; float* ssq; XcdBarrier xb;
    __device__ __forceinline__ void fused(pg8::f32x4 (&acc)[2][2][4][2], const pg8::Unit& u, int wr, int wc, int fr, int fq, LAS unsigned char* lds, int wid, int lane) const {
        typedef pg8::f32x4 f4;
        LAS float* P = (LAS float*)lds;
        LAS float* S = P + 1024;
        const int row0 = u.pm * 256 + wr * 64 + fr, col0 = u.pn * 256 + wc * 32 + 8 * fq;
        const int l16 = (lane ^ 16) << 2, l32 = (lane ^ 32) << 2;
#pragma unroll
        for (int ai = 0; ai < 2; ++ai)
#pragma unroll
            for (int m = 0; m < 4; ++m) { const int r = row0 + ai * 128 + m * 16; const float* bp = base + (size_t)r * 2048; float s = 0.f;
#pragma unroll
                for (int bj = 0; bj < 2; ++bj)
#pragma unroll
                    for (int n = 0; n < 2; ++n) { const int c = col0 + bj * 128 + 4 * n; const f4 bv = *(const f4*)(bp + c), gv = *(const f4*)(gate + c);
                        const f4 x = bv + gv * acc[ai][bj][m][n]; acc[ai][bj][m][n] = x; s += (x[0] * x[0] + x[1] * x[1]) + (x[2] * x[2] + x[3] * x[3]); }
                s += __int_as_float(__builtin_amdgcn_ds_bpermute(l16, __float_as_int(s)));
                s += __int_as_float(__builtin_amdgcn_ds_bpermute(l32, __float_as_int(s)));
                if (fq == 0) P[(ai * 128 + wr * 64 + m * 16 + fr) * 4 + wc] = s;
                asm volatile("" ::: "memory"); }
        __syncthreads();
        const int tid = threadIdx.x;
        if (tid < 256) ssq[(size_t)u.pn * 8192 + u.pm * 256 + tid] = (P[tid * 4] + P[tid * 4 + 1]) + (P[tid * 4 + 2] + P[tid * 4 + 3]);
        xcd_barrier(xb);
        if (tid < 256) { float t = 0.f;
#pragma unroll
            for (int p = 0; p < 8; ++p) t += ssq[(size_t)p * 8192 + u.pm * 256 + tid];
            S[tid] = 1.f / sqrtf(t * (1.f / 2048.f) + 1e-6f); }
        __syncthreads();
#pragma unroll
        for (int ai = 0; ai < 2; ++ai)
#pragma unroll
            for (int m = 0; m < 4; ++m) { const int rl = ai * 128 + wr * 64 + m * 16 + fr; const float rs = S[rl]; float* op = out + (size_t)(u.pm * 256 + rl) * 2048;
#pragma unroll
                for (int bj = 0; bj < 2; ++bj)
#pragma unroll
                    for (int n = 0; n < 2; ++n) { const int c = col0 + bj * 128 + 4 * n; *(f4*)(op + c) = acc[ai][bj][m][n] * rs * *(const f4*)(gfin + c); } }
    }
};
__device__ __forceinline__ void unpack16(const u32x4 a, const u32x4 b, float* v) {
#pragma unroll
    for (int i = 0; i < 4; ++i) { v[2 * i] = __uint_as_float(a[i] << 16); v[2 * i + 1] = __uint_as_float(a[i] & 0xffff0000u); v[8 + 2 * i] = __uint_as_float(b[i] << 16); v[8 + 2 * i + 1] = __uint_as_float(b[i] & 0xffff0000u); }
}
__device__ __forceinline__ void p3_post(ArgsP A, int tid) {
    unsigned char* ws = A->ws;
    const bf16* PROJ = (const bf16*)(ws + WS_PROJ);
    for (int it = blockIdx.x * NT + tid; it < 33 * 3 * 2048; it += gridDim.x * NT) {
        const int ch = it & 2047, j = (it >> 11) % 3, sq = it / (3 * 2048);
        const int r = (sq == 0) ? (MP - 3 + j) : (MP + 16 * (sq - 1) + 13 + j);
        const float val = bf2f(PROJ[(size_t)r * NINP + C_QM + ch]);
        if (sq == 0) A->out[O_CVP + (size_t)j * 2048 + ch] = val; else A->out[O_CVS + ((size_t)(sq - 1) * 3 + j) * 2048 + ch] = val;
    }
}
typedef short v4i16_t __attribute__((ext_vector_type(4)));
__device__ __forceinline__ s16x4 tr_rd(LAS const unsigned char* p) { return __builtin_bit_cast(s16x4, __builtin_amdgcn_ds_read_tr16_b64_v4i16((LAS v4i16_t*)p)); }
__device__ __forceinline__ bf16x8 mk8(s16x4 a, s16x4 b) { return (bf16x8){a[0], a[1], a[2], a[3], b[0], b[1], b[2], b[3]}; }
__device__ __forceinline__ int tr_off(int pitch, int krow, int colbase, int lane) { return (krow + ((lane & 15) >> 2)) * pitch + (colbase + 16 * ((lane >> 4) & 1) + 4 * (lane & 3)) * 2; }
__device__ __forceinline__ void unpack8(const u32x4 a, float* v) {
#pragma unroll
    for (int i = 0; i < 4; ++i) { v[2 * i] = __uint_as_float(a[i] << 16); v[2 * i + 1] = __uint_as_float(a[i] & 0xffff0000u); }
}
__device__ __forceinline__ int unit_row0(int u) { return (u < 128) ? 64 * u : MP + 16 * (u - 128); }
__device__ __forceinline__ void conv8(const bf16* PROJ, const float* __restrict__ stconv, const float* __restrict__ wconv, const float* __restrict__ bconv, int u, int s, int ch0, float* o) {
    const int r0 = unit_row0(u);
    f32x4 a0 = *(const f32x4*)(bconv + ch0), a1 = *(const f32x4*)(bconv + ch0 + 4);
#pragma unroll
    for (int j = 0; j < 4; ++j) { const int tau = s - 3 + j; float x[8];
        if (tau >= 0 || (u > 0 && u < 128)) unpack8(*(const u32x4*)(PROJ + (size_t)(r0 + tau) * NINP + C_QM + ch0), x);
        else if (u >= 128) { const float* p = stconv + ((size_t)(u - 128) * 3 + (3 + tau)) * 2048 + ch0; const f32x4 y0 = *(const f32x4*)p, y1 = *(const f32x4*)(p + 4);
            x[0] = y0[0]; x[1] = y0[1]; x[2] = y0[2]; x[3] = y0[3]; x[4] = y1[0]; x[5] = y1[1]; x[6] = y1[2]; x[7] = y1[3]; }
        else {
#pragma unroll
            for (int i = 0; i < 8; ++i) x[i] = 0.f; }
        const f32x4 w0 = *(const f32x4*)(wconv + j * 2048 + ch0), w1 = *(const f32x4*)(wconv + j * 2048 + ch0 + 4);
        a0 += (f32x4){x[0], x[1], x[2], x[3]} * w0; a1 += (f32x4){x[4], x[5], x[6], x[7]} * w1; }
#pragma unroll
    for (int i = 0; i < 4; ++i) { o[i] = silu_f(a0[i]); o[4 + i] = silu_f(a1[i]); }
}
__device__ __forceinline__ void conv_rows4(const bf16* PROJ, const float* __restrict__ stconv, const float* __restrict__ wconv, const float* __restrict__ bconv, int u, int L, int s0, int ch0, float sc, u32x4* o) {
    const int r0 = unit_row0(u);
    f32x4 w0[4], w1[4];
#pragma unroll
    for (int j = 0; j < 4; ++j) { w0[j] = *(const f32x4*)(wconv + j * 2048 + ch0); w1[j] = *(const f32x4*)(wconv + j * 2048 + ch0 + 4); }
    const f32x4 b0 = *(const f32x4*)(bconv + ch0), b1 = *(const f32x4*)(bconv + ch0 + 4);
    f32x4 x0[7], x1[7];
#pragma unroll
    for (int i = 0; i < 7; ++i) { const int tau = s0 - 3 + i; x0[i] = (f32x4){0.f, 0.f, 0.f, 0.f}; x1[i] = x0[i];
        if (tau >= 0 ? (tau < L) : (u > 0 && u < 128)) { float t[8]; unpack8(*(const u32x4*)(PROJ + (size_t)(r0 + tau) * NINP + C_QM + ch0), t); x0[i] = (f32x4){t[0], t[1], t[2], t[3]}; x1[i] = (f32x4){t[4], t[5], t[6], t[7]}; }
        else if (tau < 0 && u >= 128) { const float* p = stconv + ((size_t)(u - 128) * 3 + (3 + tau)) * 2048 + ch0; x0[i] = *(const f32x4*)p; x1[i] = *(const f32x4*)(p + 4); } }
#pragma unroll
    for (int r = 0; r < 4; ++r) { f32x4 a0 = b0, a1 = b1;
#pragma unroll
        for (int j = 0; j < 4; ++j) { a0 += x0[r + j] * w0[j]; a1 += x1[r + j] * w1[j]; }
        u32x4 q = {0u, 0u, 0u, 0u};
        if (s0 + r < L) { q.x = pk2(silu_f(a0[0]) * sc, silu_f(a0[1]) * sc); q.y = pk2(silu_f(a0[2]) * sc, silu_f(a0[3]) * sc); q.z = pk2(silu_f(a1[0]) * sc, silu_f(a1[1]) * sc); q.w = pk2(silu_f(a1[2]) * sc, silu_f(a1[3]) * sc); }
        o[r] = q; }
}
__device__ __forceinline__ u32x4 pack8(const float* v, float sc) { u32x4 o; o.x = pk2(v[0] * sc, v[1] * sc); o.y = pk2(v[2] * sc, v[3] * sc); o.z = pk2(v[4] * sc, v[5] * sc); o.w = pk2(v[6] * sc, v[7] * sc); return o; }
__device__ __forceinline__ float logsigmoid_f(float f) { return fminf(f, 0.f) - log1pf(__expf(-fabsf(f))); }
__device__ __forceinline__ void load_gates(const bf16* PROJ, const float* bi, const float* bfg, int u, int h, int t, float& ig, float& lf) {
    const int L = (u < 128) ? 64 : 16; const int r = unit_row0(u) + t;
    ig = -INFINITY; lf = 0.f;
    if (t < L) { ig = bf2f(PROJ[(size_t)r * NINP + C_IG + h]) + bi[h]; lf = logsigmoid_f(bf2f(PROJ[(size_t)r * NINP + C_FG + h]) + bfg[h]); }
}
__device__ __forceinline__ float scan_add(float v, int lane) {
#pragma unroll
    for (int o = 1; o < 64; o <<= 1) { const float x = lane_get(v, lane - o); if (lane >= o) v += x; }
    return v;
}
__device__ __forceinline__ float scan_max(float v, int lane) {
#pragma unroll
    for (int o = 1; o < 64; o <<= 1) { const float x = lane_get(v, lane - o); if (lane >= o) v = fmaxf(v, x); }
    return v;
}
constexpr int MA_K = 0, MA_V = 36864, MA_W = 73728;
constexpr int PK = 576;
__device__ __forceinline__ void mlstm_phaseA(ArgsP A, LAS unsigned char* lds, int u, int h, int tid, int wave, int lane) {
    unsigned char* ws = A->ws; const bf16* PROJ = (const bf16*)(ws + WS_PROJ);
    float* SC = (float*)(ws + WS_SCAL);
    LAS float* wl = (LAS float*)(lds + MA_W);
    const int L = (u < 128) ? 64 : 16, r0 = unit_row0(u);
    if (wave == 0) {
        float ig, lf; load_gates(PROJ, A->in[21], A->in[22], u, h, lane, ig, lf);
        const float b = scan_add(lf, lane); const float G = lane_get(b, 63);
        const float uu = (lane < L) ? G - b + ig : -INFINITY; const float mloc = wave_max(uu, lane);
        wl[lane] = (lane < L) ? __expf(uu - mloc) : 0.f;
        if (lane == 0) { SC[u * 4 + h] = G; SC[640 + u * 4 + h] = mloc; }
    }
    { const int c8 = 8 * (tid & 31), s0 = 4 * (tid >> 5);
      u32x4 ko[4]; conv_rows4(PROJ, A->in[4], A->in[19], A->in[20], u, L, s0, 1024 + h * 256 + c8, 0.0625f, ko);
      u32x4 vr[4];
#pragma unroll
      for (int r = 0; r < 4; ++r) { vr[r] = (u32x4){0u, 0u, 0u, 0u}; if (s0 + r < L) vr[r] = *(const u32x4*)(PROJ + (size_t)(r0 + s0 + r) * NINP + C_VM + h * 256 + c8); }
#pragma unroll
      for (int r = 0; r < 4; ++r) *(LAS u32x4*)(lds + MA_K + (s0 + r) * PK + c8 * 2) = ko[r];
      __syncthreads();
#pragma unroll
      for (int r = 0; r < 4; ++r) { float v[8]; unpack8(vr[r], v); *(LAS u32x4*)(lds + MA_V + (s0 + r) * PK + c8 * 2) = pack8(v, wl[s0 + r]); } }
    __syncthreads();
    { const int i32 = lane & 31, hi = lane >> 5, eb = wave;
      bf16x8 af[4];
#pragma unroll
      for (int ks = 0; ks < 4; ++ks) { const int o = tr_off(PK, 16 * ks + 8 * hi, 32 * eb, lane); af[ks] = mk8(tr_rd(lds + MA_V + o), tr_rd(lds + MA_V + o + 4 * PK)); }
      bf16* dC = (bf16*)(ws + WS_DC) + ((size_t)(u * 4 + h) * 256 + 32 * eb + i32) * 256 + 4 * hi;
      for (int db = 0; db < 8; ++db) { f32x16 acc = {};
#pragma unroll
          for (int ks = 0; ks < 4; ++ks) { const int o = tr_off(PK, 16 * ks + 8 * hi, 32 * db, lane); const bf16x8 bfr = mk8(tr_rd(lds + MA_K + o), tr_rd(lds + MA_K + o + 4 * PK));
              acc = __builtin_amdgcn_mfma_f32_32x32x16_bf16(bfr, af[ks], acc, 0, 0, 0); }
#pragma unroll
          for (int g4 = 0; g4 < 4; ++g4) { u32x2 o; o.x = pk2(acc[4 * g4], acc[4 * g4 + 1]); o.y = pk2(acc[4 * g4 + 2], acc[4 * g4 + 3]); *(u32x2*)(dC + 32 * db + 8 * g4) = o; } } }
    if (tid < 256) { float a = 0.f;
        for (int s = 0; s < 64; ++s) a += wl[s] * bf2f(*(LAS const unsigned short*)(lds + MA_K + s * PK + tid * 2));
        ((float*)(ws + WS_DN))[(size_t)(u * 4 + h) * 256 + tid] = a; }
    __syncthreads();
}
__device__ __forceinline__ void mlstm_phaseB(ArgsP A, LAS unsigned char* lds, int tid, int wave, int lane) {
    unsigned char* ws = A->ws; const float* SC = (const float*)(ws + WS_SCAL); float* MPREV = (float*)(ws + WS_SCAL) + 1280;
    const bf16* DC = (const bf16*)(ws + WS_DC); bf16* CP = (bf16*)(ws + WS_CPREV); const float* DN = (const float*)(ws + WS_DN); float* NP = (float*)(ws + WS_NPREV);
    const int gid = blockIdx.x * NT + tid, gsz = gridDim.x * NT;
    LAS float* AL = (LAS float*)lds; LAS float* BE = AL + 512;
    if (wave < 4) { const int h = wave; const float g0 = SC[lane * 4 + h], g1 = SC[(64 + lane) * 4 + h], l0 = SC[640 + lane * 4 + h], l1 = SC[640 + (64 + lane) * 4 + h];
        float m = 0.f;
        for (int c = 0; c < 128; ++c) { const float G = lane_get((c < 64) ? g0 : g1, c & 63), ml = lane_get((c < 64) ? l0 : l1, c & 63);
            const float mn = fmaxf(G + m, ml);
            if (lane == 0) { AL[h * 128 + c] = __expf(G + m - mn); BE[h * 128 + c] = __expf(ml - mn); if (blockIdx.x == 0) MPREV[c * 4 + h] = m; }
            m = mn; }
        if (blockIdx.x == 0 && lane == 0) A->out[O_MPO + h] = m; }
    __syncthreads();
    for (int idx = gid; idx < 4 * 32768; idx += gsz) { const int h = idx >> 15, el = (idx & 32767) * 2;
        float c0 = 0.f, c1 = 0.f;
        for (int cb = 0; cb < 128; cb += 32) { unsigned d[32];
#pragma unroll
            for (int j = 0; j < 32; ++j) d[j] = *(const unsigned*)(DC + ((size_t)((cb + j) * 4 + h) << 16) + el);
#pragma unroll
            for (int j = 0; j < 32; ++j) { const int c = cb + j; const float al = AL[h * 128 + c], be = BE[h * 128 + c];
                *(unsigned*)(CP + ((size_t)(c * 4 + h) << 16) + el) = pk2(c0, c1);
                c0 = al * c0 + be * __uint_as_float(d[j] << 16); c1 = al * c1 + be * __uint_as_float(d[j] & 0xffff0000u); } }
        *(f32x2_t*)(A->out + O_CP + ((size_t)h << 16) + el) = (f32x2_t){c0, c1}; }
    for (int idx = gid; idx < 4 * 256; idx += gsz) { const int h = idx >> 8, d = idx & 255; float n = 0.f;
        for (int cb = 0; cb < 128; cb += 32) { float dn[32];
#pragma unroll
            for (int j = 0; j < 32; ++j) dn[j] = DN[(size_t)((cb + j) * 4 + h) * 256 + d];
#pragma unroll
            for (int j = 0; j < 32; ++j) { const int c = cb + j; NP[(size_t)(c * 4 + h) * 256 + d] = n; n = AL[h * 128 + c] * n + BE[h * 128 + c] * dn[j]; } }
        A->out[O_NP + h * 256 + d] = n; }
    const float* C0 = A->in[5]; const float* N0 = A->in[6]; const float* M0 = A->in[7];
    for (int i0 = gid; i0 < 128 * 32768; i0 += 8 * gsz) {
        f32x2_t c[8]; unsigned d[8]; float m[8], G[8], ml[8];
#pragma unroll
        for (int k = 0; k < 8; ++k) { const int idx = i0 + k * gsz; if (idx < 128 * 32768) { const int bh = idx >> 15, el = (idx & 32767) * 2, ui = (128 + (bh >> 2)) * 4 + (bh & 3);
            m[k] = M0[bh]; G[k] = SC[ui]; ml[k] = SC[640 + ui]; c[k] = *(const f32x2_t*)(C0 + ((size_t)bh << 16) + el); d[k] = *(const unsigned*)(DC + ((size_t)ui << 16) + el); } }
#pragma unroll
        for (int k = 0; k < 8; ++k) { const int idx = i0 + k * gsz; if (idx < 128 * 32768) { const int bh = idx >> 15, el = (idx & 32767) * 2, ui = (128 + (bh >> 2)) * 4 + (bh & 3);
            const float mn = fmaxf(G[k] + m[k], ml[k]); const float al = __expf(G[k] + m[k] - mn), be = __expf(ml[k] - mn);
            *(unsigned*)(CP + ((size_t)ui << 16) + el) = pk2(c[k].x, c[k].y);
            *(f32x2_t*)(A->out + O_CS + ((size_t)bh << 16) + el) = (f32x2_t){al * c[k].x + be * __uint_as_float(d[k] << 16), al * c[k].y + be * __uint_as_float(d[k] & 0xffff0000u)};
            if (el == 0) { MPREV[ui] = m[k]; A->out[O_MSO + bh] = mn; } } } }
    for (int idx = gid; idx < 128 * 256; idx += gsz) { const int bh = idx >> 8, d = idx & 255, ui = (128 + (bh >> 2)) * 4 + (bh & 3);
        const float m = M0[bh], G = SC[ui], ml = SC[640 + ui]; const float mn = fmaxf(G + m, ml); const float al = __expf(G + m - mn), be = __expf(ml - mn);
        const float n = N0[idx]; NP[(size_t)ui * 256 + d] = n; A->out[O_NS + idx] = al * n + be * DN[(size_t)ui * 256 + d]; }
}
constexpr int MC_Q = 0, MC_K = 33792, MC_V = 67584, MC_S = 104448, MC_F = 113664;
constexpr int PQ = 528, PS = 144;
__device__ __forceinline__ void mlstm_phaseC(ArgsP A, LAS unsigned char* lds, int u, int h, int tid, int wave, int lane) {
    unsigned char* ws = A->ws; const bf16* PROJ = (const bf16*)(ws + WS_PROJ);
    const int L = (u < 128) ? 64 : 16, r0 = unit_row0(u), uh = u * 4 + h;
    LAS float* F = (LAS float*)(lds + MC_F);
    LAS float* rt = F, *gg = F + 64, *winter = F + 128, *eden = F + 192, *nq = F + 256, *denp = F + 320, *ssq = F + 448;
    const int i32 = lane & 31, hi = lane >> 5;
    LAS float* nl = F + 960;
    if (wave == 1) *(LAS f32x4*)(nl + 4 * lane) = *(const f32x4*)((const float*)(ws + WS_NPREV) + (size_t)uh * 256 + 4 * lane);
    if (wave == 0) {
        float ig, lf; load_gates(PROJ, A->in[21], A->in[22], u, h, lane, ig, lf);
        const float b = scan_add(lf, lane); const float g = (lane < L) ? ig - b : -INFINITY; const float cm = scan_max(g, lane);
        const float mprev = ((const float*)(ws + WS_SCAL))[1280 + uh]; const float mx = fmaxf(mprev, cm);
        rt[lane] = -mx; gg[lane] = g; winter[lane] = __expf(mprev - mx); eden[lane] = __expf(-(b + mx));
    }
    { const int c8 = 8 * (tid & 31), s0 = 4 * (tid >> 5);
      u32x4 qo[4], ko[4], vo[4];
      conv_rows4(PROJ, A->in[4], A->in[19], A->in[20], u, L, s0, h * 256 + c8, 1.f, qo);
      conv_rows4(PROJ, A->in[4], A->in[19], A->in[20], u, L, s0, 1024 + h * 256 + c8, 0.0625f, ko);
#pragma unroll
      for (int r = 0; r < 4; ++r) { vo[r] = (u32x4){0u, 0u, 0u, 0u}; if (s0 + r < L) vo[r] = *(const u32x4*)(PROJ + (size_t)(r0 + s0 + r) * NINP + C_VM + h * 256 + c8); }
#pragma unroll
      for (int r = 0; r < 4; ++r) { *(LAS u32x4*)(lds + MC_Q + (s0 + r) * PQ + c8 * 2) = qo[r]; *(LAS u32x4*)(lds + MC_K + (s0 + r) * PQ + c8 * 2) = ko[r]; *(LAS u32x4*)(lds + MC_V + (s0 + r) * PK + c8 * 2) = vo[r]; } }
    bf16x8 ca[16];
    { const bf16* Cp = (const bf16*)(ws + WS_CPREV) + ((size_t)uh * 256 + 32 * wave + i32) * 256 + 8 * hi;
#pragma unroll
      for (int kk = 0; kk < 16; ++kk) ca[kk] = *(const bf16x8*)(Cp + 16 * kk); }
    __syncthreads();
    if (wave < 3) {
        const int tt = (wave > 0) ? 1 : 0, st = (wave == 2) ? 1 : 0;
        f32x16 acc = {};
#pragma unroll 4
        for (int kk = 0; kk < 16; ++kk) { const bf16x8 a = *(LAS const bf16x8*)(lds + MC_K + (32 * st + i32) * PQ + (16 * kk + 8 * hi) * 2), b = *(LAS const bf16x8*)(lds + MC_Q + (32 * tt + i32) * PQ + (16 * kk + 8 * hi) * 2);
            acc = __builtin_amdgcn_mfma_f32_32x32x16_bf16(a, b, acc, 0, 0, 0); }
        const int t = 32 * tt + i32; const float rtt = rt[t]; float rs = 0.f;
#pragma unroll
        for (int g4 = 0; g4 < 4; ++g4) { const int s0 = 32 * st + 8 * g4 + 4 * hi; float v[4];
#pragma unroll
            for (int j = 0; j < 4; ++j) { const int s = s0 + j; const float e = __expf(rtt + gg[s]) * acc[4 * g4 + j]; v[j] = (s <= t) ? e : 0.f; rs += v[j]; }
            u32x2 o; o.x = pk2(v[0], v[1]); o.y = pk2(v[2], v[3]); *(LAS u32x2*)(lds + MC_S + t * PS + s0 * 2) = o; }
        rs = xhalf_sum(rs);
        if (hi == 0) { denp[st * 64 + t] = rs; if (wave == 0) denp[64 + t] = 0.f; }
    } else if (wave == 3) {
        const LAS float* np = nl + 8 * hi;
#pragma unroll
        for (int tt = 0; tt < 2; ++tt) { f32x16 acc = {};
#pragma unroll 4
            for (int kk = 0; kk < 16; ++kk) { u32x4 aw = {0u, 0u, 0u, 0u};
                if (i32 == 0) { const f32x4 n0 = *(const LAS f32x4*)(np + 16 * kk), n1 = *(const LAS f32x4*)(np + 16 * kk + 4); aw.x = pk2(n0[0], n0[1]); aw.y = pk2(n0[2], n0[3]); aw.z = pk2(n1[0], n1[1]); aw.w = pk2(n1[2], n1[3]); }
                const bf16x8 b = *(LAS const bf16x8*)(lds + MC_Q + (32 * tt + i32) * PQ + (16 * kk + 8 * hi) * 2);
                acc = __builtin_amdgcn_mfma_f32_32x32x16_bf16(__builtin_bit_cast(bf16x8, aw), b, acc, 0, 0, 0); }
            if (hi == 0) nq[32 * tt + i32] = acc[0]; }
    }
    __syncthreads();
    const int eb = wave, ntt = (L > 32) ? 2 : 1;
    u32x2 ovp[2][4]; f32x4 gmp[4];
#pragma unroll
    for (int g4 = 0; g4 < 4; ++g4) { const int e = 32 * eb + 8 * g4 + 4 * hi; gmp[g4] = *(const f32x4*)(A->in[23] + h * 256 + e);
#pragma unroll
        for (int tt = 0; tt < 2; ++tt) { const int t = 32 * tt + i32; ovp[tt][g4] = (u32x2){0u, 0u};
            if (t < L) ovp[tt][g4] = *(const u32x2*)(PROJ + (size_t)(r0 + t) * NINP + C_OM + h * 256 + e); } }
    bf16x8 va[4];
#pragma unroll
    for (int ks = 0; ks < 4; ++ks) { const int o = tr_off(PK, 16 * ks + 8 * hi, 32 * eb, lane); va[ks] = mk8(tr_rd(lds + MC_V + o), tr_rd(lds + MC_V + o + 4 * PK)); }
    f32x16 hv[2];
#pragma unroll
    for (int tt = 0; tt < 2; ++tt) { f32x16 acc = {};
        if (tt < ntt) { const int t = 32 * tt + i32;
#pragma unroll
            for (int kk = 0; kk < 16; ++kk) { const bf16x8 b = *(LAS const bf16x8*)(lds + MC_Q + t * PQ + (16 * kk + 8 * hi) * 2);
                acc = __builtin_amdgcn_mfma_f32_32x32x16_bf16(ca[kk], b, acc, 0, 0, 0); }
            const float wi = winter[t];
#pragma unroll
            for (int r = 0; r < 16; ++r) acc[r] *= wi;
#pragma unroll
            for (int ks = 0; ks < 4; ++ks) if (ks < 2 * (tt + 1)) { const bf16x8 b = *(LAS const bf16x8*)(lds + MC_S + t * PS + (16 * ks + 8 * hi) * 2);
                acc = __builtin_amdgcn_mfma_f32_32x32x16_bf16(va[ks], b, acc, 0, 0, 0); }
            const float den = wi * nq[t] + denp[t] + denp[64 + t]; const float inv = 1.f / fmaxf(fabsf(den), eden[t]); float sq = 0.f;
#pragma unroll
            for (int r = 0; r < 16; ++r) { acc[r] *= inv; sq += acc[r] * acc[r]; }
            sq = xhalf_sum(sq); if (hi == 0) ssq[wave * 64 + t] = sq; }
        hv[tt] = acc; }
    __syncthreads();
    bf16* MIX = (bf16*)(ws + WS_MIX);
#pragma unroll
    for (int tt = 0; tt < 2; ++tt) if (tt < ntt) { const int t = 32 * tt + i32;
        if (t < L) { float tot = 0.f;
#pragma unroll
            for (int w = 0; w < 8; ++w) tot += ssq[w * 64 + t];
            const float rstd = 1.f / sqrtf(tot * (1.f / 256.f) + EPS); const size_t row = (size_t)(r0 + t);
#pragma unroll
            for (int g4 = 0; g4 < 4; ++g4) { const int e = 32 * eb + 8 * g4 + 4 * hi; const f32x4 g = gmp[g4];
                const u32x2 ov = ovp[tt][g4];
                const float o0 = sigmoid_f(__uint_as_float(ov.x << 16)), o1 = sigmoid_f(__uint_as_float(ov.x & 0xffff0000u)), o2 = sigmoid_f(__uint_as_float(ov.y << 16)), o3 = sigmoid_f(__uint_as_float(ov.y & 0xffff0000u));
                u32x2 w; w.x = pk2(hv[tt][4 * g4] * rstd * g[0] * o0, hv[tt][4 * g4 + 1] * rstd * g[1] * o1); w.y = pk2(hv[tt][4 * g4 + 2] * rstd * g[2] * o2, hv[tt][4 * g4 + 3] * rstd * g[3] * o3);
                *(u32x2*)(MIX + row * DM + 1024 + h * 256 + e) = w; } } }
    __syncthreads();
}
constexpr int AT_PKT = 272, AT_PVT = 320, AT_V = 17408, AT_BUF = 37888;
struct AttnState { f32x16 o[4]; bf16x8 pf[4]; float m, l; };
__device__ __forceinline__ float xhalf_max(float v) { auto rr = __builtin_amdgcn_permlane32_swap(__float_as_uint(v), __float_as_uint(v), false, false); return fmaxf(__uint_as_float(rr[0]), __uint_as_float(rr[1])); }
constexpr float ATT_THR = 6.0f;
__device__ __forceinline__ void attn_qk(LAS const unsigned char* kt, int map, const bf16x8 (&qf)[4], const AttnState& S, f32x16 (&p)[2], int lane) {
    const int i32 = lane & 31, hi = lane >> 5;
#pragma unroll
    for (int kb = 0; kb < 2; ++kb) { f32x16 acc = {};
#pragma unroll
        for (int d0 = 0; d0 < 4; ++d0) { const bf16x8 a = *(LAS const bf16x8*)(kt + (32 * kb + i32) * AT_PKT + (64 * map + 16 * d0 + 8 * hi) * 2);
            acc = __builtin_amdgcn_mfma_f32_32x32x16_bf16(a, qf[d0], acc, 0, 0, 0); }
        p[kb] = acc; }
}
__device__ __forceinline__ void attn_pv(LAS const unsigned char* vt, AttnState& S, int lane) {
    const int hi = lane >> 5;
    LAS const unsigned char* base = vt + tr_off(AT_PVT, 4 * hi, 0, lane);
#pragma unroll
    for (int st = 0; st < 4; ++st) { s16x4 lo[4], hh[4];
#pragma unroll
        for (int eb = 0; eb < 4; ++eb) { lo[eb] = tr_rd(base + st * 16 * AT_PVT + eb * 64); hh[eb] = tr_rd(base + st * 16 * AT_PVT + eb * 64 + 8 * AT_PVT); }
#pragma unroll
        for (int eb = 0; eb < 4; ++eb) S.o[eb] = __builtin_amdgcn_mfma_f32_32x32x16_bf16(mk8(lo[eb], hh[eb]), S.pf[st], S.o[eb], 0, 0, 0);
    }
}
__device__ __forceinline__ void attn_softmax(f32x16 (&p)[2], AttnState& S, int nvalid, int lane) {
    const int hi = lane >> 5;
    if (nvalid < 64) {
#pragma unroll
        for (int kb = 0; kb < 2; ++kb)
#pragma unroll
            for (int r = 0; r < 16; ++r) if (32 * kb + crow(r, hi) >= nvalid) p[kb][r] = -INFINITY; }
    float ma = fmaxf(fmaxf(p[0][0], p[0][1]), p[1][0]), mb = fmaxf(fmaxf(p[0][2], p[0][3]), p[1][1]);
    ma = fmaxf(fmaxf(ma, p[1][2]), p[1][3]);
#pragma unroll
    for (int r = 4; r < 16; r += 4) { ma = fmaxf(fmaxf(ma, p[0][r]), p[0][r + 1]); mb = fmaxf(fmaxf(mb, p[0][r + 2]), p[0][r + 3]); ma = fmaxf(fmaxf(ma, p[1][r]), p[1][r + 1]); mb = fmaxf(fmaxf(mb, p[1][r + 2]), p[1][r + 3]); }
    const float mref = S.m; const float mx = xhalf_max(fmaxf(ma, mb)) - mref;
#pragma unroll
    for (int kb = 0; kb < 2; ++kb)
#pragma unroll
        for (int r = 0; r < 16; ++r) p[kb][r] = __builtin_amdgcn_exp2f(p[kb][r] - mref);
    if (__any(mx > ATT_THR)) {
        const float dl = fmaxf(mx, 0.f); S.m += dl;
        const float f = __builtin_amdgcn_exp2f(-dl); S.l *= f;
#pragma unroll
        for (int kb = 0; kb < 2; ++kb)
#pragma unroll
            for (int r = 0; r < 16; ++r) p[kb][r] *= f;
#pragma unroll
        for (int eb = 0; eb < 4; ++eb)
#pragma unroll
            for (int r = 0; r < 16; ++r) S.o[eb][r] *= f;
    }
    float sa = 0.f, sb = 0.f;
#pragma unroll
    for (int kb = 0; kb < 2; ++kb)
#pragma unroll
        for (int r = 0; r < 16; r += 2) { sa += p[kb][r]; sb += p[kb][r + 1]; }
    S.l += sa + sb;
#pragma unroll
    for (int kb = 0; kb < 2; ++kb)
#pragma unroll
        for (int ks = 0; ks < 2; ++ks) { u32x4 pw; pw.x = pk2(p[kb][8 * ks], p[kb][8 * ks + 1]); pw.y = pk2(p[kb][8 * ks + 2], p[kb][8 * ks + 3]); pw.z = pk2(p[kb][8 * ks + 4], p[kb][8 * ks + 5]); pw.w = pk2(p[kb][8 * ks + 6], p[kb][8 * ks + 7]);
            S.pf[2 * kb + ks] = __builtin_bit_cast(bf16x8, pw); }
}
__device__ __forceinline__ void attn_step(LAS const unsigned char* ktn, LAS const unsigned char* vtc, int map, const bf16x8 (&qf)[4], AttnState& S, int lane) {
    const int i32 = lane & 31, hi = lane >> 5;
    f32x16 p[2];
    LAS const unsigned char* base = vtc + tr_off(AT_PVT, 4 * hi, 0, lane);
    s16x4 lo[2][4], hh[2][4];
#pragma unroll
    for (int eb = 0; eb < 4; ++eb) { lo[0][eb] = tr_rd(base + eb * 64); hh[0][eb] = tr_rd(base + eb * 64 + 8 * AT_PVT); }
#pragma unroll
    for (int kb = 0; kb < 2; ++kb) { f32x16 acc = {};
#pragma unroll
        for (int d0 = 0; d0 < 4; ++d0) { const bf16x8 a = *(LAS const bf16x8*)(ktn + (32 * kb + i32) * AT_PKT + (64 * map + 16 * d0 + 8 * hi) * 2);
            acc = __builtin_amdgcn_mfma_f32_32x32x16_bf16(a, qf[d0], acc, 0, 0, 0); }
        p[kb] = acc; }
    const float mref = S.m;
    __builtin_amdgcn_sched_barrier(0);
#pragma unroll
    for (int st = 0; st < 4; ++st) {
        if (st < 3) {
#pragma unroll
            for (int eb = 0; eb < 4; ++eb) { lo[(st + 1) & 1][eb] = tr_rd(base + (st + 1) * 16 * AT_PVT + eb * 64); hh[(st + 1) & 1][eb] = tr_rd(base + (st + 1) * 16 * AT_PVT + eb * 64 + 8 * AT_PVT); } }
        __builtin_amdgcn_sched_barrier(0);
#pragma unroll
        for (int eb = 0; eb < 4; ++eb) {
            S.o[eb] = __builtin_amdgcn_mfma_f32_32x32x16_bf16(mk8(lo[st & 1][eb], hh[st & 1][eb]), S.pf[st], S.o[eb], 0, 0, 0);
            const int e0 = 2 * (4 * st + eb);
            p[e0 >> 4][e0 & 15] = __builtin_amdgcn_exp2f(p[e0 >> 4][e0 & 15] - mref); p[e0 >> 4][(e0 & 15) + 1] = __builtin_amdgcn_exp2f(p[e0 >> 4][(e0 & 15) + 1] - mref);
            __builtin_amdgcn_sched_barrier(0);
        }
    }
    float ma = fmaxf(fmaxf(p[0][0], p[0][1]), p[1][0]), mb = fmaxf(fmaxf(p[0][2], p[0][3]), p[1][1]);
    ma = fmaxf(fmaxf(ma, p[1][2]), p[1][3]);
#pragma unroll
    for (int r = 4; r < 16; r += 4) { ma = fmaxf(fmaxf(ma, p[0][r]), p[0][r + 1]); mb = fmaxf(fmaxf(mb, p[0][r + 2]), p[0][r + 3]); ma = fmaxf(fmaxf(ma, p[1][r]), p[1][r + 1]); mb = fmaxf(fmaxf(mb, p[1][r + 2]), p[1][r + 3]); }
    const float emx = xhalf_max(fmaxf(ma, mb));
    if (__any(emx > 64.0f)) {
        const float dl = fmaxf(__builtin_amdgcn_logf(emx), 0.f);
        S.m += dl;
        const float f = __builtin_amdgcn_exp2f(-dl); S.l *= f;
#pragma unroll
        for (int kb = 0; kb < 2; ++kb)
#pragma unroll
            for (int r = 0; r < 16; ++r) p[kb][r] *= f;
#pragma unroll
        for (int eb = 0; eb < 4; ++eb)
#pragma unroll
            for (int r = 0; r < 16; ++r) S.o[eb][r] *= f;
    }
    float sa = 0.f, sb = 0.f;
#pragma unroll
    for (int kb = 0; kb < 2; ++kb)
#pragma unroll
        for (int r = 0; r < 16; r += 2) { sa += p[kb][r]; sb += p[kb][r + 1]; }
    S.l += sa + sb;
#pragma unroll
    for (int kb = 0; kb < 2; ++kb)
#pragma unroll
        for (int ks = 0; ks < 2; ++ks) { u32x4 pw; pw.x = pk2(p[kb][8 * ks], p[kb][8 * ks + 1]); pw.y = pk2(p[kb][8 * ks + 2], p[kb][8 * ks + 3]); pw.z = pk2(p[kb][8 * ks + 4], p[kb][8 * ks + 5]); pw.w = pk2(p[kb][8 * ks + 6], p[kb][8 * ks + 7]);
            S.pf[2 * kb + ks] = __builtin_bit_cast(bf16x8, pw); }
}
__device__ __forceinline__ void attn_tile(LAS const unsigned char* kt, LAS const unsigned char* vt, int map, const bf16x8 (&qf)[4], AttnState& S, int nvalid, int lane) {
    f32x16 p[2]; attn_qk(kt, map, qf, S, p, lane); attn_softmax(p, S, nvalid, lane); attn_pv(vt, S, lane);
}
__device__ __forceinline__ void attn_finish(ArgsP A, LAS unsigned char* lds, AttnState& S, int map, int g, int h, size_t row_base, int nrows, float lam, int lane) {
    const int i32 = lane & 31, hi = lane >> 5;
    const float lt = xhalf_sum(S.l); const float inv = 1.f / lt;
    LAS float* X = (LAS float*)lds + g * 4096;
    __syncthreads();
    if (map == 1) {
#pragma unroll
        for (int eb = 0; eb < 4; ++eb)
#pragma unroll
            for (int r = 0; r < 16; ++r) X[(32 * eb + crow(r, hi)) * 32 + i32] = S.o[eb][r] * inv; }
    __syncthreads();
    if (map == 0) { float sq = 0.f;
#pragma unroll
        for (int eb = 0; eb < 4; ++eb)
#pragma unroll
            for (int r = 0; r < 16; ++r) { const float v = S.o[eb][r] * inv - lam * X[(32 * eb + crow(r, hi)) * 32 + i32]; S.o[eb][r] = v; sq += v * v; }
        sq = xhalf_sum(sq);
        const float rstd = (1.f - LAM_INIT) / sqrtf(sq * (1.f / 128.f) + EPS);
        if (i32 < nrows) { bf16* mp = (bf16*)(A->ws + WS_MIX) + (row_base + i32) * DM + h * 128; const float* gs = A->in[18] + h * 128;
#pragma unroll
            for (int eb = 0; eb < 4; ++eb)
#pragma unroll
                for (int g4 = 0; g4 < 4; ++g4) { const int e = 32 * eb + 8 * g4 + 4 * hi; const f32x4 gv = *(const f32x4*)(gs + e);
                    u32x2 w; w.x = pk2(S.o[eb][4 * g4] * rstd * gv[0], S.o[eb][4 * g4 + 1] * rstd * gv[1]); w.y = pk2(S.o[eb][4 * g4 + 2] * rstd * gv[2], S.o[eb][4 * g4 + 3] * rstd * gv[3]);
                    *(u32x2*)(mp + e) = w; } } }
    __syncthreads();
}
__device__ __forceinline__ void attn_prompt_unit(ArgsP A, LAS unsigned char* lds, int h, int qb, float lam, int tid, int wave, int lane) {
    unsigned char* ws = A->ws; const bf16* QA = (const bf16*)(ws + WS_QA); const bf16* KA = (const bf16*)(ws + WS_KA); const bf16* PROJ = (const bf16*)(ws + WS_PROJ);
    const int map = wave & 1, g = wave >> 1, i32 = lane & 31, hi = lane >> 5;
    const int ntiles = 2 * qb + 2, mytiles = 2 * qb + (g >> 1) + 1;
    bf16x8 qf[4];
    { const bf16* qp = QA + (size_t)(128 * qb + 32 * g + i32) * 1024 + h * 128 + 64 * map + 8 * hi;
#pragma unroll
      for (int d0 = 0; d0 < 4; ++d0) qf[d0] = *(const bf16x8*)(qp + 16 * d0); }
    AttnState S; S.m = 0.f; S.l = 0.f;
#pragma unroll
    for (int i = 0; i < 4; ++i) S.pf[i] = (bf16x8){0, 0, 0, 0, 0, 0, 0, 0};
#pragma unroll
    for (int eb = 0; eb < 4; ++eb) S.o[eb] = (f32x16){};
    const int key = tid >> 3, seg = tid & 7;
    const bf16* kp = KA + (size_t)key * 1024 + h * 128 + 16 * seg; const bf16* vp = PROJ + (size_t)key * NINP + C_VA + h * 128 + 16 * seg;
    const int ko = key * AT_PKT + seg * 32, vo = AT_V + key * AT_PVT + seg * 32;
    { u32x4 k0 = *(const u32x4*)kp, k1 = *(const u32x4*)(kp + 8), v0 = *(const u32x4*)vp, v1 = *(const u32x4*)(vp + 8);
      const bf16* kq = kp + (size_t)64 * 1024; const bf16* vq = vp + (size_t)64 * NINP;
      u32x4 k2 = *(const u32x4*)kq, k3 = *(const u32x4*)(kq + 8), v2 = *(const u32x4*)vq, v3 = *(const u32x4*)(vq + 8);
      *(LAS u32x4*)(lds + ko) = k0; *(LAS u32x4*)(lds + ko + 16) = k1; *(LAS u32x4*)(lds + vo) = v0; *(LAS u32x4*)(lds + vo + 16) = v1;
      *(LAS u32x4*)(lds + AT_BUF + ko) = k2; *(LAS u32x4*)(lds + AT_BUF + ko + 16) = k3; *(LAS u32x4*)(lds + AT_BUF + vo) = v2; *(LAS u32x4*)(lds + AT_BUF + vo + 16) = v3; }
    __syncthreads();
    { f32x16 p[2]; attn_qk(lds, map, qf, S, p, lane); attn_softmax(p, S, 64, lane); }
    int bc = 0, bn = AT_BUF, bw = 2 * AT_BUF;
    for (int j = 0; j < ntiles; ++j) {
        const bool more = (j + 2 < ntiles);
        u32x4 k0, k1, v0, v1;
        if (more) { const bf16* kq = kp + (size_t)(j + 2) * 64 * 1024; const bf16* vq = vp + (size_t)(j + 2) * 64 * NINP;
            k0 = *(const u32x4*)kq; k1 = *(const u32x4*)(kq + 8); v0 = *(const u32x4*)vq; v1 = *(const u32x4*)(vq + 8); }
        if (j + 1 < mytiles) attn_step(lds + bn, lds + bc + AT_V, map, qf, S, lane);
        else if (j < mytiles) attn_pv(lds + bc + AT_V, S, lane);
        if (more) { LAS unsigned char* w = lds + bw; *(LAS u32x4*)(w + ko) = k0; *(LAS u32x4*)(w + ko + 16) = k1; *(LAS u32x4*)(w + vo) = v0; *(LAS u32x4*)(w + vo + 16) = v1; }
        __syncthreads();
        const int t = bc; bc = bn; bn = bw; bw = t;
    }
    attn_finish(A, lds, S, map, g, h, (size_t)(128 * qb + 32 * g), 32, lam, lane);
}
__device__ __forceinline__ void attn_sample_unit(ArgsP A, LAS unsigned char* lds, int b, int h, float lam, int tid, int wave, int lane) {
    unsigned char* ws = A->ws; const bf16* QA = (const bf16*)(ws + WS_QA); const bf16* KA = (const bf16*)(ws + WS_KA); const bf16* PROJ = (const bf16*)(ws + WS_PROJ);
    const int map = wave & 1, i32 = lane & 31, hi = lane >> 5; const bool comp = wave < 2;
    bf16x8 qf[4];
#pragma unroll
    for (int d0 = 0; d0 < 4; ++d0) qf[d0] = (bf16x8){0, 0, 0, 0, 0, 0, 0, 0};
    if (i32 < 16) { const bf16* qp = QA + (size_t)(MP + 16 * b + i32) * 1024 + h * 128 + 64 * map + 8 * hi;
#pragma unroll
      for (int d0 = 0; d0 < 4; ++d0) qf[d0] = *(const bf16x8*)(qp + 16 * d0); }
    AttnState S; S.m = 0.f; S.l = 0.f;
#pragma unroll
    for (int i = 0; i < 4; ++i) S.pf[i] = (bf16x8){0, 0, 0, 0, 0, 0, 0, 0};
#pragma unroll
    for (int eb = 0; eb < 4; ++eb) S.o[eb] = (f32x16){};
    const int key = tid >> 3, seg = tid & 7;
    const float* kc = A->in[2] + (((size_t)b * PAST + key) * 8 + h) * 128 + 16 * seg; const float* vc = A->in[3] + (((size_t)b * PAST + key) * 8 + h) * 128 + 16 * seg;
    const int ko = key * AT_PKT + seg * 32, vo = AT_V + key * AT_PVT + seg * 32;
    f32x4 kr[4], vr[4];
#pragma unroll
    for (int i = 0; i < 4; ++i) { kr[i] = *(const f32x4*)(kc + 4 * i); vr[i] = *(const f32x4*)(vc + 4 * i); }
    for (int j = 0; j < 17; ++j) {
        LAS unsigned char* nb = lds + (j & 1) * AT_BUF;
        if (j < 16) { u32x4 a, c;
            a.x = pk2(kr[0][0], kr[0][1]); a.y = pk2(kr[0][2], kr[0][3]); a.z = pk2(kr[1][0], kr[1][1]); a.w = pk2(kr[1][2], kr[1][3]);
            c.x = pk2(kr[2][0], kr[2][1]); c.y = pk2(kr[2][2], kr[2][3]); c.z = pk2(kr[3][0], kr[3][1]); c.w = pk2(kr[3][2], kr[3][3]);
            *(LAS u32x4*)(nb + ko) = a; *(LAS u32x4*)(nb + ko + 16) = c;
            a.x = pk2(vr[0][0], vr[0][1]); a.y = pk2(vr[0][2], vr[0][3]); a.z = pk2(vr[1][0], vr[1][1]); a.w = pk2(vr[1][2], vr[1][3]);
            c.x = pk2(vr[2][0], vr[2][1]); c.y = pk2(vr[2][2], vr[2][3]); c.z = pk2(vr[3][0], vr[3][1]); c.w = pk2(vr[3][2], vr[3][3]);
            *(LAS u32x4*)(nb + vo) = a; *(LAS u32x4*)(nb + vo + 16) = c;
        } else { u32x4 a = {0u, 0u, 0u, 0u}, c = a, d = a, e = a;
            if (key < 16) { const bf16* kq = KA + (size_t)(MP + 16 * b + key) * 1024 + h * 128 + 16 * seg; const bf16* vq = PROJ + (size_t)(MP + 16 * b + key) * NINP + C_VA + h * 128 + 16 * seg;
                a = *(const u32x4*)kq; c = *(const u32x4*)(kq + 8); d = *(const u32x4*)vq; e = *(const u32x4*)(vq + 8); }
            *(LAS u32x4*)(nb + ko) = a; *(LAS u32x4*)(nb + ko + 16) = c; *(LAS u32x4*)(nb + vo) = d; *(LAS u32x4*)(nb + vo + 16) = e; }
        if (j + 1 < 16) {
#pragma unroll
            for (int i = 0; i < 4; ++i) { kr[i] = *(const f32x4*)(kc + (size_t)(j + 1) * 64 * 1024 + 4 * i); vr[i] = *(const f32x4*)(vc + (size_t)(j + 1) * 64 * 1024 + 4 * i); } }
        __syncthreads();
        if (comp) attn_tile(nb, nb + AT_V, map, qf, S, (j < 16) ? 64 : 16, lane);
    }
    attn_finish(A, lds, S, comp ? map : 2, 0, h, (size_t)(MP + 16 * b), 16, lam, lane);
}
template <int NPART> __device__ __forceinline__ void final_norm_rows(float* y, const float* __restrict__ g, int wave, int lane, const float* x1S, const bf16* part, const float* gate) {
    const int gw = blockIdx.x * NW + wave, NGW = gridDim.x * NW;
    for (int r = MP + gw; r < MTOK; r += NGW) { float* yr = y + (size_t)r * DM; f32x4 v[8]; float s = 0.f;
        if (r < MP) {
#pragma unroll
            for (int j = 0; j < 8; ++j) v[j] = *(const f32x4*)(yr + 256 * j + 4 * lane);
        } else {
            const float* gr = gate + (size_t)(1 + ((r - MP) >> 4)) * 12288;
#pragma unroll
            for (int j = 0; j < 8; ++j) { const int c = 256 * j + 4 * lane; f32x4 a = {0.f, 0.f, 0.f, 0.f};
                f32x4 t[NPART];
#pragma unroll
                for (int p = 0; p < NPART; ++p) t[p] = ld_bf4(part + ((size_t)p * MS + (r - MP)) * DM + c);
#pragma unroll
                for (int p = 0; p < NPART; ++p) a += t[p];
                v[j] = *(const f32x4*)(x1S + (size_t)(r - MP) * DM + c) + *(const f32x4*)(gr + c) * a; } }
#pragma unroll
        for (int j = 0; j < 8; ++j) s += (v[j].x * v[j].x + v[j].y * v[j].y) + (v[j].z * v[j].z + v[j].w * v[j].w);
        const float rstd = 1.f / sqrtf(wave_sum(s, lane) * (1.f / DM) + EPS);
#pragma unroll
        for (int j = 0; j < 8; ++j) { const f32x4 gg = *(const f32x4*)(g + 256 * j + 4 * lane); *(f32x4*)(yr + 256 * j + 4 * lane) = v[j] * rstd * gg; } }
}
__global__ void __launch_bounds__(NT, 2) fwd_megakernel(Args A_) {
    extern __shared__ __attribute__((aligned(16))) unsigned char lds_raw[];
    LAS unsigned char* lds = (LAS unsigned char*)lds_raw;
    cg::grid_group grid = cg::this_grid();
    int tid, lane, wave;
#define FRESH_TID() do { tid = threadIdx.x; asm volatile("" : "+v"(tid)); lane = tid & 63; wave = __builtin_amdgcn_readfirstlane(tid >> 6); } while (0)
    FRESH_TID();
    ArgsP A = FRESH_ARGS();
    unsigned char* ws = A->ws;
    float* mod = (float*)(ws + WS_MOD);
    const int G = gridDim.x, bid = blockIdx.x;
    A = FRESH_ARGS(); ws = A->ws; mod = (float*)(ws + WS_MOD); FRESH_TID();
    if (tid < 2) ((volatile LAS unsigned*)(lds + LDS_BYTES - 16))[tid] = 0u;
    __syncthreads();
    XcdBarrier xb = xcd_barrier_post((unsigned*)(ws + WS_FLAG) + 1024, (volatile LAS unsigned*)(lds + LDS_BYTES - 16));
    if (ws == nullptr) grid.sync();
#ifndef NO_P0
    p0_prologue(A, lds, tid, wave, lane);
#endif
    xcd_barrier(xb);
    A = FRESH_ARGS(); ws = A->ws; mod = (float*)(ws + WS_MOD); FRESH_TID();
    norm_mod_rows<0>(A->in[0], A->in[1], A->in[12], mod, 0, 2048, (bf16*)(ws + WS_XN), wave, lane);
    xcd_barrier(xb);
    A = FRESH_ARGS(); ws = A->ws; mod = (float*)(ws + WS_MOD); FRESH_TID();
    { pg8::Gemm g{(const pg8::bf16_t*)(ws + WS_XN), (const pg8::bf16_t*)(ws + WS_WIN), MTOK, NINP, DM, DM}; pg8::StaticOrder S; S.init(MTOK, NINP, G, bid);
      pg8::EpiProj E{(pg8::bf16_t*)(ws + WS_PROJ), NINP, (pg8::bf16_t*)(ws + WS_QA), (pg8::bf16_t*)(ws + WS_KA), A->out + O_KP, A->out + O_KS, A->out + O_VP, A->out + O_VS, (const float*)(ws + WS_ROPE), QSCALE};
      pg8::gemm_phase<pg8::EpiProj, pg8::StaticOrder, true, true>(lds, g, S, E); }
    xcd_barrier(xb);
    A = FRESH_ARGS(); ws = A->ws; mod = (float*)(ws + WS_MOD); FRESH_TID();
#ifndef NO_P3
    p3_post(A, tid);
#endif
#ifndef NO_PA
    for (int i = bid; i < NCH * 4; i += G) mlstm_phaseA(A, lds, i >> 2, i & 3, tid, wave, lane);
#endif
    xcd_barrier(xb);
    A = FRESH_ARGS(); ws = A->ws; mod = (float*)(ws + WS_MOD); FRESH_TID();
#ifndef NO_PB
    mlstm_phaseB(A, lds, tid, wave, lane);
#endif
    xcd_barrier(xb);
    A = FRESH_ARGS(); ws = A->ws; mod = (float*)(ws + WS_MOD); FRESH_TID();
    { const float s1 = wave_sum(A->in[14][lane] * A->in[15][lane], lane), s2 = wave_sum(A->in[16][lane] * A->in[17][lane], lane);
      const float lam = __expf(s1) - __expf(s2) + LAM_INIT;
      for (int i = bid; i < 256; i += G) { const int h = i & 7, p = i >> 3; const int rot = (p & 1) ? 0 : 3;
          for (int sl = 0; sl < 6; ++sl) { int kk = sl + rot; if (kk >= 6) kk -= 6;
              FRESH_TID();
              if (kk < 2) attn_prompt_unit(A, lds, h, kk == 0 ? 63 - p : p, lam, tid, wave, lane);
              else if (kk == 2) attn_sample_unit(A, lds, i >> 3, i & 7, lam, tid, wave, lane);
              else { const int cu = i + 256 * (kk - 3); if (cu < NCH * 4) mlstm_phaseC(A, lds, cu >> 2, cu & 3, tid, wave, lane); } } }
    }
    xcd_barrier(xb);
    A = FRESH_ARGS(); ws = A->ws; mod = (float*)(ws + WS_MOD); FRESH_TID();
    { pg8::Gemm g{(const pg8::bf16_t*)(ws + WS_MIX), (const pg8::bf16_t*)(ws + WS_WOUT), MP, DM, DM, DM}; pg8::StaticOrder S; S.init(MP, DM, G, bid);
      pg8::EpiResid E{A->in[0], A->in[1], mod + 4096, (float*)(ws + WS_X1)};
      pg8::gemm_phase<pg8::EpiResid, pg8::StaticOrder, true, true>(lds, g, S, E); }
    for (int un = bid; un < 128; un += G) { const int tile = un >> 3, kc = un & 7;
      pg8::Gemm g{(const pg8::bf16_t*)(ws + WS_MIX) + 256 * kc, (const pg8::bf16_t*)(ws + WS_WOUT) + 256 * kc, MTOK, DM, 256, DM}; pg8::OneUnit S{{32 + (tile >> 3), tile & 7}};
      pg8::EpiPart E{(pg8::bf16_t*)(ws + WS_PART6) + (size_t)kc * MS * DM, DM};
      pg8::gemm_phase<pg8::EpiPart, pg8::OneUnit, false, true>(lds, g, S, E); }
    xcd_barrier(xb);
    A = FRESH_ARGS(); ws = A->ws; mod = (float*)(ws + WS_MOD); FRESH_TID();
    norm_mod_rows<8>((const float*)(ws + WS_X1), A->in[1], A->in[25], mod, 6144, 8192, (bf16*)(ws + WS_XN), wave, lane, (const bf16*)(ws + WS_PART6), 4096, (float*)(ws + WS_X1) + (size_t)MP * DM);
    xcd_barrier(xb);
    A = FRESH_ARGS(); ws = A->ws; mod = (float*)(ws + WS_MOD); FRESH_TID();
    { pg8::Gemm g{(const pg8::bf16_t*)(ws + WS_XN), (const pg8::bf16_t*)(ws + WS_WUP), MP, DFF, DM, DM}; pg8::StaticOrder S; S.init(MP, DFF, G, bid);
      pg8::EpiStore<2> E{(pg8::bf16_t*)(ws + WS_H), DFF};
      pg8::gemm_phase<pg8::EpiStore<2>, pg8::StaticOrder, true, true>(lds, g, S, E); }
    for (int un = bid; un < 256; un += G) { const int tile = un >> 2, kq = un & 3;
      pg8::Gemm g{(const pg8::bf16_t*)(ws + WS_XN) + 512 * kq, (const pg8::bf16_t*)(ws + WS_WUP) + 512 * kq, MTOK, DFF, 512, DM}; pg8::OneUnit S{{32 + (tile >> 5), tile & 31}};
      pg8::EpiPart E{(pg8::bf16_t*)(ws + WS_PART8) + (size_t)kq * MS * DFF, DFF};
      pg8::gemm_phase<pg8::EpiPart, pg8::OneUnit, false, true>(lds, g, S, E); }
    xcd_barrier(xb);
    A = FRESH_ARGS(); ws = A->ws; mod = (float*)(ws + WS_MOD); FRESH_TID();
    { const bf16* P8 = (const bf16*)(ws + WS_PART8); bf16* H = (bf16*)(ws + WS_H);
      for (int r = bid; r < MS; r += G)
          for (int c = 4 * tid; c < DFF; c += 4 * NT) { f32x4 a = ld_bf4(P8 + (size_t)r * DFF + c);
#pragma unroll
              for (int p = 1; p < 4; ++p) a += ld_bf4(P8 + ((size_t)p * MS + r) * DFF + c);
              a.x = fmaxf(a.x, 0.f); a.y = fmaxf(a.y, 0.f); a.z = fmaxf(a.z, 0.f); a.w = fmaxf(a.w, 0.f);
              u32x2 o; o.x = pk2(a.x * a.x, a.y * a.y); o.y = pk2(a.z * a.z, a.w * a.w); *(u32x2*)(H + (size_t)(MP + r) * DFF + c) = o; }
      __threadfence(); __syncthreads();
      if (tid == 0) __hip_atomic_fetch_add((unsigned*)(ws + WS_FLAG), 1u, __ATOMIC_RELEASE, __HIP_MEMORY_SCOPE_AGENT); }
    { if (tid == 0) { while (__hip_atomic_load((unsigned*)(ws + WS_FLAG), __ATOMIC_ACQUIRE, __HIP_MEMORY_SCOPE_AGENT) < (unsigned)G) __builtin_amdgcn_s_sleep(8); }
      __syncthreads(); __builtin_amdgcn_fence(__ATOMIC_ACQUIRE, "agent"); }
    for (int un = bid; un < 256; un += G) { const int tile = un >> 4, kc = un & 15;
      pg8::Gemm g{(const pg8::bf16_t*)(ws + WS_H) + 512 * kc, (const pg8::bf16_t*)(ws + WS_WDN) + 512 * kc, MTOK, DM, 512, DFF}; pg8::OneUnit S{{32 + (tile >> 3), tile & 7}};
      pg8::EpiPart E{(pg8::bf16_t*)(ws + WS_PART9) + (size_t)kc * MS * DM, DM};
      pg8::gemm_phase<pg8::EpiPart, pg8::OneUnit, false, true>(lds, g, S, E); }
    { pg8::Gemm g{(const pg8::bf16_t*)(ws + WS_H), (const pg8::bf16_t*)(ws + WS_WDN), MP, DM, DFF, DFF}; pg8::StaticOrder S; S.init(MP, DM, G, bid);
      EpiResidNorm E{(const float*)(ws + WS_X1), mod + 10240, A->in[28], A->out, (float*)(ws + WS_SCAL) + 16384, xb};
      pg8::gemm_phase<EpiResidNorm, pg8::StaticOrder, true, true>(lds, g, S, E); }
    A = FRESH_ARGS(); ws = A->ws; mod = (float*)(ws + WS_MOD); FRESH_TID();
    final_norm_rows<16>(A->out, A->in[28], wave, lane, (const float*)(ws + WS_X1) + (size_t)MP * DM, (const bf16*)(ws + WS_PART9), mod + 10240);
}

extern "C" void kernel_launch(void* const* d_in, const int* in_sizes, int n_in, void* d_out, int out_size, void* d_ws, size_t ws_size, hipStream_t stream) {
    static int grid = 0;
    if (grid == 0) {
        if (n_in != 29 || ws_size < WS_END) { fprintf(stderr, "kernel_launch: unexpected n_in %d / ws %zu\n", n_in, ws_size); grid = -1; return; }
        int dev = 0, cus = 0, per_cu = 0;
        (void)hipGetDevice(&dev); (void)hipDeviceGetAttribute(&cus, hipDeviceAttributeMultiprocessorCount, dev);
        (void)hipFuncSetAttribute((const void*)fwd_megakernel, hipFuncAttributeMaxDynamicSharedMemorySize, LDS_BYTES);
        (void)hipOccupancyMaxActiveBlocksPerMultiprocessor(&per_cu, (const void*)fwd_megakernel, NT, LDS_BYTES);
        (void)hipGetLastError();
        grid = cus;
    }
    if (grid < 0) return;
    (void)hipMemsetAsync((char*)d_ws + WS_FLAG, 0, 32768, stream);
    Args a{};
    for (int i = 0; i < 29; ++i) a.in[i] = (const float*)d_in[i];
    a.out = (float*)d_out; a.ws = (unsigned char*)d_ws;
    void* args[] = {&a};
    hipError_t e = hipLaunchCooperativeKernel((void*)fwd_megakernel, dim3(grid), dim3(NT), args, LDS_BYTES, stream);
    if (e != hipSuccess) fprintf(stderr, "cooperative launch failed: %s (grid %d)\n", hipGetErrorString(e), grid);
}
```
